# Optimizing an MI355X kernel written in HIP

```python
import math
import jax, jax.numpy as jnp
from jax import lax
import numpy as np

D_MODEL = 1024
BATCH = 32
SEQ = 2048
DEPTH = 2
DEC_BATCH = 16
DEC_SEQ = 32
PAST_LEN = 2048

CHUNK = 64
Q_BLOCK = 128
ROPE_THETA = 10000.0
EPS = 1e-6
DA_HEAD_DIM = 64
DA_V_DIM = 2 * DA_HEAD_DIM
DA_HEADS = D_MODEL // DA_V_DIM
V_HEAD_DIM = 128
MLA_HEADS = D_MODEL // V_HEAD_DIM
NOPE_DIM = 128
ROPE_DIM = 64
Q_LORA = 384
KV_LORA = 256
MLA_SCALE = (NOPE_DIM + ROPE_DIM) ** -0.5
D_FF = 2816
CONV_W = 3
DA_Q_COLS = DA_HEADS * 2 * DA_HEAD_DIM
DA_K_COLS = DA_HEADS * 2 * DA_HEAD_DIM
DA_V_COLS = DA_HEADS * DA_V_DIM
GATE_COLS = 2 * D_MODEL
IN_COLS = DA_Q_COLS + DA_K_COLS + DA_V_COLS + Q_LORA + KV_LORA + ROPE_DIM + GATE_COLS

kernel_name = "diffattn_mla_convffn_streaming_step"


def rmsnorm(x, g):
    xf = x.astype(jnp.float32)
    y = xf * lax.rsqrt(jnp.mean(xf * xf, axis=-1, keepdims=True) + EPS)
    return (y * g.astype(jnp.float32)).astype(x.dtype)


def rope(x, pos):
    half = x.shape[-1] // 2
    inv = jnp.power(ROPE_THETA, -jnp.arange(half, dtype=jnp.float32) / half)
    ang = pos.astype(jnp.float32)[:, None] * inv[None, :]
    ang = ang.reshape((ang.shape[0],) + (1,) * (x.ndim - 3) + (half,))
    cos, sin = jnp.cos(ang), jnp.sin(ang)
    xf = x.astype(jnp.float32)
    x1, x2 = xf[..., :half], xf[..., half:]
    return jnp.concatenate([x1 * cos - x2 * sin, x2 * cos + x1 * sin], axis=-1).astype(x.dtype)


def chunk_mask(q_pos, k_pos):
    return (k_pos[None, :] // CHUNK) <= (q_pos[:, None] // CHUNK)


def masked_softmax(s, mask):
    return jax.nn.softmax(jnp.where(mask, s, -1e30), axis=-1)


def query_blocks(fn, qs, q_pos):
    S = q_pos.shape[0]
    if S <= Q_BLOCK or S % Q_BLOCK:
        return fn(qs, q_pos)
    nb = S // Q_BLOCK
    B = qs[0].shape[0]
    qs_b = tuple(jnp.moveaxis(q.reshape((B, nb, Q_BLOCK) + q.shape[2:]), 1, 0) for q in qs)
    out = lax.map(lambda a: fn(a[0], a[1]), (qs_b, q_pos.reshape(nb, Q_BLOCK)))
    out = jnp.moveaxis(out, 0, 1)
    return out.reshape((B, S) + out.shape[3:])


def diff_attention(q, q_pos, k, v, k_pos, lam):
    d = DA_HEAD_DIM
    scale = d ** -0.5
    mask = chunk_mask(q_pos, k_pos)
    s1 = jnp.einsum('bshd,bthd->bhst', q[..., :d], k[..., :d]).astype(jnp.float32) * scale
    s2 = jnp.einsum('bshd,bthd->bhst', q[..., d:], k[..., d:]).astype(jnp.float32) * scale
    a = (masked_softmax(s1, mask) - lam * masked_softmax(s2, mask)).astype(v.dtype)
    return jnp.einsum('bhst,bthv->bshv', a, v)


def latent_attention(q_lat, q_rope, q_pos, c_kv, k_rope, k_pos):
    mask = chunk_mask(q_pos, k_pos)
    s = (jnp.einsum('bshc,btc->bhst', q_lat, c_kv).astype(jnp.float32)
         + jnp.einsum('bshr,btr->bhst', q_rope, k_rope).astype(jnp.float32)) * MLA_SCALE
    p = masked_softmax(s, mask).astype(c_kv.dtype)
    return jnp.einsum('bhst,btc->bshc', p, c_kv)


def trunk_layer(x, past, lidx, w):
    (g_attn, w_in, b_gate, lam_q1, lam_k1, lam_q2, lam_k2, g_da_head, g_cq, w_uq, g_ckv,
     w_uk, w_uv, w_o, g_ffn, w_up, w_conv, b_conv, w_down) = w
    B, S, _ = x.shape
    past_len = 0 if past is None else past[0].shape[1]
    q_pos = past_len + jnp.arange(S, dtype=jnp.int32)
    k_pos = jnp.arange(past_len + S, dtype=jnp.int32)

    h = rmsnorm(x, g_attn)
    z = h @ w_in
    o1 = DA_Q_COLS
    o2 = o1 + DA_K_COLS
    o3 = o2 + DA_V_COLS
    o4 = o3 + Q_LORA
    o5 = o4 + KV_LORA
    o6 = o5 + ROPE_DIM
    q_da = rope(z[..., :o1].reshape(B, S, DA_HEADS, 2, DA_HEAD_DIM), q_pos).reshape(B, S, DA_HEADS, 2 * DA_HEAD_DIM)
    k_da = rope(z[..., o1:o2].reshape(B, S, DA_HEADS, 2, DA_HEAD_DIM), q_pos).reshape(B, S, DA_HEADS, 2 * DA_HEAD_DIM)
    v_da = z[..., o2:o3].reshape(B, S, DA_HEADS, DA_V_DIM)
    c_q = rmsnorm(z[..., o3:o4], g_cq)
    c_kv = rmsnorm(z[..., o4:o5], g_ckv)
    k_rope = rope(z[..., o5:o6], q_pos)
    gates = jax.nn.sigmoid(z[..., o6:] + b_gate)

    if past is None:
        k_all, v_all, ckv_all, kr_all = k_da, v_da, c_kv, k_rope
        prev_conv = jnp.zeros((B, CONV_W - 1, 2 * D_FF), x.dtype)
    else:
        k_all = jnp.concatenate([past[0], k_da], axis=1)
        v_all = jnp.concatenate([past[1], v_da], axis=1)
        ckv_all = jnp.concatenate([past[2], c_kv], axis=1)
        kr_all = jnp.concatenate([past[3], k_rope], axis=1)
        prev_conv = past[4]

    f32 = jnp.float32
    lam_init = 0.8 - 0.6 * math.exp(-0.3 * lidx)
    lam = (jnp.exp(jnp.sum(lam_q1.astype(f32) * lam_k1.astype(f32)))
           - jnp.exp(jnp.sum(lam_q2.astype(f32) * lam_k2.astype(f32))) + lam_init)
    o_da = query_blocks(lambda qs, qp: diff_attention(qs[0], qp, k_all, v_all, k_pos, lam), (q_da,), q_pos)
    o_da = (rmsnorm(o_da, g_da_head) * (1.0 - lam_init)).reshape(B, S, D_MODEL)

    q = jnp.einsum('bsc,chn->bshn', c_q, w_uq)
    q_rope = rope(q[..., NOPE_DIM:], q_pos)
    q_lat = jnp.einsum('bshn,hcn->bshc', q[..., :NOPE_DIM], w_uk)
    o_lat = query_blocks(lambda qs, qp: latent_attention(qs[0], qs[1], qp, ckv_all, kr_all, k_pos), (q_lat, q_rope), q_pos)
    o_mla = jnp.einsum('bshc,hcv->bshv', o_lat, w_uv).reshape(B, S, D_MODEL)

    x = x + (gates[..., :D_MODEL] * o_da + gates[..., D_MODEL:] * o_mla) @ w_o

    u = rmsnorm(x, g_ffn) @ w_up
    padded = jnp.concatenate([prev_conv, u], axis=1)
    c = b_conv + w_conv[0] * padded[:, 0:S]
    for j in range(1, CONV_W):
        c = c + w_conv[j] * padded[:, j:j + S]
    x = x + (jax.nn.silu(c[..., :D_FF]) * c[..., D_FF:]) @ w_down
    return x, (k_da, v_da, c_kv, k_rope, padded[:, S:])


def setup_inputs(seed: int = 0) -> dict:
    key = jax.random.key(seed)
    ks = iter(jax.random.split(key, 40))
    f32 = jnp.float32

    def nrm(shape, scale):
        return jax.random.normal(next(ks), shape, f32) * scale

    def gain(shape):
        return 1.0 + 0.01 * jax.random.normal(next(ks), shape, f32)

    L = DEPTH
    return {
        "x_prompt": nrm((BATCH, SEQ, D_MODEL), 1.0),
        "x_sample": nrm((DEC_BATCH, DEC_SEQ, D_MODEL), 1.0),
        "cache_dk": nrm((L, DEC_BATCH, PAST_LEN, DA_HEADS, 2 * DA_HEAD_DIM), 1.0),
        "cache_dv": nrm((L, DEC_BATCH, PAST_LEN, DA_HEADS, DA_V_DIM), 1.0),
        "cache_ckv": nrm((L, DEC_BATCH, PAST_LEN, KV_LORA), 1.0),
        "cache_krope": nrm((L, DEC_BATCH, PAST_LEN, ROPE_DIM), 1.0),
        "state_conv": nrm((L, DEC_BATCH, CONV_W - 1, 2 * D_FF), 1.0),
        "g_attn": gain((L, D_MODEL)),
        "w_in": nrm((L, D_MODEL, IN_COLS), D_MODEL ** -0.5),
        "b_gate": nrm((L, GATE_COLS), 0.01),
        "lam_q1": nrm((L, DA_HEAD_DIM), 0.1),
        "lam_k1": nrm((L, DA_HEAD_DIM), 0.1),
        "lam_q2": nrm((L, DA_HEAD_DIM), 0.1),
        "lam_k2": nrm((L, DA_HEAD_DIM), 0.1),
        "g_da_head": gain((L, DA_V_DIM)),
        "g_cq": gain((L, Q_LORA)),
        "w_uq": nrm((L, Q_LORA, MLA_HEADS, NOPE_DIM + ROPE_DIM), Q_LORA ** -0.5),
        "g_ckv": gain((L, KV_LORA)),
        "w_uk": nrm((L, MLA_HEADS, KV_LORA, NOPE_DIM), KV_LORA ** -0.5),
        "w_uv": nrm((L, MLA_HEADS, KV_LORA, V_HEAD_DIM), KV_LORA ** -0.5),
        "w_o": nrm((L, D_MODEL, D_MODEL), D_MODEL ** -0.5),
        "g_ffn": gain((L, D_MODEL)),
        "w_up": nrm((L, D_MODEL, 2 * D_FF), D_MODEL ** -0.5),
        "w_conv": nrm((L, CONV_W, 2 * D_FF), CONV_W ** -0.5),
        "b_conv": nrm((L, 2 * D_FF), 0.01),
        "w_down": nrm((L, D_FF, D_MODEL), D_FF ** -0.5),
        "g_final": gain((D_MODEL,)),
    }


def reference(x_prompt, x_sample, cache_dk, cache_dv, cache_ckv, cache_krope, state_conv,
              g_attn, w_in, b_gate, lam_q1, lam_k1, lam_q2, lam_k2, g_da_head, g_cq, w_uq,
              g_ckv, w_uk, w_uv, w_o, g_ffn, w_up, w_conv, b_conv, w_down, g_final):
    weights = (g_attn, w_in, b_gate, lam_q1, lam_k1, lam_q2, lam_k2, g_da_head, g_cq, w_uq,
               g_ckv, w_uk, w_uv, w_o, g_ffn, w_up, w_conv, b_conv, w_down)
    yp, ys = x_prompt, x_sample
    st_p, st_s = [], []
    for l in range(DEPTH):
        w = tuple(a[l] for a in weights)
        yp, sp = trunk_layer(yp, None, l, w)
        past = (cache_dk[l], cache_dv[l], cache_ckv[l], cache_krope[l], state_conv[l])
        ys, ss = trunk_layer(ys, past, l, w)
        st_p.append(sp)
        st_s.append(ss)
    y_prompt = rmsnorm(yp, g_final)
    y_sample = rmsnorm(ys, g_final)
    new_dk_p = jnp.stack([s[0] for s in st_p])
    new_dv_p = jnp.stack([s[1] for s in st_p])
    new_ckv_p = jnp.stack([s[2] for s in st_p])
    new_kr_p = jnp.stack([s[3] for s in st_p])
    new_conv_p = jnp.stack([s[4] for s in st_p])
    new_dk_s = jnp.stack([s[0] for s in st_s])
    new_dv_s = jnp.stack([s[1] for s in st_s])
    new_ckv_s = jnp.stack([s[2] for s in st_s])
    new_kr_s = jnp.stack([s[3] for s in st_s])
    new_conv_s = jnp.stack([s[4] for s in st_s])
    return (y_prompt, y_sample, new_dk_p, new_dv_p, new_ckv_p, new_kr_p, new_conv_p,
            new_dk_s, new_dv_s, new_ckv_s, new_kr_s, new_conv_s)
```

```cpp
#include <hip/hip_runtime.h>
#include <hip/hip_cooperative_groups.h>
#include <cstdio>
#include <cstdint>
namespace cg = cooperative_groups;
#define LANE_ID() ({ int l_ = (int)__builtin_amdgcn_mbcnt_hi(~0u, __builtin_amdgcn_mbcnt_lo(~0u, 0u)); asm volatile("" : "+v"(l_)); l_; })
namespace pg8 {
#define PG8_LAS __attribute__((address_space(3)))
typedef unsigned short bf16_t;
typedef short bf16x8 __attribute__((ext_vector_type(8)));
typedef float f32x4 __attribute__((ext_vector_type(4)));
typedef unsigned u32x4 __attribute__((ext_vector_type(4)));
constexpr int BM = 256, BK = 64, HALF = 128, HTB = HALF * BK * 2  , STAGE_BYTES = 8 * HTB, NXCD = 8, WGM = 8;

__host__ __device__ __forceinline__ int lds_byte(int r, int c) { const int st = (r >> 4) * 2 + (c >> 5), rr = r & 15, cc = c & 31, ob = rr * 64 + cc * 2; return st * 1024 + (ob ^ (((ob >> 9) & 1) << 5)); }
__host__ __device__ __forceinline__ void stage_rc(int b, int& R, int& C) { const int st = b / 1024, sb = b % 1024, swz = sb ^ (((sb >> 9) & 1) << 5); R = (st >> 1) * 16 + swz / 64; C = (st & 1) * 32 + (swz % 64) / 2; }
__host__ __device__ __forceinline__ int perm32(int rho) { const int n = rho >> 4, i = rho & 15; return 8 * (i >> 2) + 4 * n + (i & 3); }

struct Unit { int pm, pn; };
struct Gemm { const bf16_t* A; const bf16_t* Bt; int M, N, K; };

struct StaticOrder {
    int nM, nN, nwg, G, c;
    __host__ __device__ void init(int M, int N, int G_, int c_) { nM = M / BM; nN = N / BM; nwg = nM * nN; G = G_; c = c_; }
    __host__ __device__ bool next(int i, Unit& u) const {
        const long L = (long)i * G + c; if (L >= nwg) return false;
        int wgid = (int)L; { const int q = nwg / NXCD, r = nwg % NXCD, xcd = wgid % NXCD, off = wgid / NXCD; wgid = (xcd < r ? xcd * (q + 1) : r * (q + 1) + (xcd - r) * q) + off; }
        const int nig = WGM * nN, gid = wgid / nig, fm = gid * WGM, gsz = (nM - fm) < WGM ? (nM - fm) : WGM;
        u.pm = fm + ((wgid % nig) % gsz); u.pn = (wgid % nig) / gsz; return true;
    }
    __device__ __forceinline__ void a_ready(const Unit&) const {}
    __device__ __forceinline__ void done(const Unit&) const {}
};

typedef float f32x2_cv __attribute__((ext_vector_type(2))); typedef __bf16 bf16x2_cv __attribute__((ext_vector_type(2)));
__device__ __forceinline__ unsigned cvt_pk_bf16(float lo, float hi) { f32x2_cv v = {lo, hi}; bf16x2_cv b = __builtin_convertvector(v, bf16x2_cv); return __builtin_bit_cast(unsigned, b); }
template <class Epi, class Sched, bool ALIGN_EPI = false, bool SP2 = false>
__device__ __forceinline__ void gemm_phase(PG8_LAS unsigned char* lds, const Gemm g, const Sched& S, const Epi& E, const int wid_in) {
    const int wid = wid_in, lane = LANE_ID(), tid = (wid << 6) | lane, wr = wid >> 2, wc = wid & 3, fr = lane & 15, fq = lane >> 4;
    const int K = g.K, nt = K / BK;
    unsigned voffA[2], voffB[2];
#pragma unroll
    for (int i = 0; i < 2; ++i) { int R, C; stage_rc(tid * 16 + i * 8192, R, C); const int Rb = Epi::PERM ? ((R & ~31) + perm32(R & 31)) : R;
        voffA[i] = (unsigned)(R * K + C) * 2u; voffB[i] = (unsigned)(Rb * K + C) * 2u; }
    const size_t kstep = (size_t)(BK * 2);
    const size_t hstep = (size_t)HALF * K * 2;
    const size_t tstep = 2 * hstep;
    const unsigned ldsw = (unsigned)wid * 1024u;
    const int aoff = lds_byte(wr * 64 + fr, fq * 8), boff = lds_byte(wc * 32 + fr, fq * 8);
#define PG8_SA(b, h) (((b) * 2 + (h)) * HTB)
#define PG8_SB(b, h) ((4 + (b) * 2 + (h)) * HTB)
#define PG8_STAGE(bufoff, gbase, voff) do { _Pragma("unroll") for (int _i = 0; _i < 2; ++_i) \
        __builtin_amdgcn_global_load_lds((const unsigned*)((const char*)(gbase) + (voff)[_i]), (PG8_LAS unsigned*)(lds + (bufoff) + ldsw + _i * 8192), 16, 0, 0); } while (0)
#define PG8_LDA(dst, b, h) do { _Pragma("unroll") for (int m = 0; m < 4; ++m) _Pragma("unroll") for (int k = 0; k < 2; ++k) dst[m][k] = *(const PG8_LAS bf16x8*)(lds + PG8_SA(b, h) + aoff + m * 2048 + k * 1024); } while (0)
#define PG8_LDB(dst, b, h) do { _Pragma("unroll") for (int n = 0; n < 2; ++n) _Pragma("unroll") for (int k = 0; k < 2; ++k) dst[n][k] = *(const PG8_LAS bf16x8*)(lds + PG8_SB(b, h) + boff + n * 2048 + k * 1024); } while (0)
#define PG8_MMA(ai, bj, At, Bt) do { __builtin_amdgcn_s_setprio(1); _Pragma("unroll") for (int m = 0; m < 4; ++m) _Pragma("unroll") for (int n = 0; n < 2; ++n) _Pragma("unroll") for (int k = 0; k < 2; ++k) \
        acc[ai][bj][m][n] = __builtin_amdgcn_mfma_f32_16x16x32_bf16(Bt[n][k], At[m][k], acc[ai][bj][m][n], 0, 0, 0); __builtin_amdgcn_s_setprio(0); } while (0)
#define PG8_WAIT_V(n) asm volatile("s_waitcnt vmcnt(" #n ")" ::: "memory")
#define PG8_WAIT_L(n) asm volatile("s_waitcnt lgkmcnt(" #n ")" ::: "memory")
#define PG8_BAR __builtin_amdgcn_s_barrier()
#define PG8_SCHED __builtin_amdgcn_sched_barrier(0)
    Unit cur, nxt; int ui = 0;
    if (!S.next(0, cur)) return;
    f32x4 acc[2][2][4][2];
#pragma unroll
    for (int a = 0; a < 2; ++a)
#pragma unroll
        for (int b = 0; b < 2; ++b)
#pragma unroll
            for (int m = 0; m < 4; ++m)
#pragma unroll
                for (int n = 0; n < 2; ++n) acc[a][b][m][n] = (f32x4){0.f, 0.f, 0.f, 0.f};
    bf16x8 At[4][2], B0[2][2], B1[2][2];
    const char* cA = (const char*)g.A + (size_t)cur.pm * tstep; const char* cB = (const char*)g.Bt + (size_t)cur.pn * tstep;
    S.a_ready(cur);
    if constexpr (SP2) {
        PG8_STAGE(PG8_SB(0, 0), cB, voffB); PG8_STAGE(PG8_SB(0, 1), cB + hstep, voffB); PG8_STAGE(PG8_SA(0, 0), cA, voffA); PG8_STAGE(PG8_SA(0, 1), cA + hstep, voffA);
        if (wr == 1) PG8_BAR;
        PG8_WAIT_V(2); PG8_BAR;
        PG8_STAGE(PG8_SB(1, 0), cB + kstep, voffB); PG8_STAGE(PG8_SA(1, 0), cA + kstep, voffA); PG8_STAGE(PG8_SB(1, 1), cB + hstep + kstep, voffB);
        PG8_WAIT_V(6); PG8_BAR;
    } else {
        PG8_STAGE(PG8_SB(0, 0), cB, voffB); PG8_STAGE(PG8_SA(0, 0), cA, voffA); PG8_STAGE(PG8_SB(0, 1), cB + hstep, voffB); PG8_STAGE(PG8_SA(0, 1), cA + hstep, voffA);
        if (wr == 1) PG8_BAR;
        PG8_WAIT_V(4); PG8_BAR;
        PG8_STAGE(PG8_SB(1, 0), cB + kstep, voffB); PG8_STAGE(PG8_SA(1, 0), cA + kstep, voffA); PG8_STAGE(PG8_SB(1, 1), cB + hstep + kstep, voffB);
        PG8_WAIT_V(6); PG8_BAR;
    }
    for (;;) {
        const bool has_next = S.next(ui + 1, nxt);
        const char* nA = has_next ? (const char*)g.A + (size_t)nxt.pm * tstep : cA; const char* nB = has_next ? (const char*)g.Bt + (size_t)nxt.pn * tstep : cB;
        for (int t = 0; t < nt; t += 2) {
            const bool last = (t == nt - 2);
            const char* a1 = cA + (size_t)(t + 1) * kstep;
            const char* a2 = last ? nA : cA + (size_t)(t + 2) * kstep; const char* b2 = last ? nB : cB + (size_t)(t + 2) * kstep;
            const char* a3 = a2 + kstep; const char* b3 = b2 + kstep;
            if (last && has_next) S.a_ready(nxt);
            if constexpr (SP2) {
            PG8_LDB(B0, 0, 0); PG8_LDB(B1, 0, 1); PG8_SCHED; PG8_LDA(At, 0, 0); PG8_STAGE(PG8_SA(1, 1), a1 + hstep, voffA);
            PG8_WAIT_V(8); PG8_WAIT_L(0); PG8_BAR; PG8_MMA(0, 0, At, B0); PG8_MMA(0, 1, At, B1); PG8_BAR; PG8_SCHED;
            PG8_LDA(At, 0, 1); PG8_STAGE(PG8_SB(0, 0), b2, voffB); PG8_STAGE(PG8_SB(0, 1), b2 + hstep, voffB); PG8_STAGE(PG8_SA(0, 0), a2, voffA);
            PG8_WAIT_V(8); PG8_WAIT_L(0); PG8_BAR; PG8_MMA(1, 0, At, B0); PG8_MMA(1, 1, At, B1); PG8_BAR; PG8_SCHED;
            PG8_LDB(B0, 1, 0); PG8_LDB(B1, 1, 1); PG8_SCHED; PG8_LDA(At, 1, 0); PG8_STAGE(PG8_SA(0, 1), a2 + hstep, voffA);
            PG8_WAIT_V(8); PG8_WAIT_L(0); PG8_BAR; PG8_MMA(0, 0, At, B0); PG8_MMA(0, 1, At, B1); PG8_BAR; PG8_SCHED;
            PG8_LDA(At, 1, 1); PG8_STAGE(PG8_SB(1, 0), b3, voffB); PG8_STAGE(PG8_SB(1, 1), b3 + hstep, voffB); PG8_STAGE(PG8_SA(1, 0), a3, voffA);
            PG8_WAIT_V(8); PG8_WAIT_L(0); PG8_BAR; PG8_MMA(1, 0, At, B0); PG8_MMA(1, 1, At, B1); PG8_BAR; PG8_SCHED;
            } else {
            PG8_LDB(B0, 0, 0); PG8_SCHED; PG8_LDA(At, 0, 0); PG8_STAGE(PG8_SA(1, 1), a1 + hstep, voffA);
            PG8_WAIT_L(8); PG8_BAR; PG8_WAIT_L(0); PG8_MMA(0, 0, At, B0); PG8_BAR; PG8_SCHED;
            PG8_LDB(B1, 0, 1); PG8_STAGE(PG8_SB(0, 0), b2, voffB);
            PG8_BAR; PG8_WAIT_L(0); PG8_MMA(0, 1, At, B1); PG8_BAR;
            PG8_LDA(At, 0, 1); PG8_STAGE(PG8_SA(0, 0), a2, voffA);
            PG8_BAR; PG8_WAIT_L(0); PG8_MMA(1, 0, At, B0); PG8_BAR; PG8_SCHED;
            PG8_STAGE(PG8_SB(0, 1), b2 + hstep, voffB);
            PG8_WAIT_V(6); PG8_BAR; PG8_MMA(1, 1, At, B1); PG8_BAR;
            PG8_LDB(B0, 1, 0); PG8_SCHED; PG8_LDA(At, 1, 0); PG8_STAGE(PG8_SA(0, 1), a2 + hstep, voffA);
            PG8_WAIT_L(8); PG8_BAR; PG8_WAIT_L(0); PG8_MMA(0, 0, At, B0); PG8_BAR; PG8_SCHED;
            PG8_LDB(B1, 1, 1); PG8_STAGE(PG8_SB(1, 0), b3, voffB);
            PG8_BAR; PG8_WAIT_L(0); PG8_MMA(0, 1, At, B1); PG8_BAR;
            PG8_LDA(At, 1, 1); PG8_STAGE(PG8_SA(1, 0), a3, voffA);
            PG8_BAR; PG8_WAIT_L(0); PG8_MMA(1, 0, At, B0); PG8_BAR; PG8_SCHED;
            PG8_STAGE(PG8_SB(1, 1), b3 + hstep, voffB);
            PG8_WAIT_V(6); PG8_BAR; PG8_MMA(1, 1, At, B1); PG8_BAR;
            }
        }
        if constexpr (ALIGN_EPI) { if (wr == 0) PG8_BAR; }
        if constexpr (!Epi::AFTER_DRAIN) { E(acc, cur, wr, wc, fr, fq); S.done(cur); }
        if (!has_next) break;
#pragma unroll
        for (int a = 0; a < 2; ++a)
#pragma unroll
            for (int b = 0; b < 2; ++b)
#pragma unroll
                for (int m = 0; m < 4; ++m)
#pragma unroll
                    for (int n = 0; n < 2; ++n) acc[a][b][m][n] = (f32x4){0.f, 0.f, 0.f, 0.f};
        cur = nxt; cA = nA; cB = nB; ++ui;
        if constexpr (ALIGN_EPI) { if (wr == 1) PG8_BAR; }
    }
    PG8_WAIT_V(0);
    if constexpr (!ALIGN_EPI) { if (wr == 0) PG8_BAR; }
    PG8_BAR;
    if constexpr (Epi::AFTER_DRAIN) { E.fused(acc, cur, wr, wc, fr, fq, lds, wid, lane); S.done(cur); }
#undef PG8_SA
#undef PG8_SB
#undef PG8_STAGE
#undef PG8_LDA
#undef PG8_LDB
#undef PG8_MMA
#undef PG8_WAIT_V
#undef PG8_WAIT_L
#undef PG8_BAR
#undef PG8_SCHED
}
}
#define PG8_SP2 true
#define PG8_ALIGN true
using pg8::bf16_t; using pg8::bf16x8; using pg8::f32x4; using pg8::Unit; using pg8::cvt_pk_bf16;
#define LAS __attribute__((address_space(3)))
typedef float f32x16 __attribute__((ext_vector_type(16)));
typedef unsigned u32x2 __attribute__((ext_vector_type(2)));
typedef unsigned u32x4 __attribute__((ext_vector_type(4)));
typedef short v4i16_t __attribute__((ext_vector_type(4)));

constexpr int MP = 65536, MSMP = 512, MT = MP + MSMP, MC = 32768;
constexpr int INC = 5824, NIN = 5888, QL = 384, KVL = 256, NQ = 1536, NKV = 2048, DFF = 2816, NUP = 5632;
constexpr float EPS = 1e-6f, LOG2E = 1.4426950408889634f;
constexpr float QS_DA = 0.125f * LOG2E;
constexpr float QS_MLA = 0.07216878364870322f * LOG2E;
constexpr size_t O_DKP = (size_t)MT * 1024;
constexpr size_t O_DVP = O_DKP + 2 * (size_t)MP * 1024;
constexpr size_t O_CKVP = O_DVP + 2 * (size_t)MP * 1024;
constexpr size_t O_KRP = O_CKVP + 2 * (size_t)MP * 256;
constexpr size_t O_CVP = O_KRP + 2 * (size_t)MP * 64;
constexpr size_t O_DKS = O_CVP + 2 * 32 * 2 * 5632;
constexpr size_t O_DVS = O_DKS + 2 * 512 * 1024;
constexpr size_t O_CKVS = O_DVS + 2 * 512 * 1024;
constexpr size_t O_KRS = O_CKVS + 2 * 512 * 256;
constexpr size_t O_CVS = O_KRS + 2 * 512 * 64;
constexpr size_t O_END = O_CVS + 2 * 16 * 2 * 5632;
constexpr size_t A256(size_t x) { return (x + 255) & ~(size_t)255; }
constexpr size_t W_CTL = 0;
constexpr size_t W_ROPE = 4096;
constexpr size_t W_SS = A256(W_ROPE + (size_t)2080 * 64 * 4);
constexpr size_t W_WIN = A256(W_SS + (size_t)9 * MT * 4);
constexpr size_t W_WQ = A256(W_WIN + (size_t)2 * NIN * 1024 * 2);
constexpr size_t W_WKV = A256(W_WQ + (size_t)2 * NQ * QL * 2);
constexpr size_t W_WKVC = A256(W_WKV + (size_t)2 * NKV * KVL * 2);
constexpr size_t W_WO = A256(W_WKVC + (size_t)2 * NKV * KVL * 2);
constexpr size_t W_WUP = A256(W_WO + (size_t)2 * 1024 * 1024 * 2);
constexpr size_t W_WDN = A256(W_WUP + (size_t)2 * NUP * 1024 * 2);
constexpr size_t W_HX = A256(W_WDN + (size_t)2 * 1024 * DFF * 2);
constexpr size_t W_X = A256(W_HX + (size_t)MT * 1024 * 2);
constexpr size_t W_QDA = A256(W_X + (size_t)MT * 1024 * 4);
constexpr size_t W_KDA = A256(W_QDA + (size_t)MT * 1024 * 2);
constexpr size_t W_VDA = A256(W_KDA + (size_t)MT * 1024 * 2);
constexpr size_t W_G = A256(W_VDA + (size_t)MT * 1024 * 2);
constexpr size_t W_CKV = A256(W_G + (size_t)MT * 2048 * 2);
constexpr size_t W_CQ = A256(W_CKV + (size_t)MT * 256 * 2);
constexpr size_t W_KR = A256(W_CQ + (size_t)MT * 384 * 2);
constexpr size_t W_QM = A256(W_KR + (size_t)MT * 64 * 2);
constexpr size_t W_KN = A256(W_QM + (size_t)MT * 1536 * 2);
constexpr size_t W_VM = A256(W_KN + (size_t)MT * 1024 * 2);
constexpr size_t W_MRG = A256(W_VM + (size_t)MT * 1024 * 2);
constexpr size_t W_U = A256(W_MRG + (size_t)MT * 1024 * 2);
constexpr size_t W_ACT = A256(W_U + (size_t)MT * NUP * 2);
constexpr size_t W_KC = A256(W_ACT + (size_t)MT * DFF * 2);
constexpr size_t W_VC = A256(W_KC + (size_t)2 * MC * 1024 * 2);
constexpr size_t W_KRC = A256(W_VC + (size_t)2 * MC * 1024 * 2);
constexpr size_t W_CKVC = A256(W_KRC + (size_t)2 * MC * 64 * 2);
constexpr size_t W_KNC = A256(W_CKVC + (size_t)2 * MC * 256 * 2);
constexpr size_t W_VMC = A256(W_KNC + (size_t)2 * MC * 1024 * 2);
constexpr size_t W_END = A256(W_VMC + (size_t)2 * MC * 1024 * 2);

struct Params { const float* in[27]; float* out; unsigned char* ws; };

__device__ __forceinline__ void st_bf16x4(bf16_t* p, f32x4 v) { u32x2 w; w.x = cvt_pk_bf16(v[0], v[1]); w.y = cvt_pk_bf16(v[2], v[3]); *(u32x2*)p = w; }
__device__ __forceinline__ float fast_rcp(float x) { return __builtin_amdgcn_rcpf(x); }
__device__ __forceinline__ float fast_exp2(float x) { return __builtin_amdgcn_exp2f(x); }
__device__ __forceinline__ float sigmoidf_(float x) { return fast_rcp(1.f + fast_exp2(-x * LOG2E)); }
__device__ __forceinline__ float bf2f(unsigned short b) { return __uint_as_float((unsigned)b << 16); }
__device__ __forceinline__ int row_of(const Unit& u, int ai, int wr, int m, int fr) { return u.pm * 256 + ai * 128 + wr * 64 + m * 16 + fr; }
__device__ __forceinline__ float sq4(f32x4 v) { return (v[0] * v[0] + v[1] * v[1]) + (v[2] * v[2] + v[3] * v[3]); }

__device__ __forceinline__ float add_x16(float s) { return s + __int_as_float(__builtin_amdgcn_ds_swizzle(__float_as_int(s), 0x401F)); }
__device__ __forceinline__ float add_x32(float s) { auto rr = __builtin_amdgcn_permlane32_swap(__float_as_uint(s), __float_as_uint(s), false, false); return __uint_as_float(rr[0]) + __uint_as_float(rr[1]); }
__device__ __forceinline__ float max_x32(float s) { auto rr = __builtin_amdgcn_permlane32_swap(__float_as_uint(s), __float_as_uint(s), false, false); return fmaxf(__uint_as_float(rr[0]), __uint_as_float(rr[1])); }
struct EpiInProj {
    static constexpr bool PERM = false, AFTER_DRAIN = false;
    unsigned char* ws; float* out; const float* bgate; int l;
    __device__ __forceinline__ void operator()(const f32x4 (&acc)[2][2][4][2], const Unit& u, int wr, int wc, int fr, int fq) const {
        const int pn = u.pn;
        const float* SSb = (const float*)(ws + W_SS); const float* ssx = SSb + (size_t)(2 * l) * MT; const float* rope = (const float*)(ws + W_ROPE);
        float* sscq = (float*)(ws + W_SS) + (size_t)(5 + l) * MT; float* ssckv = (float*)(ws + W_SS) + (size_t)(7 + l) * MT;
        bf16_t* QDA = (bf16_t*)(ws + W_QDA); bf16_t* KDA = (bf16_t*)(ws + W_KDA); bf16_t* VDA = (bf16_t*)(ws + W_VDA); bf16_t* G = (bf16_t*)(ws + W_G);
        bf16_t* CKV = (bf16_t*)(ws + W_CKV); bf16_t* CQ = (bf16_t*)(ws + W_CQ); bf16_t* KR = (bf16_t*)(ws + W_KR);
        float* dkp = out + O_DKP + (size_t)l * MP * 1024; float* dks = out + O_DKS + (size_t)l * MSMP * 1024; float* dvp = out + O_DVP + (size_t)l * MP * 1024; float* dvs = out + O_DVS + (size_t)l * MSMP * 1024;
        float* ckp = out + O_CKVP + (size_t)l * MP * 256; float* cks = out + O_CKVS + (size_t)l * MSMP * 256; float* krp = out + O_KRP + (size_t)l * MP * 64; float* krs = out + O_KRS + (size_t)l * MSMP * 64;
        if (pn < 8) {
            const bool isk = pn >= 4; const int cb = 256 * (pn & 3) + 64 * wc;
#pragma unroll
            for (int ai = 0; ai < 2; ++ai)
#pragma unroll
                for (int m = 0; m < 4; ++m) { asm volatile("" ::: "memory");
                    const int row = row_of(u, ai, wr, m, fr); const float rstd = rsqrtf(ssx[row] * (1.f / 1024.f) + EPS);
                    const bool samp = row >= MP; const int orow = samp ? row - MP : row; const int pos = samp ? 2048 + (orow & 31) : (row & 2047);
                    const float* rt = rope + (size_t)pos * 64;
#pragma unroll
                    for (int n = 0; n < 2; ++n) {
                        const int i0 = 16 * n + 4 * fq; const f32x4 cs = *(const f32x4*)(rt + i0), sn = *(const f32x4*)(rt + 32 + i0);
                        const f32x4 x1 = acc[ai][0][m][n] * rstd, x2 = acc[ai][1][m][n] * rstd;
                        f32x4 o1 = x1 * cs - x2 * sn, o2 = x2 * cs + x1 * sn;
                        if (!isk) { o1 = o1 * QS_DA; o2 = o2 * QS_DA; bf16_t* q = QDA + (size_t)row * 1024 + cb + i0; st_bf16x4(q, o1); st_bf16x4(q + 32, o2); }
                        else { bf16_t* k = KDA + (size_t)row * 1024 + cb + i0; st_bf16x4(k, o1); st_bf16x4(k + 32, o2);
                               float* d = (samp ? dks : dkp) + (size_t)orow * 1024 + cb + i0; *(f32x4*)d = o1; *(f32x4*)(d + 32) = o2; }
                    }
                }
        } else if (pn < 12) {
            const int cb = 256 * (pn - 8) + 32 * wc + 4 * fq;
#pragma unroll
            for (int ai = 0; ai < 2; ++ai)
#pragma unroll
                for (int m = 0; m < 4; ++m) { asm volatile("" ::: "memory");
                    const int row = row_of(u, ai, wr, m, fr); const float rstd = rsqrtf(ssx[row] * (1.f / 1024.f) + EPS);
                    const bool samp = row >= MP; const int orow = samp ? row - MP : row;
                    float* d = (samp ? dvs : dvp) + (size_t)orow * 1024 + cb; bf16_t* v = VDA + (size_t)row * 1024 + cb;
#pragma unroll
                    for (int bj = 0; bj < 2; ++bj)
#pragma unroll
                        for (int n = 0; n < 2; ++n) { const f32x4 x = acc[ai][bj][m][n] * rstd; *(f32x4*)(d + 128 * bj + 16 * n) = x; st_bf16x4(v + 128 * bj + 16 * n, x); }
                }
        } else if (pn < 20) {
            const int cb = 256 * (pn - 12) + 32 * wc + 4 * fq;
            f32x4 bv[2][2];
#pragma unroll
            for (int bj = 0; bj < 2; ++bj)
#pragma unroll
                for (int n = 0; n < 2; ++n) bv[bj][n] = *(const f32x4*)(bgate + cb + 128 * bj + 16 * n);
#pragma unroll
            for (int ai = 0; ai < 2; ++ai)
#pragma unroll
                for (int m = 0; m < 4; ++m) { asm volatile("" ::: "memory");
                    const int row = row_of(u, ai, wr, m, fr); const float rstd = rsqrtf(ssx[row] * (1.f / 1024.f) + EPS);
                    bf16_t* g = G + (size_t)row * 2048 + cb;
#pragma unroll
                    for (int bj = 0; bj < 2; ++bj)
#pragma unroll
                        for (int n = 0; n < 2; ++n) { f32x4 x = acc[ai][bj][m][n] * rstd + bv[bj][n];
                            x[0] = sigmoidf_(x[0]); x[1] = sigmoidf_(x[1]); x[2] = sigmoidf_(x[2]); x[3] = sigmoidf_(x[3]); st_bf16x4(g + 128 * bj + 16 * n, x); }
                }
        } else if (pn == 20) {
            const int cb = 32 * wc + 4 * fq;
#pragma unroll
            for (int ai = 0; ai < 2; ++ai)
#pragma unroll
                for (int m = 0; m < 4; ++m) { asm volatile("" ::: "memory");
                    const int row = row_of(u, ai, wr, m, fr); const float rstd = rsqrtf(ssx[row] * (1.f / 1024.f) + EPS);
                    const bool samp = row >= MP; const int orow = samp ? row - MP : row;
                    float* d = (samp ? cks : ckp) + (size_t)orow * 256 + cb; bf16_t* c = CKV + (size_t)row * 256 + cb; float s = 0.f;
#pragma unroll
                    for (int bj = 0; bj < 2; ++bj)
#pragma unroll
                        for (int n = 0; n < 2; ++n) { const f32x4 x = acc[ai][bj][m][n] * rstd; s += sq4(x); *(f32x4*)(d + 128 * bj + 16 * n) = x; st_bf16x4(c + 128 * bj + 16 * n, x); }
                    s = add_x16(s); s = add_x32(s);
                    if (fq == 0) unsafeAtomicAdd(ssckv + row, s);
                }
        } else if (pn == 21) {
            const int cb = 32 * wc + 4 * fq;
#pragma unroll
            for (int ai = 0; ai < 2; ++ai)
#pragma unroll
                for (int m = 0; m < 4; ++m) { asm volatile("" ::: "memory");
                    const int row = row_of(u, ai, wr, m, fr); const float rstd = rsqrtf(ssx[row] * (1.f / 1024.f) + EPS);
                    bf16_t* c = CQ + (size_t)row * 384 + cb; float s = 0.f;
#pragma unroll
                    for (int bj = 0; bj < 2; ++bj)
#pragma unroll
                        for (int n = 0; n < 2; ++n) { const f32x4 x = acc[ai][bj][m][n] * rstd; s += sq4(x); st_bf16x4(c + 128 * bj + 16 * n, x); }
                    s = add_x16(s); s = add_x32(s);
                    if (fq == 0) unsafeAtomicAdd(sscq + row, s);
                }
        } else {
#pragma unroll
            for (int ai = 0; ai < 2; ++ai)
#pragma unroll
                for (int m = 0; m < 4; ++m) { asm volatile("" ::: "memory");
                    const int row = row_of(u, ai, wr, m, fr); const float rstd = rsqrtf(ssx[row] * (1.f / 1024.f) + EPS);
                    const bool samp = row >= MP; const int orow = samp ? row - MP : row; const int pos = samp ? 2048 + (orow & 31) : (row & 2047);
                    bf16_t* c = CQ + (size_t)row * 384 + 256 + 32 * wc + 4 * fq; float s = 0.f;
#pragma unroll
                    for (int n = 0; n < 2; ++n) { const f32x4 x = acc[ai][0][m][n] * rstd; s += sq4(x); st_bf16x4(c + 16 * n, x); }
                    s = add_x16(s); s = add_x32(s);
                    if (fq == 0) unsafeAtomicAdd(sscq + row, s);
                    if (wc < 2) {
                        const int i0 = 16 * wc + 4 * fq; const float* rt = rope + (size_t)pos * 64;
                        const f32x4 cs = *(const f32x4*)(rt + i0), sn = *(const f32x4*)(rt + 32 + i0);
                        const f32x4 x1 = acc[ai][1][m][0] * rstd, x2 = acc[ai][1][m][1] * rstd;
                        const f32x4 o1 = x1 * cs - x2 * sn, o2 = x2 * cs + x1 * sn;
                        float* d = (samp ? krs : krp) + (size_t)orow * 64 + i0; *(f32x4*)d = o1; *(f32x4*)(d + 32) = o2;
                        bf16_t* k = KR + (size_t)row * 64 + i0; st_bf16x4(k, o1); st_bf16x4(k + 32, o2);
                    }
                }
        }
    }
};

struct EpiQ {
    static constexpr bool PERM = false, AFTER_DRAIN = false;
    const float* sscq; const float* rope; bf16_t* QM;
    __device__ __forceinline__ void operator()(const f32x4 (&acc)[2][2][4][2], const Unit& u, int wr, int wc, int fr, int fq) const {
        const int pn = u.pn;
#pragma unroll
        for (int ai = 0; ai < 2; ++ai)
#pragma unroll
            for (int m = 0; m < 4; ++m) { asm volatile("" ::: "memory");
                const int row = row_of(u, ai, wr, m, fr); const float rs = rsqrtf(sscq[row] * (1.f / 384.f) + EPS) * QS_MLA;
                bf16_t* q = QM + (size_t)row * 1536;
                if (pn < 4) {
#pragma unroll
                    for (int bj = 0; bj < 2; ++bj)
#pragma unroll
                        for (int n = 0; n < 2; ++n) st_bf16x4(q + (2 * pn + bj) * 192 + 32 * wc + 16 * n + 4 * fq, acc[ai][bj][m][n] * rs);
                } else {
                    const int pos = row >= MP ? 2048 + ((row - MP) & 31) : (row & 2047); const float* rt = rope + (size_t)pos * 64;
                    bf16_t* qh = q + (4 * (pn - 4) + wc) * 192 + 128;
#pragma unroll
                    for (int n = 0; n < 2; ++n) {
                        const int i0 = 16 * n + 4 * fq; const f32x4 cs = *(const f32x4*)(rt + i0), sn = *(const f32x4*)(rt + 32 + i0);
                        const f32x4 x1 = acc[ai][0][m][n] * rs, x2 = acc[ai][1][m][n] * rs;
                        st_bf16x4(qh + i0, x1 * cs - x2 * sn); st_bf16x4(qh + 32 + i0, x2 * cs + x1 * sn);
                    }
                }
            }
    }
};

struct EpiKV {
    static constexpr bool PERM = false, AFTER_DRAIN = false;
    const float* ss; bf16_t *O0, *O1;
    __device__ __forceinline__ void operator()(const f32x4 (&acc)[2][2][4][2], const Unit& u, int wr, int wc, int fr, int fq) const {
        bf16_t* base = (u.pn < 4 ? O0 : O1) + 256 * (u.pn & 3) + 32 * wc + 4 * fq;
#pragma unroll
        for (int ai = 0; ai < 2; ++ai)
#pragma unroll
            for (int m = 0; m < 4; ++m) { asm volatile("" ::: "memory");
                const int row = row_of(u, ai, wr, m, fr); const float rs = ss ? rsqrtf(ss[row] * (1.f / 256.f) + EPS) : 1.f;
                bf16_t* o = base + (size_t)row * 1024;
#pragma unroll
                for (int bj = 0; bj < 2; ++bj)
#pragma unroll
                    for (int n = 0; n < 2; ++n) st_bf16x4(o + 128 * bj + 16 * n, acc[ai][bj][m][n] * rs);
            }
    }
};

struct EpiRes {
    static constexpr bool PERM = false, AFTER_DRAIN = false;
    const float* xp; const float* xs;
    float* X; bf16_t* HX; float* ssn;
    __device__ __forceinline__ void operator()(const f32x4 (&acc)[2][2][4][2], const Unit& u, int wr, int wc, int fr, int fq) const {
        const int cb = 256 * u.pn + 32 * wc + 4 * fq;
#pragma unroll
        for (int ai = 0; ai < 2; ++ai)
#pragma unroll
            for (int m = 0; m < 4; ++m) { asm volatile("" ::: "memory");
                const int row = row_of(u, ai, wr, m, fr);
                const float* xi = (row >= MP ? xs + (size_t)(row - MP) * 1024 : xp + (size_t)row * 1024) + cb;
                float* xo = X + (size_t)row * 1024 + cb; bf16_t* h = HX + (size_t)row * 1024 + cb; float s = 0.f;
#pragma unroll
                for (int bj = 0; bj < 2; ++bj)
#pragma unroll
                    for (int n = 0; n < 2; ++n) { const f32x4 x = *(const f32x4*)(xi + 128 * bj + 16 * n) + acc[ai][bj][m][n]; s += sq4(x); *(f32x4*)(xo + 128 * bj + 16 * n) = x; st_bf16x4(h + 128 * bj + 16 * n, x); }
                s = add_x16(s); s = add_x32(s);
                if (fq == 0) unsafeAtomicAdd(ssn + row, s);
            }
    }
};

struct EpiUp {
    static constexpr bool PERM = false, AFTER_DRAIN = false;
    const float* ssx; bf16_t* U; float* cvp; float* cvs;
    __device__ __forceinline__ void operator()(const f32x4 (&acc)[2][2][4][2], const Unit& u, int wr, int wc, int fr, int fq) const {
        const int cb = 128 * u.pn + 32 * wc + 4 * fq;
#pragma unroll
        for (int ai = 0; ai < 2; ++ai)
#pragma unroll
            for (int m = 0; m < 4; ++m) { asm volatile("" ::: "memory");
                const int row = row_of(u, ai, wr, m, fr); const float rstd = rsqrtf(ssx[row] * (1.f / 1024.f) + EPS);
                bf16_t* o = U + (size_t)row * NUP + cb;
                float* cv = nullptr;
                if (row >= MP) { const int r = row - MP, s = r & 31; if (s >= 30) cv = cvs + ((size_t)(r >> 5) * 2 + (s - 30)) * NUP + cb; }
                else { const int s = row & 2047; if (s >= 2046) cv = cvp + ((size_t)(row >> 11) * 2 + (s - 2046)) * NUP + cb; }
#pragma unroll
                for (int bj = 0; bj < 2; ++bj)
#pragma unroll
                    for (int n = 0; n < 2; ++n) { const f32x4 x = acc[ai][bj][m][n] * rstd; st_bf16x4(o + DFF * bj + 16 * n, x); if (cv) *(f32x4*)(cv + DFF * bj + 16 * n) = x; }
            }
    }
};
struct KVD { const bf16_t* k; const bf16_t* k2; const bf16_t* v; int kp, k2p, vp; };
constexpr int ATT_KBUF = 64 * 400, ATT_VOFF = 2 * ATT_KBUF, ATT_VIMG = 32 * 320, ATT_VBUF = 2 * ATT_VIMG;

template <int DQK>
__device__ __forceinline__ void attn_pass(LAS unsigned char* lds, const int wid, const bf16_t* qrow, const KVD& dm, const KVD& dl, int nmain, int ntw, int ntc, f32x16 (&o)[4], float& linv) {
    constexpr int NCH = DQK / 8, KST = DQK * 2 + 16, NKI = NCH / 8, NS = DQK / 16;
    const int lane = LANE_ID(), tid = (wid << 6) | lane, r32 = lane & 31, hi = lane >> 5;
    bf16x8 q[NS];
#pragma unroll
    for (int s = 0; s < NS; ++s) q[s] = *(const bf16x8*)(qrow + 16 * s + 8 * hi);
    u32x4 kr[NKI], vr[2];
#define ATT_GLOADK(t) do { const bool lastt = (t) >= nmain; const KVD& d = lastt ? dl : dm; const int rb = lastt ? 0 : (t) * 64; const int rm = lastt ? 31 : 63; \
        _Pragma("unroll") for (int i = 0; i < NKI; ++i) { const int id = tid + 512 * i, kro = id / NCH, kc = id - kro * NCH; const int r = rb + (kro & rm); \
            kr[i] = (DQK == 64 || kc < 16) ? *(const u32x4*)(d.k + (size_t)r * d.kp + kc * 8) : *(const u32x4*)(d.k2 + (size_t)r * d.k2p + (kc - 16) * 8); } } while (0)
#define ATT_GLOADV(t) do { const bool lastt = (t) >= nmain; const KVD& d = lastt ? dl : dm; const int rb = lastt ? 0 : (t) * 64; const int rm = lastt ? 31 : 63; \
        _Pragma("unroll") for (int i = 0; i < 2; ++i) { const int r = rb + (((tid >> 4) + 32 * i) & rm); vr[i] = *(const u32x4*)(d.v + (size_t)r * d.vp + (tid & 15) * 8); } } while (0)
#define ATT_LSTORE(b) do { \
        _Pragma("unroll") for (int i = 0; i < NKI; ++i) { const int id = tid + 512 * i, kro = id / NCH, kc = id - kro * NCH; *(LAS u32x4*)(lds + (b) * ATT_KBUF + kro * KST + kc * 16) = kr[i]; } \
        _Pragma("unroll") for (int i = 0; i < 2; ++i) *(LAS u32x4*)(lds + ATT_VOFF + (b) * ATT_VBUF + i * ATT_VIMG + (tid >> 4) * 320 + (tid & 15) * 16) = vr[i]; } while (0)
    ATT_GLOADK(0); ATT_GLOADV(0); ATT_LSTORE(0); __syncthreads();
    float m_run = -INFINITY, l_run = 0.f;
#pragma unroll
    for (int c = 0; c < 4; ++c)
#pragma unroll
        for (int r = 0; r < 16; ++r) o[c][r] = 0.f;
    const int vlane = (4 * hi + ((lane & 15) >> 2)) * 320 + (2 * ((lane >> 4) & 1) + ((lane & 3) >> 1)) * 16 + 8 * (lane & 1);
    for (int t = 0; t < ntw; ++t) {
        if (t + 1 < ntw) ATT_GLOADK(t + 1);
        bool vloaded = false;
        if (t < ntc) {
            const LAS unsigned char* kb = lds + (t & 1) * ATT_KBUF + r32 * KST + hi * 16;
            const LAS unsigned char* vb = lds + ATT_VOFF + (t & 1) * ATT_VBUF;
            f32x16 p0, p1;
#pragma unroll
            for (int r = 0; r < 16; ++r) { p0[r] = 0.f; p1[r] = 0.f; }
#pragma unroll
            for (int s = 0; s < NS; ++s) {
                const bf16x8 k0 = *(const LAS bf16x8*)(kb + s * 32), k1 = *(const LAS bf16x8*)(kb + 32 * KST + s * 32);
                p0 = __builtin_amdgcn_mfma_f32_32x32x16_bf16(k0, q[s], p0, 0, 0, 0);
                p1 = __builtin_amdgcn_mfma_f32_32x32x16_bf16(k1, q[s], p1, 0, 0, 0);
            }
            if (t >= nmain) {
#pragma unroll
                for (int r = 0; r < 16; ++r) p1[r] = -INFINITY;
            }
            float mt = fmaxf(p0[0], p1[0]);
#pragma unroll
            for (int r = 1; r < 16; ++r) mt = fmaxf(mt, fmaxf(p0[r], p1[r]));
            mt = max_x32(mt);
            const float mn = fmaxf(m_run, mt), alpha = fast_exp2(m_run - mn); m_run = mn;
            float rs = 0.f;
#pragma unroll
            for (int r = 0; r < 16; ++r) { p0[r] = fast_exp2(p0[r] - mn); p1[r] = fast_exp2(p1[r] - mn); rs += p0[r] + p1[r]; }
            l_run = l_run * alpha + rs;
#pragma unroll
            for (int c = 0; c < 4; ++c)
#pragma unroll
                for (int r = 0; r < 16; ++r) o[c][r] *= alpha;
            asm volatile("" ::: "memory");
            if (t + 1 < ntw) { ATT_GLOADV(t + 1); vloaded = true; }
            bf16x8 pf[2][2];
#pragma unroll
            for (int ks = 0; ks < 2; ++ks) {
                u32x4 a, b;
                a.x = cvt_pk_bf16(p0[8 * ks + 0], p0[8 * ks + 1]); a.y = cvt_pk_bf16(p0[8 * ks + 2], p0[8 * ks + 3]); a.z = cvt_pk_bf16(p0[8 * ks + 4], p0[8 * ks + 5]); a.w = cvt_pk_bf16(p0[8 * ks + 6], p0[8 * ks + 7]);
                b.x = cvt_pk_bf16(p1[8 * ks + 0], p1[8 * ks + 1]); b.y = cvt_pk_bf16(p1[8 * ks + 2], p1[8 * ks + 3]); b.z = cvt_pk_bf16(p1[8 * ks + 4], p1[8 * ks + 5]); b.w = cvt_pk_bf16(p1[8 * ks + 6], p1[8 * ks + 7]);
                pf[0][ks] = __builtin_bit_cast(bf16x8, a); pf[1][ks] = __builtin_bit_cast(bf16x8, b);
            }
#pragma unroll
            for (int c = 0; c < 4; ++c)
#pragma unroll
                for (int kbk = 0; kbk < 2; ++kbk)
#pragma unroll
                    for (int ks = 0; ks < 2; ++ks) {
                        const LAS unsigned char* a0 = vb + vlane + kbk * ATT_VIMG + (16 * ks) * 320 + c * 64;
                        const v4i16_t t0 = __builtin_amdgcn_ds_read_tr16_b64_v4i16((LAS v4i16_t*)a0);
                        const v4i16_t t1 = __builtin_amdgcn_ds_read_tr16_b64_v4i16((LAS v4i16_t*)(a0 + 8 * 320));
                        const bf16x8 vf = (bf16x8){t0[0], t0[1], t0[2], t0[3], t1[0], t1[1], t1[2], t1[3]};
                        o[c] = __builtin_amdgcn_mfma_f32_32x32x16_bf16(vf, pf[kbk][ks], o[c], 0, 0, 0);
                    }
        }
        if (t + 1 < ntw) { if (!vloaded) ATT_GLOADV(t + 1); ATT_LSTORE((t + 1) & 1); }
        __syncthreads();
    }
    const float lt = add_x32(l_run);
    linv = fast_rcp(lt);
#undef ATT_GLOADK
#undef ATT_GLOADV
#undef ATT_LSTORE
}

struct AttnCtx { unsigned char* ws; const float* gda; float lam, lam1m; unsigned* counter; int l; };
constexpr int ATT_NUNITS = 128 + 2048;
__device__ __forceinline__ void attn_phase(LAS unsigned char* lds, const AttnCtx& C, const int wid) {
#define TID_NOW() LANE_ID()
    LAS unsigned* ubox = (LAS unsigned*)(lds + 131072);
    const bf16_t* QDA = (const bf16_t*)(C.ws + W_QDA); const bf16_t* KDA = (const bf16_t*)(C.ws + W_KDA); const bf16_t* VDA = (const bf16_t*)(C.ws + W_VDA);
    const bf16_t* GG = (const bf16_t*)(C.ws + W_G); bf16_t* MRG = (bf16_t*)(C.ws + W_MRG);
    for (;;) {
        if (wid == 0 && TID_NOW() == 0) ubox[0] = atomicAdd(C.counter, 1u);
        __syncthreads();
        const int un = (int)ubox[0];
        __syncthreads();
        if (un >= ATT_NUNITS) break;
        const bool samp = un < 128;
        int b, h, qb = 0;
        if (samp) { b = un >> 3; h = un & 7; } else { const int v = un - 128; qb = 7 - (v >> 8); b = (v & 255) >> 3; h = v & 7; }
        const int row = samp ? MP + b * 32 + (TID_NOW() & 31) : b * 2048 + qb * 256 + wid * 32 + (TID_NOW() & 31);
        const int ntw = samp ? 33 : 4 * qb + 4, nmain = samp ? 32 : ntw, ntc = samp ? (wid == 0 ? 33 : 0) : 4 * qb + (wid >> 1) + 1;
        const size_t kr0 = (size_t)b * 2048;
        const size_t fr0 = (size_t)MP + b * 32;
        const size_t coff = (size_t)C.l * MC;
        f32x16 o[4]; float linv;
#ifndef NO_DIFF
        {
            unsigned o1[32];
#pragma unroll 1
            for (int st = 0; st < 2; ++st) {
                KVD dm, dl;
                const bf16_t* Kb = samp ? (const bf16_t*)(C.ws + W_KC) + coff * 1024 : KDA; const bf16_t* Vb = samp ? (const bf16_t*)(C.ws + W_VC) + coff * 1024 : VDA;
                dm.k = Kb + kr0 * 1024 + h * 128 + st * 64; dm.k2 = dm.k; dm.v = Vb + kr0 * 1024 + h * 128; dm.kp = 1024; dm.k2p = 1024; dm.vp = 1024;
                dl.k = KDA + fr0 * 1024 + h * 128 + st * 64; dl.k2 = dl.k; dl.v = VDA + fr0 * 1024 + h * 128; dl.kp = 1024; dl.k2p = 1024; dl.vp = 1024;
                attn_pass<64>(lds, wid, QDA + (size_t)row * 1024 + h * 128 + st * 64, dm, dl, nmain, ntw, ntc, o, linv);
                if (st == 0) {
#pragma unroll
                    for (int c = 0; c < 4; ++c)
#pragma unroll
                        for (int r = 0; r < 16; r += 2) o1[c * 8 + (r >> 1)] = cvt_pk_bf16(o[c][r] * linv, o[c][r + 1] * linv);
                }
            }
            if (ntc > 0) {
                int rowe = row; asm volatile("" : "+v"(rowe));
                const int hi = (TID_NOW() >> 5) & 1;
                const float ll = C.lam * linv; float ss = 0.f;
#pragma unroll
                for (int c = 0; c < 4; ++c)
#pragma unroll
                    for (int r = 0; r < 16; r += 2) { const unsigned w = o1[c * 8 + (r >> 1)];
                        const float x0 = __uint_as_float(w << 16) - ll * o[c][r], x1 = __uint_as_float(w & 0xffff0000u) - ll * o[c][r + 1]; o[c][r] = x0; o[c][r + 1] = x1; ss += x0 * x0 + x1 * x1; }
                ss = add_x32(ss);
                const float rn = rsqrtf(ss * (1.f / 128.f) + EPS) * C.lam1m;
                const bf16_t* ga = GG + (size_t)rowe * 2048 + h * 128; bf16_t* mo = MRG + (size_t)rowe * 1024 + h * 128;
#pragma unroll
                for (int c = 0; c < 4; ++c)
#pragma unroll
                    for (int g = 0; g < 4; ++g) {
                        const int d0 = 32 * c + 8 * g + 4 * hi;
                        const u32x2 gw = *(const u32x2*)(ga + d0); const f32x4 gd = *(const f32x4*)(C.gda + d0);
                        const float g0 = __uint_as_float(gw.x << 16), g1 = __uint_as_float(gw.x & 0xffff0000u), g2 = __uint_as_float(gw.y << 16), g3 = __uint_as_float(gw.y & 0xffff0000u);
                        f32x4 r; r[0] = o[c][4 * g + 0] * rn * gd[0] * g0; r[1] = o[c][4 * g + 1] * rn * gd[1] * g1; r[2] = o[c][4 * g + 2] * rn * gd[2] * g2; r[3] = o[c][4 * g + 3] * rn * gd[3] * g3;
                        st_bf16x4(mo + d0, r);
                    }
            }
        }
#endif
#ifndef NO_MLA
        {
            KVD dm, dl;
            const bf16_t* KN = (const bf16_t*)(C.ws + W_KN); const bf16_t* VM = (const bf16_t*)(C.ws + W_VM); const bf16_t* KR = (const bf16_t*)(C.ws + W_KR);
            dm.k = (samp ? (const bf16_t*)(C.ws + W_KNC) + coff * 1024 : KN) + kr0 * 1024 + h * 128; dm.k2 = (samp ? (const bf16_t*)(C.ws + W_KRC) + coff * 64 : KR) + kr0 * 64;
            dm.v = (samp ? (const bf16_t*)(C.ws + W_VMC) + coff * 1024 : VM) + kr0 * 1024 + h * 128; dm.kp = 1024; dm.k2p = 64; dm.vp = 1024;
            dl.k = KN + fr0 * 1024 + h * 128; dl.k2 = KR + fr0 * 64; dl.v = VM + fr0 * 1024 + h * 128; dl.kp = 1024; dl.k2p = 64; dl.vp = 1024;
            attn_pass<192>(lds, wid, (const bf16_t*)(C.ws + W_QM) + (size_t)row * 1536 + h * 192, dm, dl, nmain, ntw, ntc, o, linv);
            if (ntc > 0) {
                int rowe = row; asm volatile("" : "+v"(rowe));
                const int hi = (TID_NOW() >> 5) & 1;
                const bf16_t* gb = GG + (size_t)rowe * 2048 + 1024 + h * 128; bf16_t* mo = MRG + (size_t)rowe * 1024 + h * 128;
#pragma unroll
                for (int c = 0; c < 4; ++c)
#pragma unroll
                    for (int g = 0; g < 4; ++g) {
                        const int d0 = 32 * c + 8 * g + 4 * hi;
                        const u32x2 gw = *(const u32x2*)(gb + d0); const u32x2 xw = *(const u32x2*)(mo + d0);
                        const float g0 = __uint_as_float(gw.x << 16), g1 = __uint_as_float(gw.x & 0xffff0000u), g2 = __uint_as_float(gw.y << 16), g3 = __uint_as_float(gw.y & 0xffff0000u);
                        f32x4 r;
                        r[0] = __uint_as_float(xw.x << 16) + g0 * o[c][4 * g + 0] * linv; r[1] = __uint_as_float(xw.x & 0xffff0000u) + g1 * o[c][4 * g + 1] * linv;
                        r[2] = __uint_as_float(xw.y << 16) + g2 * o[c][4 * g + 2] * linv; r[3] = __uint_as_float(xw.y & 0xffff0000u) + g3 * o[c][4 * g + 3] * linv;
                        st_bf16x4(mo + d0, r);
                    }
            }
        }
#endif
    }
}
__device__ __forceinline__ float wave_sum(float v) {
#pragma unroll
    for (int o = 1; o < 64; o <<= 1) v += __shfl_xor(v, o);
    return v;
}
__device__ __forceinline__ unsigned f2bf(float f) { unsigned u = __float_as_uint(f); return (u + 0x7fffu + ((u >> 16) & 1u)) >> 16; }
__device__ __forceinline__ unsigned pk2(float lo, float hi) { return f2bf(lo) | (f2bf(hi) << 16); }
__device__ __forceinline__ int ropemap(int v) { return 64 * ((v >> 5) & 3) + 32 * (v >> 7) + (v & 31); }

__device__ __forceinline__ void prep_weights(const Params& P, LAS unsigned char* lds, int gw, int ngw, int wave, int lane) {
    LAS float* scr = (LAS float*)(lds + wave * 8704);
    constexpr int IT0 = 16 * (NIN / 32), IT1 = 6 * (NQ / 32), IT2 = 4 * (NKV / 32), IT4 = 16 * 32, IT5 = 16 * (NUP / 32), IT6 = 44 * 32;
    constexpr int ITL = IT0 + IT1 + 2 * IT2 + IT4 + IT5 + IT6;
    for (int it = gw; it < 2 * ITL; it += ngw) {
        const int l = it / ITL; int r = it - l * ITL;
        int mat;
        if (r < IT0) mat = 0; else if ((r -= IT0) < IT1) mat = 1; else if ((r -= IT1) < IT2) mat = 2; else if ((r -= IT2) < IT2) mat = 3;
        else if ((r -= IT2) < IT4) mat = 4; else if ((r -= IT4) < IT5) mat = 5; else { r -= IT5; mat = 6; }
        const float* W; const float* gk = nullptr; bf16_t* WT; int K, NN; long stride;
        switch (mat) {
            case 0: W = P.in[8] + (size_t)l * 1024 * INC; gk = P.in[7] + l * 1024; WT = (bf16_t*)(P.ws + W_WIN) + (size_t)l * NIN * 1024; K = 1024; NN = NIN; stride = INC; break;
            case 1: W = P.in[16] + (size_t)l * QL * NQ; gk = P.in[15] + l * QL; WT = (bf16_t*)(P.ws + W_WQ) + (size_t)l * NQ * QL; K = QL; NN = NQ; stride = NQ; break;
            case 2: W = nullptr; gk = P.in[17] + l * KVL; WT = (bf16_t*)(P.ws + W_WKV) + (size_t)l * NKV * KVL; K = KVL; NN = NKV; stride = 128; break;
            case 3: W = nullptr; WT = (bf16_t*)(P.ws + W_WKVC) + (size_t)l * NKV * KVL; K = KVL; NN = NKV; stride = 128; break;
            case 4: W = P.in[20] + (size_t)l * 1024 * 1024; WT = (bf16_t*)(P.ws + W_WO) + (size_t)l * 1024 * 1024; K = 1024; NN = 1024; stride = 1024; break;
            case 5: W = P.in[22] + (size_t)l * 1024 * NUP; gk = P.in[21] + l * 1024; WT = (bf16_t*)(P.ws + W_WUP) + (size_t)l * NUP * 1024; K = 1024; NN = NUP; stride = NUP; break;
            default: W = P.in[25] + (size_t)l * DFF * 1024; WT = (bf16_t*)(P.ws + W_WDN) + (size_t)l * 1024 * DFF; K = DFF; NN = 1024; stride = 1024; break;
        }
        const int nblk = NN / 32, kb = r / nblk, nb = r - kb * nblk, k0 = 64 * kb, n0 = 32 * nb;
        const int np = n0 + (lane & 31); long off = -1;
        {
            const int tile = np >> 8, v = np & 255;
            switch (mat) {
                case 0:
                    if (tile < 4) off = 256 * tile + ropemap(v);
                    else if (tile < 8) off = 1024 + 256 * (tile - 4) + ropemap(v);
                    else if (tile < 12) off = 2048 + 256 * (tile - 8) + v;
                    else if (tile < 20) off = 3776 + 256 * (tile - 12) + v;
                    else if (tile == 20) off = 3456 + v;
                    else if (tile == 21) off = 3072 + v;
                    else { if (v < 128) off = 3072 + 256 + v; else { const int w = v - 128, wc = w >> 5; if (wc < 2) off = 3712 + 32 * ((w >> 4) & 1) + 16 * wc + (w & 15); } }
                    break;
                case 1:
                    if (tile < 4) off = (np >> 7) * 192 + (np & 127);
                    else { const int hh = 4 * (tile - 4) + ((v >> 5) & 3); off = hh * 192 + 128 + 32 * (v >> 7) + (v & 31); }
                    break;
                case 2: case 3: {
                    const int c = np & 1023, hh = c >> 7, n = c & 127;
                    W = (np < 1024 ? P.in[18] : P.in[19]) + (size_t)l * 8 * 256 * 128; off = (long)hh * 32768 + n; } break;
                case 5: off = (v < 128) ? 128 * tile + v : DFF + 128 * tile + (v - 128); break;
                default: off = np; break;
            }
        }
#pragma unroll 8
        for (int i = 0; i < 32; ++i) { const int kk = 2 * i + (lane >> 5); float v = 0.f;
            if (off >= 0) { v = W[(size_t)(k0 + kk) * stride + off]; if (gk) v *= gk[k0 + kk]; }
            scr[kk * 33 + (lane & 31)] = v; }
        asm volatile("s_waitcnt lgkmcnt(0)" ::: "memory");
        const int c = lane & 7;
#pragma unroll
        for (int j = 0; j < 4; ++j) { const int n = (lane >> 3) + 8 * j; const LAS float* s = scr + (8 * c) * 33 + n;
            u32x4 o; o.x = pk2(s[0 * 33], s[1 * 33]); o.y = pk2(s[2 * 33], s[3 * 33]); o.z = pk2(s[4 * 33], s[5 * 33]); o.w = pk2(s[6 * 33], s[7 * 33]);
            *(u32x4*)(WT + (size_t)(n0 + n) * K + k0 + 8 * c) = o; }
        asm volatile("s_waitcnt lgkmcnt(0)" ::: "memory");
    }
}

__device__ __forceinline__ void sincos_f(float a, float& s, float& c) {
    const float n = rintf(a * 0.6366197723675814f);
    float r = fmaf(-n, 1.5703125f, a); r = fmaf(-n, 4.837512969970703125e-4f, r); r = fmaf(-n, 7.54978995489188e-8f, r);
    const float r2 = r * r;
    const float sp = r + r * r2 * (-1.6666666667e-1f + r2 * (8.3333333333e-3f + r2 * (-1.9841269841e-4f + r2 * 2.7557319224e-6f)));
    const float cp = 1.f + r2 * (-0.5f + r2 * (4.1666666667e-2f + r2 * (-1.3888888889e-3f + r2 * (2.4801587302e-5f + r2 * -2.7557319224e-7f))));
    const int qd = ((int)n) & 3;
    s = (qd == 0) ? sp : (qd == 1) ? cp : (qd == 2) ? -sp : -cp;
    c = (qd == 0) ? cp : (qd == 1) ? -sp : (qd == 2) ? -cp : sp;
}

__device__ __forceinline__ void cvt_stream(const float* src, bf16_t* dst, size_t n8, size_t gt, size_t ngt) {
    for (size_t i = gt; i < n8; i += ngt) { const f32x4 a = *(const f32x4*)(src + i * 8), b = *(const f32x4*)(src + i * 8 + 4);
        u32x4 o; o.x = cvt_pk_bf16(a[0], a[1]); o.y = cvt_pk_bf16(a[2], a[3]); o.z = cvt_pk_bf16(b[0], b[1]); o.w = cvt_pk_bf16(b[2], b[3]); *(u32x4*)(dst + i * 8) = o; }
}

__device__ __forceinline__ void conv_phase(const Params& P, int l, size_t gt, size_t ngt) {
    const bf16_t* U = (const bf16_t*)(P.ws + W_U); bf16_t* ACT = (bf16_t*)(P.ws + W_ACT);
    const float* wc = P.in[23] + (size_t)l * 3 * NUP; const float* bc = P.in[24] + (size_t)l * NUP; const float* stc = P.in[6] + (size_t)l * 16 * 2 * NUP;
    constexpr int NCC = DFF / 8, NRB = MT / 32;
    for (size_t it = gt; it < (size_t)NRB * NCC; it += ngt) {
        const int rb = (int)(it / NCC), cc = (int)(it - (size_t)rb * NCC), r0 = rb * 32, j0 = cc * 8;
        float w[2][4][8];
#pragma unroll
        for (int gv = 0; gv < 2; ++gv)
#pragma unroll
            for (int k = 0; k < 4; ++k) { const float* p = (k < 3 ? wc + (size_t)k * NUP : bc) + gv * DFF + j0; const f32x4 a = *(const f32x4*)p, b = *(const f32x4*)(p + 4);
#pragma unroll
                for (int e = 0; e < 4; ++e) { w[gv][k][e] = a[e]; w[gv][k][4 + e] = b[e]; } }
        float u1[2][8], u2[2][8];
        const bool samp = r0 >= MP; const bool seq0 = samp || ((r0 & 2047) == 0);
#pragma unroll
        for (int gv = 0; gv < 2; ++gv) {
            if (seq0) {
                if (samp) { const float* s0 = stc + (unsigned)(((r0 - MP) >> 5) * 2 * NUP + gv * DFF + j0);
#pragma unroll
                    for (int e = 0; e < 8; ++e) { u2[gv][e] = s0[e]; u1[gv][e] = s0[NUP + e]; } }
                else {
#pragma unroll
                    for (int e = 0; e < 8; ++e) { u2[gv][e] = 0.f; u1[gv][e] = 0.f; } }
            } else {
                const unsigned ua = (unsigned)(r0 - 2) * (unsigned)NUP + (unsigned)(gv * DFF + j0); const u32x4 a = *(const u32x4*)(U + ua), b = *(const u32x4*)(U + (ua + (unsigned)NUP));
#pragma unroll
                for (int e = 0; e < 4; ++e) { u2[gv][2 * e] = __uint_as_float(a[e] << 16); u2[gv][2 * e + 1] = __uint_as_float(a[e] & 0xffff0000u);
                                              u1[gv][2 * e] = __uint_as_float(b[e] << 16); u1[gv][2 * e + 1] = __uint_as_float(b[e] & 0xffff0000u); }
            }
        }
#pragma unroll 4
        for (int r = 0; r < 32; ++r) {
            const unsigned uo = (unsigned)(r0 + r) * (unsigned)NUP + (unsigned)j0; const u32x4 ug = *(const u32x4*)(U + uo), uv = *(const u32x4*)(U + (uo + (unsigned)DFF));
            float res[8];
#pragma unroll
            for (int e = 0; e < 8; ++e) {
                const float g0 = (e & 1) ? __uint_as_float(ug[e >> 1] & 0xffff0000u) : __uint_as_float(ug[e >> 1] << 16);
                const float v0 = (e & 1) ? __uint_as_float(uv[e >> 1] & 0xffff0000u) : __uint_as_float(uv[e >> 1] << 16);
                const float cg = w[0][3][e] + w[0][0][e] * u2[0][e] + w[0][1][e] * u1[0][e] + w[0][2][e] * g0;
                const float cv = w[1][3][e] + w[1][0][e] * u2[1][e] + w[1][1][e] * u1[1][e] + w[1][2][e] * v0;
                u2[0][e] = u1[0][e]; u1[0][e] = g0; u2[1][e] = u1[1][e]; u1[1][e] = v0;
                res[e] = cg * sigmoidf_(cg) * cv;
            }
            u32x4 o; o.x = cvt_pk_bf16(res[0], res[1]); o.y = cvt_pk_bf16(res[2], res[3]); o.z = cvt_pk_bf16(res[4], res[5]); o.w = cvt_pk_bf16(res[6], res[7]);
            *(u32x4*)(ACT + ((unsigned)(r0 + r) * (unsigned)DFF + (unsigned)j0)) = o;
        }
    }
}
constexpr int LDS_BYTES = 147456;
template <class Epi> __device__ __forceinline__ void run_gemm(LAS unsigned char* lds, const int wid, const bf16_t* A, const bf16_t* Bt, int M, int N, int K, const Epi& E) {
    int gx = (int)gridDim.x, bx = (int)blockIdx.x, wv = wid; asm volatile("" : "+s"(gx), "+s"(bx), "+s"(wv));
    pg8::Gemm g{A, Bt, M, N, K}; pg8::StaticOrder S; S.init(M, N, gx, bx);
#ifndef NO_GEMM
    pg8::gemm_phase<Epi, pg8::StaticOrder, PG8_ALIGN, PG8_SP2>(lds, g, S, E, wv);
#endif
}

__global__ void __launch_bounds__(512, 2) fwd_megakernel(Params P) {
    extern __shared__ __attribute__((aligned(16))) unsigned char lds_raw[];
    LAS unsigned char* lds = (LAS unsigned char*)lds_raw;
    cg::grid_group grid = cg::this_grid();
    const int wave_s = __builtin_amdgcn_readfirstlane((int)threadIdx.x >> 6);
#define TID_DEFS const int lane = LANE_ID(), wave = wave_s, tid = (wave << 6) | lane; \
    const int G = gridDim.x, gw = blockIdx.x * 8 + wave, ngw = G * 8; const size_t gt = (size_t)blockIdx.x * 512 + tid, ngt = (size_t)G * 512; (void)lane; (void)gw; (void)ngw; (void)gt; (void)ngt;
    unsigned char* ws = P.ws; float* out = P.out;
#define gbar() do { asm volatile("s_waitcnt vmcnt(0) lgkmcnt(0)" ::: "memory"); __syncthreads(); bar_gen += gridDim.x; \
        if (wave_s == 0 && LANE_ID() == 0) { asm volatile("buffer_wbl2 sc1\n\ts_waitcnt vmcnt(0) lgkmcnt(0)" ::: "memory"); __threadfence(); asm volatile("s_waitcnt vmcnt(0) lgkmcnt(0)" ::: "memory"); \
            __hip_atomic_fetch_add(ctl + 128, 1u, __ATOMIC_RELAXED, __HIP_MEMORY_SCOPE_AGENT); \
            while (__hip_atomic_load(ctl + 128, __ATOMIC_RELAXED, __HIP_MEMORY_SCOPE_AGENT) < bar_gen) __builtin_amdgcn_s_sleep(2); } \
        __syncthreads(); __threadfence(); asm volatile("buffer_inv sc1\n\ts_waitcnt vmcnt(0) lgkmcnt(0)" ::: "memory"); } while (0)
#define OPAQ() do { unsigned a_ = (unsigned)(uintptr_t)P.ws, b_ = (unsigned)((uintptr_t)P.ws >> 32), c_ = (unsigned)(uintptr_t)P.out, d_ = (unsigned)((uintptr_t)P.out >> 32); \
        asm volatile("" : "+s"(a_), "+s"(b_), "+s"(c_), "+s"(d_)); ws = (unsigned char*)(((uintptr_t)b_ << 32) | a_); out = (float*)(((uintptr_t)d_ << 32) | c_); } while (0)
    unsigned* ctl = (unsigned*)(ws + W_CTL); float* ctlf = (float*)(ws + W_CTL);
    float* rope = (float*)(ws + W_ROPE); float* SS = (float*)(ws + W_SS);
#define B_HX ((bf16_t*)(ws + W_HX))
#define B_X ((float*)(ws + W_X))
#define B_QDA ((bf16_t*)(ws + W_QDA))
#define B_KDA ((bf16_t*)(ws + W_KDA))
#define B_VDA ((bf16_t*)(ws + W_VDA))
#define B_GG ((bf16_t*)(ws + W_G))
#define B_CKV ((bf16_t*)(ws + W_CKV))
#define B_CQ ((bf16_t*)(ws + W_CQ))
#define B_KR ((bf16_t*)(ws + W_KR))
#define B_QM ((bf16_t*)(ws + W_QM))
#define B_KN ((bf16_t*)(ws + W_KN))
#define B_VM ((bf16_t*)(ws + W_VM))
#define B_MRG ((bf16_t*)(ws + W_MRG))
#define B_U ((bf16_t*)(ws + W_U))
#define B_ACT ((bf16_t*)(ws + W_ACT))
#define B_KC ((bf16_t*)(ws + W_KC))
#define B_VC ((bf16_t*)(ws + W_VC))
#define B_KRC ((bf16_t*)(ws + W_KRC))
#define B_CKVC ((bf16_t*)(ws + W_CKVC))
#define B_KNC ((bf16_t*)(ws + W_KNC))
#define B_VMC ((bf16_t*)(ws + W_VMC))
    {
    TID_DEFS
#ifndef NO_PREP
    prep_weights(P, lds, gw, ngw, wave, lane);
#endif
    for (size_t idx = gt; idx < (size_t)2080 * 32; idx += ngt) {
        const int pos = (int)(idx >> 5), i = (int)(idx & 31);
        double inv = 1.0; for (int k = 0; k < i; ++k) inv *= 0.74989420933245582730;
        const double ang = (double)pos * inv; const double n = __builtin_rint(ang * 0.63661977236758134308);
        double r = __builtin_fma(-n, 1.57079632679489655800, ang); r = __builtin_fma(-n, 6.12323399573676603587e-17, r);
        const float rf = (float)r, r2 = rf * rf;
        const float sp = rf + rf * r2 * (-1.6666666667e-1f + r2 * (8.3333333333e-3f + r2 * (-1.9841269841e-4f + r2 * 2.7557319224e-6f)));
        const float cp = 1.f + r2 * (-0.5f + r2 * (4.1666666667e-2f + r2 * (-1.3888888889e-3f + r2 * (2.4801587302e-5f + r2 * -2.7557319224e-7f))));
        const int qd = ((int)n) & 3;
        rope[(size_t)pos * 64 + 32 + i] = (qd == 0) ? sp : (qd == 1) ? cp : (qd == 2) ? -sp : -cp;
        rope[(size_t)pos * 64 + i] = (qd == 0) ? cp : (qd == 1) ? -sp : (qd == 2) ? -cp : sp;
    }
    for (size_t idx = gt; idx < (size_t)8 * MT; idx += ngt) SS[MT + idx] = 0.f;
    if (blockIdx.x == 0 && tid < 64) {
        if (tid < 3) __hip_atomic_store(ctl + (tid == 2 ? 128 : tid * 16), 0u, __ATOMIC_RELAXED, __HIP_MEMORY_SCOPE_AGENT);
        for (int l = 0; l < 2; ++l) {
        OPAQ();
            const float a = wave_sum(P.in[10][l * 64 + lane] * P.in[11][l * 64 + lane]), b = wave_sum(P.in[12][l * 64 + lane] * P.in[13][l * 64 + lane]);
            const float li = 0.8f - 0.6f * expf(-0.3f * (float)l);
            if (lane == 0) { ctlf[64 + 2 * l] = expf(a) - expf(b) + li; ctlf[65 + 2 * l] = 1.f - li; }
        }
    }
    for (int row = gw; row < MT; row += ngw) {
        const float* xr = (row >= MP ? P.in[1] + (size_t)(row - MP) * 1024 : P.in[0] + (size_t)row * 1024); float s = 0.f;
#pragma unroll
        for (int j = 0; j < 4; ++j) { const f32x4 v = *(const f32x4*)(xr + 256 * j + 4 * lane); s += sq4(v); st_bf16x4(B_HX + (size_t)row * 1024 + 256 * j + 4 * lane, v); }
        s = wave_sum(s); if (lane == 0) SS[row] = s;
    }
    cvt_stream(P.in[2], B_KC, (size_t)2 * MC * 1024 / 8, gt, ngt);
    cvt_stream(P.in[3], B_VC, (size_t)2 * MC * 1024 / 8, gt, ngt);
    cvt_stream(P.in[4], B_CKVC, (size_t)2 * MC * 256 / 8, gt, ngt);
    cvt_stream(P.in[5], B_KRC, (size_t)2 * MC * 64 / 8, gt, ngt);
    }
    __threadfence(); asm volatile("buffer_wbl2 sc1\n\ts_waitcnt vmcnt(0) lgkmcnt(0)" ::: "memory");
    grid.sync();
    __threadfence(); asm volatile("buffer_inv sc1\n\ts_waitcnt vmcnt(0) lgkmcnt(0)" ::: "memory");
    unsigned bar_gen = 0;

#pragma unroll 1
    for (int l = 0; l < 2; ++l) {
        OPAQ();
        float* ssx_attn = SS + (size_t)(2 * l) * MT; float* ssx_ffn = SS + (size_t)(2 * l + 1) * MT; float* ssx_next = SS + (size_t)(2 * l + 2) * MT;
        float* sscq = SS + (size_t)(5 + l) * MT; float* ssckv = SS + (size_t)(7 + l) * MT;
        float* ckp = out + O_CKVP + (size_t)l * MP * 256; float* cks = out + O_CKVS + (size_t)l * MSMP * 256;
        {
            EpiInProj E; E.ws = ws; E.out = out; E.bgate = P.in[9] + (size_t)l * 2048; E.l = l;
            run_gemm(lds, wave_s, B_HX, (const bf16_t*)(ws + W_WIN) + (size_t)l * NIN * 1024, MT, NIN, 1024, E);
        }
        gbar(); OPAQ();
        {
            EpiQ E; E.sscq = sscq; E.rope = rope; E.QM = B_QM;
            run_gemm(lds, wave_s, B_CQ, (const bf16_t*)(ws + W_WQ) + (size_t)l * NQ * QL, MT, NQ, QL, E);
        }
        {
            EpiKV E; E.ss = ssckv; E.O0 = B_KN; E.O1 = B_VM;
            run_gemm(lds, wave_s, B_CKV, (const bf16_t*)(ws + W_WKV) + (size_t)l * NKV * KVL, MT, NKV, KVL, E);
        }
        if (l == 0) {
#pragma unroll 1
            for (int l2 = 0; l2 < 2; ++l2) {
                EpiKV E; E.ss = nullptr; E.O0 = B_KNC + (size_t)l2 * MC * 1024; E.O1 = B_VMC + (size_t)l2 * MC * 1024;
                run_gemm(lds, wave_s, B_CKVC + (size_t)l2 * MC * 256, (const bf16_t*)(ws + W_WKVC) + (size_t)l2 * NKV * KVL, MC, NKV, KVL, E);
            }
        }
        {
            TID_DEFS
            const float* gk = P.in[17] + (size_t)l * 256;
            for (size_t idx = gt; idx < (size_t)MT * 64; idx += ngt) {
                const int row = (int)(idx >> 6), c4 = (int)(idx & 63);
                float* p = (row >= MP ? cks + (size_t)(row - MP) * 256 : ckp + (size_t)row * 256) + 4 * c4;
                const float rs = rsqrtf(ssckv[row] * (1.f / 256.f) + EPS); const f32x4 g = *(const f32x4*)(gk + 4 * c4);
                *(f32x4*)p = *(const f32x4*)p * rs * g;
            }
        }
        gbar(); OPAQ();
        {
            AttnCtx C; C.ws = ws; C.gda = P.in[14] + (size_t)l * 128; C.lam = __int_as_float(__builtin_amdgcn_readfirstlane(__float_as_int(ctlf[64 + 2 * l]))); C.lam1m = __int_as_float(__builtin_amdgcn_readfirstlane(__float_as_int(ctlf[65 + 2 * l]))); C.counter = ctl + 16 * l; C.l = l;
#ifndef NO_ATTN
            { int wv = wave_s; asm volatile("" : "+s"(wv)); attn_phase(lds, C, wv); }
#endif
        }
        gbar(); OPAQ();
        {
            EpiRes E; E.xp = (l == 0) ? P.in[0] : B_X; E.xs = (l == 0) ? P.in[1] : B_X + (size_t)MP * 1024; E.X = B_X; E.HX = B_HX; E.ssn = ssx_ffn;
            run_gemm(lds, wave_s, B_MRG, (const bf16_t*)(ws + W_WO) + (size_t)l * 1024 * 1024, MT, 1024, 1024, E);
        }
        gbar(); OPAQ();
        {
            EpiUp E; E.ssx = ssx_ffn; E.U = B_U; E.cvp = out + O_CVP + (size_t)l * 32 * 2 * NUP; E.cvs = out + O_CVS + (size_t)l * 16 * 2 * NUP;
            run_gemm(lds, wave_s, B_HX, (const bf16_t*)(ws + W_WUP) + (size_t)l * NUP * 1024, MT, NUP, 1024, E);
        }
        gbar(); OPAQ();
#ifndef NO_CONV
        { TID_DEFS conv_phase(P, l, gt, ngt); }
#endif
        gbar(); OPAQ();
        {
            EpiRes E; E.xp = B_X; E.xs = B_X + (size_t)MP * 1024; E.X = B_X; E.HX = B_HX; E.ssn = ssx_next;
            run_gemm(lds, wave_s, B_ACT, (const bf16_t*)(ws + W_WDN) + (size_t)l * 1024 * DFF, MT, 1024, DFF, E);
        }
        gbar(); OPAQ();
    }
    {
        TID_DEFS
        const float* ssf = SS + (size_t)4 * MT; const float* gf = P.in[26];
        for (size_t idx = gt; idx < (size_t)MT * 256; idx += ngt) {
            const int row = (int)(idx >> 8), c4 = (int)(idx & 255);
            const float rs = rsqrtf(ssf[row] * (1.f / 1024.f) + EPS);
            *(f32x4*)(out + (size_t)row * 1024 + 4 * c4) = *(const f32x4*)(B_X + (size_t)row * 1024 + 4 * c4) * rs * *(const f32x4*)(gf + 4 * c4);
        }
    }
}

extern "C" void kernel_launch(void* const* d_in, const int* in_sizes, int n_in, void* d_out, int out_size, void* d_ws, size_t ws_size, hipStream_t stream) {
    static int grid_blocks = 0;
    if (grid_blocks == 0) {
        if (n_in != 27 || (size_t)out_size != O_END || ws_size < W_END) { fprintf(stderr, "kernel_launch: unexpected problem (n_in %d, out %d vs %zu, ws %zu vs %zu)\n", n_in, out_size, (size_t)O_END, ws_size, (size_t)W_END); grid_blocks = -1; return; }
        int dev = 0, cus = 0, per_cu = 0;
        (void)hipGetDevice(&dev); (void)hipDeviceGetAttribute(&cus, hipDeviceAttributeMultiprocessorCount, dev);
        (void)hipFuncSetAttribute((const void*)fwd_megakernel, hipFuncAttributeMaxDynamicSharedMemorySize, LDS_BYTES);
        (void)hipOccupancyMaxActiveBlocksPerMultiprocessor(&per_cu, (const void*)fwd_megakernel, 512, LDS_BYTES);
        if (per_cu < 1) per_cu = 1;
        grid_blocks = cus * per_cu;
    }
    if (grid_blocks < 0) return;
    Params p{};
    for (int i = 0; i < 27; ++i) p.in[i] = (const float*)d_in[i];
    p.out = (float*)d_out; p.ws = (unsigned char*)d_ws;
    void* args[] = {&p};
    hipError_t e = hipLaunchCooperativeKernel((void*)fwd_megakernel, dim3(grid_blocks), dim3(512), args, LDS_BYTES, stream);
    if (e != hipSuccess) fprintf(stderr, "cooperative launch failed: %s (grid %d)\n", hipGetErrorString(e), grid_blocks);
}
```

```cpp
#include <hip/hip_runtime.h>
#include <hip/hip_cooperative_groups.h>
#include <cstdio>
#include <cstdint>
namespace cg = cooperative_groups;
#define LANE_ID() ({ int l_ = (int)__builtin_amdgcn_mbcnt_hi(~0u, __builtin_amdgcn_mbcnt_lo(~0u, 0u)); asm volatile("" : "+v"(l_)); l_; })
namespace pg8 {
#define PG8_LAS __attribute__((address_space(3)))
typedef unsigned short bf16_t;
typedef short bf16x8 __attribute__((ext_vector_type(8)));
typedef float f32x4 __attribute__((ext_vector_type(4)));
typedef unsigned u32x4 __attribute__((ext_vector_type(4)));
constexpr int BM = 256, BK = 64, HALF = 128, HTB = HALF * BK * 2  , STAGE_BYTES = 8 * HTB, NXCD = 8, WGM = 8;

__host__ __device__ __forceinline__ int lds_byte(int r, int c) { const int st = (r >> 4) * 2 + (c >> 5), rr = r & 15, cc = c & 31, ob = rr * 64 + cc * 2; return st * 1024 + (ob ^ (((ob >> 9) & 1) << 5)); }
__host__ __device__ __forceinline__ void stage_rc(int b, int& R, int& C) { const int st = b / 1024, sb = b % 1024, swz = sb ^ (((sb >> 9) & 1) << 5); R = (st >> 1) * 16 + swz / 64; C = (st & 1) * 32 + (swz % 64) / 2; }
__host__ __device__ __forceinline__ int perm32(int rho) { const int n = rho >> 4, i = rho & 15; return 8 * (i >> 2) + 4 * n + (i & 3); }

struct Unit { int pm, pn; };
struct Gemm { const bf16_t* A; const bf16_t* Bt; int M, N, K; };

struct StaticOrder {
    int nM, nN, nwg, G, c;
    __host__ __device__ void init(int M, int N, int G_, int c_) { nM = M / BM; nN = N / BM; nwg = nM * nN; G = G_; c = c_; }
    __host__ __device__ bool next(int i, Unit& u) const {
        const long L = (long)i * G + c; if (L >= nwg) return false;
        int wgid = (int)L; { const int q = nwg / NXCD, r = nwg % NXCD, xcd = wgid % NXCD, off = wgid / NXCD; wgid = (xcd < r ? xcd * (q + 1) : r * (q + 1) + (xcd - r) * q) + off; }
        const int nig = WGM * nN, gid = wgid / nig, fm = gid * WGM, gsz = (nM - fm) < WGM ? (nM - fm) : WGM;
        u.pm = fm + ((wgid % nig) % gsz); u.pn = (wgid % nig) / gsz; return true;
    }
    __device__ __forceinline__ void a_ready(const Unit&) const {}
    __device__ __forceinline__ void done(const Unit&) const {}
};

typedef float f32x2_cv __attribute__((ext_vector_type(2))); typedef __bf16 bf16x2_cv __attribute__((ext_vector_type(2)));
__device__ __forceinline__ unsigned cvt_pk_bf16(float lo, float hi) { f32x2_cv v = {lo, hi}; bf16x2_cv b = __builtin_convertvector(v, bf16x2_cv); return __builtin_bit_cast(unsigned, b); }
template <class Epi, class Sched, bool ALIGN_EPI = false, bool SP2 = false>
__device__ __forceinline__ void gemm_phase(PG8_LAS unsigned char* lds, const Gemm g, const Sched& S, const Epi& E, const int wid_in) {
    const int wid = wid_in, lane = LANE_ID(), tid = (wid << 6) | lane, wr = wid >> 2, wc = wid & 3, fr = lane & 15, fq = lane >> 4;
    const int K = g.K, nt = K / BK;
    unsigned voffA[2], voffB[2];
#pragma unroll
    for (int i = 0; i < 2; ++i) { int R, C; stage_rc(tid * 16 + i * 8192, R, C); const int Rb = Epi::PERM ? ((R & ~31) + perm32(R & 31)) : R;
        voffA[i] = (unsigned)(R * K + C) * 2u; voffB[i] = (unsigned)(Rb * K + C) * 2u; }
    const size_t kstep = (size_t)(BK * 2);
    const size_t hstep = (size_t)HALF * K * 2;
    const size_t tstep = 2 * hstep;
    const unsigned ldsw = (unsigned)wid * 1024u;
    const int aoff = lds_byte(wr * 64 + fr, fq * 8), boff = lds_byte(wc * 32 + fr, fq * 8);
#define PG8_SA(b, h) (((b) * 2 + (h)) * HTB)
#define PG8_SB(b, h) ((4 + (b) * 2 + (h)) * HTB)
#define PG8_STAGE(bufoff, gbase, voff) do { _Pragma("unroll") for (int _i = 0; _i < 2; ++_i) \
        __builtin_amdgcn_global_load_lds((const unsigned*)((const char*)(gbase) + (voff)[_i]), (PG8_LAS unsigned*)(lds + (bufoff) + ldsw + _i * 8192), 16, 0, 0); } while (0)
#define PG8_LDA(dst, b, h) do { _Pragma("unroll") for (int m = 0; m < 4; ++m) _Pragma("unroll") for (int k = 0; k < 2; ++k) dst[m][k] = *(const PG8_LAS bf16x8*)(lds + PG8_SA(b, h) + aoff + m * 2048 + k * 1024); } while (0)
#define PG8_LDB(dst, b, h) do { _Pragma("unroll") for (int n = 0; n < 2; ++n) _Pragma("unroll") for (int k = 0; k < 2; ++k) dst[n][k] = *(const PG8_LAS bf16x8*)(lds + PG8_SB(b, h) + boff + n * 2048 + k * 1024); } while (0)
#define PG8_MMA(ai, bj, At, Bt) do { __builtin_amdgcn_s_setprio(1); _Pragma("unroll") for (int m = 0; m < 4; ++m) _Pragma("unroll") for (int n = 0; n < 2; ++n) _Pragma("unroll") for (int k = 0; k < 2; ++k) \
        acc[ai][bj][m][n] = __builtin_amdgcn_mfma_f32_16x16x32_bf16(Bt[n][k], At[m][k], acc[ai][bj][m][n], 0, 0, 0); __builtin_amdgcn_s_setprio(0); } while (0)
#define PG8_WAIT_V(n) asm volatile("s_waitcnt vmcnt(" #n ")" ::: "memory")
#define PG8_WAIT_L(n) asm volatile("s_waitcnt lgkmcnt(" #n ")" ::: "memory")
#define PG8_BAR __builtin_amdgcn_s_barrier()
#define PG8_SCHED __builtin_amdgcn_sched_barrier(0)
    Unit cur, nxt; int ui = 0;
    if (!S.next(0, cur)) return;
    f32x4 acc[2][2][4][2];
#pragma unroll
    for (int a = 0; a < 2; ++a)
#pragma unroll
        for (int b = 0; b < 2; ++b)
#pragma unroll
            for (int m = 0; m < 4; ++m)
#pragma unroll
                for (int n = 0; n < 2; ++n) acc[a][b][m][n] = (f32x4){0.f, 0.f, 0.f, 0.f};
    bf16x8 At[4][2], B0[2][2], B1[2][2];
    const char* cA = (const char*)g.A + (size_t)cur.pm * tstep; const char* cB = (const char*)g.Bt + (size_t)cur.pn * tstep;
    S.a_ready(cur);
    if constexpr (SP2) {
        PG8_STAGE(PG8_SB(0, 0), cB, voffB); PG8_STAGE(PG8_SB(0, 1), cB + hstep, voffB); PG8_STAGE(PG8_SA(0, 0), cA, voffA); PG8_STAGE(PG8_SA(0, 1), cA + hstep, voffA);
        if (wr == 1) PG8_BAR;
        PG8_WAIT_V(2); PG8_BAR;
        PG8_STAGE(PG8_SB(1, 0), cB + kstep, voffB); PG8_STAGE(PG8_SA(1, 0), cA + kstep, voffA); PG8_STAGE(PG8_SB(1, 1), cB + hstep + kstep, voffB);
        PG8_WAIT_V(6); PG8_BAR;
    } else {
        PG8_STAGE(PG8_SB(0, 0), cB, voffB); PG8_STAGE(PG8_SA(0, 0), cA, voffA); PG8_STAGE(PG8_SB(0, 1), cB + hstep, voffB); PG8_STAGE(PG8_SA(0, 1), cA + hstep, voffA);
        if (wr == 1) PG8_BAR;
        PG8_WAIT_V(4); PG8_BAR;
        PG8_STAGE(PG8_SB(1, 0), cB + kstep, voffB); PG8_STAGE(PG8_SA(1, 0), cA + kstep, voffA); PG8_STAGE(PG8_SB(1, 1), cB + hstep + kstep, voffB);
        PG8_WAIT_V(6); PG8_BAR;
    }
    for (;;) {
        const bool has_next = S.next(ui + 1, nxt);
        const char* nA = has_next ? (const char*)g.A + (size_t)nxt.pm * tstep : cA; const char* nB = has_next ? (const char*)g.Bt + (size_t)nxt.pn * tstep : cB;
        for (int t = 0; t < nt; t += 2) {
            const bool last = (t == nt - 2);
            const char* a1 = cA + (size_t)(t + 1) * kstep;
            const char* a2 = last ? nA : cA + (size_t)(t + 2) * kstep; const char* b2 = last ? nB : cB + (size_t)(t + 2) * kstep;
            const char* a3 = a2 + kstep; const char* b3 = b2 + kstep;
            if (last && has_next) S.a_ready(nxt);
            if constexpr (SP2) {
            PG8_LDB(B0, 0, 0); PG8_LDB(B1, 0, 1); PG8_SCHED; PG8_LDA(At, 0, 0); PG8_STAGE(PG8_SA(1, 1), a1 + hstep, voffA);
            PG8_WAIT_V(8); PG8_WAIT_L(0); PG8_BAR; PG8_MMA(0, 0, At, B0); PG8_MMA(0, 1, At, B1); PG8_BAR; PG8_SCHED;
            PG8_LDA(At, 0, 1); PG8_STAGE(PG8_SB(0, 0), b2, voffB); PG8_STAGE(PG8_SB(0, 1), b2 + hstep, voffB); PG8_STAGE(PG8_SA(0, 0), a2, voffA);
            PG8_WAIT_V(8); PG8_WAIT_L(0); PG8_BAR; PG8_MMA(1, 0, At, B0); PG8_MMA(1, 1, At, B1); PG8_BAR; PG8_SCHED;
            PG8_LDB(B0, 1, 0); PG8_LDB(B1, 1, 1); PG8_SCHED; PG8_LDA(At, 1, 0); PG8_STAGE(PG8_SA(0, 1), a2 + hstep, voffA);
            PG8_WAIT_V(8); PG8_WAIT_L(0); PG8_BAR; PG8_MMA(0, 0, At, B0); PG8_MMA(0, 1, At, B1); PG8_BAR; PG8_SCHED;
            PG8_LDA(At, 1, 1); PG8_STAGE(PG8_SB(1, 0), b3, voffB); PG8_STAGE(PG8_SB(1, 1), b3 + hstep, voffB); PG8_STAGE(PG8_SA(1, 0), a3, voffA);
            PG8_WAIT_V(8); PG8_WAIT_L(0); PG8_BAR; PG8_MMA(1, 0, At, B0); PG8_MMA(1, 1, At, B1); PG8_BAR; PG8_SCHED;
            } else {
            PG8_LDB(B0, 0, 0); PG8_SCHED; PG8_LDA(At, 0, 0); PG8_STAGE(PG8_SA(1, 1), a1 + hstep, voffA);
            PG8_WAIT_L(8); PG8_BAR; PG8_WAIT_L(0); PG8_MMA(0, 0, At, B0); PG8_BAR; PG8_SCHED;
            PG8_LDB(B1, 0, 1); PG8_STAGE(PG8_SB(0, 0), b2, voffB);
            PG8_BAR; PG8_WAIT_L(0); PG8_MMA(0, 1, At, B1); PG8_BAR;
            PG8_LDA(At, 0, 1); PG8_STAGE(PG8_SA(0, 0), a2, voffA);
            PG8_BAR; PG8_WAIT_L(0); PG8_MMA(1, 0, At, B0); PG8_BAR; PG8_SCHED;
            PG8_STAGE(PG8_SB(0, 1), b2 + hstep, voffB);
            PG8_WAIT_V(6); PG8_BAR; PG8_MMA(1, 1, At, B1); PG8_BAR;
            PG8_LDB(B0, 1, 0); PG8_SCHED; PG8_LDA(At, 1, 0); PG8_STAGE(PG8_SA(0, 1), a2 + hstep, voffA);
            PG8_WAIT_L(8); PG8_BAR; PG8_WAIT_L(0); PG8_MMA(0, 0, At, B0); PG8_BAR; PG8_SCHED;
            PG8_LDB(B1, 1, 1); PG8_STAGE(PG8_SB(1, 0), b3, voffB);
            PG8_BAR; PG8_WAIT_L(0); PG8_MMA(0, 1, At, B1); PG8_BAR;
            PG8_LDA(At, 1, 1); PG8_STAGE(PG8_SA(1, 0), a3, voffA);
            PG8_BAR; PG8_WAIT_L(0); PG8_MMA(1, 0, At, B0); PG8_BAR; PG8_SCHED;
            PG8_STAGE(PG8_SB(1, 1), b3 + hstep, voffB);
            PG8_WAIT_V(6); PG8_BAR; PG8_MMA(1, 1, At, B1); PG8_BAR;
            }
        }
        if constexpr (ALIGN_EPI) { if (wr == 0) PG8_BAR; }
        if constexpr (!Epi::AFTER_DRAIN) { E(acc, cur, wr, wc, fr, fq); S.done(cur); }
        if (!has_next) break;
#pragma unroll
        for (int a = 0; a < 2; ++a)
#pragma unroll
            for (int b = 0; b < 2; ++b)
#pragma unroll
                for (int m = 0; m < 4; ++m)
#pragma unroll
                    for (int n = 0; n < 2; ++n) acc[a][b][m][n] = (f32x4){0.f, 0.f, 0.f, 0.f};
        cur = nxt; cA = nA; cB = nB; ++ui;
        if constexpr (ALIGN_EPI) { if (wr == 1) PG8_BAR; }
    }
    PG8_WAIT_V(0);
    if constexpr (!ALIGN_EPI) { if (wr == 0) PG8_BAR; }
    PG8_BAR;
    if constexpr (Epi::AFTER_DRAIN) { E.fused(acc, cur, wr, wc, fr, fq, lds, wid, lane); S.done(cur); }
#undef PG8_SA
#undef PG8_SB
#undef PG8_STAGE
#undef PG8_LDA
#undef PG8_LDB
#undef PG8_MMA
#undef PG8_WAIT_V
#undef PG8_WAIT_L
#undef PG8_BAR
#undef PG8_SCHED
}
}
#define PG8_SP2 true
#define PG8_ALIGN true
using pg8::bf16_t; using pg8::bf16x8; using pg8::f32x4; using pg8::Unit; using pg8::cvt_pk_bf16;
#define LAS __attribute__((address_space(3)))
typedef float f32x16 __attribute__((ext_vector_type(16)));
typedef unsigned u32x2 __attribute__((ext_vector_type(2)));
typedef unsigned u32x4 __attribute__((ext_vector_type(4)));
typedef short v4i16_t __attribute__((ext_vector_type(4)));

constexpr int MP = 65536, MSMP = 512, MT = MP + MSMP, MC = 32768;
constexpr int INC = 5824, NIN = 5888, QL = 384, KVL = 256, NQ = 1536, NKV = 2048, DFF = 2816, NUP = 5632;
constexpr float EPS = 1e-6f, LOG2E = 1.4426950408889634f;
constexpr float QS_DA = 0.125f * LOG2E;
constexpr float QS_MLA = 0.07216878364870322f * LOG2E;
constexpr size_t O_DKP = (size_t)MT * 1024;
constexpr size_t O_DVP = O_DKP + 2 * (size_t)MP * 1024;
constexpr size_t O_CKVP = O_DVP + 2 * (size_t)MP * 1024;
constexpr size_t O_KRP = O_CKVP + 2 * (size_t)MP * 256;
constexpr size_t O_CVP = O_KRP + 2 * (size_t)MP * 64;
constexpr size_t O_DKS = O_CVP + 2 * 32 * 2 * 5632;
constexpr size_t O_DVS = O_DKS + 2 * 512 * 1024;
constexpr size_t O_CKVS = O_DVS + 2 * 512 * 1024;
constexpr size_t O_KRS = O_CKVS + 2 * 512 * 256;
constexpr size_t O_CVS = O_KRS + 2 * 512 * 64;
constexpr size_t O_END = O_CVS + 2 * 16 * 2 * 5632;
constexpr size_t A256(size_t x) { return (x + 255) & ~(size_t)255; }
constexpr size_t W_CTL = 0;
constexpr size_t W_ROPE = 4096;
constexpr size_t W_SS = A256(W_ROPE + (size_t)2080 * 64 * 4);
constexpr size_t W_WIN = A256(W_SS + (size_t)9 * MT * 4);
constexpr size_t W_WQ = A256(W_WIN + (size_t)2 * NIN * 1024 * 2);
constexpr size_t W_WKV = A256(W_WQ + (size_t)2 * NQ * QL * 2);
constexpr size_t W_WKVC = A256(W_WKV + (size_t)2 * NKV * KVL * 2);
constexpr size_t W_WO = A256(W_WKVC + (size_t)2 * NKV * KVL * 2);
constexpr size_t W_WUP = A256(W_WO + (size_t)2 * 1024 * 1024 * 2);
constexpr size_t W_WDN = A256(W_WUP + (size_t)2 * NUP * 1024 * 2);
constexpr size_t W_HX = A256(W_WDN + (size_t)2 * 1024 * DFF * 2);
constexpr size_t W_X = A256(W_HX + (size_t)MT * 1024 * 2);
constexpr size_t W_QDA = A256(W_X + (size_t)MT * 1024 * 4);
constexpr size_t W_KDA = A256(W_QDA + (size_t)MT * 1024 * 2);
constexpr size_t W_VDA = A256(W_KDA + (size_t)MT * 1024 * 2);
constexpr size_t W_G = A256(W_VDA + (size_t)MT * 1024 * 2);
constexpr size_t W_CKV = A256(W_G + (size_t)MT * 2048 * 2);
constexpr size_t W_CQ = A256(W_CKV + (size_t)MT * 256 * 2);
constexpr size_t W_KR = A256(W_CQ + (size_t)MT * 384 * 2);
constexpr size_t W_QM = A256(W_KR + (size_t)MT * 64 * 2);
constexpr size_t W_KN = A256(W_QM + (size_t)MT * 1536 * 2);
constexpr size_t W_VM = A256(W_KN + (size_t)MT * 1024 * 2);
constexpr size_t W_MRG = A256(W_VM + (size_t)MT * 1024 * 2);
constexpr size_t W_U = A256(W_MRG + (size_t)MT * 1024 * 2);
constexpr size_t W_ACT = A256(W_U + (size_t)MT * NUP * 2);
constexpr size_t W_KC = A256(W_ACT + (size_t)MT * DFF * 2);
constexpr size_t W_VC = A256(W_KC + (size_t)2 * MC * 1024 * 2);
constexpr size_t W_KRC = A256(W_VC + (size_t)2 * MC * 1024 * 2);
constexpr size_t W_CKVC = A256(W_KRC + (size_t)2 * MC * 64 * 2);
constexpr size_t W_KNC = A256(W_CKVC + (size_t)2 * MC * 256 * 2);
constexpr size_t W_VMC = A256(W_KNC + (size_t)2 * MC * 1024 * 2);
constexpr size_t W_END = A256(W_VMC + (size_t)2 * MC * 1024 * 2);

struct Params { const float* in[27]; float* out; unsigned char* ws; };

__device__ __forceinline__ void st_bf16x4(bf16_t* p, f32x4 v) { u32x2 w; w.x = cvt_pk_bf16(v[0], v[1]); w.y = cvt_pk_bf16(v[2], v[3]); *(u32x2*)p = w; }
__device__ __forceinline__ float fast_rcp(float x) { return __builtin_amdgcn_rcpf(x); }
__device__ __forceinline__ float fast_exp2(float x) { return __builtin_amdgcn_exp2f(x); }
__device__ __forceinline__ float sigmoidf_(float x) { return fast_rcp(1.f + fast_exp2(-x * LOG2E)); }
__device__ __forceinline__ float bf2f(unsigned short b) { return __uint_as_float((unsigned)b << 16); }
__device__ __forceinline__ int row_of(const Unit& u, int ai, int wr, int m, int fr) { return u.pm * 256 + ai * 128 + wr * 64 + m * 16 + fr; }
__device__ __forceinline__ float sq4(f32x4 v) { return (v[0] * v[0] + v[1] * v[1]) + (v[2] * v[2] + v[3] * v[3]); }

__device__ __forceinline__ float add_x16(float s) { return s + __int_as_float(__builtin_amdgcn_ds_swizzle(__float_as_int(s), 0x401F)); }
__device__ __forceinline__ float add_x32(float s) { auto rr = __builtin_amdgcn_permlane32_swap(__float_as_uint(s), __float_as_uint(s), false, false); return __uint_as_float(rr[0]) + __uint_as_float(rr[1]); }
__device__ __forceinline__ float max_x32(float s) { auto rr = __builtin_amdgcn_permlane32_swap(__float_as_uint(s), __float_as_uint(s), false, false); return fmaxf(__uint_as_float(rr[0]), __uint_as_float(rr[1])); }
#define LOAD_RS8(name, ptr, scale, mul) float name[2][4]; { _Pragma("unroll") for (int ai_ = 0; ai_ < 2; ++ai_) _Pragma("unroll") for (int m_ = 0; m_ < 4; ++m_) name[ai_][m_] = (ptr)[row_of(u, ai_, wr, m_, fr)]; \
    _Pragma("unroll") for (int ai_ = 0; ai_ < 2; ++ai_) _Pragma("unroll") for (int m_ = 0; m_ < 4; ++m_) name[ai_][m_] = rsqrtf(name[ai_][m_] * (scale) + EPS) * (mul); }
struct EpiInProj {
    static constexpr bool PERM = false, AFTER_DRAIN = false;
    unsigned char* ws; float* out; const float* bgate; int l;
    __device__ __forceinline__ void operator()(const f32x4 (&acc)[2][2][4][2], const Unit& u, int wr, int wc, int fr, int fq) const {
        const int pn = u.pn;
        const float* SSb = (const float*)(ws + W_SS); const float* ssx = SSb + (size_t)(2 * l) * MT; const float* rope = (const float*)(ws + W_ROPE);
        float* sscq = (float*)(ws + W_SS) + (size_t)(5 + l) * MT; float* ssckv = (float*)(ws + W_SS) + (size_t)(7 + l) * MT;
        bf16_t* QDA = (bf16_t*)(ws + W_QDA); bf16_t* KDA = (bf16_t*)(ws + W_KDA); bf16_t* VDA = (bf16_t*)(ws + W_VDA); bf16_t* G = (bf16_t*)(ws + W_G);
        bf16_t* CKV = (bf16_t*)(ws + W_CKV); bf16_t* CQ = (bf16_t*)(ws + W_CQ); bf16_t* KR = (bf16_t*)(ws + W_KR);
        float* dkp = out + O_DKP + (size_t)l * MP * 1024; float* dks = out + O_DKS + (size_t)l * MSMP * 1024; float* dvp = out + O_DVP + (size_t)l * MP * 1024; float* dvs = out + O_DVS + (size_t)l * MSMP * 1024;
        float* ckp = out + O_CKVP + (size_t)l * MP * 256; float* cks = out + O_CKVS + (size_t)l * MSMP * 256; float* krp = out + O_KRP + (size_t)l * MP * 64; float* krs = out + O_KRS + (size_t)l * MSMP * 64;
        LOAD_RS8(rs8, ssx, 1.f / 1024.f, 1.f)
        if (pn < 8) {
            const bool isk = pn >= 4; const int cb = 256 * (pn & 3) + 64 * wc;
#pragma unroll
            for (int ai = 0; ai < 2; ++ai)
#pragma unroll
                for (int m = 0; m < 4; ++m) { if ((m & 1) == 0) asm volatile("" ::: "memory");
                    const int row = row_of(u, ai, wr, m, fr); const float rstd = rs8[ai][m];
                    const bool samp = row >= MP; const int orow = samp ? row - MP : row; const int pos = samp ? 2048 + (orow & 31) : (row & 2047);
                    const float* rt = rope + (size_t)pos * 64;
#pragma unroll
                    for (int n = 0; n < 2; ++n) {
                        const int i0 = 16 * n + 4 * fq; const f32x4 cs = *(const f32x4*)(rt + i0), sn = *(const f32x4*)(rt + 32 + i0);
                        const f32x4 x1 = acc[ai][0][m][n] * rstd, x2 = acc[ai][1][m][n] * rstd;
                        f32x4 o1 = x1 * cs - x2 * sn, o2 = x2 * cs + x1 * sn;
                        if (!isk) { o1 = o1 * QS_DA; o2 = o2 * QS_DA; bf16_t* q = QDA + (size_t)row * 1024 + cb + i0; st_bf16x4(q, o1); st_bf16x4(q + 32, o2); }
                        else { bf16_t* k = KDA + (size_t)row * 1024 + cb + i0; st_bf16x4(k, o1); st_bf16x4(k + 32, o2);
                               float* d = (samp ? dks : dkp) + (size_t)orow * 1024 + cb + i0; *(f32x4*)d = o1; *(f32x4*)(d + 32) = o2; }
                    }
                }
        } else if (pn < 12) {
            const int cb = 256 * (pn - 8) + 32 * wc + 4 * fq;
#pragma unroll
            for (int ai = 0; ai < 2; ++ai)
#pragma unroll
                for (int m = 0; m < 4; ++m) { if ((m & 1) == 0) asm volatile("" ::: "memory");
                    const int row = row_of(u, ai, wr, m, fr); const float rstd = rs8[ai][m];
                    const bool samp = row >= MP; const int orow = samp ? row - MP : row;
                    float* d = (samp ? dvs : dvp) + (size_t)orow * 1024 + cb; bf16_t* v = VDA + (size_t)row * 1024 + cb;
#pragma unroll
                    for (int bj = 0; bj < 2; ++bj)
#pragma unroll
                        for (int n = 0; n < 2; ++n) { const f32x4 x = acc[ai][bj][m][n] * rstd; *(f32x4*)(d + 128 * bj + 16 * n) = x; st_bf16x4(v + 128 * bj + 16 * n, x); }
                }
        } else if (pn < 20) {
            const int cb = 256 * (pn - 12) + 32 * wc + 4 * fq;
            f32x4 bv[2][2];
#pragma unroll
            for (int bj = 0; bj < 2; ++bj)
#pragma unroll
                for (int n = 0; n < 2; ++n) bv[bj][n] = *(const f32x4*)(bgate + cb + 128 * bj + 16 * n);
#pragma unroll
            for (int ai = 0; ai < 2; ++ai)
#pragma unroll
                for (int m = 0; m < 4; ++m) { if ((m & 1) == 0) asm volatile("" ::: "memory");
                    const int row = row_of(u, ai, wr, m, fr); const float rstd = rs8[ai][m];
                    bf16_t* g = G + (size_t)row * 2048 + cb;
#pragma unroll
                    for (int bj = 0; bj < 2; ++bj)
#pragma unroll
                        for (int n = 0; n < 2; ++n) { f32x4 x = acc[ai][bj][m][n] * rstd + bv[bj][n];
                            x[0] = sigmoidf_(x[0]); x[1] = sigmoidf_(x[1]); x[2] = sigmoidf_(x[2]); x[3] = sigmoidf_(x[3]); st_bf16x4(g + 128 * bj + 16 * n, x); }
                }
        } else if (pn == 20) {
            const int cb = 32 * wc + 4 * fq;
#pragma unroll
            for (int ai = 0; ai < 2; ++ai)
#pragma unroll
                for (int m = 0; m < 4; ++m) { if ((m & 1) == 0) asm volatile("" ::: "memory");
                    const int row = row_of(u, ai, wr, m, fr); const float rstd = rs8[ai][m];
                    const bool samp = row >= MP; const int orow = samp ? row - MP : row;
                    float* d = (samp ? cks : ckp) + (size_t)orow * 256 + cb; bf16_t* c = CKV + (size_t)row * 256 + cb; float s = 0.f;
#pragma unroll
                    for (int bj = 0; bj < 2; ++bj)
#pragma unroll
                        for (int n = 0; n < 2; ++n) { const f32x4 x = acc[ai][bj][m][n] * rstd; s += sq4(x); *(f32x4*)(d + 128 * bj + 16 * n) = x; st_bf16x4(c + 128 * bj + 16 * n, x); }
                    s = add_x16(s); s = add_x32(s);
                    if (fq == 0) unsafeAtomicAdd(ssckv + row, s);
                }
        } else if (pn == 21) {
            const int cb = 32 * wc + 4 * fq;
#pragma unroll
            for (int ai = 0; ai < 2; ++ai)
#pragma unroll
                for (int m = 0; m < 4; ++m) { if ((m & 1) == 0) asm volatile("" ::: "memory");
                    const int row = row_of(u, ai, wr, m, fr); const float rstd = rs8[ai][m];
                    bf16_t* c = CQ + (size_t)row * 384 + cb; float s = 0.f;
#pragma unroll
                    for (int bj = 0; bj < 2; ++bj)
#pragma unroll
                        for (int n = 0; n < 2; ++n) { const f32x4 x = acc[ai][bj][m][n] * rstd; s += sq4(x); st_bf16x4(c + 128 * bj + 16 * n, x); }
                    s = add_x16(s); s = add_x32(s);
                    if (fq == 0) unsafeAtomicAdd(sscq + row, s);
                }
        } else {
#pragma unroll
            for (int ai = 0; ai < 2; ++ai)
#pragma unroll
                for (int m = 0; m < 4; ++m) { if ((m & 1) == 0) asm volatile("" ::: "memory");
                    const int row = row_of(u, ai, wr, m, fr); const float rstd = rs8[ai][m];
                    const bool samp = row >= MP; const int orow = samp ? row - MP : row; const int pos = samp ? 2048 + (orow & 31) : (row & 2047);
                    bf16_t* c = CQ + (size_t)row * 384 + 256 + 32 * wc + 4 * fq; float s = 0.f;
#pragma unroll
                    for (int n = 0; n < 2; ++n) { const f32x4 x = acc[ai][0][m][n] * rstd; s += sq4(x); st_bf16x4(c + 16 * n, x); }
                    s = add_x16(s); s = add_x32(s);
                    if (fq == 0) unsafeAtomicAdd(sscq + row, s);
                    if (wc < 2) {
                        const int i0 = 16 * wc + 4 * fq; const float* rt = rope + (size_t)pos * 64;
                        const f32x4 cs = *(const f32x4*)(rt + i0), sn = *(const f32x4*)(rt + 32 + i0);
                        const f32x4 x1 = acc[ai][1][m][0] * rstd, x2 = acc[ai][1][m][1] * rstd;
                        const f32x4 o1 = x1 * cs - x2 * sn, o2 = x2 * cs + x1 * sn;
                        float* d = (samp ? krs : krp) + (size_t)orow * 64 + i0; *(f32x4*)d = o1; *(f32x4*)(d + 32) = o2;
                        bf16_t* k = KR + (size_t)row * 64 + i0; st_bf16x4(k, o1); st_bf16x4(k + 32, o2);
                    }
                }
        }
    }
};

struct EpiQ {
    static constexpr bool PERM = false, AFTER_DRAIN = false;
    const float* sscq; const float* rope; bf16_t* QM;
    __device__ __forceinline__ void operator()(const f32x4 (&acc)[2][2][4][2], const Unit& u, int wr, int wc, int fr, int fq) const {
        const int pn = u.pn;
        LOAD_RS8(rs8, sscq, 1.f / 384.f, QS_MLA)
#pragma unroll
        for (int ai = 0; ai < 2; ++ai)
#pragma unroll
            for (int m = 0; m < 4; ++m) { if ((m & 1) == 0) asm volatile("" ::: "memory");
                const int row = row_of(u, ai, wr, m, fr); const float rs = rs8[ai][m];
                bf16_t* q = QM + (size_t)row * 1536;
                if (pn < 4) {
#pragma unroll
                    for (int bj = 0; bj < 2; ++bj)
#pragma unroll
                        for (int n = 0; n < 2; ++n) st_bf16x4(q + (2 * pn + bj) * 192 + 32 * wc + 16 * n + 4 * fq, acc[ai][bj][m][n] * rs);
                } else {
                    const int pos = row >= MP ? 2048 + ((row - MP) & 31) : (row & 2047); const float* rt = rope + (size_t)pos * 64;
                    bf16_t* qh = q + (4 * (pn - 4) + wc) * 192 + 128;
#pragma unroll
                    for (int n = 0; n < 2; ++n) {
                        const int i0 = 16 * n + 4 * fq; const f32x4 cs = *(const f32x4*)(rt + i0), sn = *(const f32x4*)(rt + 32 + i0);
                        const f32x4 x1 = acc[ai][0][m][n] * rs, x2 = acc[ai][1][m][n] * rs;
                        st_bf16x4(qh + i0, x1 * cs - x2 * sn); st_bf16x4(qh + 32 + i0, x2 * cs + x1 * sn);
                    }
                }
            }
    }
};

template <bool HAS_SS> struct EpiKV {
    static constexpr bool PERM = false, AFTER_DRAIN = false;
    const float* ss; bf16_t *O0, *O1;
    __device__ __forceinline__ void operator()(const f32x4 (&acc)[2][2][4][2], const Unit& u, int wr, int wc, int fr, int fq) const {
        bf16_t* base = (u.pn < 4 ? O0 : O1) + 256 * (u.pn & 3) + 32 * wc + 4 * fq;
        float rs8[2][4];
        if constexpr (HAS_SS) { LOAD_RS8(t8, ss, 1.f / 256.f, 1.f) _Pragma("unroll") for (int a = 0; a < 2; ++a) _Pragma("unroll") for (int b = 0; b < 4; ++b) rs8[a][b] = t8[a][b]; }
#pragma unroll
        for (int ai = 0; ai < 2; ++ai)
#pragma unroll
            for (int m = 0; m < 4; ++m) { if ((m & 1) == 0) asm volatile("" ::: "memory");
                const int row = row_of(u, ai, wr, m, fr); const float rs = HAS_SS ? rs8[ai][m] : 1.f;
                bf16_t* o = base + (size_t)row * 1024;
#pragma unroll
                for (int bj = 0; bj < 2; ++bj)
#pragma unroll
                    for (int n = 0; n < 2; ++n) st_bf16x4(o + 128 * bj + 16 * n, acc[ai][bj][m][n] * rs);
            }
    }
};

struct EpiRes {
    static constexpr bool PERM = false, AFTER_DRAIN = false;
    const float* xp; const float* xs; float* X; bf16_t* HX; float* ssn;
    __device__ __forceinline__ void operator()(const f32x4 (&acc)[2][2][4][2], const Unit& u, int wr, int wc, int fr, int fq) const {
        const int cb = 256 * u.pn + 32 * wc + 4 * fq;
#pragma unroll
        for (int ai = 0; ai < 2; ++ai)
#pragma unroll
            for (int m = 0; m < 4; ++m) { if ((m & 1) == 0) asm volatile("" ::: "memory");
                const int row = row_of(u, ai, wr, m, fr);
                bf16_t* h = HX + (size_t)row * 1024 + cb; float s = 0.f;
                f32x4 xo[2][2];
                if (xp) { const float* xi = (row >= MP ? xs + (size_t)(row - MP) * 1024 : xp + (size_t)row * 1024) + cb;
#pragma unroll
                    for (int bj = 0; bj < 2; ++bj)
#pragma unroll
                        for (int n = 0; n < 2; ++n) xo[bj][n] = *(const f32x4*)(xi + 128 * bj + 16 * n); }
                else {
#pragma unroll
                    for (int bj = 0; bj < 2; ++bj)
#pragma unroll
                        for (int n = 0; n < 2; ++n) { const u32x2 w = *(const u32x2*)(h + 128 * bj + 16 * n);
                            xo[bj][n] = (f32x4){__uint_as_float(w.x << 16), __uint_as_float(w.x & 0xffff0000u), __uint_as_float(w.y << 16), __uint_as_float(w.y & 0xffff0000u)}; } }
#pragma unroll
                for (int bj = 0; bj < 2; ++bj)
#pragma unroll
                    for (int n = 0; n < 2; ++n) { const f32x4 x = xo[bj][n] + acc[ai][bj][m][n]; s += sq4(x); st_bf16x4(h + 128 * bj + 16 * n, x);
                        if (X) *(f32x4*)(X + (size_t)row * 1024 + cb + 128 * bj + 16 * n) = x; }
                s = add_x16(s); s = add_x32(s);
                if (fq == 0) unsafeAtomicAdd(ssn + row, s);
            }
    }
};

struct EpiUp {
    static constexpr bool PERM = false, AFTER_DRAIN = false;
    const float* ssx; bf16_t* U; float* cvp; float* cvs;
    __device__ __forceinline__ void operator()(const f32x4 (&acc)[2][2][4][2], const Unit& u, int wr, int wc, int fr, int fq) const {
        const int cb = 128 * u.pn + 32 * wc + 4 * fq;
        LOAD_RS8(rs8, ssx, 1.f / 1024.f, 1.f)
#pragma unroll
        for (int ai = 0; ai < 2; ++ai)
#pragma unroll
            for (int m = 0; m < 4; ++m) { if ((m & 1) == 0) asm volatile("" ::: "memory");
                const int row = row_of(u, ai, wr, m, fr); const float rstd = rs8[ai][m];
                bf16_t* o = U + (size_t)row * NUP + cb;
                float* cv = nullptr;
                if (row >= MP) { const int r = row - MP, s = r & 31; if (s >= 30) cv = cvs + ((size_t)(r >> 5) * 2 + (s - 30)) * NUP + cb; }
                else { const int s = row & 2047; if (s >= 2046) cv = cvp + ((size_t)(row >> 11) * 2 + (s - 2046)) * NUP + cb; }
#pragma unroll
                for (int bj = 0; bj < 2; ++bj)
#pragma unroll
                    for (int n = 0; n < 2; ++n) { const f32x4 x = acc[ai][bj][m][n] * rstd; st_bf16x4(o + DFF * bj + 16 * n, x); if (cv) *(f32x4*)(cv + DFF * bj + 16 * n) = x; }
            }
    }
};
struct KVD { const bf16_t* k; const bf16_t* k2; const bf16_t* v; int kp, k2p, vp; };
constexpr int ATT_KBUF = 64 * 400, ATT_VOFF = 2 * ATT_KBUF, ATT_VIMG = 32 * 320, ATT_VBUF = 2 * ATT_VIMG;

template <int DQK>
__device__ __forceinline__ void attn_pass(LAS unsigned char* lds, const int wid, const bf16_t* qrow, const KVD& dm, const KVD& dl, int nmain, int ntw, int ntc, f32x16 (&o)[4], float& linv) {
    constexpr int NCH = DQK / 8, KST = DQK * 2 + 16, NKI = NCH / 8, NS = DQK / 16;
    const int lane = LANE_ID(), tid = (wid << 6) | lane, r32 = lane & 31, hi = lane >> 5;
    bf16x8 q[NS];
#pragma unroll
    for (int s = 0; s < NS; ++s) q[s] = *(const bf16x8*)(qrow + 16 * s + 8 * hi);
    u32x4 kr[NKI], vr[2];
#define ATT_GLOADK(t) do { const bool lastt = (t) >= nmain; const KVD& d = lastt ? dl : dm; const int rb = lastt ? 0 : (t) * 64; const int rm = lastt ? 31 : 63; \
        _Pragma("unroll") for (int i = 0; i < NKI; ++i) { const int id = tid + 512 * i, kro = id / NCH, kc = id - kro * NCH; const int r = rb + (kro & rm); \
            kr[i] = (DQK == 64 || kc < 16) ? *(const u32x4*)(d.k + (size_t)r * d.kp + kc * 8) : *(const u32x4*)(d.k2 + (size_t)r * d.k2p + (kc - 16) * 8); } } while (0)
#define ATT_GLOADV(t) do { const bool lastt = (t) >= nmain; const KVD& d = lastt ? dl : dm; const int rb = lastt ? 0 : (t) * 64; const int rm = lastt ? 31 : 63; \
        _Pragma("unroll") for (int i = 0; i < 2; ++i) { const int r = rb + (((tid >> 4) + 32 * i) & rm); vr[i] = *(const u32x4*)(d.v + (size_t)r * d.vp + (tid & 15) * 8); } } while (0)
#define ATT_LSTORE(b) do { \
        _Pragma("unroll") for (int i = 0; i < NKI; ++i) { const int id = tid + 512 * i, kro = id / NCH, kc = id - kro * NCH; *(LAS u32x4*)(lds + (b) * ATT_KBUF + kro * KST + kc * 16) = kr[i]; } \
        _Pragma("unroll") for (int i = 0; i < 2; ++i) *(LAS u32x4*)(lds + ATT_VOFF + (b) * ATT_VBUF + i * ATT_VIMG + (tid >> 4) * 320 + (tid & 15) * 16) = vr[i]; } while (0)
    ATT_GLOADK(0); ATT_GLOADV(0); ATT_LSTORE(0); __syncthreads();
    float m_run = -INFINITY, l_run = 0.f;
#pragma unroll
    for (int c = 0; c < 4; ++c)
#pragma unroll
        for (int r = 0; r < 16; ++r) o[c][r] = 0.f;
    const int vlane = (4 * hi + ((lane & 15) >> 2)) * 320 + (2 * ((lane >> 4) & 1) + ((lane & 3) >> 1)) * 16 + 8 * (lane & 1);
    for (int t = 0; t < ntw; ++t) {
        if (t + 1 < ntw) ATT_GLOADK(t + 1);
        bool vloaded = false;
        if (t < ntc) {
            const LAS unsigned char* kb = lds + (t & 1) * ATT_KBUF + r32 * KST + hi * 16;
            const LAS unsigned char* vb = lds + ATT_VOFF + (t & 1) * ATT_VBUF;
            f32x16 p0, p1;
#pragma unroll
            for (int r = 0; r < 16; ++r) { p0[r] = 0.f; p1[r] = 0.f; }
#pragma unroll
            for (int s = 0; s < NS; ++s) {
                const bf16x8 k0 = *(const LAS bf16x8*)(kb + s * 32), k1 = *(const LAS bf16x8*)(kb + 32 * KST + s * 32);
                p0 = __builtin_amdgcn_mfma_f32_32x32x16_bf16(k0, q[s], p0, 0, 0, 0);
                p1 = __builtin_amdgcn_mfma_f32_32x32x16_bf16(k1, q[s], p1, 0, 0, 0);
            }
            if (t >= nmain) {
#pragma unroll
                for (int r = 0; r < 16; ++r) p1[r] = -INFINITY;
            }
            float mt = fmaxf(p0[0], p1[0]);
#pragma unroll
            for (int r = 1; r < 16; ++r) mt = fmaxf(mt, fmaxf(p0[r], p1[r]));
            mt = max_x32(mt);
            const float mn = fmaxf(m_run, mt), alpha = fast_exp2(m_run - mn); m_run = mn;
            float rs = 0.f;
#pragma unroll
            for (int r = 0; r < 16; ++r) { p0[r] = fast_exp2(p0[r] - mn); p1[r] = fast_exp2(p1[r] - mn); rs += p0[r] + p1[r]; }
            l_run = l_run * alpha + rs;
#pragma unroll
            for (int c = 0; c < 4; ++c)
#pragma unroll
                for (int r = 0; r < 16; ++r) o[c][r] *= alpha;
            asm volatile("" ::: "memory");
            if (t + 1 < ntw) { ATT_GLOADV(t + 1); vloaded = true; }
            bf16x8 pf[2][2];
#pragma unroll
            for (int ks = 0; ks < 2; ++ks) {
                u32x4 a, b;
                a.x = cvt_pk_bf16(p0[8 * ks + 0], p0[8 * ks + 1]); a.y = cvt_pk_bf16(p0[8 * ks + 2], p0[8 * ks + 3]); a.z = cvt_pk_bf16(p0[8 * ks + 4], p0[8 * ks + 5]); a.w = cvt_pk_bf16(p0[8 * ks + 6], p0[8 * ks + 7]);
                b.x = cvt_pk_bf16(p1[8 * ks + 0], p1[8 * ks + 1]); b.y = cvt_pk_bf16(p1[8 * ks + 2], p1[8 * ks + 3]); b.z = cvt_pk_bf16(p1[8 * ks + 4], p1[8 * ks + 5]); b.w = cvt_pk_bf16(p1[8 * ks + 6], p1[8 * ks + 7]);
                pf[0][ks] = __builtin_bit_cast(bf16x8, a); pf[1][ks] = __builtin_bit_cast(bf16x8, b);
            }
#pragma unroll
            for (int c = 0; c < 4; ++c)
#pragma unroll
                for (int kbk = 0; kbk < 2; ++kbk)
#pragma unroll
                    for (int ks = 0; ks < 2; ++ks) {
                        const LAS unsigned char* a0 = vb + vlane + kbk * ATT_VIMG + (16 * ks) * 320 + c * 64;
                        const v4i16_t t0 = __builtin_amdgcn_ds_read_tr16_b64_v4i16((LAS v4i16_t*)a0);
                        const v4i16_t t1 = __builtin_amdgcn_ds_read_tr16_b64_v4i16((LAS v4i16_t*)(a0 + 8 * 320));
                        const bf16x8 vf = (bf16x8){t0[0], t0[1], t0[2], t0[3], t1[0], t1[1], t1[2], t1[3]};
                        o[c] = __builtin_amdgcn_mfma_f32_32x32x16_bf16(vf, pf[kbk][ks], o[c], 0, 0, 0);
                    }
        }
        if (t + 1 < ntw) { if (!vloaded) ATT_GLOADV(t + 1); ATT_LSTORE((t + 1) & 1); }
        __syncthreads();
    }
    const float lt = add_x32(l_run);
    linv = fast_rcp(lt);
#undef ATT_GLOADK
#undef ATT_GLOADV
#undef ATT_LSTORE
}

struct AttnCtx { unsigned char* ws; const float* gda; float lam, lam1m; unsigned* counter; int l; };
constexpr int ATT_NUNITS = 128 + 2048;
__device__ __forceinline__ void attn_phase(LAS unsigned char* lds, const AttnCtx& C, const int wid) {
#define TID_NOW() LANE_ID()
    LAS unsigned* ubox = (LAS unsigned*)(lds + 131072);
    const bf16_t* QDA = (const bf16_t*)(C.ws + W_QDA); const bf16_t* KDA = (const bf16_t*)(C.ws + W_KDA); const bf16_t* VDA = (const bf16_t*)(C.ws + W_VDA);
    const bf16_t* GG = (const bf16_t*)(C.ws + W_G); bf16_t* MRG = (bf16_t*)(C.ws + W_MRG);
    for (;;) {
        if (wid == 0 && TID_NOW() == 0) ubox[0] = atomicAdd(C.counter, 1u);
        __syncthreads();
        const int un = (int)ubox[0];
        __syncthreads();
        if (un >= ATT_NUNITS) break;
        const bool samp = un < 128;
        int b, h, qb = 0;
        if (samp) { b = un >> 3; h = un & 7; } else { const int v = un - 128; qb = 7 - (v >> 8); b = (v & 255) >> 3; h = v & 7; }
        const int row = samp ? MP + b * 32 + (TID_NOW() & 31) : b * 2048 + qb * 256 + wid * 32 + (TID_NOW() & 31);
        const int ntw = samp ? 33 : 4 * qb + 4, nmain = samp ? 32 : ntw, ntc = samp ? (wid == 0 ? 33 : 0) : 4 * qb + (wid >> 1) + 1;
        const size_t kr0 = (size_t)b * 2048;
        const size_t fr0 = (size_t)MP + b * 32;
        const size_t coff = (size_t)C.l * MC;
        f32x16 o[4]; float linv;
#ifndef NO_DIFF
        {
            unsigned o1[32];
#pragma unroll 1
            for (int st = 0; st < 2; ++st) {
                KVD dm, dl;
                const bf16_t* Kb = samp ? (const bf16_t*)(C.ws + W_KC) + coff * 1024 : KDA; const bf16_t* Vb = samp ? (const bf16_t*)(C.ws + W_VC) + coff * 1024 : VDA;
                dm.k = Kb + kr0 * 1024 + h * 128 + st * 64; dm.k2 = dm.k; dm.v = Vb + kr0 * 1024 + h * 128; dm.kp = 1024; dm.k2p = 1024; dm.vp = 1024;
                dl.k = KDA + fr0 * 1024 + h * 128 + st * 64; dl.k2 = dl.k; dl.v = VDA + fr0 * 1024 + h * 128; dl.kp = 1024; dl.k2p = 1024; dl.vp = 1024;
                attn_pass<64>(lds, wid, QDA + (size_t)row * 1024 + h * 128 + st * 64, dm, dl, nmain, ntw, ntc, o, linv);
                if (st == 0) {
#pragma unroll
                    for (int c = 0; c < 4; ++c)
#pragma unroll
                        for (int r = 0; r < 16; r += 2) o1[c * 8 + (r >> 1)] = cvt_pk_bf16(o[c][r] * linv, o[c][r + 1] * linv);
                }
            }
            if (ntc > 0) {
                int rowe = row; asm volatile("" : "+v"(rowe));
                const int hi = (TID_NOW() >> 5) & 1;
                const float ll = C.lam * linv; float ss = 0.f;
#pragma unroll
                for (int c = 0; c < 4; ++c)
#pragma unroll
                    for (int r = 0; r < 16; r += 2) { const unsigned w = o1[c * 8 + (r >> 1)];
                        const float x0 = __uint_as_float(w << 16) - ll * o[c][r], x1 = __uint_as_float(w & 0xffff0000u) - ll * o[c][r + 1]; o[c][r] = x0; o[c][r + 1] = x1; ss += x0 * x0 + x1 * x1; }
                ss = add_x32(ss);
                const float rn = rsqrtf(ss * (1.f / 128.f) + EPS) * C.lam1m;
                const bf16_t* ga = GG + (size_t)rowe * 2048 + h * 128; bf16_t* mo = MRG + (size_t)rowe * 1024 + h * 128;
#pragma unroll
                for (int c = 0; c < 4; ++c)
#pragma unroll
                    for (int g = 0; g < 4; ++g) {
                        const int d0 = 32 * c + 8 * g + 4 * hi;
                        const u32x2 gw = *(const u32x2*)(ga + d0); const f32x4 gd = *(const f32x4*)(C.gda + d0);
                        const float g0 = __uint_as_float(gw.x << 16), g1 = __uint_as_float(gw.x & 0xffff0000u), g2 = __uint_as_float(gw.y << 16), g3 = __uint_as_float(gw.y & 0xffff0000u);
                        f32x4 r; r[0] = o[c][4 * g + 0] * rn * gd[0] * g0; r[1] = o[c][4 * g + 1] * rn * gd[1] * g1; r[2] = o[c][4 * g + 2] * rn * gd[2] * g2; r[3] = o[c][4 * g + 3] * rn * gd[3] * g3;
                        st_bf16x4(mo + d0, r);
                    }
            }
        }
#endif
#ifndef NO_MLA
        {
            KVD dm, dl;
            const bf16_t* KN = (const bf16_t*)(C.ws + W_KN); const bf16_t* VM = (const bf16_t*)(C.ws + W_VM); const bf16_t* KR = (const bf16_t*)(C.ws + W_KR);
            dm.k = (samp ? (const bf16_t*)(C.ws + W_KNC) + coff * 1024 : KN) + kr0 * 1024 + h * 128; dm.k2 = (samp ? (const bf16_t*)(C.ws + W_KRC) + coff * 64 : KR) + kr0 * 64;
            dm.v = (samp ? (const bf16_t*)(C.ws + W_VMC) + coff * 1024 : VM) + kr0 * 1024 + h * 128; dm.kp = 1024; dm.k2p = 64; dm.vp = 1024;
            dl.k = KN + fr0 * 1024 + h * 128; dl.k2 = KR + fr0 * 64; dl.v = VM + fr0 * 1024 + h * 128; dl.kp = 1024; dl.k2p = 64; dl.vp = 1024;
            attn_pass<192>(lds, wid, (const bf16_t*)(C.ws + W_QM) + (size_t)row * 1536 + h * 192, dm, dl, nmain, ntw, ntc, o, linv);
            if (ntc > 0) {
                int rowe = row; asm volatile("" : "+v"(rowe));
                const int hi = (TID_NOW() >> 5) & 1;
                const bf16_t* gb = GG + (size_t)rowe * 2048 + 1024 + h * 128; bf16_t* mo = MRG + (size_t)rowe * 1024 + h * 128;
#pragma unroll
                for (int c = 0; c < 4; ++c)
#pragma unroll
                    for (int g = 0; g < 4; ++g) {
                        const int d0 = 32 * c + 8 * g + 4 * hi;
                        const u32x2 gw = *(const u32x2*)(gb + d0); const u32x2 xw = *(const u32x2*)(mo + d0);
                        const float g0 = __uint_as_float(gw.x << 16), g1 = __uint_as_float(gw.x & 0xffff0000u), g2 = __uint_as_float(gw.y << 16), g3 = __uint_as_float(gw.y & 0xffff0000u);
                        f32x4 r;
                        r[0] = __uint_as_float(xw.x << 16) + g0 * o[c][4 * g + 0] * linv; r[1] = __uint_as_float(xw.x & 0xffff0000u) + g1 * o[c][4 * g + 1] * linv;
                        r[2] = __uint_as_float(xw.y << 16) + g2 * o[c][4 * g + 2] * linv; r[3] = __uint_as_float(xw.y & 0xffff0000u) + g3 * o[c][4 * g + 3] * linv;
                        st_bf16x4(mo + d0, r);
                    }
            }
        }
#endif
    }
}
__device__ __forceinline__ float wave_sum(float v) {
#pragma unroll
    for (int o = 1; o < 64; o <<= 1) v += __shfl_xor(v, o);
    return v;
}
__device__ __forceinline__ unsigned f2bf(float f) { unsigned u = __float_as_uint(f); return (u + 0x7fffu + ((u >> 16) & 1u)) >> 16; }
__device__ __forceinline__ unsigned pk2(float lo, float hi) { return f2bf(lo) | (f2bf(hi) << 16); }
__device__ __forceinline__ int ropemap(int v) { return 64 * ((v >> 5) & 3) + 32 * (v >> 7) + (v & 31); }

__device__ __forceinline__ void prep_weights(const Params& P, LAS unsigned char* lds, int gw, int ngw, int wave, int lane) {
    LAS float* scr = (LAS float*)(lds + wave * 8704);
    constexpr int IT0 = 16 * (NIN / 32), IT1 = 6 * (NQ / 32), IT2 = 4 * (NKV / 32), IT4 = 16 * 32, IT5 = 16 * (NUP / 32), IT6 = 44 * 32;
    constexpr int ITL = IT0 + IT1 + 2 * IT2 + IT4 + IT5 + IT6;
    for (int it = gw; it < 2 * ITL; it += ngw) {
        const int l = it / ITL; int r = it - l * ITL;
        int mat;
        if (r < IT0) mat = 0; else if ((r -= IT0) < IT1) mat = 1; else if ((r -= IT1) < IT2) mat = 2; else if ((r -= IT2) < IT2) mat = 3;
        else if ((r -= IT2) < IT4) mat = 4; else if ((r -= IT4) < IT5) mat = 5; else { r -= IT5; mat = 6; }
        const float* W; const float* gk = nullptr; bf16_t* WT; int K, NN; long stride;
        switch (mat) {
            case 0: W = P.in[8] + (size_t)l * 1024 * INC; gk = P.in[7] + l * 1024; WT = (bf16_t*)(P.ws + W_WIN) + (size_t)l * NIN * 1024; K = 1024; NN = NIN; stride = INC; break;
            case 1: W = P.in[16] + (size_t)l * QL * NQ; gk = P.in[15] + l * QL; WT = (bf16_t*)(P.ws + W_WQ) + (size_t)l * NQ * QL; K = QL; NN = NQ; stride = NQ; break;
            case 2: W = nullptr; gk = P.in[17] + l * KVL; WT = (bf16_t*)(P.ws + W_WKV) + (size_t)l * NKV * KVL; K = KVL; NN = NKV; stride = 128; break;
            case 3: W = nullptr; WT = (bf16_t*)(P.ws + W_WKVC) + (size_t)l * NKV * KVL; K = KVL; NN = NKV; stride = 128; break;
            case 4: W = P.in[20] + (size_t)l * 1024 * 1024; WT = (bf16_t*)(P.ws + W_WO) + (size_t)l * 1024 * 1024; K = 1024; NN = 1024; stride = 1024; break;
            case 5: W = P.in[22] + (size_t)l * 1024 * NUP; gk = P.in[21] + l * 1024; WT = (bf16_t*)(P.ws + W_WUP) + (size_t)l * NUP * 1024; K = 1024; NN = NUP; stride = NUP; break;
            default: W = P.in[25] + (size_t)l * DFF * 1024; WT = (bf16_t*)(P.ws + W_WDN) + (size_t)l * 1024 * DFF; K = DFF; NN = 1024; stride = 1024; break;
        }
        const int nblk = NN / 32, kb = r / nblk, nb = r - kb * nblk, k0 = 64 * kb, n0 = 32 * nb;
        const int np = n0 + (lane & 31); long off = -1;
        {
            const int tile = np >> 8, v = np & 255;
            switch (mat) {
                case 0:
                    if (tile < 4) off = 256 * tile + ropemap(v);
                    else if (tile < 8) off = 1024 + 256 * (tile - 4) + ropemap(v);
                    else if (tile < 12) off = 2048 + 256 * (tile - 8) + v;
                    else if (tile < 20) off = 3776 + 256 * (tile - 12) + v;
                    else if (tile == 20) off = 3456 + v;
                    else if (tile == 21) off = 3072 + v;
                    else { if (v < 128) off = 3072 + 256 + v; else { const int w = v - 128, wc = w >> 5; if (wc < 2) off = 3712 + 32 * ((w >> 4) & 1) + 16 * wc + (w & 15); } }
                    break;
                case 1:
                    if (tile < 4) off = (np >> 7) * 192 + (np & 127);
                    else { const int hh = 4 * (tile - 4) + ((v >> 5) & 3); off = hh * 192 + 128 + 32 * (v >> 7) + (v & 31); }
                    break;
                case 2: case 3: {
                    const int c = np & 1023, hh = c >> 7, n = c & 127;
                    W = (np < 1024 ? P.in[18] : P.in[19]) + (size_t)l * 8 * 256 * 128; off = (long)hh * 32768 + n; } break;
                case 5: off = (v < 128) ? 128 * tile + v : DFF + 128 * tile + (v - 128); break;
                default: off = np; break;
            }
        }
#pragma unroll 8
        for (int i = 0; i < 32; ++i) { const int kk = 2 * i + (lane >> 5); float v = 0.f;
            if (off >= 0) { v = W[(size_t)(k0 + kk) * stride + off]; if (gk) v *= gk[k0 + kk]; }
            scr[kk * 33 + (lane & 31)] = v; }
        asm volatile("s_waitcnt lgkmcnt(0)" ::: "memory");
        const int c = lane & 7;
#pragma unroll
        for (int j = 0; j < 4; ++j) { const int n = (lane >> 3) + 8 * j; const LAS float* s = scr + (8 * c) * 33 + n;
            u32x4 o; o.x = pk2(s[0 * 33], s[1 * 33]); o.y = pk2(s[2 * 33], s[3 * 33]); o.z = pk2(s[4 * 33], s[5 * 33]); o.w = pk2(s[6 * 33], s[7 * 33]);
            *(u32x4*)(WT + (size_t)(n0 + n) * K + k0 + 8 * c) = o; }
        asm volatile("s_waitcnt lgkmcnt(0)" ::: "memory");
    }
}

__device__ __forceinline__ void sincos_f(float a, float& s, float& c) {
    const float n = rintf(a * 0.6366197723675814f);
    float r = fmaf(-n, 1.5703125f, a); r = fmaf(-n, 4.837512969970703125e-4f, r); r = fmaf(-n, 7.54978995489188e-8f, r);
    const float r2 = r * r;
    const float sp = r + r * r2 * (-1.6666666667e-1f + r2 * (8.3333333333e-3f + r2 * (-1.9841269841e-4f + r2 * 2.7557319224e-6f)));
    const float cp = 1.f + r2 * (-0.5f + r2 * (4.1666666667e-2f + r2 * (-1.3888888889e-3f + r2 * (2.4801587302e-5f + r2 * -2.7557319224e-7f))));
    const int qd = ((int)n) & 3;
    s = (qd == 0) ? sp : (qd == 1) ? cp : (qd == 2) ? -sp : -cp;
    c = (qd == 0) ? cp : (qd == 1) ? -sp : (qd == 2) ? -cp : sp;
}

__device__ __forceinline__ void cvt_stream(const float* src, bf16_t* dst, size_t n8, size_t gt, size_t ngt) {
    for (size_t i = gt; i < n8; i += ngt) { const f32x4 a = *(const f32x4*)(src + i * 8), b = *(const f32x4*)(src + i * 8 + 4);
        u32x4 o; o.x = cvt_pk_bf16(a[0], a[1]); o.y = cvt_pk_bf16(a[2], a[3]); o.z = cvt_pk_bf16(b[0], b[1]); o.w = cvt_pk_bf16(b[2], b[3]); *(u32x4*)(dst + i * 8) = o; }
}

__device__ __forceinline__ void conv_phase(const Params& P, int l, size_t gt, size_t ngt) {
    const bf16_t* U = (const bf16_t*)(P.ws + W_U); bf16_t* ACT = (bf16_t*)(P.ws + W_ACT);
    const float* wc = P.in[23] + (size_t)l * 3 * NUP; const float* bc = P.in[24] + (size_t)l * NUP; const float* stc = P.in[6] + (size_t)l * 16 * 2 * NUP;
    constexpr int NCC = DFF / 8, NRB = MT / 32;
    for (size_t it = gt; it < (size_t)NRB * NCC; it += ngt) {
        const int rb = (int)(it / NCC), cc = (int)(it - (size_t)rb * NCC), r0 = rb * 32, j0 = cc * 8;
        float w[2][4][8];
#pragma unroll
        for (int gv = 0; gv < 2; ++gv)
#pragma unroll
            for (int k = 0; k < 4; ++k) { const float* p = (k < 3 ? wc + (size_t)k * NUP : bc) + gv * DFF + j0; const f32x4 a = *(const f32x4*)p, b = *(const f32x4*)(p + 4);
#pragma unroll
                for (int e = 0; e < 4; ++e) { w[gv][k][e] = a[e]; w[gv][k][4 + e] = b[e]; } }
        float u1[2][8], u2[2][8];
        const bool samp = r0 >= MP; const bool seq0 = samp || ((r0 & 2047) == 0);
#pragma unroll
        for (int gv = 0; gv < 2; ++gv) {
            if (seq0) {
                if (samp) { const float* s0 = stc + (unsigned)(((r0 - MP) >> 5) * 2 * NUP + gv * DFF + j0);
#pragma unroll
                    for (int e = 0; e < 8; ++e) { u2[gv][e] = s0[e]; u1[gv][e] = s0[NUP + e]; } }
                else {
#pragma unroll
                    for (int e = 0; e < 8; ++e) { u2[gv][e] = 0.f; u1[gv][e] = 0.f; } }
            } else {
                const unsigned ua = (unsigned)(r0 - 2) * (unsigned)NUP + (unsigned)(gv * DFF + j0); const u32x4 a = *(const u32x4*)(U + ua), b = *(const u32x4*)(U + (ua + (unsigned)NUP));
#pragma unroll
                for (int e = 0; e < 4; ++e) { u2[gv][2 * e] = __uint_as_float(a[e] << 16); u2[gv][2 * e + 1] = __uint_as_float(a[e] & 0xffff0000u);
                                              u1[gv][2 * e] = __uint_as_float(b[e] << 16); u1[gv][2 * e + 1] = __uint_as_float(b[e] & 0xffff0000u); }
            }
        }
#pragma unroll 4
        for (int r = 0; r < 32; ++r) {
            const unsigned uo = (unsigned)(r0 + r) * (unsigned)NUP + (unsigned)j0; const u32x4 ug = *(const u32x4*)(U + uo), uv = *(const u32x4*)(U + (uo + (unsigned)DFF));
            float res[8];
#pragma unroll
            for (int e = 0; e < 8; ++e) {
                const float g0 = (e & 1) ? __uint_as_float(ug[e >> 1] & 0xffff0000u) : __uint_as_float(ug[e >> 1] << 16);
                const float v0 = (e & 1) ? __uint_as_float(uv[e >> 1] & 0xffff0000u) : __uint_as_float(uv[e >> 1] << 16);
                const float cg = w[0][3][e] + w[0][0][e] * u2[0][e] + w[0][1][e] * u1[0][e] + w[0][2][e] * g0;
                const float cv = w[1][3][e] + w[1][0][e] * u2[1][e] + w[1][1][e] * u1[1][e] + w[1][2][e] * v0;
                u2[0][e] = u1[0][e]; u1[0][e] = g0; u2[1][e] = u1[1][e]; u1[1][e] = v0;
                res[e] = cg * sigmoidf_(cg) * cv;
            }
            u32x4 o; o.x = cvt_pk_bf16(res[0], res[1]); o.y = cvt_pk_bf16(res[2], res[3]); o.z = cvt_pk_bf16(res[4], res[5]); o.w = cvt_pk_bf16(res[6], res[7]);
            *(u32x4*)(ACT + ((unsigned)(r0 + r) * (unsigned)DFF + (unsigned)j0)) = o;
        }
    }
}
constexpr int LDS_BYTES = 147456;
template <class Epi> __device__ __forceinline__ void run_gemm(LAS unsigned char* lds, const int wid, const bf16_t* A, const bf16_t* Bt, int M, int N, int K, const Epi& E) {
    int gx = (int)gridDim.x, bx = (int)blockIdx.x, wv = wid; asm volatile("" : "+s"(gx), "+s"(bx), "+s"(wv));
    pg8::Gemm g{A, Bt, M, N, K}; pg8::StaticOrder S; S.init(M, N, gx, bx);
#ifndef NO_GEMM
    pg8::gemm_phase<Epi, pg8::StaticOrder, PG8_ALIGN, PG8_SP2>(lds, g, S, E, wv);
#endif
}

__global__ void __launch_bounds__(512, 2) fwd_megakernel(Params P) {
    extern __shared__ __attribute__((aligned(16))) unsigned char lds_raw[];
    LAS unsigned char* lds = (LAS unsigned char*)lds_raw;
    cg::grid_group grid = cg::this_grid();
    const int wave_s = __builtin_amdgcn_readfirstlane((int)threadIdx.x >> 6);
#define TID_DEFS const int lane = LANE_ID(), wave = wave_s, tid = (wave << 6) | lane; \
    const int G = gridDim.x, gw = blockIdx.x * 8 + wave, ngw = G * 8; const size_t gt = (size_t)blockIdx.x * 512 + tid, ngt = (size_t)G * 512; (void)lane; (void)gw; (void)ngw; (void)gt; (void)ngt;
    unsigned char* ws = P.ws; float* out = P.out;
#define gbar() do { asm volatile("s_waitcnt vmcnt(0) lgkmcnt(0)" ::: "memory"); __syncthreads(); bar_gen += gridDim.x; \
        if (wave_s == 0 && LANE_ID() == 0) { asm volatile("buffer_wbl2 sc1\n\ts_waitcnt vmcnt(0) lgkmcnt(0)" ::: "memory"); __threadfence(); asm volatile("s_waitcnt vmcnt(0) lgkmcnt(0)" ::: "memory"); \
            __hip_atomic_fetch_add(ctl + 128, 1u, __ATOMIC_RELAXED, __HIP_MEMORY_SCOPE_AGENT); \
            while (__hip_atomic_load(ctl + 128, __ATOMIC_RELAXED, __HIP_MEMORY_SCOPE_AGENT) < bar_gen) __builtin_amdgcn_s_sleep(2); } \
        __syncthreads(); __threadfence(); asm volatile("buffer_inv sc1\n\ts_waitcnt vmcnt(0) lgkmcnt(0)" ::: "memory"); } while (0)
#ifdef PROBE_SEL
    unsigned long long pr_acc = 0, pr_t0 = 0;
#define PR_BEGIN(c) do { if ((PROBE_SEL >> (c)) & 1) pr_t0 = __builtin_amdgcn_s_memrealtime(); } while (0)
#define PR_END(c) do { if ((PROBE_SEL >> (c)) & 1) pr_acc += __builtin_amdgcn_s_memrealtime() - pr_t0; } while (0)
#else
#define PR_BEGIN(c)
#define PR_END(c)
#endif
#define OPAQ() do { unsigned a_ = (unsigned)(uintptr_t)P.ws, b_ = (unsigned)((uintptr_t)P.ws >> 32), c_ = (unsigned)(uintptr_t)P.out, d_ = (unsigned)((uintptr_t)P.out >> 32); \
        asm volatile("" : "+s"(a_), "+s"(b_), "+s"(c_), "+s"(d_)); ws = (unsigned char*)(((uintptr_t)b_ << 32) | a_); out = (float*)(((uintptr_t)d_ << 32) | c_); } while (0)
    unsigned* ctl = (unsigned*)(ws + W_CTL); float* ctlf = (float*)(ws + W_CTL);
    float* rope = (float*)(ws + W_ROPE); float* SS = (float*)(ws + W_SS);
#define B_HX ((bf16_t*)(ws + W_HX))
#define B_X ((float*)(ws + W_X))
#define B_QDA ((bf16_t*)(ws + W_QDA))
#define B_KDA ((bf16_t*)(ws + W_KDA))
#define B_VDA ((bf16_t*)(ws + W_VDA))
#define B_GG ((bf16_t*)(ws + W_G))
#define B_CKV ((bf16_t*)(ws + W_CKV))
#define B_CQ ((bf16_t*)(ws + W_CQ))
#define B_KR ((bf16_t*)(ws + W_KR))
#define B_QM ((bf16_t*)(ws + W_QM))
#define B_KN ((bf16_t*)(ws + W_KN))
#define B_VM ((bf16_t*)(ws + W_VM))
#define B_MRG ((bf16_t*)(ws + W_MRG))
#define B_U ((bf16_t*)(ws + W_U))
#define B_ACT ((bf16_t*)(ws + W_ACT))
#define B_KC ((bf16_t*)(ws + W_KC))
#define B_VC ((bf16_t*)(ws + W_VC))
#define B_KRC ((bf16_t*)(ws + W_KRC))
#define B_CKVC ((bf16_t*)(ws + W_CKVC))
#define B_KNC ((bf16_t*)(ws + W_KNC))
#define B_VMC ((bf16_t*)(ws + W_VMC))
    PR_BEGIN(0);
    {
    TID_DEFS
#ifndef NO_PREP
    prep_weights(P, lds, gw, ngw, wave, lane);
#endif
    for (size_t idx = gt; idx < (size_t)2080 * 32; idx += ngt) {
        const int pos = (int)(idx >> 5), i = (int)(idx & 31);
        double inv = 1.0; for (int k = 0; k < i; ++k) inv *= 0.74989420933245582730;
        const double ang = (double)pos * inv; const double n = __builtin_rint(ang * 0.63661977236758134308);
        double r = __builtin_fma(-n, 1.57079632679489655800, ang); r = __builtin_fma(-n, 6.12323399573676603587e-17, r);
        const float rf = (float)r, r2 = rf * rf;
        const float sp = rf + rf * r2 * (-1.6666666667e-1f + r2 * (8.3333333333e-3f + r2 * (-1.9841269841e-4f + r2 * 2.7557319224e-6f)));
        const float cp = 1.f + r2 * (-0.5f + r2 * (4.1666666667e-2f + r2 * (-1.3888888889e-3f + r2 * (2.4801587302e-5f + r2 * -2.7557319224e-7f))));
        const int qd = ((int)n) & 3;
        rope[(size_t)pos * 64 + 32 + i] = (qd == 0) ? sp : (qd == 1) ? cp : (qd == 2) ? -sp : -cp;
        rope[(size_t)pos * 64 + i] = (qd == 0) ? cp : (qd == 1) ? -sp : (qd == 2) ? -cp : sp;
    }
    for (size_t idx = gt; idx < (size_t)8 * MT; idx += ngt) SS[MT + idx] = 0.f;
    if (blockIdx.x == 0 && tid < 64) {
        if (tid < 5) __hip_atomic_store(ctl + (tid == 4 ? 128 : tid * 16), 0u, __ATOMIC_RELAXED, __HIP_MEMORY_SCOPE_AGENT);
        for (int l = 0; l < 2; ++l) {
        OPAQ();
            const float a = wave_sum(P.in[10][l * 64 + lane] * P.in[11][l * 64 + lane]), b = wave_sum(P.in[12][l * 64 + lane] * P.in[13][l * 64 + lane]);
            const float li = 0.8f - 0.6f * expf(-0.3f * (float)l);
            if (lane == 0) { ctlf[64 + 2 * l] = expf(a) - expf(b) + li; ctlf[65 + 2 * l] = 1.f - li; }
        }
    }
    for (int row = gw; row < MT; row += ngw) {
        const float* xr = (row >= MP ? P.in[1] + (size_t)(row - MP) * 1024 : P.in[0] + (size_t)row * 1024); float s = 0.f;
#pragma unroll
        for (int j = 0; j < 4; ++j) { const f32x4 v = *(const f32x4*)(xr + 256 * j + 4 * lane); s += sq4(v); st_bf16x4(B_HX + (size_t)row * 1024 + 256 * j + 4 * lane, v); }
        s = wave_sum(s); if (lane == 0) SS[row] = s;
    }
    cvt_stream(P.in[2], B_KC, (size_t)2 * MC * 1024 / 8, gt, ngt);
    cvt_stream(P.in[3], B_VC, (size_t)2 * MC * 1024 / 8, gt, ngt);
    cvt_stream(P.in[4], B_CKVC, (size_t)2 * MC * 256 / 8, gt, ngt);
    cvt_stream(P.in[5], B_KRC, (size_t)2 * MC * 64 / 8, gt, ngt);
    }
    __threadfence(); asm volatile("buffer_wbl2 sc1\n\ts_waitcnt vmcnt(0) lgkmcnt(0)" ::: "memory");
    grid.sync();
    __threadfence(); asm volatile("buffer_inv sc1\n\ts_waitcnt vmcnt(0) lgkmcnt(0)" ::: "memory");
    unsigned bar_gen = 0;
    PR_END(0);

#pragma unroll 1
    for (int l = 0; l < 2; ++l) {
        OPAQ();
        float* ssx_attn = SS + (size_t)(2 * l) * MT; float* ssx_ffn = SS + (size_t)(2 * l + 1) * MT; float* ssx_next = SS + (size_t)(2 * l + 2) * MT;
        float* sscq = SS + (size_t)(5 + l) * MT; float* ssckv = SS + (size_t)(7 + l) * MT;
        float* ckp = out + O_CKVP + (size_t)l * MP * 256; float* cks = out + O_CKVS + (size_t)l * MSMP * 256;
        PR_BEGIN(1);
        {
            EpiInProj E; E.ws = ws; E.out = out; E.bgate = P.in[9] + (size_t)l * 2048; E.l = l;
            run_gemm(lds, wave_s, B_HX, (const bf16_t*)(ws + W_WIN) + (size_t)l * NIN * 1024, MT, NIN, 1024, E);
        }
        gbar(); OPAQ();
        PR_END(1);
        PR_BEGIN(2);
        {
            EpiQ E; E.sscq = sscq; E.rope = rope; E.QM = B_QM;
            run_gemm(lds, wave_s, B_CQ, (const bf16_t*)(ws + W_WQ) + (size_t)l * NQ * QL, MT, NQ, QL, E);
        }
        {
            EpiKV<true> E; E.ss = ssckv; E.O0 = B_KN; E.O1 = B_VM;
            run_gemm(lds, wave_s, B_CKV, (const bf16_t*)(ws + W_WKV) + (size_t)l * NKV * KVL, MT, NKV, KVL, E);
        }
        if (l == 0) {
#pragma unroll 1
            for (int l2 = 0; l2 < 2; ++l2) {
                EpiKV<false> E; E.ss = nullptr; E.O0 = B_KNC + (size_t)l2 * MC * 1024; E.O1 = B_VMC + (size_t)l2 * MC * 1024;
                run_gemm(lds, wave_s, B_CKVC + (size_t)l2 * MC * 256, (const bf16_t*)(ws + W_WKVC) + (size_t)l2 * NKV * KVL, MC, NKV, KVL, E);
            }
        }
        {
            TID_DEFS
            const float* gk = P.in[17] + (size_t)l * 256;
            for (size_t idx = gt; idx < (size_t)MT * 64; idx += ngt) {
                const int row = (int)(idx >> 6), c4 = (int)(idx & 63);
                float* p = (row >= MP ? cks + (size_t)(row - MP) * 256 : ckp + (size_t)row * 256) + 4 * c4;
                const float rs = rsqrtf(ssckv[row] * (1.f / 256.f) + EPS); const f32x4 g = *(const f32x4*)(gk + 4 * c4);
                *(f32x4*)p = *(const f32x4*)p * rs * g;
            }
        }
        gbar(); OPAQ();
        PR_END(2);
        PR_BEGIN(3);
        {
            AttnCtx C; C.ws = ws; C.gda = P.in[14] + (size_t)l * 128; C.lam = __int_as_float(__builtin_amdgcn_readfirstlane(__float_as_int(ctlf[64 + 2 * l]))); C.lam1m = __int_as_float(__builtin_amdgcn_readfirstlane(__float_as_int(ctlf[65 + 2 * l]))); C.counter = ctl + 16 * l; C.l = l;
#ifndef NO_ATTN
            { int wv = wave_s; asm volatile("" : "+s"(wv)); attn_phase(lds, C, wv); }
#ifdef PROBE_ATTN2
            gbar(); OPAQ(); C.counter = ctl + 32 + 16 * l; { int wv = wave_s; asm volatile("" : "+s"(wv)); attn_phase(lds, C, wv); }
#endif
#endif
        }
        gbar(); OPAQ();
        PR_END(3);
        PR_BEGIN(4);
        {
            EpiRes E; E.xp = (l == 0) ? P.in[0] : nullptr; E.xs = P.in[1]; E.X = nullptr; E.HX = B_HX; E.ssn = ssx_ffn;
            run_gemm(lds, wave_s, B_MRG, (const bf16_t*)(ws + W_WO) + (size_t)l * 1024 * 1024, MT, 1024, 1024, E);
        }
        gbar(); OPAQ();
        PR_END(4);
        PR_BEGIN(5);
        {
            EpiUp E; E.ssx = ssx_ffn; E.U = B_U; E.cvp = out + O_CVP + (size_t)l * 32 * 2 * NUP; E.cvs = out + O_CVS + (size_t)l * 16 * 2 * NUP;
            run_gemm(lds, wave_s, B_HX, (const bf16_t*)(ws + W_WUP) + (size_t)l * NUP * 1024, MT, NUP, 1024, E);
        }
        gbar(); OPAQ();
        PR_END(5);
#ifndef NO_CONV
        PR_BEGIN(6);
        { TID_DEFS conv_phase(P, l, gt, ngt); }
#endif
        gbar(); OPAQ();
        PR_END(6);
        PR_BEGIN(7);
        {
            EpiRes E; E.xp = nullptr; E.xs = nullptr; E.X = (l == 1) ? B_X : nullptr; E.HX = B_HX; E.ssn = ssx_next;
            run_gemm(lds, wave_s, B_ACT, (const bf16_t*)(ws + W_WDN) + (size_t)l * 1024 * DFF, MT, 1024, DFF, E);
        }
        gbar(); OPAQ();
        PR_END(7);
    }
    PR_BEGIN(8);
    {
        TID_DEFS
        const float* ssf = SS + (size_t)4 * MT; const float* gf = P.in[26];
        for (size_t idx = gt; idx < (size_t)MT * 256; idx += ngt) {
            const int row = (int)(idx >> 8), c4 = (int)(idx & 255);
            const float rs = rsqrtf(ssf[row] * (1.f / 1024.f) + EPS);
            *(f32x4*)(out + (size_t)row * 1024 + 4 * c4) = *(const f32x4*)(B_X + (size_t)row * 1024 + 4 * c4) * rs * *(const f32x4*)(gf + 4 * c4);
        }
    }
#ifdef PROBE_SEL
    PR_END(8);
    if (blockIdx.x == 0) { const unsigned long long s0 = __builtin_amdgcn_s_memrealtime(); while (__builtin_amdgcn_s_memrealtime() - s0 < pr_acc) __builtin_amdgcn_s_sleep(32); }
#endif
}

extern "C" void kernel_launch(void* const* d_in, const int* in_sizes, int n_in, void* d_out, int out_size, void* d_ws, size_t ws_size, hipStream_t stream) {
    static int grid_blocks = 0;
    if (grid_blocks == 0) {
        if (n_in != 27 || (size_t)out_size != O_END || ws_size < W_END) { fprintf(stderr, "kernel_launch: unexpected problem (n_in %d, out %d vs %zu, ws %zu vs %zu)\n", n_in, out_size, (size_t)O_END, ws_size, (size_t)W_END); grid_blocks = -1; return; }
        int dev = 0, cus = 0, per_cu = 0;
        (void)hipGetDevice(&dev); (void)hipDeviceGetAttribute(&cus, hipDeviceAttributeMultiprocessorCount, dev);
        (void)hipFuncSetAttribute((const void*)fwd_megakernel, hipFuncAttributeMaxDynamicSharedMemorySize, LDS_BYTES);
        (void)hipOccupancyMaxActiveBlocksPerMultiprocessor(&per_cu, (const void*)fwd_megakernel, 512, LDS_BYTES);
        if (per_cu < 1) per_cu = 1;
        grid_blocks = cus * per_cu;
    }
    if (grid_blocks < 0) return;
    Params p{};
    for (int i = 0; i < 27; ++i) p.in[i] = (const float*)d_in[i];
    p.out = (float*)d_out; p.ws = (unsigned char*)d_ws;
    void* args[] = {&p};
    hipError_t e = hipLaunchCooperativeKernel((void*)fwd_megakernel, dim3(grid_blocks), dim3(512), args, LDS_BYTES, stream);
    if (e != hipSuccess) fprintf(stderr, "cooperative launch failed: %s (grid %d)\n", hipGetErrorString(e), grid_blocks);
}
```

```cpp
#include <hip/hip_runtime.h>
#include <hip/hip_cooperative_groups.h>
#include <cstdio>
#include <cstdint>
namespace cg = cooperative_groups;
#define LANE_ID() ({ int l_ = (int)__builtin_amdgcn_mbcnt_hi(~0u, __builtin_amdgcn_mbcnt_lo(~0u, 0u)); asm volatile("" : "+v"(l_)); l_; })
namespace pg8 {
#define PG8_LAS __attribute__((address_space(3)))
typedef unsigned short bf16_t;
typedef short bf16x8 __attribute__((ext_vector_type(8)));
typedef float f32x4 __attribute__((ext_vector_type(4)));
typedef unsigned u32x4 __attribute__((ext_vector_type(4)));
constexpr int BM = 256, BK = 64, HALF = 128, HTB = HALF * BK * 2  , STAGE_BYTES = 8 * HTB, NXCD = 8, WGM = 8;

__host__ __device__ __forceinline__ int lds_byte(int r, int c) { const int st = (r >> 4) * 2 + (c >> 5), rr = r & 15, cc = c & 31, ob = rr * 64 + cc * 2; return st * 1024 + (ob ^ (((ob >> 9) & 1) << 5)); }
__host__ __device__ __forceinline__ void stage_rc(int b, int& R, int& C) { const int st = b / 1024, sb = b % 1024, swz = sb ^ (((sb >> 9) & 1) << 5); R = (st >> 1) * 16 + swz / 64; C = (st & 1) * 32 + (swz % 64) / 2; }
__host__ __device__ __forceinline__ int perm32(int rho) { const int n = rho >> 4, i = rho & 15; return 8 * (i >> 2) + 4 * n + (i & 3); }

struct Unit { int pm, pn; };
struct Gemm { const bf16_t* A; const bf16_t* Bt; int M, N, K; };

struct StaticOrder {
    int nM, nN, nwg, G, c;
    __host__ __device__ void init(int M, int N, int G_, int c_) { nM = M / BM; nN = N / BM; nwg = nM * nN; G = G_; c = c_; }
    __host__ __device__ bool next(int i, Unit& u) const {
        const long L = (long)i * G + c; if (L >= nwg) return false;
        int wgid = (int)L; { const int q = nwg / NXCD, r = nwg % NXCD, xcd = wgid % NXCD, off = wgid / NXCD; wgid = (xcd < r ? xcd * (q + 1) : r * (q + 1) + (xcd - r) * q) + off; }
        const int nig = WGM * nN, gid = wgid / nig, fm = gid * WGM, gsz = (nM - fm) < WGM ? (nM - fm) : WGM;
        u.pm = fm + ((wgid % nig) % gsz); u.pn = (wgid % nig) / gsz; return true;
    }
    __device__ __forceinline__ void a_ready(const Unit&) const {}
    __device__ __forceinline__ void done(const Unit&) const {}
};

typedef float f32x2_cv __attribute__((ext_vector_type(2))); typedef __bf16 bf16x2_cv __attribute__((ext_vector_type(2)));
__device__ __forceinline__ unsigned cvt_pk_bf16(float lo, float hi) { f32x2_cv v = {lo, hi}; bf16x2_cv b = __builtin_convertvector(v, bf16x2_cv); return __builtin_bit_cast(unsigned, b); }
template <class Epi, class Sched, bool ALIGN_EPI = false, bool SP2 = false>
__device__ __forceinline__ void gemm_phase(PG8_LAS unsigned char* lds, const Gemm g, const Sched& S, const Epi& E, const int wid_in) {
    const int wid = wid_in, lane = LANE_ID(), tid = (wid << 6) | lane, wr = wid >> 2, wc = wid & 3, fr = lane & 15, fq = lane >> 4;
    const int K = g.K, nt = K / BK;
    unsigned voffA[2], voffB[2];
#pragma unroll
    for (int i = 0; i < 2; ++i) { int R, C; stage_rc(tid * 16 + i * 8192, R, C); const int Rb = Epi::PERM ? ((R & ~31) + perm32(R & 31)) : R;
        voffA[i] = (unsigned)(R * K + C) * 2u; voffB[i] = (unsigned)(Rb * K + C) * 2u; }
    const size_t kstep = (size_t)(BK * 2);
    const size_t hstep = (size_t)HALF * K * 2;
    const size_t tstep = 2 * hstep;
    const unsigned ldsw = (unsigned)wid * 1024u;
    const int aoff = lds_byte(wr * 64 + fr, fq * 8), boff = lds_byte(wc * 32 + fr, fq * 8);
#define PG8_SA(b, h) (((b) * 2 + (h)) * HTB)
#define PG8_SB(b, h) ((4 + (b) * 2 + (h)) * HTB)
#define PG8_STAGE(bufoff, gbase, voff) do { _Pragma("unroll") for (int _i = 0; _i < 2; ++_i) \
        __builtin_amdgcn_global_load_lds((const unsigned*)((const char*)(gbase) + (voff)[_i]), (PG8_LAS unsigned*)(lds + (bufoff) + ldsw + _i * 8192), 16, 0, 0); } while (0)
#define PG8_LDA(dst, b, h) do { _Pragma("unroll") for (int m = 0; m < 4; ++m) _Pragma("unroll") for (int k = 0; k < 2; ++k) dst[m][k] = *(const PG8_LAS bf16x8*)(lds + PG8_SA(b, h) + aoff + m * 2048 + k * 1024); } while (0)
#define PG8_LDB(dst, b, h) do { _Pragma("unroll") for (int n = 0; n < 2; ++n) _Pragma("unroll") for (int k = 0; k < 2; ++k) dst[n][k] = *(const PG8_LAS bf16x8*)(lds + PG8_SB(b, h) + boff + n * 2048 + k * 1024); } while (0)
#define PG8_MMA(ai, bj, At, Bt) do { __builtin_amdgcn_s_setprio(1); _Pragma("unroll") for (int m = 0; m < 4; ++m) _Pragma("unroll") for (int n = 0; n < 2; ++n) _Pragma("unroll") for (int k = 0; k < 2; ++k) \
        acc[ai][bj][m][n] = __builtin_amdgcn_mfma_f32_16x16x32_bf16(Bt[n][k], At[m][k], acc[ai][bj][m][n], 0, 0, 0); __builtin_amdgcn_s_setprio(0); } while (0)
#define PG8_WAIT_V(n) asm volatile("s_waitcnt vmcnt(" #n ")" ::: "memory")
#define PG8_WAIT_L(n) asm volatile("s_waitcnt lgkmcnt(" #n ")" ::: "memory")
#define PG8_BAR __builtin_amdgcn_s_barrier()
#define PG8_SCHED __builtin_amdgcn_sched_barrier(0)
    Unit cur, nxt; int ui = 0;
    if (!S.next(0, cur)) return;
    f32x4 acc[2][2][4][2];
#pragma unroll
    for (int a = 0; a < 2; ++a)
#pragma unroll
        for (int b = 0; b < 2; ++b)
#pragma unroll
            for (int m = 0; m < 4; ++m)
#pragma unroll
                for (int n = 0; n < 2; ++n) acc[a][b][m][n] = (f32x4){0.f, 0.f, 0.f, 0.f};
    bf16x8 At[4][2], B0[2][2], B1[2][2];
    const char* cA = (const char*)g.A + (size_t)cur.pm * tstep; const char* cB = (const char*)g.Bt + (size_t)cur.pn * tstep;
    S.a_ready(cur);
    if constexpr (SP2) {
        PG8_STAGE(PG8_SB(0, 0), cB, voffB); PG8_STAGE(PG8_SB(0, 1), cB + hstep, voffB); PG8_STAGE(PG8_SA(0, 0), cA, voffA); PG8_STAGE(PG8_SA(0, 1), cA + hstep, voffA);
        if (wr == 1) PG8_BAR;
        PG8_WAIT_V(2); PG8_BAR;
        PG8_STAGE(PG8_SB(1, 0), cB + kstep, voffB); PG8_STAGE(PG8_SA(1, 0), cA + kstep, voffA); PG8_STAGE(PG8_SB(1, 1), cB + hstep + kstep, voffB);
        PG8_WAIT_V(6); PG8_BAR;
    } else {
        PG8_STAGE(PG8_SB(0, 0), cB, voffB); PG8_STAGE(PG8_SA(0, 0), cA, voffA); PG8_STAGE(PG8_SB(0, 1), cB + hstep, voffB); PG8_STAGE(PG8_SA(0, 1), cA + hstep, voffA);
        if (wr == 1) PG8_BAR;
        PG8_WAIT_V(4); PG8_BAR;
        PG8_STAGE(PG8_SB(1, 0), cB + kstep, voffB); PG8_STAGE(PG8_SA(1, 0), cA + kstep, voffA); PG8_STAGE(PG8_SB(1, 1), cB + hstep + kstep, voffB);
        PG8_WAIT_V(6); PG8_BAR;
    }
    for (;;) {
        const bool has_next = S.next(ui + 1, nxt);
        const char* nA = has_next ? (const char*)g.A + (size_t)nxt.pm * tstep : cA; const char* nB = has_next ? (const char*)g.Bt + (size_t)nxt.pn * tstep : cB;
        for (int t = 0; t < nt; t += 2) {
            const bool last = (t == nt - 2);
            const char* a1 = cA + (size_t)(t + 1) * kstep;
            const char* a2 = last ? nA : cA + (size_t)(t + 2) * kstep; const char* b2 = last ? nB : cB + (size_t)(t + 2) * kstep;
            const char* a3 = a2 + kstep; const char* b3 = b2 + kstep;
            if (last && has_next) S.a_ready(nxt);
            if constexpr (SP2) {
            PG8_LDB(B0, 0, 0); PG8_LDB(B1, 0, 1); PG8_SCHED; PG8_LDA(At, 0, 0); PG8_STAGE(PG8_SA(1, 1), a1 + hstep, voffA);
            PG8_WAIT_V(8); PG8_WAIT_L(0); PG8_BAR; PG8_MMA(0, 0, At, B0); PG8_MMA(0, 1, At, B1); PG8_BAR; PG8_SCHED;
            PG8_LDA(At, 0, 1); PG8_STAGE(PG8_SB(0, 0), b2, voffB); PG8_STAGE(PG8_SB(0, 1), b2 + hstep, voffB); PG8_STAGE(PG8_SA(0, 0), a2, voffA);
            PG8_WAIT_V(8); PG8_WAIT_L(0); PG8_BAR; PG8_MMA(1, 0, At, B0); PG8_MMA(1, 1, At, B1); PG8_BAR; PG8_SCHED;
            PG8_LDB(B0, 1, 0); PG8_LDB(B1, 1, 1); PG8_SCHED; PG8_LDA(At, 1, 0); PG8_STAGE(PG8_SA(0, 1), a2 + hstep, voffA);
            PG8_WAIT_V(8); PG8_WAIT_L(0); PG8_BAR; PG8_MMA(0, 0, At, B0); PG8_MMA(0, 1, At, B1); PG8_BAR; PG8_SCHED;
            PG8_LDA(At, 1, 1); PG8_STAGE(PG8_SB(1, 0), b3, voffB); PG8_STAGE(PG8_SB(1, 1), b3 + hstep, voffB); PG8_STAGE(PG8_SA(1, 0), a3, voffA);
            PG8_WAIT_V(8); PG8_WAIT_L(0); PG8_BAR; PG8_MMA(1, 0, At, B0); PG8_MMA(1, 1, At, B1); PG8_BAR; PG8_SCHED;
            } else {
            PG8_LDB(B0, 0, 0); PG8_SCHED; PG8_LDA(At, 0, 0); PG8_STAGE(PG8_SA(1, 1), a1 + hstep, voffA);
            PG8_WAIT_L(8); PG8_BAR; PG8_WAIT_L(0); PG8_MMA(0, 0, At, B0); PG8_BAR; PG8_SCHED;
            PG8_LDB(B1, 0, 1); PG8_STAGE(PG8_SB(0, 0), b2, voffB);
            PG8_BAR; PG8_WAIT_L(0); PG8_MMA(0, 1, At, B1); PG8_BAR;
            PG8_LDA(At, 0, 1); PG8_STAGE(PG8_SA(0, 0), a2, voffA);
            PG8_BAR; PG8_WAIT_L(0); PG8_MMA(1, 0, At, B0); PG8_BAR; PG8_SCHED;
            PG8_STAGE(PG8_SB(0, 1), b2 + hstep, voffB);
            PG8_WAIT_V(6); PG8_BAR; PG8_MMA(1, 1, At, B1); PG8_BAR;
            PG8_LDB(B0, 1, 0); PG8_SCHED; PG8_LDA(At, 1, 0); PG8_STAGE(PG8_SA(0, 1), a2 + hstep, voffA);
            PG8_WAIT_L(8); PG8_BAR; PG8_WAIT_L(0); PG8_MMA(0, 0, At, B0); PG8_BAR; PG8_SCHED;
            PG8_LDB(B1, 1, 1); PG8_STAGE(PG8_SB(1, 0), b3, voffB);
            PG8_BAR; PG8_WAIT_L(0); PG8_MMA(0, 1, At, B1); PG8_BAR;
            PG8_LDA(At, 1, 1); PG8_STAGE(PG8_SA(1, 0), a3, voffA);
            PG8_BAR; PG8_WAIT_L(0); PG8_MMA(1, 0, At, B0); PG8_BAR; PG8_SCHED;
            PG8_STAGE(PG8_SB(1, 1), b3 + hstep, voffB);
            PG8_WAIT_V(6); PG8_BAR; PG8_MMA(1, 1, At, B1); PG8_BAR;
            }
        }
        if constexpr (ALIGN_EPI) { if (wr == 0) PG8_BAR; }
        if constexpr (!Epi::AFTER_DRAIN) { const int le = LANE_ID(); E(acc, cur, wr, wc, le & 15, le >> 4); S.done(cur); }
        if (!has_next) break;
#pragma unroll
        for (int a = 0; a < 2; ++a)
#pragma unroll
            for (int b = 0; b < 2; ++b)
#pragma unroll
                for (int m = 0; m < 4; ++m)
#pragma unroll
                    for (int n = 0; n < 2; ++n) acc[a][b][m][n] = (f32x4){0.f, 0.f, 0.f, 0.f};
        cur = nxt; cA = nA; cB = nB; ++ui;
        if constexpr (ALIGN_EPI) { if (wr == 1) PG8_BAR; }
    }
    PG8_WAIT_V(0);
    if constexpr (!ALIGN_EPI) { if (wr == 0) PG8_BAR; }
    PG8_BAR;
    if constexpr (Epi::AFTER_DRAIN) { E.fused(acc, cur, wr, wc, fr, fq, lds, wid, lane); S.done(cur); }
#undef PG8_SA
#undef PG8_SB
#undef PG8_STAGE
#undef PG8_LDA
#undef PG8_LDB
#undef PG8_MMA
#undef PG8_WAIT_V
#undef PG8_WAIT_L
#undef PG8_BAR
#undef PG8_SCHED
}
}
#define PG8_SP2 true
#define PG8_ALIGN true
using pg8::bf16_t; using pg8::bf16x8; using pg8::f32x4; using pg8::Unit; using pg8::cvt_pk_bf16;
#define LAS __attribute__((address_space(3)))
typedef float f32x16 __attribute__((ext_vector_type(16)));
typedef unsigned u32x2 __attribute__((ext_vector_type(2)));
typedef unsigned u32x4 __attribute__((ext_vector_type(4)));
typedef short v4i16_t __attribute__((ext_vector_type(4)));

constexpr int MP = 65536, MSMP = 512, MT = MP + MSMP, MC = 32768;
constexpr int INC = 5824, NIN = 5888, QL = 384, KVL = 256, NQ = 1536, NKV = 2048, DFF = 2816, NUP = 5632;
constexpr float EPS = 1e-6f, LOG2E = 1.4426950408889634f;
constexpr float QS_DA = 0.125f * LOG2E;
constexpr float QS_MLA = 0.07216878364870322f * LOG2E;
constexpr size_t O_DKP = (size_t)MT * 1024;
constexpr size_t O_DVP = O_DKP + 2 * (size_t)MP * 1024;
constexpr size_t O_CKVP = O_DVP + 2 * (size_t)MP * 1024;
constexpr size_t O_KRP = O_CKVP + 2 * (size_t)MP * 256;
constexpr size_t O_CVP = O_KRP + 2 * (size_t)MP * 64;
constexpr size_t O_DKS = O_CVP + 2 * 32 * 2 * 5632;
constexpr size_t O_DVS = O_DKS + 2 * 512 * 1024;
constexpr size_t O_CKVS = O_DVS + 2 * 512 * 1024;
constexpr size_t O_KRS = O_CKVS + 2 * 512 * 256;
constexpr size_t O_CVS = O_KRS + 2 * 512 * 64;
constexpr size_t O_END = O_CVS + 2 * 16 * 2 * 5632;
constexpr size_t A256(size_t x) { return (x + 255) & ~(size_t)255; }
constexpr size_t W_CTL = 0;
constexpr size_t W_ROPE = 4096;
constexpr size_t W_SS = A256(W_ROPE + (size_t)2080 * 64 * 4);
constexpr size_t W_WIN = A256(W_SS + (size_t)9 * MT * 4);
constexpr size_t W_WQ = A256(W_WIN + (size_t)2 * NIN * 1024 * 2);
constexpr size_t W_WKV = A256(W_WQ + (size_t)2 * NQ * QL * 2);
constexpr size_t W_WKVC = A256(W_WKV + (size_t)2 * NKV * KVL * 2);
constexpr size_t W_WO = A256(W_WKVC + (size_t)2 * NKV * KVL * 2);
constexpr size_t W_WUP = A256(W_WO + (size_t)2 * 1024 * 1024 * 2);
constexpr size_t W_WDN = A256(W_WUP + (size_t)2 * NUP * 1024 * 2);
constexpr size_t W_HX = A256(W_WDN + (size_t)2 * 1024 * DFF * 2);
constexpr size_t W_X = A256(W_HX + (size_t)MT * 1024 * 2);
constexpr size_t W_QDA = A256(W_X + (size_t)MT * 1024 * 4);
constexpr size_t W_KDA = A256(W_QDA + (size_t)MT * 1024 * 2);
constexpr size_t W_VDA = A256(W_KDA + (size_t)MT * 1024 * 2);
constexpr size_t W_G = A256(W_VDA + (size_t)MT * 1024 * 2);
constexpr size_t W_CKV = A256(W_G + (size_t)MT * 2048 * 2);
constexpr size_t W_CQ = A256(W_CKV + (size_t)MT * 256 * 2);
constexpr size_t W_KR = A256(W_CQ + (size_t)MT * 384 * 2);
constexpr size_t W_QM = A256(W_KR + (size_t)MT * 64 * 2);
constexpr size_t W_KN = A256(W_QM + (size_t)MT * 1536 * 2);
constexpr size_t W_VM = A256(W_KN + (size_t)MT * 1024 * 2);
constexpr size_t W_MRG = A256(W_VM + (size_t)MT * 1024 * 2);
constexpr size_t W_U = A256(W_MRG + (size_t)MT * 1024 * 2);
constexpr size_t W_ACT = A256(W_U + (size_t)MT * NUP * 2);
constexpr size_t W_KC = A256(W_ACT + (size_t)MT * DFF * 2);
constexpr size_t W_VC = A256(W_KC + (size_t)2 * MC * 1024 * 2);
constexpr size_t W_KRC = A256(W_VC + (size_t)2 * MC * 1024 * 2);
constexpr size_t W_CKVC = A256(W_KRC + (size_t)2 * MC * 64 * 2);
constexpr size_t W_KNC = A256(W_CKVC + (size_t)2 * MC * 256 * 2);
constexpr size_t W_VMC = A256(W_KNC + (size_t)2 * MC * 1024 * 2);
constexpr size_t W_END = A256(W_VMC + (size_t)2 * MC * 1024 * 2);

struct Params { const float* in[27]; float* out; unsigned char* ws; };

#define GAS __attribute__((address_space(1)))
__device__ __forceinline__ void st_bf16x4(bf16_t* p, f32x4 v) { u32x2 w; w.x = cvt_pk_bf16(v[0], v[1]); w.y = cvt_pk_bf16(v[2], v[3]); *(GAS u32x2*)p = w; }
__device__ __forceinline__ f32x4 ldg4(const float* p) { return *(const GAS f32x4*)p; }
__device__ __forceinline__ void stg4(float* p, f32x4 v) { *(GAS f32x4*)p = v; }
__device__ __forceinline__ u32x4 ldgu4(const void* p) { return *(const GAS u32x4*)p; }
__device__ __forceinline__ u32x2 ldgu2(const void* p) { return *(const GAS u32x2*)p; }
__device__ __forceinline__ float ldg1(const float* p) { return *(const GAS float*)p; }
__device__ __forceinline__ float fast_rcp(float x) { return __builtin_amdgcn_rcpf(x); }
__device__ __forceinline__ float fast_exp2(float x) { return __builtin_amdgcn_exp2f(x); }
__device__ __forceinline__ float sigmoidf_(float x) { return fast_rcp(1.f + fast_exp2(-x * LOG2E)); }
__device__ __forceinline__ float bf2f(unsigned short b) { return __uint_as_float((unsigned)b << 16); }
__device__ __forceinline__ int row_of(const Unit& u, int ai, int wr, int m, int fr) { return u.pm * 256 + ai * 128 + wr * 64 + m * 16 + fr; }
__device__ __forceinline__ float sq4(f32x4 v) { return (v[0] * v[0] + v[1] * v[1]) + (v[2] * v[2] + v[3] * v[3]); }

__device__ __forceinline__ float add_x16(float s) { return s + __int_as_float(__builtin_amdgcn_ds_swizzle(__float_as_int(s), 0x401F)); }
__device__ __forceinline__ float add_x32(float s) { auto rr = __builtin_amdgcn_permlane32_swap(__float_as_uint(s), __float_as_uint(s), false, false); return __uint_as_float(rr[0]) + __uint_as_float(rr[1]); }
__device__ __forceinline__ float max_x32(float s) { auto rr = __builtin_amdgcn_permlane32_swap(__float_as_uint(s), __float_as_uint(s), false, false); return fmaxf(__uint_as_float(rr[0]), __uint_as_float(rr[1])); }
#define LOAD_RS8(name, ptr, scale, mul) float name[2][4]; { _Pragma("unroll") for (int ai_ = 0; ai_ < 2; ++ai_) _Pragma("unroll") for (int m_ = 0; m_ < 4; ++m_) name[ai_][m_] = ldg1((ptr) + row_of(u, ai_, wr, m_, fr)); \
    _Pragma("unroll") for (int ai_ = 0; ai_ < 2; ++ai_) _Pragma("unroll") for (int m_ = 0; m_ < 4; ++m_) name[ai_][m_] = rsqrtf(name[ai_][m_] * (scale) + EPS) * (mul); }
struct EpiInProj {
    static constexpr bool PERM = false, AFTER_DRAIN = false;
    unsigned char* ws; float* out; const float* bgate; int l;
    __device__ __forceinline__ void operator()(const f32x4 (&acc)[2][2][4][2], const Unit& u, int wr, int wc, int fr, int fq) const {
        const int pn = u.pn;
        const float* SSb = (const float*)(ws + W_SS); const float* ssx = SSb + (size_t)(2 * l) * MT; const float* rope = (const float*)(ws + W_ROPE);
        float* sscq = (float*)(ws + W_SS) + (size_t)(5 + l) * MT; float* ssckv = (float*)(ws + W_SS) + (size_t)(7 + l) * MT;
        bf16_t* QDA = (bf16_t*)(ws + W_QDA); bf16_t* KDA = (bf16_t*)(ws + W_KDA); bf16_t* VDA = (bf16_t*)(ws + W_VDA); bf16_t* G = (bf16_t*)(ws + W_G);
        bf16_t* CKV = (bf16_t*)(ws + W_CKV); bf16_t* CQ = (bf16_t*)(ws + W_CQ); bf16_t* KR = (bf16_t*)(ws + W_KR);
        float* dkp = out + O_DKP + (size_t)l * MP * 1024; float* dks = out + O_DKS + (size_t)l * MSMP * 1024; float* dvp = out + O_DVP + (size_t)l * MP * 1024; float* dvs = out + O_DVS + (size_t)l * MSMP * 1024;
        float* ckp = out + O_CKVP + (size_t)l * MP * 256; float* cks = out + O_CKVS + (size_t)l * MSMP * 256; float* krp = out + O_KRP + (size_t)l * MP * 64; float* krs = out + O_KRS + (size_t)l * MSMP * 64;
        LOAD_RS8(rs8, ssx, 1.f / 1024.f, 1.f)
        if (pn < 8) {
            const bool isk = pn >= 4; const int cb = 256 * (pn & 3) + 64 * wc;
#pragma unroll
            for (int ai = 0; ai < 2; ++ai)
#pragma unroll
                for (int m = 0; m < 4; ++m) { if ((m & 1) == 0) asm volatile("" ::: "memory");
                    const int row = row_of(u, ai, wr, m, fr); const float rstd = rs8[ai][m];
                    const bool samp = row >= MP; const int orow = samp ? row - MP : row; const int pos = samp ? 2048 + (orow & 31) : (row & 2047);
                    const float* rt = rope + (size_t)pos * 64;
#pragma unroll
                    for (int n = 0; n < 2; ++n) {
                        const int i0 = 16 * n + 4 * fq; const f32x4 cs = ldg4(rt + i0), sn = ldg4(rt + 32 + i0);
                        const f32x4 x1 = acc[ai][0][m][n] * rstd, x2 = acc[ai][1][m][n] * rstd;
                        f32x4 o1 = x1 * cs - x2 * sn, o2 = x2 * cs + x1 * sn;
                        if (!isk) { o1 = o1 * QS_DA; o2 = o2 * QS_DA; bf16_t* q = QDA + (size_t)row * 1024 + cb + i0; st_bf16x4(q, o1); st_bf16x4(q + 32, o2); }
                        else { bf16_t* k = KDA + (size_t)row * 1024 + cb + i0; st_bf16x4(k, o1); st_bf16x4(k + 32, o2);
                               float* d = (samp ? dks : dkp) + (size_t)orow * 1024 + cb + i0; stg4(d, o1); stg4((d + 32), o2); }
                    }
                }
        } else if (pn < 12) {
            const int cb = 256 * (pn - 8) + 32 * wc + 4 * fq;
#pragma unroll
            for (int ai = 0; ai < 2; ++ai)
#pragma unroll
                for (int m = 0; m < 4; ++m) { if ((m & 1) == 0) asm volatile("" ::: "memory");
                    const int row = row_of(u, ai, wr, m, fr); const float rstd = rs8[ai][m];
                    const bool samp = row >= MP; const int orow = samp ? row - MP : row;
                    float* d = (samp ? dvs : dvp) + (size_t)orow * 1024 + cb; bf16_t* v = VDA + (size_t)row * 1024 + cb;
#pragma unroll
                    for (int bj = 0; bj < 2; ++bj)
#pragma unroll
                        for (int n = 0; n < 2; ++n) { const f32x4 x = acc[ai][bj][m][n] * rstd; stg4((d + 128 * bj + 16 * n), x); st_bf16x4(v + 128 * bj + 16 * n, x); }
                }
        } else if (pn < 20) {
            const int cb = 256 * (pn - 12) + 32 * wc + 4 * fq;
            f32x4 bv[2][2];
#pragma unroll
            for (int bj = 0; bj < 2; ++bj)
#pragma unroll
                for (int n = 0; n < 2; ++n) bv[bj][n] = ldg4(bgate + cb + 128 * bj + 16 * n);
#pragma unroll
            for (int ai = 0; ai < 2; ++ai)
#pragma unroll
                for (int m = 0; m < 4; ++m) { if ((m & 1) == 0) asm volatile("" ::: "memory");
                    const int row = row_of(u, ai, wr, m, fr); const float rstd = rs8[ai][m];
                    bf16_t* g = G + (size_t)row * 2048 + cb;
#pragma unroll
                    for (int bj = 0; bj < 2; ++bj)
#pragma unroll
                        for (int n = 0; n < 2; ++n) { f32x4 x = acc[ai][bj][m][n] * rstd + bv[bj][n];
                            x[0] = sigmoidf_(x[0]); x[1] = sigmoidf_(x[1]); x[2] = sigmoidf_(x[2]); x[3] = sigmoidf_(x[3]); st_bf16x4(g + 128 * bj + 16 * n, x); }
                }
        } else if (pn == 20) {
            const int cb = 32 * wc + 4 * fq;
#pragma unroll
            for (int ai = 0; ai < 2; ++ai)
#pragma unroll
                for (int m = 0; m < 4; ++m) { if ((m & 1) == 0) asm volatile("" ::: "memory");
                    const int row = row_of(u, ai, wr, m, fr); const float rstd = rs8[ai][m];
                    const bool samp = row >= MP; const int orow = samp ? row - MP : row;
                    float* d = (samp ? cks : ckp) + (size_t)orow * 256 + cb; bf16_t* c = CKV + (size_t)row * 256 + cb; float s = 0.f;
#pragma unroll
                    for (int bj = 0; bj < 2; ++bj)
#pragma unroll
                        for (int n = 0; n < 2; ++n) { const f32x4 x = acc[ai][bj][m][n] * rstd; s += sq4(x); stg4((d + 128 * bj + 16 * n), x); st_bf16x4(c + 128 * bj + 16 * n, x); }
                    s = add_x16(s); s = add_x32(s);
                    if (fq == 0) unsafeAtomicAdd(ssckv + row, s);
                }
        } else if (pn == 21) {
            const int cb = 32 * wc + 4 * fq;
#pragma unroll
            for (int ai = 0; ai < 2; ++ai)
#pragma unroll
                for (int m = 0; m < 4; ++m) { if ((m & 1) == 0) asm volatile("" ::: "memory");
                    const int row = row_of(u, ai, wr, m, fr); const float rstd = rs8[ai][m];
                    bf16_t* c = CQ + (size_t)row * 384 + cb; float s = 0.f;
#pragma unroll
                    for (int bj = 0; bj < 2; ++bj)
#pragma unroll
                        for (int n = 0; n < 2; ++n) { const f32x4 x = acc[ai][bj][m][n] * rstd; s += sq4(x); st_bf16x4(c + 128 * bj + 16 * n, x); }
                    s = add_x16(s); s = add_x32(s);
                    if (fq == 0) unsafeAtomicAdd(sscq + row, s);
                }
        } else {
#pragma unroll
            for (int ai = 0; ai < 2; ++ai)
#pragma unroll
                for (int m = 0; m < 4; ++m) { if ((m & 1) == 0) asm volatile("" ::: "memory");
                    const int row = row_of(u, ai, wr, m, fr); const float rstd = rs8[ai][m];
                    const bool samp = row >= MP; const int orow = samp ? row - MP : row; const int pos = samp ? 2048 + (orow & 31) : (row & 2047);
                    bf16_t* c = CQ + (size_t)row * 384 + 256 + 32 * wc + 4 * fq; float s = 0.f;
#pragma unroll
                    for (int n = 0; n < 2; ++n) { const f32x4 x = acc[ai][0][m][n] * rstd; s += sq4(x); st_bf16x4(c + 16 * n, x); }
                    s = add_x16(s); s = add_x32(s);
                    if (fq == 0) unsafeAtomicAdd(sscq + row, s);
                    if (wc < 2) {
                        const int i0 = 16 * wc + 4 * fq; const float* rt = rope + (size_t)pos * 64;
                        const f32x4 cs = ldg4(rt + i0), sn = ldg4(rt + 32 + i0);
                        const f32x4 x1 = acc[ai][1][m][0] * rstd, x2 = acc[ai][1][m][1] * rstd;
                        const f32x4 o1 = x1 * cs - x2 * sn, o2 = x2 * cs + x1 * sn;
                        float* d = (samp ? krs : krp) + (size_t)orow * 64 + i0; stg4(d, o1); stg4((d + 32), o2);
                        bf16_t* k = KR + (size_t)row * 64 + i0; st_bf16x4(k, o1); st_bf16x4(k + 32, o2);
                    }
                }
        }
    }
};

struct EpiQ {
    static constexpr bool PERM = false, AFTER_DRAIN = false;
    const float* sscq; const float* rope; bf16_t* QM;
    __device__ __forceinline__ void operator()(const f32x4 (&acc)[2][2][4][2], const Unit& u, int wr, int wc, int fr, int fq) const {
        const int pn = u.pn;
        LOAD_RS8(rs8, sscq, 1.f / 384.f, QS_MLA)
#pragma unroll
        for (int ai = 0; ai < 2; ++ai)
#pragma unroll
            for (int m = 0; m < 4; ++m) { if ((m & 1) == 0) asm volatile("" ::: "memory");
                const int row = row_of(u, ai, wr, m, fr); const float rs = rs8[ai][m];
                bf16_t* q = QM + (size_t)row * 1536;
                if (pn < 4) {
#pragma unroll
                    for (int bj = 0; bj < 2; ++bj)
#pragma unroll
                        for (int n = 0; n < 2; ++n) st_bf16x4(q + (2 * pn + bj) * 192 + 32 * wc + 16 * n + 4 * fq, acc[ai][bj][m][n] * rs);
                } else {
                    const int pos = row >= MP ? 2048 + ((row - MP) & 31) : (row & 2047); const float* rt = rope + (size_t)pos * 64;
                    bf16_t* qh = q + (4 * (pn - 4) + wc) * 192 + 128;
#pragma unroll
                    for (int n = 0; n < 2; ++n) {
                        const int i0 = 16 * n + 4 * fq; const f32x4 cs = ldg4(rt + i0), sn = ldg4(rt + 32 + i0);
                        const f32x4 x1 = acc[ai][0][m][n] * rs, x2 = acc[ai][1][m][n] * rs;
                        st_bf16x4(qh + i0, x1 * cs - x2 * sn); st_bf16x4(qh + 32 + i0, x2 * cs + x1 * sn);
                    }
                }
            }
    }
};

template <bool HAS_SS> struct EpiKV {
    static constexpr bool PERM = false, AFTER_DRAIN = false;
    const float* ss; bf16_t *O0, *O1;
    __device__ __forceinline__ void operator()(const f32x4 (&acc)[2][2][4][2], const Unit& u, int wr, int wc, int fr, int fq) const {
        bf16_t* base = (u.pn < 4 ? O0 : O1) + 256 * (u.pn & 3) + 32 * wc + 4 * fq;
        float rs8[2][4];
        if constexpr (HAS_SS) { LOAD_RS8(t8, ss, 1.f / 256.f, 1.f) _Pragma("unroll") for (int a = 0; a < 2; ++a) _Pragma("unroll") for (int b = 0; b < 4; ++b) rs8[a][b] = t8[a][b]; }
#pragma unroll
        for (int ai = 0; ai < 2; ++ai)
#pragma unroll
            for (int m = 0; m < 4; ++m) { if ((m & 1) == 0) asm volatile("" ::: "memory");
                const int row = row_of(u, ai, wr, m, fr); const float rs = HAS_SS ? rs8[ai][m] : 1.f;
                bf16_t* o = base + (size_t)row * 1024;
#pragma unroll
                for (int bj = 0; bj < 2; ++bj)
#pragma unroll
                    for (int n = 0; n < 2; ++n) st_bf16x4(o + 128 * bj + 16 * n, acc[ai][bj][m][n] * rs);
            }
    }
};

struct EpiRes {
    static constexpr bool PERM = false, AFTER_DRAIN = false;
    const float* xp; const float* xs; float* X; bf16_t* HX; float* ssn;
    __device__ __forceinline__ void operator()(const f32x4 (&acc)[2][2][4][2], const Unit& u, int wr, int wc, int fr, int fq) const {
        const int cb = 256 * u.pn + 32 * wc + 4 * fq;
#pragma unroll
        for (int ai = 0; ai < 2; ++ai)
#pragma unroll
            for (int m = 0; m < 4; ++m) { if ((m & 1) == 0) asm volatile("" ::: "memory");
                const int row = row_of(u, ai, wr, m, fr);
                bf16_t* h = HX + (size_t)row * 1024 + cb; float s = 0.f;
                f32x4 xo[2][2];
                if (xp) { const float* xi = (row >= MP ? xs + (size_t)(row - MP) * 1024 : xp + (size_t)row * 1024) + cb;
#pragma unroll
                    for (int bj = 0; bj < 2; ++bj)
#pragma unroll
                        for (int n = 0; n < 2; ++n) xo[bj][n] = ldg4(xi + 128 * bj + 16 * n); }
                else {
#pragma unroll
                    for (int bj = 0; bj < 2; ++bj)
#pragma unroll
                        for (int n = 0; n < 2; ++n) { const u32x2 w = ldgu2(h + 128 * bj + 16 * n);
                            xo[bj][n] = (f32x4){__uint_as_float(w.x << 16), __uint_as_float(w.x & 0xffff0000u), __uint_as_float(w.y << 16), __uint_as_float(w.y & 0xffff0000u)}; } }
#pragma unroll
                for (int bj = 0; bj < 2; ++bj)
#pragma unroll
                    for (int n = 0; n < 2; ++n) { const f32x4 x = xo[bj][n] + acc[ai][bj][m][n]; s += sq4(x); st_bf16x4(h + 128 * bj + 16 * n, x);
                        if (X) stg4((X + (size_t)row * 1024 + cb + 128 * bj + 16 * n), x); }
                s = add_x16(s); s = add_x32(s);
                if (fq == 0) unsafeAtomicAdd(ssn + row, s);
            }
    }
};

struct EpiUp {
    static constexpr bool PERM = false, AFTER_DRAIN = false;
    const float* ssx; bf16_t* U; float* cvp; float* cvs;
    __device__ __forceinline__ void operator()(const f32x4 (&acc)[2][2][4][2], const Unit& u, int wr, int wc, int fr, int fq) const {
        const int cb = 128 * u.pn + 32 * wc + 4 * fq;
        LOAD_RS8(rs8, ssx, 1.f / 1024.f, 1.f)
#pragma unroll
        for (int ai = 0; ai < 2; ++ai)
#pragma unroll
            for (int m = 0; m < 4; ++m) { if ((m & 1) == 0) asm volatile("" ::: "memory");
                const int row = row_of(u, ai, wr, m, fr); const float rstd = rs8[ai][m];
                bf16_t* o = U + (size_t)row * NUP + cb;
                float* cv = nullptr;
                if (row >= MP) { const int r = row - MP, s = r & 31; if (s >= 30) cv = cvs + ((size_t)(r >> 5) * 2 + (s - 30)) * NUP + cb; }
                else { const int s = row & 2047; if (s >= 2046) cv = cvp + ((size_t)(row >> 11) * 2 + (s - 2046)) * NUP + cb; }
#pragma unroll
                for (int bj = 0; bj < 2; ++bj)
#pragma unroll
                    for (int n = 0; n < 2; ++n) { const f32x4 x = acc[ai][bj][m][n] * rstd; st_bf16x4(o + DFF * bj + 16 * n, x); if (cv) stg4((cv + DFF * bj + 16 * n), x); }
            }
    }
};
struct KVD { const bf16_t* k; const bf16_t* k2; const bf16_t* v; };
constexpr int ATT_KBUF = 64 * 400, ATT_VOFF = 2 * ATT_KBUF, ATT_VIMG = 32 * 320, ATT_VBUF = 2 * ATT_VIMG;

template <int DQK>
__device__ __forceinline__ void attn_pass(LAS unsigned char* lds, const int wid, const bf16_t* qrow, const KVD& dm, const KVD& dl, int nmain, int ntw, int ntc, f32x16 (&o)[4], float& linv) {
    constexpr int NCH = DQK / 8, KST = DQK * 2 + 16, NKI = NCH / 8, NS = DQK / 16;
    const int lane = LANE_ID(), tid = (wid << 6) | lane, r32 = lane & 31, hi = lane >> 5;
    bf16x8 q[NS];
#pragma unroll
    for (int s = 0; s < NS; ++s) q[s] = __builtin_bit_cast(bf16x8, ldgu4(qrow + 16 * s + 8 * hi));
    u32x4 kr[NKI], vr[2];
#define ATT_GLOADK(t) do { const bool lastt = (t) >= nmain; const KVD& d = lastt ? dl : dm; const int rb = lastt ? 0 : (t) * 64; const int rm = lastt ? 31 : 63; \
        _Pragma("unroll") for (int i = 0; i < NKI; ++i) { const int id = tid + 512 * i, kro = id / NCH, kc = id - kro * NCH; const int r = rb + (kro & rm); \
            kr[i] = (DQK == 64 || kc < 16) ? ldgu4(d.k + (size_t)r * 1024 + kc * 8) : ldgu4(d.k2 + (size_t)r * 64 + (kc - 16) * 8); } } while (0)
#define ATT_GLOADV(t) do { const bool lastt = (t) >= nmain; const KVD& d = lastt ? dl : dm; const int rb = lastt ? 0 : (t) * 64; const int rm = lastt ? 31 : 63; \
        _Pragma("unroll") for (int i = 0; i < 2; ++i) { const int r = rb + (((tid >> 4) + 32 * i) & rm); vr[i] = ldgu4(d.v + (size_t)r * 1024 + (tid & 15) * 8); } } while (0)
#define ATT_LSTORE(b) do { \
        _Pragma("unroll") for (int i = 0; i < NKI; ++i) { const int id = tid + 512 * i, kro = id / NCH, kc = id - kro * NCH; *(LAS u32x4*)(lds + (b) * ATT_KBUF + kro * KST + kc * 16) = kr[i]; } \
        _Pragma("unroll") for (int i = 0; i < 2; ++i) *(LAS u32x4*)(lds + ATT_VOFF + (b) * ATT_VBUF + i * ATT_VIMG + (tid >> 4) * 320 + (tid & 15) * 16) = vr[i]; } while (0)
    ATT_GLOADK(0); ATT_GLOADV(0); ATT_LSTORE(0); __syncthreads();
    float m_run = 0.f, l_run = 0.f;
#pragma unroll
    for (int c = 0; c < 4; ++c)
#pragma unroll
        for (int r = 0; r < 16; ++r) o[c][r] = 0.f;
    const int vlane = (4 * hi + ((lane & 15) >> 2)) * 320 + (2 * ((lane >> 4) & 1) + ((lane & 3) >> 1)) * 16 + 8 * (lane & 1);
    for (int t = 0; t < ntw; ++t) {
        if (t + 1 < ntw) ATT_GLOADK(t + 1);
        bool vloaded = false;
        if (t < ntc) {
            const LAS unsigned char* kb = lds + (t & 1) * ATT_KBUF + r32 * KST + hi * 16;
            const LAS unsigned char* vb = lds + ATT_VOFF + (t & 1) * ATT_VBUF;
            f32x16 p0, p1;
#pragma unroll
            for (int r = 0; r < 16; ++r) { p0[r] = 0.f; p1[r] = 0.f; }
            constexpr int KCH = (DQK == 64) ? 2 : 1, NG = NS / KCH;
            bf16x8 kf[2][2 * KCH];
#define ATT_LDK(ch, b) do { _Pragma("unroll") for (int j_ = 0; j_ < KCH; ++j_) { kf[b][2 * j_] = *(const LAS bf16x8*)(kb + (KCH * (ch) + j_) * 32); kf[b][2 * j_ + 1] = *(const LAS bf16x8*)(kb + 32 * KST + (KCH * (ch) + j_) * 32); } } while (0)
            ATT_LDK(0, 0); __builtin_amdgcn_sched_barrier(0);
#pragma unroll
            for (int ch = 0; ch < NG; ++ch) {
                if (ch + 1 < NG) ATT_LDK(ch + 1, (ch + 1) & 1);
                __builtin_amdgcn_sched_barrier(0);
#pragma unroll
                for (int j = 0; j < KCH; ++j) {
                    p0 = __builtin_amdgcn_mfma_f32_32x32x16_bf16(kf[ch & 1][2 * j], q[KCH * ch + j], p0, 0, 0, 0);
                    p1 = __builtin_amdgcn_mfma_f32_32x32x16_bf16(kf[ch & 1][2 * j + 1], q[KCH * ch + j], p1, 0, 0, 0);
                }
                __builtin_amdgcn_sched_barrier(0);
            }
#undef ATT_LDK
            bf16x8 vf[2][4];
#define ATT_LDV(cmb, b) do { _Pragma("unroll") for (int c_ = 0; c_ < 4; ++c_) { const LAS unsigned char* a0_ = vb + vlane + ((cmb) >> 1) * ATT_VIMG + (16 * ((cmb) & 1)) * 320 + c_ * 64; \
                const v4i16_t t0_ = __builtin_amdgcn_ds_read_tr16_b64_v4i16((LAS v4i16_t*)a0_), t1_ = __builtin_amdgcn_ds_read_tr16_b64_v4i16((LAS v4i16_t*)(a0_ + 8 * 320)); \
                vf[b][c_] = (bf16x8){t0_[0], t0_[1], t0_[2], t0_[3], t1_[0], t1_[1], t1_[2], t1_[3]}; } } while (0)
#pragma unroll
            for (int r = 0; r < 16; ++r) { p0[r] -= m_run; p1[r] -= m_run; }
            if (t >= nmain) { asm volatile("" ::: "memory");
#pragma unroll
                for (int r = 0; r < 16; ++r) p1[r] = -INFINITY;
            }
            float mt = __builtin_fmaxf(__builtin_fmaxf(p0[0], p1[0]), p0[1]);
#pragma unroll
            for (int r = 1; r < 15; r += 2) { mt = __builtin_fmaxf(__builtin_fmaxf(mt, p1[r]), p0[r + 1]); mt = __builtin_fmaxf(__builtin_fmaxf(mt, p1[r + 1]), p0[r + 2 < 16 ? r + 2 : 15]); }
            mt = __builtin_fmaxf(mt, p1[15]);
            mt = max_x32(mt);
            const float dref = (t == 0 || mt > 8.f) ? mt : 0.f;
            if (__builtin_amdgcn_ballot_w64(dref != 0.f) != 0ull) {
                m_run += dref;
#pragma unroll
                for (int r = 0; r < 16; ++r) { p0[r] -= dref; p1[r] -= dref; }
                if (t > 0) { const float f = fast_exp2(-dref); l_run *= f;
#pragma unroll
                    for (int c = 0; c < 4; ++c)
#pragma unroll
                        for (int r = 0; r < 16; ++r) o[c][r] *= f; }
            }
            float rs = 0.f;
#pragma unroll
            for (int r = 0; r < 16; ++r) { p0[r] = fast_exp2(p0[r]); p1[r] = fast_exp2(p1[r]); rs += p0[r] + p1[r]; }
            l_run += rs;
            asm volatile("" ::: "memory");
            if (t + 1 < ntw) { ATT_GLOADV(t + 1); vloaded = true; }
            bf16x8 pf[2][2];
#pragma unroll
            for (int ks = 0; ks < 2; ++ks) {
                u32x4 a, b;
                a.x = cvt_pk_bf16(p0[8 * ks + 0], p0[8 * ks + 1]); a.y = cvt_pk_bf16(p0[8 * ks + 2], p0[8 * ks + 3]); a.z = cvt_pk_bf16(p0[8 * ks + 4], p0[8 * ks + 5]); a.w = cvt_pk_bf16(p0[8 * ks + 6], p0[8 * ks + 7]);
                b.x = cvt_pk_bf16(p1[8 * ks + 0], p1[8 * ks + 1]); b.y = cvt_pk_bf16(p1[8 * ks + 2], p1[8 * ks + 3]); b.z = cvt_pk_bf16(p1[8 * ks + 4], p1[8 * ks + 5]); b.w = cvt_pk_bf16(p1[8 * ks + 6], p1[8 * ks + 7]);
                pf[0][ks] = __builtin_bit_cast(bf16x8, a); pf[1][ks] = __builtin_bit_cast(bf16x8, b);
            }
            __builtin_amdgcn_sched_barrier(0);
            ATT_LDV(0, 0); __builtin_amdgcn_sched_barrier(0);
#pragma unroll
            for (int cmb = 0; cmb < 4; ++cmb) {
                if (cmb + 1 < 4) ATT_LDV(cmb + 1, (cmb + 1) & 1);
                __builtin_amdgcn_sched_barrier(0);
#pragma unroll
                for (int c = 0; c < 4; ++c) o[c] = __builtin_amdgcn_mfma_f32_32x32x16_bf16(vf[cmb & 1][c], pf[cmb >> 1][cmb & 1], o[c], 0, 0, 0);
                __builtin_amdgcn_sched_barrier(0);
            }
#undef ATT_LDV
        }
        if (t + 1 < ntw) { if (!vloaded) ATT_GLOADV(t + 1); ATT_LSTORE((t + 1) & 1); }
        __syncthreads();
    }
    const float lt = add_x32(l_run);
    linv = fast_rcp(lt);
#undef ATT_GLOADK
#undef ATT_GLOADV
#undef ATT_LSTORE
}

struct AttnCtx { unsigned char* ws; const float* gda; float lam, lam1m; unsigned* counter; int l; };
constexpr int ATT_NUNITS = 128 + 2048;
__device__ __forceinline__ void attn_phase(LAS unsigned char* lds, const AttnCtx& C, const int wid) {
#define TID_NOW() LANE_ID()
    LAS unsigned* ubox = (LAS unsigned*)(lds + 131072);
    if (wid < 4) __builtin_amdgcn_s_setprio(3); else __builtin_amdgcn_s_setprio(0);
    const bf16_t* QDA = (const bf16_t*)(C.ws + W_QDA); const bf16_t* KDA = (const bf16_t*)(C.ws + W_KDA); const bf16_t* VDA = (const bf16_t*)(C.ws + W_VDA);
    const bf16_t* GG = (const bf16_t*)(C.ws + W_G); bf16_t* MRG = (bf16_t*)(C.ws + W_MRG);
    for (;;) {
        if (wid == 0 && TID_NOW() == 0) ubox[0] = atomicAdd(C.counter, 1u);
        __syncthreads();
        const int un = (int)ubox[0];
        __syncthreads();
        if (un >= ATT_NUNITS) break;
        const bool samp = un < 128;
        int b, h, qb = 0;
        if (samp) { b = un >> 3; h = un & 7; } else { const int v = un - 128; qb = 7 - (v >> 8); b = (v & 255) >> 3; h = v & 7; }
        const int row = samp ? MP + b * 32 + (TID_NOW() & 31) : b * 2048 + qb * 256 + wid * 32 + (TID_NOW() & 31);
        const int ntw = samp ? 33 : 4 * qb + 4, nmain = samp ? 32 : ntw, ntc = samp ? (wid == 0 ? 33 : 0) : 4 * qb + (wid >> 1) + 1;
        const size_t kr0 = (size_t)b * 2048;
        const size_t fr0 = (size_t)MP + b * 32;
        const size_t coff = (size_t)C.l * MC;
        f32x16 o[4]; float linv;
#ifndef NO_DIFF
        {
            unsigned o1[32];
#pragma unroll 1
            for (int st = 0; st < 2; ++st) {
                KVD dm, dl;
                const bf16_t* Kb = samp ? (const bf16_t*)(C.ws + W_KC) + coff * 1024 : KDA; const bf16_t* Vb = samp ? (const bf16_t*)(C.ws + W_VC) + coff * 1024 : VDA;
                dm.k = Kb + kr0 * 1024 + h * 128 + st * 64; dm.k2 = dm.k; dm.v = Vb + kr0 * 1024 + h * 128;
                dl.k = KDA + fr0 * 1024 + h * 128 + st * 64; dl.k2 = dl.k; dl.v = VDA + fr0 * 1024 + h * 128;
                attn_pass<64>(lds, wid, QDA + (size_t)row * 1024 + h * 128 + st * 64, dm, dl, nmain, ntw, ntc, o, linv);
                if (st == 0) {
#pragma unroll
                    for (int c = 0; c < 4; ++c)
#pragma unroll
                        for (int r = 0; r < 16; r += 2) o1[c * 8 + (r >> 1)] = cvt_pk_bf16(o[c][r] * linv, o[c][r + 1] * linv);
                }
            }
            if (ntc > 0) {
                int rowe = row; asm volatile("" : "+v"(rowe));
                const int hi = (TID_NOW() >> 5) & 1;
                const float ll = C.lam * linv; float ss = 0.f;
#pragma unroll
                for (int c = 0; c < 4; ++c)
#pragma unroll
                    for (int r = 0; r < 16; r += 2) { const unsigned w = o1[c * 8 + (r >> 1)];
                        const float x0 = __uint_as_float(w << 16) - ll * o[c][r], x1 = __uint_as_float(w & 0xffff0000u) - ll * o[c][r + 1]; o[c][r] = x0; o[c][r + 1] = x1; ss += x0 * x0 + x1 * x1; }
                ss = add_x32(ss);
                const float rn = rsqrtf(ss * (1.f / 128.f) + EPS) * C.lam1m;
                const bf16_t* ga = GG + (size_t)rowe * 2048 + h * 128; bf16_t* mo = MRG + (size_t)rowe * 1024 + h * 128;
#pragma unroll
                for (int c = 0; c < 4; ++c)
#pragma unroll
                    for (int g = 0; g < 4; ++g) {
                        const int d0 = 32 * c + 8 * g + 4 * hi;
                        const u32x2 gw = ldgu2(ga + d0); const f32x4 gd = ldg4(C.gda + d0);
                        const float g0 = __uint_as_float(gw.x << 16), g1 = __uint_as_float(gw.x & 0xffff0000u), g2 = __uint_as_float(gw.y << 16), g3 = __uint_as_float(gw.y & 0xffff0000u);
                        f32x4 r; r[0] = o[c][4 * g + 0] * rn * gd[0] * g0; r[1] = o[c][4 * g + 1] * rn * gd[1] * g1; r[2] = o[c][4 * g + 2] * rn * gd[2] * g2; r[3] = o[c][4 * g + 3] * rn * gd[3] * g3;
                        st_bf16x4(mo + d0, r);
                    }
            }
        }
#endif
#ifndef NO_MLA
        {
            KVD dm, dl;
            const bf16_t* KN = (const bf16_t*)(C.ws + W_KN); const bf16_t* VM = (const bf16_t*)(C.ws + W_VM); const bf16_t* KR = (const bf16_t*)(C.ws + W_KR);
            dm.k = (samp ? (const bf16_t*)(C.ws + W_KNC) + coff * 1024 : KN) + kr0 * 1024 + h * 128; dm.k2 = (samp ? (const bf16_t*)(C.ws + W_KRC) + coff * 64 : KR) + kr0 * 64;
            dm.v = (samp ? (const bf16_t*)(C.ws + W_VMC) + coff * 1024 : VM) + kr0 * 1024 + h * 128;
            dl.k = KN + fr0 * 1024 + h * 128; dl.k2 = KR + fr0 * 64; dl.v = VM + fr0 * 1024 + h * 128;
            attn_pass<192>(lds, wid, (const bf16_t*)(C.ws + W_QM) + (size_t)row * 1536 + h * 192, dm, dl, nmain, ntw, ntc, o, linv);
            if (ntc > 0) {
                int rowe = row; asm volatile("" : "+v"(rowe));
                const int hi = (TID_NOW() >> 5) & 1;
                const bf16_t* gb = GG + (size_t)rowe * 2048 + 1024 + h * 128; bf16_t* mo = MRG + (size_t)rowe * 1024 + h * 128;
#pragma unroll
                for (int c = 0; c < 4; ++c)
#pragma unroll
                    for (int g = 0; g < 4; ++g) {
                        const int d0 = 32 * c + 8 * g + 4 * hi;
                        const u32x2 gw = ldgu2(gb + d0); const u32x2 xw = ldgu2(mo + d0);
                        const float g0 = __uint_as_float(gw.x << 16), g1 = __uint_as_float(gw.x & 0xffff0000u), g2 = __uint_as_float(gw.y << 16), g3 = __uint_as_float(gw.y & 0xffff0000u);
                        f32x4 r;
                        r[0] = __uint_as_float(xw.x << 16) + g0 * o[c][4 * g + 0] * linv; r[1] = __uint_as_float(xw.x & 0xffff0000u) + g1 * o[c][4 * g + 1] * linv;
                        r[2] = __uint_as_float(xw.y << 16) + g2 * o[c][4 * g + 2] * linv; r[3] = __uint_as_float(xw.y & 0xffff0000u) + g3 * o[c][4 * g + 3] * linv;
                        st_bf16x4(mo + d0, r);
                    }
            }
        }
#endif
    }
    __builtin_amdgcn_s_setprio(0);
}
__device__ __forceinline__ float wave_sum(float v) {
#pragma unroll
    for (int o = 1; o < 64; o <<= 1) v += __shfl_xor(v, o);
    return v;
}
__device__ __forceinline__ unsigned f2bf(float f) { unsigned u = __float_as_uint(f); return (u + 0x7fffu + ((u >> 16) & 1u)) >> 16; }
__device__ __forceinline__ unsigned pk2(float lo, float hi) { return f2bf(lo) | (f2bf(hi) << 16); }
__device__ __forceinline__ int ropemap(int v) { return 64 * ((v >> 5) & 3) + 32 * (v >> 7) + (v & 31); }

__device__ __forceinline__ void prep_weights(const Params& P, LAS unsigned char* lds, int gw, int ngw, int wave, int lane) {
    LAS float* scr = (LAS float*)(lds + wave * 8704);
    constexpr int IT0 = 16 * (NIN / 32), IT1 = 6 * (NQ / 32), IT2 = 4 * (NKV / 32), IT4 = 16 * 32, IT5 = 16 * (NUP / 32), IT6 = 44 * 32;
    constexpr int ITL = IT0 + IT1 + 2 * IT2 + IT4 + IT5 + IT6;
    for (int it = gw; it < 2 * ITL; it += ngw) {
        const int l = it / ITL; int r = it - l * ITL;
        int mat;
        if (r < IT0) mat = 0; else if ((r -= IT0) < IT1) mat = 1; else if ((r -= IT1) < IT2) mat = 2; else if ((r -= IT2) < IT2) mat = 3;
        else if ((r -= IT2) < IT4) mat = 4; else if ((r -= IT4) < IT5) mat = 5; else { r -= IT5; mat = 6; }
        const float* W; const float* gk = nullptr; bf16_t* WT; int K, NN; long stride;
        switch (mat) {
            case 0: W = P.in[8] + (size_t)l * 1024 * INC; gk = P.in[7] + l * 1024; WT = (bf16_t*)(P.ws + W_WIN) + (size_t)l * NIN * 1024; K = 1024; NN = NIN; stride = INC; break;
            case 1: W = P.in[16] + (size_t)l * QL * NQ; gk = P.in[15] + l * QL; WT = (bf16_t*)(P.ws + W_WQ) + (size_t)l * NQ * QL; K = QL; NN = NQ; stride = NQ; break;
            case 2: W = nullptr; gk = P.in[17] + l * KVL; WT = (bf16_t*)(P.ws + W_WKV) + (size_t)l * NKV * KVL; K = KVL; NN = NKV; stride = 128; break;
            case 3: W = nullptr; WT = (bf16_t*)(P.ws + W_WKVC) + (size_t)l * NKV * KVL; K = KVL; NN = NKV; stride = 128; break;
            case 4: W = P.in[20] + (size_t)l * 1024 * 1024; WT = (bf16_t*)(P.ws + W_WO) + (size_t)l * 1024 * 1024; K = 1024; NN = 1024; stride = 1024; break;
            case 5: W = P.in[22] + (size_t)l * 1024 * NUP; gk = P.in[21] + l * 1024; WT = (bf16_t*)(P.ws + W_WUP) + (size_t)l * NUP * 1024; K = 1024; NN = NUP; stride = NUP; break;
            default: W = P.in[25] + (size_t)l * DFF * 1024; WT = (bf16_t*)(P.ws + W_WDN) + (size_t)l * 1024 * DFF; K = DFF; NN = 1024; stride = 1024; break;
        }
        const int nblk = NN / 32, kb = r / nblk, nb = r - kb * nblk, k0 = 64 * kb, n0 = 32 * nb;
        const int np = n0 + (lane & 31); long off = -1;
        {
            const int tile = np >> 8, v = np & 255;
            switch (mat) {
                case 0:
                    if (tile < 4) off = 256 * tile + ropemap(v);
                    else if (tile < 8) off = 1024 + 256 * (tile - 4) + ropemap(v);
                    else if (tile < 12) off = 2048 + 256 * (tile - 8) + v;
                    else if (tile < 20) off = 3776 + 256 * (tile - 12) + v;
                    else if (tile == 20) off = 3456 + v;
                    else if (tile == 21) off = 3072 + v;
                    else { if (v < 128) off = 3072 + 256 + v; else { const int w = v - 128, wc = w >> 5; if (wc < 2) off = 3712 + 32 * ((w >> 4) & 1) + 16 * wc + (w & 15); } }
                    break;
                case 1:
                    if (tile < 4) off = (np >> 7) * 192 + (np & 127);
                    else { const int hh = 4 * (tile - 4) + ((v >> 5) & 3); off = hh * 192 + 128 + 32 * (v >> 7) + (v & 31); }
                    break;
                case 2: case 3: {
                    const int c = np & 1023, hh = c >> 7, n = c & 127;
                    W = (np < 1024 ? P.in[18] : P.in[19]) + (size_t)l * 8 * 256 * 128; off = (long)hh * 32768 + n; } break;
                case 5: off = (v < 128) ? 128 * tile + v : DFF + 128 * tile + (v - 128); break;
                default: off = np; break;
            }
        }
#pragma unroll 8
        for (int i = 0; i < 32; ++i) { const int kk = 2 * i + (lane >> 5); float v = 0.f;
            if (off >= 0) { v = W[(size_t)(k0 + kk) * stride + off]; if (gk) v *= gk[k0 + kk]; }
            scr[kk * 33 + (lane & 31)] = v; }
        asm volatile("s_waitcnt lgkmcnt(0)" ::: "memory");
        const int c = lane & 7;
#pragma unroll
        for (int j = 0; j < 4; ++j) { const int n = (lane >> 3) + 8 * j; const LAS float* s = scr + (8 * c) * 33 + n;
            u32x4 o; o.x = pk2(s[0 * 33], s[1 * 33]); o.y = pk2(s[2 * 33], s[3 * 33]); o.z = pk2(s[4 * 33], s[5 * 33]); o.w = pk2(s[6 * 33], s[7 * 33]);
            *(u32x4*)(WT + (size_t)(n0 + n) * K + k0 + 8 * c) = o; }
        asm volatile("s_waitcnt lgkmcnt(0)" ::: "memory");
    }
}

__device__ __forceinline__ void sincos_f(float a, float& s, float& c) {
    const float n = rintf(a * 0.6366197723675814f);
    float r = fmaf(-n, 1.5703125f, a); r = fmaf(-n, 4.837512969970703125e-4f, r); r = fmaf(-n, 7.54978995489188e-8f, r);
    const float r2 = r * r;
    const float sp = r + r * r2 * (-1.6666666667e-1f + r2 * (8.3333333333e-3f + r2 * (-1.9841269841e-4f + r2 * 2.7557319224e-6f)));
    const float cp = 1.f + r2 * (-0.5f + r2 * (4.1666666667e-2f + r2 * (-1.3888888889e-3f + r2 * (2.4801587302e-5f + r2 * -2.7557319224e-7f))));
    const int qd = ((int)n) & 3;
    s = (qd == 0) ? sp : (qd == 1) ? cp : (qd == 2) ? -sp : -cp;
    c = (qd == 0) ? cp : (qd == 1) ? -sp : (qd == 2) ? -cp : sp;
}

__device__ __forceinline__ void cvt_stream(const float* src, bf16_t* dst, size_t n8, size_t gt, size_t ngt) {
    for (size_t i = gt; i < n8; i += ngt) { const f32x4 a = *(const f32x4*)(src + i * 8), b = *(const f32x4*)(src + i * 8 + 4);
        u32x4 o; o.x = cvt_pk_bf16(a[0], a[1]); o.y = cvt_pk_bf16(a[2], a[3]); o.z = cvt_pk_bf16(b[0], b[1]); o.w = cvt_pk_bf16(b[2], b[3]); *(u32x4*)(dst + i * 8) = o; }
}

__device__ __forceinline__ void conv_phase(const Params& P, int l, size_t gt, size_t ngt) {
    const bf16_t* U = (const bf16_t*)(P.ws + W_U); bf16_t* ACT = (bf16_t*)(P.ws + W_ACT);
    const float* wc = P.in[23] + (size_t)l * 3 * NUP; const float* bc = P.in[24] + (size_t)l * NUP; const float* stc = P.in[6] + (size_t)l * 16 * 2 * NUP;
    constexpr int NCC = DFF / 8, NRB = MT / 32;
    for (size_t it = gt; it < (size_t)NRB * NCC; it += ngt) {
        const int rb = (int)(it / NCC), cc = (int)(it - (size_t)rb * NCC), r0 = rb * 32, j0 = cc * 8;
        float w[2][4][8];
#pragma unroll
        for (int gv = 0; gv < 2; ++gv)
#pragma unroll
            for (int k = 0; k < 4; ++k) { const float* p = (k < 3 ? wc + (size_t)k * NUP : bc) + gv * DFF + j0; const f32x4 a = *(const f32x4*)p, b = *(const f32x4*)(p + 4);
#pragma unroll
                for (int e = 0; e < 4; ++e) { w[gv][k][e] = a[e]; w[gv][k][4 + e] = b[e]; } }
        float u1[2][8], u2[2][8];
        const bool samp = r0 >= MP; const bool seq0 = samp || ((r0 & 2047) == 0);
#pragma unroll
        for (int gv = 0; gv < 2; ++gv) {
            if (seq0) {
                if (samp) { const float* s0 = stc + (unsigned)(((r0 - MP) >> 5) * 2 * NUP + gv * DFF + j0);
#pragma unroll
                    for (int e = 0; e < 8; ++e) { u2[gv][e] = s0[e]; u1[gv][e] = s0[NUP + e]; } }
                else {
#pragma unroll
                    for (int e = 0; e < 8; ++e) { u2[gv][e] = 0.f; u1[gv][e] = 0.f; } }
            } else {
                const unsigned ua = (unsigned)(r0 - 2) * (unsigned)NUP + (unsigned)(gv * DFF + j0); const u32x4 a = *(const u32x4*)(U + ua), b = *(const u32x4*)(U + (ua + (unsigned)NUP));
#pragma unroll
                for (int e = 0; e < 4; ++e) { u2[gv][2 * e] = __uint_as_float(a[e] << 16); u2[gv][2 * e + 1] = __uint_as_float(a[e] & 0xffff0000u);
                                              u1[gv][2 * e] = __uint_as_float(b[e] << 16); u1[gv][2 * e + 1] = __uint_as_float(b[e] & 0xffff0000u); }
            }
        }
#pragma unroll 4
        for (int r = 0; r < 32; ++r) {
            const unsigned uo = (unsigned)(r0 + r) * (unsigned)NUP + (unsigned)j0; const u32x4 ug = *(const u32x4*)(U + uo), uv = *(const u32x4*)(U + (uo + (unsigned)DFF));
            float res[8];
#pragma unroll
            for (int e = 0; e < 8; ++e) {
                const float g0 = (e & 1) ? __uint_as_float(ug[e >> 1] & 0xffff0000u) : __uint_as_float(ug[e >> 1] << 16);
                const float v0 = (e & 1) ? __uint_as_float(uv[e >> 1] & 0xffff0000u) : __uint_as_float(uv[e >> 1] << 16);
                const float cg = w[0][3][e] + w[0][0][e] * u2[0][e] + w[0][1][e] * u1[0][e] + w[0][2][e] * g0;
                const float cv = w[1][3][e] + w[1][0][e] * u2[1][e] + w[1][1][e] * u1[1][e] + w[1][2][e] * v0;
                u2[0][e] = u1[0][e]; u1[0][e] = g0; u2[1][e] = u1[1][e]; u1[1][e] = v0;
                res[e] = cg * sigmoidf_(cg) * cv;
            }
            u32x4 o; o.x = cvt_pk_bf16(res[0], res[1]); o.y = cvt_pk_bf16(res[2], res[3]); o.z = cvt_pk_bf16(res[4], res[5]); o.w = cvt_pk_bf16(res[6], res[7]);
            *(u32x4*)(ACT + ((unsigned)(r0 + r) * (unsigned)DFF + (unsigned)j0)) = o;
        }
    }
}
constexpr int LDS_BYTES = 147456;
template <class Epi> __device__ __forceinline__ void run_gemm(LAS unsigned char* lds, const int wid, const bf16_t* A, const bf16_t* Bt, int M, int N, int K, const Epi& E) {
    int gx = (int)gridDim.x, bx = (int)blockIdx.x, wv = wid; asm volatile("" : "+s"(gx), "+s"(bx), "+s"(wv));
    pg8::Gemm g{A, Bt, M, N, K}; pg8::StaticOrder S; S.init(M, N, gx, bx);
#ifndef NO_GEMM
    pg8::gemm_phase<Epi, pg8::StaticOrder, PG8_ALIGN, PG8_SP2>(lds, g, S, E, wv);
#endif
}

__global__ void __launch_bounds__(512, 2) fwd_megakernel(Params P) {
    extern __shared__ __attribute__((aligned(16))) unsigned char lds_raw[];
    LAS unsigned char* lds = (LAS unsigned char*)lds_raw;
    cg::grid_group grid = cg::this_grid();
    const int wave_s = __builtin_amdgcn_readfirstlane((int)threadIdx.x >> 6);
#define TID_DEFS const int lane = LANE_ID(), wave = wave_s, tid = (wave << 6) | lane; \
    const int G = gridDim.x, gw = blockIdx.x * 8 + wave, ngw = G * 8; const size_t gt = (size_t)blockIdx.x * 512 + tid, ngt = (size_t)G * 512; (void)lane; (void)gw; (void)ngw; (void)gt; (void)ngt;
    unsigned char* ws = P.ws; float* out = P.out;
#define gbar() do { asm volatile("s_waitcnt vmcnt(0) lgkmcnt(0)" ::: "memory"); __syncthreads(); bar_gen += gridDim.x; \
        if (wave_s == 0 && LANE_ID() == 0) { asm volatile("buffer_wbl2 sc1\n\ts_waitcnt vmcnt(0) lgkmcnt(0)" ::: "memory"); __threadfence(); asm volatile("s_waitcnt vmcnt(0) lgkmcnt(0)" ::: "memory"); \
            __hip_atomic_fetch_add(ctl + 128, 1u, __ATOMIC_RELAXED, __HIP_MEMORY_SCOPE_AGENT); \
            while (__hip_atomic_load(ctl + 128, __ATOMIC_RELAXED, __HIP_MEMORY_SCOPE_AGENT) < bar_gen) __builtin_amdgcn_s_sleep(2); } \
        __syncthreads(); __threadfence(); asm volatile("buffer_inv sc1\n\ts_waitcnt vmcnt(0) lgkmcnt(0)" ::: "memory"); } while (0)
#ifdef PROBE_SEL
    unsigned long long pr_acc = 0, pr_t0 = 0;
#define PR_BEGIN(c) do { if ((PROBE_SEL >> (c)) & 1) pr_t0 = __builtin_amdgcn_s_memrealtime(); } while (0)
#define PR_END(c) do { if ((PROBE_SEL >> (c)) & 1) pr_acc += __builtin_amdgcn_s_memrealtime() - pr_t0; } while (0)
#else
#define PR_BEGIN(c)
#define PR_END(c)
#endif
#define OPAQ() do { unsigned a_ = (unsigned)(uintptr_t)P.ws, b_ = (unsigned)((uintptr_t)P.ws >> 32), c_ = (unsigned)(uintptr_t)P.out, d_ = (unsigned)((uintptr_t)P.out >> 32); \
        asm volatile("" : "+s"(a_), "+s"(b_), "+s"(c_), "+s"(d_)); ws = (unsigned char*)(((uintptr_t)b_ << 32) | a_); out = (float*)(((uintptr_t)d_ << 32) | c_); } while (0)
    unsigned* ctl = (unsigned*)(ws + W_CTL); float* ctlf = (float*)(ws + W_CTL);
    float* rope = (float*)(ws + W_ROPE); float* SS = (float*)(ws + W_SS);
#define B_HX ((bf16_t*)(ws + W_HX))
#define B_X ((float*)(ws + W_X))
#define B_QDA ((bf16_t*)(ws + W_QDA))
#define B_KDA ((bf16_t*)(ws + W_KDA))
#define B_VDA ((bf16_t*)(ws + W_VDA))
#define B_GG ((bf16_t*)(ws + W_G))
#define B_CKV ((bf16_t*)(ws + W_CKV))
#define B_CQ ((bf16_t*)(ws + W_CQ))
#define B_KR ((bf16_t*)(ws + W_KR))
#define B_QM ((bf16_t*)(ws + W_QM))
#define B_KN ((bf16_t*)(ws + W_KN))
#define B_VM ((bf16_t*)(ws + W_VM))
#define B_MRG ((bf16_t*)(ws + W_MRG))
#define B_U ((bf16_t*)(ws + W_U))
#define B_ACT ((bf16_t*)(ws + W_ACT))
#define B_KC ((bf16_t*)(ws + W_KC))
#define B_VC ((bf16_t*)(ws + W_VC))
#define B_KRC ((bf16_t*)(ws + W_KRC))
#define B_CKVC ((bf16_t*)(ws + W_CKVC))
#define B_KNC ((bf16_t*)(ws + W_KNC))
#define B_VMC ((bf16_t*)(ws + W_VMC))
    PR_BEGIN(0);
    {
    TID_DEFS
#ifndef NO_PREP
    prep_weights(P, lds, gw, ngw, wave, lane);
#endif
    for (size_t idx = gt; idx < (size_t)2080 * 32; idx += ngt) {
        const int pos = (int)(idx >> 5), i = (int)(idx & 31);
        double inv = 1.0; for (int k = 0; k < i; ++k) inv *= 0.74989420933245582730;
        const double ang = (double)pos * inv; const double n = __builtin_rint(ang * 0.63661977236758134308);
        double r = __builtin_fma(-n, 1.57079632679489655800, ang); r = __builtin_fma(-n, 6.12323399573676603587e-17, r);
        const float rf = (float)r, r2 = rf * rf;
        const float sp = rf + rf * r2 * (-1.6666666667e-1f + r2 * (8.3333333333e-3f + r2 * (-1.9841269841e-4f + r2 * 2.7557319224e-6f)));
        const float cp = 1.f + r2 * (-0.5f + r2 * (4.1666666667e-2f + r2 * (-1.3888888889e-3f + r2 * (2.4801587302e-5f + r2 * -2.7557319224e-7f))));
        const int qd = ((int)n) & 3;
        rope[(size_t)pos * 64 + 32 + i] = (qd == 0) ? sp : (qd == 1) ? cp : (qd == 2) ? -sp : -cp;
        rope[(size_t)pos * 64 + i] = (qd == 0) ? cp : (qd == 1) ? -sp : (qd == 2) ? -cp : sp;
    }
    for (size_t idx = gt; idx < (size_t)8 * MT; idx += ngt) SS[MT + idx] = 0.f;
    if (blockIdx.x == 0 && tid < 64) {
        if (tid < 5) __hip_atomic_store(ctl + (tid == 4 ? 128 : tid * 16), 0u, __ATOMIC_RELAXED, __HIP_MEMORY_SCOPE_AGENT);
        for (int l = 0; l < 2; ++l) {
        OPAQ();
            const float a = wave_sum(P.in[10][l * 64 + lane] * P.in[11][l * 64 + lane]), b = wave_sum(P.in[12][l * 64 + lane] * P.in[13][l * 64 + lane]);
            const float li = 0.8f - 0.6f * expf(-0.3f * (float)l);
            if (lane == 0) { ctlf[64 + 2 * l] = expf(a) - expf(b) + li; ctlf[65 + 2 * l] = 1.f - li; }
        }
    }
    for (int row = gw; row < MT; row += ngw) {
        const float* xr = (row >= MP ? P.in[1] + (size_t)(row - MP) * 1024 : P.in[0] + (size_t)row * 1024); float s = 0.f;
#pragma unroll
        for (int j = 0; j < 4; ++j) { const f32x4 v = *(const f32x4*)(xr + 256 * j + 4 * lane); s += sq4(v); st_bf16x4(B_HX + (size_t)row * 1024 + 256 * j + 4 * lane, v); }
        s = wave_sum(s); if (lane == 0) SS[row] = s;
    }
    cvt_stream(P.in[2], B_KC, (size_t)2 * MC * 1024 / 8, gt, ngt);
    cvt_stream(P.in[3], B_VC, (size_t)2 * MC * 1024 / 8, gt, ngt);
    cvt_stream(P.in[4], B_CKVC, (size_t)2 * MC * 256 / 8, gt, ngt);
    cvt_stream(P.in[5], B_KRC, (size_t)2 * MC * 64 / 8, gt, ngt);
    }
    __threadfence(); asm volatile("buffer_wbl2 sc1\n\ts_waitcnt vmcnt(0) lgkmcnt(0)" ::: "memory");
    grid.sync();
    __threadfence(); asm volatile("buffer_inv sc1\n\ts_waitcnt vmcnt(0) lgkmcnt(0)" ::: "memory");
    unsigned bar_gen = 0;
    PR_END(0);

#pragma unroll 1
    for (int l = 0; l < 2; ++l) {
        OPAQ();
        float* ssx_attn = SS + (size_t)(2 * l) * MT; float* ssx_ffn = SS + (size_t)(2 * l + 1) * MT; float* ssx_next = SS + (size_t)(2 * l + 2) * MT;
        float* sscq = SS + (size_t)(5 + l) * MT; float* ssckv = SS + (size_t)(7 + l) * MT;
        float* ckp = out + O_CKVP + (size_t)l * MP * 256; float* cks = out + O_CKVS + (size_t)l * MSMP * 256;
        PR_BEGIN(1);
        {
            EpiInProj E; E.ws = ws; E.out = out; E.bgate = P.in[9] + (size_t)l * 2048; E.l = l;
            run_gemm(lds, wave_s, B_HX, (const bf16_t*)(ws + W_WIN) + (size_t)l * NIN * 1024, MT, NIN, 1024, E);
        }
        gbar(); OPAQ();
        PR_END(1);
        PR_BEGIN(2);
        {
            EpiQ E; E.sscq = sscq; E.rope = rope; E.QM = B_QM;
            run_gemm(lds, wave_s, B_CQ, (const bf16_t*)(ws + W_WQ) + (size_t)l * NQ * QL, MT, NQ, QL, E);
        }
        {
            EpiKV<true> E; E.ss = ssckv; E.O0 = B_KN; E.O1 = B_VM;
            run_gemm(lds, wave_s, B_CKV, (const bf16_t*)(ws + W_WKV) + (size_t)l * NKV * KVL, MT, NKV, KVL, E);
        }
        if (l == 0) {
#pragma unroll 1
            for (int l2 = 0; l2 < 2; ++l2) {
                EpiKV<false> E; E.ss = nullptr; E.O0 = B_KNC + (size_t)l2 * MC * 1024; E.O1 = B_VMC + (size_t)l2 * MC * 1024;
                run_gemm(lds, wave_s, B_CKVC + (size_t)l2 * MC * 256, (const bf16_t*)(ws + W_WKVC) + (size_t)l2 * NKV * KVL, MC, NKV, KVL, E);
            }
        }
        {
            TID_DEFS
            const float* gk = P.in[17] + (size_t)l * 256;
            for (size_t idx = gt; idx < (size_t)MT * 64; idx += ngt) {
                const int row = (int)(idx >> 6), c4 = (int)(idx & 63);
                float* p = (row >= MP ? cks + (size_t)(row - MP) * 256 : ckp + (size_t)row * 256) + 4 * c4;
                const float rs = rsqrtf(ssckv[row] * (1.f / 256.f) + EPS); const f32x4 g = *(const f32x4*)(gk + 4 * c4);
                *(f32x4*)p = *(const f32x4*)p * rs * g;
            }
        }
        gbar(); OPAQ();
        PR_END(2);
        PR_BEGIN(3);
        {
            AttnCtx C; C.ws = ws; C.gda = P.in[14] + (size_t)l * 128; C.lam = __int_as_float(__builtin_amdgcn_readfirstlane(__float_as_int(ctlf[64 + 2 * l]))); C.lam1m = __int_as_float(__builtin_amdgcn_readfirstlane(__float_as_int(ctlf[65 + 2 * l]))); C.counter = ctl + 16 * l; C.l = l;
#ifndef NO_ATTN
            { int wv = wave_s; asm volatile("" : "+s"(wv)); attn_phase(lds, C, wv); }
#ifdef PROBE_ATTN2
            gbar(); OPAQ(); C.counter = ctl + 32 + 16 * l; { int wv = wave_s; asm volatile("" : "+s"(wv)); attn_phase(lds, C, wv); }
#endif
#endif
        }
        gbar(); OPAQ();
        PR_END(3);
        PR_BEGIN(4);
        {
            EpiRes E; E.xp = (l == 0) ? P.in[0] : nullptr; E.xs = P.in[1]; E.X = nullptr; E.HX = B_HX; E.ssn = ssx_ffn;
            run_gemm(lds, wave_s, B_MRG, (const bf16_t*)(ws + W_WO) + (size_t)l * 1024 * 1024, MT, 1024, 1024, E);
        }
        gbar(); OPAQ();
        PR_END(4);
        PR_BEGIN(5);
        {
            EpiUp E; E.ssx = ssx_ffn; E.U = B_U; E.cvp = out + O_CVP + (size_t)l * 32 * 2 * NUP; E.cvs = out + O_CVS + (size_t)l * 16 * 2 * NUP;
            run_gemm(lds, wave_s, B_HX, (const bf16_t*)(ws + W_WUP) + (size_t)l * NUP * 1024, MT, NUP, 1024, E);
        }
        gbar(); OPAQ();
        PR_END(5);
#ifndef NO_CONV
        PR_BEGIN(6);
        { TID_DEFS conv_phase(P, l, gt, ngt); }
#endif
        gbar(); OPAQ();
        PR_END(6);
        PR_BEGIN(7);
        {
            EpiRes E; E.xp = nullptr; E.xs = nullptr; E.X = (l == 1) ? B_X : nullptr; E.HX = B_HX; E.ssn = ssx_next;
            run_gemm(lds, wave_s, B_ACT, (const bf16_t*)(ws + W_WDN) + (size_t)l * 1024 * DFF, MT, 1024, DFF, E);
        }
        gbar(); OPAQ();
        PR_END(7);
    }
    PR_BEGIN(8);
    {
        TID_DEFS
        const float* ssf = SS + (size_t)4 * MT; const float* gf = P.in[26];
        for (size_t idx = gt; idx < (size_t)MT * 256; idx += ngt) {
            const int row = (int)(idx >> 8), c4 = (int)(idx & 255);
            const float rs = rsqrtf(ssf[row] * (1.f / 1024.f) + EPS);
            *(f32x4*)(out + (size_t)row * 1024 + 4 * c4) = *(const f32x4*)(B_X + (size_t)row * 1024 + 4 * c4) * rs * *(const f32x4*)(gf + 4 * c4);
        }
    }
#ifdef PROBE_SEL
    PR_END(8);
    if (blockIdx.x == 0) { const unsigned long long s0 = __builtin_amdgcn_s_memrealtime(); while (__builtin_amdgcn_s_memrealtime() - s0 < pr_acc) __builtin_amdgcn_s_sleep(32); }
#endif
}

extern "C" void kernel_launch(void* const* d_in, const int* in_sizes, int n_in, void* d_out, int out_size, void* d_ws, size_t ws_size, hipStream_t stream) {
    static int grid_blocks = 0;
    if (grid_blocks == 0) {
        if (n_in != 27 || (size_t)out_size != O_END || ws_size < W_END) { fprintf(stderr, "kernel_launch: unexpected problem (n_in %d, out %d vs %zu, ws %zu vs %zu)\n", n_in, out_size, (size_t)O_END, ws_size, (size_t)W_END); grid_blocks = -1; return; }
        int dev = 0, cus = 0, per_cu = 0;
        (void)hipGetDevice(&dev); (void)hipDeviceGetAttribute(&cus, hipDeviceAttributeMultiprocessorCount, dev);
        (void)hipFuncSetAttribute((const void*)fwd_megakernel, hipFuncAttributeMaxDynamicSharedMemorySize, LDS_BYTES);
        (void)hipOccupancyMaxActiveBlocksPerMultiprocessor(&per_cu, (const void*)fwd_megakernel, 512, LDS_BYTES);
        if (per_cu < 1) per_cu = 1;
        grid_blocks = cus * per_cu;
    }
    if (grid_blocks < 0) return;
    Params p{};
    for (int i = 0; i < 27; ++i) p.in[i] = (const float*)d_in[i];
    p.out = (float*)d_out; p.ws = (unsigned char*)d_ws;
    void* args[] = {&p};
    hipError_t e = hipLaunchCooperativeKernel((void*)fwd_megakernel, dim3(grid_blocks), dim3(512), args, LDS_BYTES, stream);
    if (e != hipSuccess) fprintf(stderr, "cooperative launch failed: %s (grid %d)\n", hipGetErrorString(e), grid_blocks);
}
```

```cpp
#include <hip/hip_runtime.h>
#include <hip/hip_cooperative_groups.h>
#include <cstdio>
#include <cstdint>
namespace cg = cooperative_groups;
#define LANE_ID() ({ int l_ = (int)__builtin_amdgcn_mbcnt_hi(~0u, __builtin_amdgcn_mbcnt_lo(~0u, 0u)); asm volatile("" : "+v"(l_)); l_; })
namespace pg8 {
#define PG8_LAS __attribute__((address_space(3)))
typedef unsigned short bf16_t;
typedef short bf16x8 __attribute__((ext_vector_type(8)));
typedef float f32x4 __attribute__((ext_vector_type(4)));
typedef unsigned u32x4 __attribute__((ext_vector_type(4)));
constexpr int BM = 256, BK = 64, HALF = 128, HTB = HALF * BK * 2  , STAGE_BYTES = 8 * HTB, NXCD = 8, WGM = 8;

__host__ __device__ __forceinline__ int lds_byte(int r, int c) { const int st = (r >> 4) * 2 + (c >> 5), rr = r & 15, cc = c & 31, ob = rr * 64 + cc * 2; return st * 1024 + (ob ^ (((ob >> 9) & 1) << 5)); }
__host__ __device__ __forceinline__ void stage_rc(int b, int& R, int& C) { const int st = b / 1024, sb = b % 1024, swz = sb ^ (((sb >> 9) & 1) << 5); R = (st >> 1) * 16 + swz / 64; C = (st & 1) * 32 + (swz % 64) / 2; }
__host__ __device__ __forceinline__ int perm32(int rho) { const int n = rho >> 4, i = rho & 15; return 8 * (i >> 2) + 4 * n + (i & 3); }

struct Unit { int pm, pn; };
struct Gemm { const bf16_t* A; const bf16_t* Bt; int M, N, K; };

struct StaticOrder {
    int nM, nN, nwg, G, c;
    __host__ __device__ void init(int M, int N, int G_, int c_) { nM = M / BM; nN = N / BM; nwg = nM * nN; G = G_; c = c_; }
    __host__ __device__ bool next(int i, Unit& u) const {
        const long L = (long)i * G + c; if (L >= nwg) return false;
        int wgid = (int)L; { const int q = nwg / NXCD, r = nwg % NXCD, xcd = wgid % NXCD, off = wgid / NXCD; wgid = (xcd < r ? xcd * (q + 1) : r * (q + 1) + (xcd - r) * q) + off; }
        const int nig = WGM * nN, gid = wgid / nig, fm = gid * WGM, gsz = (nM - fm) < WGM ? (nM - fm) : WGM;
        u.pm = fm + ((wgid % nig) % gsz); u.pn = (wgid % nig) / gsz; return true;
    }
    __device__ __forceinline__ void a_ready(const Unit&) const {}
    __device__ __forceinline__ void done(const Unit&) const {}
};

typedef float f32x2_cv __attribute__((ext_vector_type(2))); typedef __bf16 bf16x2_cv __attribute__((ext_vector_type(2)));
__device__ __forceinline__ unsigned cvt_pk_bf16(float lo, float hi) { f32x2_cv v = {lo, hi}; bf16x2_cv b = __builtin_convertvector(v, bf16x2_cv); return __builtin_bit_cast(unsigned, b); }
template <class Epi, class Sched, bool ALIGN_EPI = false, bool SP2 = false>
__device__ __forceinline__ void gemm_phase(PG8_LAS unsigned char* lds, const Gemm g, const Sched& S, const Epi& E, const int wid_in) {
    const int wid = wid_in, lane = LANE_ID(), tid = (wid << 6) | lane, wr = wid >> 2, wc = wid & 3, fr = lane & 15, fq = lane >> 4;
    const int K = g.K, nt = K / BK;
    unsigned voffA[2], voffB[2];
#pragma unroll
    for (int i = 0; i < 2; ++i) { int R, C; stage_rc(tid * 16 + i * 8192, R, C); const int Rb = Epi::PERM ? ((R & ~31) + perm32(R & 31)) : R;
        voffA[i] = (unsigned)(R * K + C) * 2u; voffB[i] = (unsigned)(Rb * K + C) * 2u; }
    const size_t kstep = (size_t)(BK * 2);
    const size_t hstep = (size_t)HALF * K * 2;
    const size_t tstep = 2 * hstep;
    const unsigned ldsw = (unsigned)wid * 1024u;
    const int aoff = lds_byte(wr * 64 + fr, fq * 8), boff = lds_byte(wc * 32 + fr, fq * 8);
#define PG8_SA(b, h) (((b) * 2 + (h)) * HTB)
#define PG8_SB(b, h) ((4 + (b) * 2 + (h)) * HTB)
#define PG8_STAGE(bufoff, gbase, voff) do { _Pragma("unroll") for (int _i = 0; _i < 2; ++_i) \
        __builtin_amdgcn_global_load_lds((const unsigned*)((const char*)(gbase) + (voff)[_i]), (PG8_LAS unsigned*)(lds + (bufoff) + ldsw + _i * 8192), 16, 0, 0); } while (0)
#define PG8_LDA(dst, b, h) do { _Pragma("unroll") for (int m = 0; m < 4; ++m) _Pragma("unroll") for (int k = 0; k < 2; ++k) dst[m][k] = *(const PG8_LAS bf16x8*)(lds + PG8_SA(b, h) + aoff + m * 2048 + k * 1024); } while (0)
#define PG8_LDB(dst, b, h) do { _Pragma("unroll") for (int n = 0; n < 2; ++n) _Pragma("unroll") for (int k = 0; k < 2; ++k) dst[n][k] = *(const PG8_LAS bf16x8*)(lds + PG8_SB(b, h) + boff + n * 2048 + k * 1024); } while (0)
#define PG8_MMA(ai, bj, At, Bt) do { __builtin_amdgcn_s_setprio(1); _Pragma("unroll") for (int m = 0; m < 4; ++m) _Pragma("unroll") for (int n = 0; n < 2; ++n) _Pragma("unroll") for (int k = 0; k < 2; ++k) \
        acc[ai][bj][m][n] = __builtin_amdgcn_mfma_f32_16x16x32_bf16(Bt[n][k], At[m][k], acc[ai][bj][m][n], 0, 0, 0); __builtin_amdgcn_s_setprio(0); } while (0)
#define PG8_WAIT_V(n) asm volatile("s_waitcnt vmcnt(" #n ")" ::: "memory")
#define PG8_WAIT_L(n) asm volatile("s_waitcnt lgkmcnt(" #n ")" ::: "memory")
#define PG8_BAR __builtin_amdgcn_s_barrier()
#define PG8_SCHED __builtin_amdgcn_sched_barrier(0)
    Unit cur, nxt; int ui = 0;
    if (!S.next(0, cur)) return;
    f32x4 acc[2][2][4][2];
#pragma unroll
    for (int a = 0; a < 2; ++a)
#pragma unroll
        for (int b = 0; b < 2; ++b)
#pragma unroll
            for (int m = 0; m < 4; ++m)
#pragma unroll
                for (int n = 0; n < 2; ++n) acc[a][b][m][n] = (f32x4){0.f, 0.f, 0.f, 0.f};
    bf16x8 At[4][2], B0[2][2], B1[2][2];
    const char* cA = (const char*)g.A + (size_t)cur.pm * tstep; const char* cB = (const char*)g.Bt + (size_t)cur.pn * tstep;
    S.a_ready(cur);
    if constexpr (SP2) {
        PG8_STAGE(PG8_SB(0, 0), cB, voffB); PG8_STAGE(PG8_SB(0, 1), cB + hstep, voffB); PG8_STAGE(PG8_SA(0, 0), cA, voffA); PG8_STAGE(PG8_SA(0, 1), cA + hstep, voffA);
        if (wr == 1) PG8_BAR;
        PG8_WAIT_V(2); PG8_BAR;
        PG8_STAGE(PG8_SB(1, 0), cB + kstep, voffB); PG8_STAGE(PG8_SA(1, 0), cA + kstep, voffA); PG8_STAGE(PG8_SB(1, 1), cB + hstep + kstep, voffB);
        PG8_WAIT_V(6); PG8_BAR;
    } else {
        PG8_STAGE(PG8_SB(0, 0), cB, voffB); PG8_STAGE(PG8_SA(0, 0), cA, voffA); PG8_STAGE(PG8_SB(0, 1), cB + hstep, voffB); PG8_STAGE(PG8_SA(0, 1), cA + hstep, voffA);
        if (wr == 1) PG8_BAR;
        PG8_WAIT_V(4); PG8_BAR;
        PG8_STAGE(PG8_SB(1, 0), cB + kstep, voffB); PG8_STAGE(PG8_SA(1, 0), cA + kstep, voffA); PG8_STAGE(PG8_SB(1, 1), cB + hstep + kstep, voffB);
        PG8_WAIT_V(6); PG8_BAR;
    }
    for (;;) {
        const bool has_next = S.next(ui + 1, nxt);
        const char* nA = has_next ? (const char*)g.A + (size_t)nxt.pm * tstep : cA; const char* nB = has_next ? (const char*)g.Bt + (size_t)nxt.pn * tstep : cB;
        for (int t = 0; t < nt; t += 2) {
            const bool last = (t == nt - 2);
            const char* a1 = cA + (size_t)(t + 1) * kstep;
            const char* a2 = last ? nA : cA + (size_t)(t + 2) * kstep; const char* b2 = last ? nB : cB + (size_t)(t + 2) * kstep;
            const char* a3 = a2 + kstep; const char* b3 = b2 + kstep;
            if (last && has_next) S.a_ready(nxt);
            if constexpr (SP2) {
            PG8_LDB(B0, 0, 0); PG8_LDB(B1, 0, 1); PG8_SCHED; PG8_LDA(At, 0, 0); PG8_STAGE(PG8_SA(1, 1), a1 + hstep, voffA);
            PG8_WAIT_V(8); PG8_WAIT_L(0); PG8_BAR; PG8_MMA(0, 0, At, B0); PG8_MMA(0, 1, At, B1); PG8_BAR; PG8_SCHED;
            PG8_LDA(At, 0, 1); PG8_STAGE(PG8_SB(0, 0), b2, voffB); PG8_STAGE(PG8_SB(0, 1), b2 + hstep, voffB); PG8_STAGE(PG8_SA(0, 0), a2, voffA);
            PG8_WAIT_V(8); PG8_WAIT_L(0); PG8_BAR; PG8_MMA(1, 0, At, B0); PG8_MMA(1, 1, At, B1); PG8_BAR; PG8_SCHED;
            PG8_LDB(B0, 1, 0); PG8_LDB(B1, 1, 1); PG8_SCHED; PG8_LDA(At, 1, 0); PG8_STAGE(PG8_SA(0, 1), a2 + hstep, voffA);
            PG8_WAIT_V(8); PG8_WAIT_L(0); PG8_BAR; PG8_MMA(0, 0, At, B0); PG8_MMA(0, 1, At, B1); PG8_BAR; PG8_SCHED;
            PG8_LDA(At, 1, 1); PG8_STAGE(PG8_SB(1, 0), b3, voffB); PG8_STAGE(PG8_SB(1, 1), b3 + hstep, voffB); PG8_STAGE(PG8_SA(1, 0), a3, voffA);
            PG8_WAIT_V(8); PG8_WAIT_L(0); PG8_BAR; PG8_MMA(1, 0, At, B0); PG8_MMA(1, 1, At, B1); PG8_BAR; PG8_SCHED;
            } else {
            PG8_LDB(B0, 0, 0); PG8_SCHED; PG8_LDA(At, 0, 0); PG8_STAGE(PG8_SA(1, 1), a1 + hstep, voffA);
            PG8_WAIT_L(8); PG8_BAR; PG8_WAIT_L(0); PG8_MMA(0, 0, At, B0); PG8_BAR; PG8_SCHED;
            PG8_LDB(B1, 0, 1); PG8_STAGE(PG8_SB(0, 0), b2, voffB);
            PG8_BAR; PG8_WAIT_L(0); PG8_MMA(0, 1, At, B1); PG8_BAR;
            PG8_LDA(At, 0, 1); PG8_STAGE(PG8_SA(0, 0), a2, voffA);
            PG8_BAR; PG8_WAIT_L(0); PG8_MMA(1, 0, At, B0); PG8_BAR; PG8_SCHED;
            PG8_STAGE(PG8_SB(0, 1), b2 + hstep, voffB);
            PG8_WAIT_V(6); PG8_BAR; PG8_MMA(1, 1, At, B1); PG8_BAR;
            PG8_LDB(B0, 1, 0); PG8_SCHED; PG8_LDA(At, 1, 0); PG8_STAGE(PG8_SA(0, 1), a2 + hstep, voffA);
            PG8_WAIT_L(8); PG8_BAR; PG8_WAIT_L(0); PG8_MMA(0, 0, At, B0); PG8_BAR; PG8_SCHED;
            PG8_LDB(B1, 1, 1); PG8_STAGE(PG8_SB(1, 0), b3, voffB);
            PG8_BAR; PG8_WAIT_L(0); PG8_MMA(0, 1, At, B1); PG8_BAR;
            PG8_LDA(At, 1, 1); PG8_STAGE(PG8_SA(1, 0), a3, voffA);
            PG8_BAR; PG8_WAIT_L(0); PG8_MMA(1, 0, At, B0); PG8_BAR; PG8_SCHED;
            PG8_STAGE(PG8_SB(1, 1), b3 + hstep, voffB);
            PG8_WAIT_V(6); PG8_BAR; PG8_MMA(1, 1, At, B1); PG8_BAR;
            }
        }
        if constexpr (ALIGN_EPI) { if (wr == 0) PG8_BAR; }
        if constexpr (!Epi::AFTER_DRAIN) { const int le = LANE_ID(); E(acc, cur, wr, wc, le & 15, le >> 4); S.done(cur); }
        if (!has_next) break;
#pragma unroll
        for (int a = 0; a < 2; ++a)
#pragma unroll
            for (int b = 0; b < 2; ++b)
#pragma unroll
                for (int m = 0; m < 4; ++m)
#pragma unroll
                    for (int n = 0; n < 2; ++n) acc[a][b][m][n] = (f32x4){0.f, 0.f, 0.f, 0.f};
        cur = nxt; cA = nA; cB = nB; ++ui;
        if constexpr (ALIGN_EPI) { if (wr == 1) PG8_BAR; }
    }
    PG8_WAIT_V(0);
    if constexpr (!ALIGN_EPI) { if (wr == 0) PG8_BAR; }
    PG8_BAR;
    if constexpr (Epi::AFTER_DRAIN) { E.fused(acc, cur, wr, wc, fr, fq, lds, wid, lane); S.done(cur); }
#undef PG8_SA
#undef PG8_SB
#undef PG8_STAGE
#undef PG8_LDA
#undef PG8_LDB
#undef PG8_MMA
#undef PG8_WAIT_V
#undef PG8_WAIT_L
#undef PG8_BAR
#undef PG8_SCHED
}
}
#define PG8_SP2 true
#define PG8_ALIGN true
using pg8::bf16_t; using pg8::bf16x8; using pg8::f32x4; using pg8::Unit; using pg8::cvt_pk_bf16;
#define LAS __attribute__((address_space(3)))
typedef float f32x16 __attribute__((ext_vector_type(16)));
typedef unsigned u32x2 __attribute__((ext_vector_type(2)));
typedef unsigned u32x4 __attribute__((ext_vector_type(4)));
typedef short v4i16_t __attribute__((ext_vector_type(4)));

constexpr int MP = 65536, MSMP = 512, MT = MP + MSMP, MC = 32768;
constexpr int INC = 5824, NIN = 5888, QL = 384, KVL = 256, NQ = 1536, NKV = 2048, DFF = 2816, NUP = 5632;
constexpr float EPS = 1e-6f, LOG2E = 1.4426950408889634f;
constexpr float QS_DA = 0.125f * LOG2E;
constexpr float QS_MLA = 0.07216878364870322f * LOG2E;
constexpr size_t O_DKP = (size_t)MT * 1024;
constexpr size_t O_DVP = O_DKP + 2 * (size_t)MP * 1024;
constexpr size_t O_CKVP = O_DVP + 2 * (size_t)MP * 1024;
constexpr size_t O_KRP = O_CKVP + 2 * (size_t)MP * 256;
constexpr size_t O_CVP = O_KRP + 2 * (size_t)MP * 64;
constexpr size_t O_DKS = O_CVP + 2 * 32 * 2 * 5632;
constexpr size_t O_DVS = O_DKS + 2 * 512 * 1024;
constexpr size_t O_CKVS = O_DVS + 2 * 512 * 1024;
constexpr size_t O_KRS = O_CKVS + 2 * 512 * 256;
constexpr size_t O_CVS = O_KRS + 2 * 512 * 64;
constexpr size_t O_END = O_CVS + 2 * 16 * 2 * 5632;
constexpr size_t A256(size_t x) { return (x + 255) & ~(size_t)255; }
constexpr size_t W_CTL = 0;
constexpr size_t W_ROPE = 4096;
constexpr size_t W_SS = A256(W_ROPE + (size_t)2080 * 64 * 4);
constexpr size_t W_WIN = A256(W_SS + (size_t)9 * MT * 4);
constexpr size_t W_WQ = A256(W_WIN + (size_t)2 * NIN * 1024 * 2);
constexpr size_t W_WKV = A256(W_WQ + (size_t)2 * NQ * QL * 2);
constexpr size_t W_WKVC = A256(W_WKV + (size_t)2 * NKV * KVL * 2);
constexpr size_t W_WO = A256(W_WKVC + (size_t)2 * NKV * KVL * 2);
constexpr size_t W_WUP = A256(W_WO + (size_t)2 * 1024 * 1024 * 2);
constexpr size_t W_WDN = A256(W_WUP + (size_t)2 * NUP * 1024 * 2);
constexpr size_t W_HX = A256(W_WDN + (size_t)2 * 1024 * DFF * 2);
constexpr size_t W_X = A256(W_HX + (size_t)MT * 1024 * 2);
constexpr size_t W_QDA = A256(W_X + (size_t)MT * 1024 * 4);
constexpr size_t W_KDA = A256(W_QDA + (size_t)MT * 1024 * 2);
constexpr size_t W_VDA = A256(W_KDA + (size_t)MT * 1024 * 2);
constexpr size_t W_G = A256(W_VDA + (size_t)MT * 1024 * 2);
constexpr size_t W_CKV = A256(W_G + (size_t)MT * 2048 * 2);
constexpr size_t W_CQ = A256(W_CKV + (size_t)MT * 256 * 2);
constexpr size_t W_KR = A256(W_CQ + (size_t)MT * 384 * 2);
constexpr size_t W_QM = A256(W_KR + (size_t)MT * 64 * 2);
constexpr size_t W_KN = A256(W_QM + (size_t)MT * 1536 * 2);
constexpr size_t W_VM = A256(W_KN + (size_t)MT * 1024 * 2);
constexpr size_t W_MRG = A256(W_VM + (size_t)MT * 1024 * 2);
constexpr size_t W_U = A256(W_MRG + (size_t)MT * 1024 * 2);
constexpr size_t W_ACT = A256(W_U + (size_t)MT * NUP * 2);
constexpr size_t W_KC = A256(W_ACT + (size_t)MT * DFF * 2);
constexpr size_t W_VC = A256(W_KC + (size_t)2 * MC * 1024 * 2);
constexpr size_t W_KRC = A256(W_VC + (size_t)2 * MC * 1024 * 2);
constexpr size_t W_CKVC = A256(W_KRC + (size_t)2 * MC * 64 * 2);
constexpr size_t W_KNC = A256(W_CKVC + (size_t)2 * MC * 256 * 2);
constexpr size_t W_VMC = A256(W_KNC + (size_t)2 * MC * 1024 * 2);
constexpr size_t W_END = A256(W_VMC + (size_t)2 * MC * 1024 * 2);

struct Params { const float* in[27]; float* out; unsigned char* ws; };

#define GAS __attribute__((address_space(1)))
__device__ __forceinline__ void st_bf16x4(bf16_t* p, f32x4 v) { u32x2 w; w.x = cvt_pk_bf16(v[0], v[1]); w.y = cvt_pk_bf16(v[2], v[3]); *(GAS u32x2*)p = w; }
__device__ __forceinline__ f32x4 ldg4(const float* p) { return *(const GAS f32x4*)p; }
__device__ __forceinline__ void stg4(float* p, f32x4 v) { *(GAS f32x4*)p = v; }
__device__ __forceinline__ u32x4 ldgu4(const void* p) { return *(const GAS u32x4*)p; }
__device__ __forceinline__ u32x2 ldgu2(const void* p) { return *(const GAS u32x2*)p; }
__device__ __forceinline__ float ldg1(const float* p) { return *(const GAS float*)p; }
__device__ __forceinline__ float fast_rcp(float x) { return __builtin_amdgcn_rcpf(x); }
__device__ __forceinline__ float fast_exp2(float x) { return __builtin_amdgcn_exp2f(x); }
__device__ __forceinline__ float sigmoidf_(float x) { return fast_rcp(1.f + fast_exp2(-x * LOG2E)); }
__device__ __forceinline__ float bf2f(unsigned short b) { return __uint_as_float((unsigned)b << 16); }
__device__ __forceinline__ int row_of(const Unit& u, int ai, int wr, int m, int fr) { return u.pm * 256 + ai * 128 + wr * 64 + m * 16 + fr; }
__device__ __forceinline__ float sq4(f32x4 v) { return (v[0] * v[0] + v[1] * v[1]) + (v[2] * v[2] + v[3] * v[3]); }

__device__ __forceinline__ float add_x16(float s) { return s + __int_as_float(__builtin_amdgcn_ds_swizzle(__float_as_int(s), 0x401F)); }
__device__ __forceinline__ float add_x32(float s) { auto rr = __builtin_amdgcn_permlane32_swap(__float_as_uint(s), __float_as_uint(s), false, false); return __uint_as_float(rr[0]) + __uint_as_float(rr[1]); }
__device__ __forceinline__ float max_x32(float s) { auto rr = __builtin_amdgcn_permlane32_swap(__float_as_uint(s), __float_as_uint(s), false, false); return fmaxf(__uint_as_float(rr[0]), __uint_as_float(rr[1])); }
#define LOAD_RS8(name, ptr, scale, mul) float name[2][4]; { _Pragma("unroll") for (int ai_ = 0; ai_ < 2; ++ai_) _Pragma("unroll") for (int m_ = 0; m_ < 4; ++m_) name[ai_][m_] = ldg1((ptr) + row_of(u, ai_, wr, m_, fr)); \
    _Pragma("unroll") for (int ai_ = 0; ai_ < 2; ++ai_) _Pragma("unroll") for (int m_ = 0; m_ < 4; ++m_) name[ai_][m_] = rsqrtf(name[ai_][m_] * (scale) + EPS) * (mul); }
struct EpiInProj {
    static constexpr bool PERM = false, AFTER_DRAIN = false;
    unsigned char* ws; float* out; const float* bgate; int l;
    __device__ __forceinline__ void operator()(const f32x4 (&acc)[2][2][4][2], const Unit& u, int wr, int wc, int fr, int fq) const {
        const int pn = u.pn;
        const float* SSb = (const float*)(ws + W_SS); const float* ssx = SSb + (size_t)(2 * l) * MT; const float* rope = (const float*)(ws + W_ROPE);
        float* sscq = (float*)(ws + W_SS) + (size_t)(5 + l) * MT; float* ssckv = (float*)(ws + W_SS) + (size_t)(7 + l) * MT;
        bf16_t* QDA = (bf16_t*)(ws + W_QDA); bf16_t* KDA = (bf16_t*)(ws + W_KDA); bf16_t* VDA = (bf16_t*)(ws + W_VDA); bf16_t* G = (bf16_t*)(ws + W_G);
        bf16_t* CKV = (bf16_t*)(ws + W_CKV); bf16_t* CQ = (bf16_t*)(ws + W_CQ); bf16_t* KR = (bf16_t*)(ws + W_KR);
        float* dkp = out + O_DKP + (size_t)l * MP * 1024; float* dks = out + O_DKS + (size_t)l * MSMP * 1024; float* dvp = out + O_DVP + (size_t)l * MP * 1024; float* dvs = out + O_DVS + (size_t)l * MSMP * 1024;
        float* ckp = out + O_CKVP + (size_t)l * MP * 256; float* cks = out + O_CKVS + (size_t)l * MSMP * 256; float* krp = out + O_KRP + (size_t)l * MP * 64; float* krs = out + O_KRS + (size_t)l * MSMP * 64;
        LOAD_RS8(rs8, ssx, 1.f / 1024.f, 1.f)
        if (pn < 8) {
            const bool isk = pn >= 4; const int cb = 256 * (pn & 3) + 64 * wc;
#pragma unroll
            for (int ai = 0; ai < 2; ++ai)
#pragma unroll
                for (int m = 0; m < 4; ++m) { if ((m & 1) == 0) asm volatile("" ::: "memory");
                    const int row = row_of(u, ai, wr, m, fr); const float rstd = rs8[ai][m];
                    const bool samp = row >= MP; const int orow = samp ? row - MP : row; const int pos = samp ? 2048 + (orow & 31) : (row & 2047);
                    const float* rt = rope + (size_t)pos * 64;
#pragma unroll
                    for (int n = 0; n < 2; ++n) {
                        const int i0 = 16 * n + 4 * fq; const f32x4 cs = ldg4(rt + i0), sn = ldg4(rt + 32 + i0);
                        const f32x4 x1 = acc[ai][0][m][n] * rstd, x2 = acc[ai][1][m][n] * rstd;
                        f32x4 o1 = x1 * cs - x2 * sn, o2 = x2 * cs + x1 * sn;
                        if (!isk) { o1 = o1 * QS_DA; o2 = o2 * QS_DA; bf16_t* q = QDA + (size_t)row * 1024 + cb + i0; st_bf16x4(q, o1); st_bf16x4(q + 32, o2); }
                        else { bf16_t* k = KDA + (size_t)row * 1024 + cb + i0; st_bf16x4(k, o1); st_bf16x4(k + 32, o2);
                               float* d = (samp ? dks : dkp) + (size_t)orow * 1024 + cb + i0; stg4(d, o1); stg4((d + 32), o2); }
                    }
                }
        } else if (pn < 12) {
            const int cb = 256 * (pn - 8) + 32 * wc + 4 * fq;
#pragma unroll
            for (int ai = 0; ai < 2; ++ai)
#pragma unroll
                for (int m = 0; m < 4; ++m) { if ((m & 1) == 0) asm volatile("" ::: "memory");
                    const int row = row_of(u, ai, wr, m, fr); const float rstd = rs8[ai][m];
                    const bool samp = row >= MP; const int orow = samp ? row - MP : row;
                    float* d = (samp ? dvs : dvp) + (size_t)orow * 1024 + cb; bf16_t* v = VDA + (size_t)row * 1024 + cb;
#pragma unroll
                    for (int bj = 0; bj < 2; ++bj)
#pragma unroll
                        for (int n = 0; n < 2; ++n) { const f32x4 x = acc[ai][bj][m][n] * rstd; stg4((d + 128 * bj + 16 * n), x); st_bf16x4(v + 128 * bj + 16 * n, x); }
                }
        } else if (pn < 20) {
            const int cb = 256 * (pn - 12) + 32 * wc + 4 * fq;
            f32x4 bv[2][2];
#pragma unroll
            for (int bj = 0; bj < 2; ++bj)
#pragma unroll
                for (int n = 0; n < 2; ++n) bv[bj][n] = ldg4(bgate + cb + 128 * bj + 16 * n);
#pragma unroll
            for (int ai = 0; ai < 2; ++ai)
#pragma unroll
                for (int m = 0; m < 4; ++m) { if ((m & 1) == 0) asm volatile("" ::: "memory");
                    const int row = row_of(u, ai, wr, m, fr); const float rstd = rs8[ai][m];
                    bf16_t* g = G + (size_t)row * 2048 + cb;
#pragma unroll
                    for (int bj = 0; bj < 2; ++bj)
#pragma unroll
                        for (int n = 0; n < 2; ++n) { f32x4 x = acc[ai][bj][m][n] * rstd + bv[bj][n];
                            x[0] = sigmoidf_(x[0]); x[1] = sigmoidf_(x[1]); x[2] = sigmoidf_(x[2]); x[3] = sigmoidf_(x[3]); st_bf16x4(g + 128 * bj + 16 * n, x); }
                }
        } else if (pn == 20) {
            const int cb = 32 * wc + 4 * fq;
#pragma unroll
            for (int ai = 0; ai < 2; ++ai)
#pragma unroll
                for (int m = 0; m < 4; ++m) { if ((m & 1) == 0) asm volatile("" ::: "memory");
                    const int row = row_of(u, ai, wr, m, fr); const float rstd = rs8[ai][m];
                    const bool samp = row >= MP; const int orow = samp ? row - MP : row;
                    float* d = (samp ? cks : ckp) + (size_t)orow * 256 + cb; bf16_t* c = CKV + (size_t)row * 256 + cb; float s = 0.f;
#pragma unroll
                    for (int bj = 0; bj < 2; ++bj)
#pragma unroll
                        for (int n = 0; n < 2; ++n) { const f32x4 x = acc[ai][bj][m][n] * rstd; s += sq4(x); stg4((d + 128 * bj + 16 * n), x); st_bf16x4(c + 128 * bj + 16 * n, x); }
                    s = add_x16(s); s = add_x32(s);
                    if (fq == 0) unsafeAtomicAdd(ssckv + row, s);
                }
        } else if (pn == 21) {
            const int cb = 32 * wc + 4 * fq;
#pragma unroll
            for (int ai = 0; ai < 2; ++ai)
#pragma unroll
                for (int m = 0; m < 4; ++m) { if ((m & 1) == 0) asm volatile("" ::: "memory");
                    const int row = row_of(u, ai, wr, m, fr); const float rstd = rs8[ai][m];
                    bf16_t* c = CQ + (size_t)row * 384 + cb; float s = 0.f;
#pragma unroll
                    for (int bj = 0; bj < 2; ++bj)
#pragma unroll
                        for (int n = 0; n < 2; ++n) { const f32x4 x = acc[ai][bj][m][n] * rstd; s += sq4(x); st_bf16x4(c + 128 * bj + 16 * n, x); }
                    s = add_x16(s); s = add_x32(s);
                    if (fq == 0) unsafeAtomicAdd(sscq + row, s);
                }
        } else {
#pragma unroll
            for (int ai = 0; ai < 2; ++ai)
#pragma unroll
                for (int m = 0; m < 4; ++m) { if ((m & 1) == 0) asm volatile("" ::: "memory");
                    const int row = row_of(u, ai, wr, m, fr); const float rstd = rs8[ai][m];
                    const bool samp = row >= MP; const int orow = samp ? row - MP : row; const int pos = samp ? 2048 + (orow & 31) : (row & 2047);
                    bf16_t* c = CQ + (size_t)row * 384 + 256 + 32 * wc + 4 * fq; float s = 0.f;
#pragma unroll
                    for (int n = 0; n < 2; ++n) { const f32x4 x = acc[ai][0][m][n] * rstd; s += sq4(x); st_bf16x4(c + 16 * n, x); }
                    s = add_x16(s); s = add_x32(s);
                    if (fq == 0) unsafeAtomicAdd(sscq + row, s);
                    if (wc < 2) {
                        const int i0 = 16 * wc + 4 * fq; const float* rt = rope + (size_t)pos * 64;
                        const f32x4 cs = ldg4(rt + i0), sn = ldg4(rt + 32 + i0);
                        const f32x4 x1 = acc[ai][1][m][0] * rstd, x2 = acc[ai][1][m][1] * rstd;
                        const f32x4 o1 = x1 * cs - x2 * sn, o2 = x2 * cs + x1 * sn;
                        float* d = (samp ? krs : krp) + (size_t)orow * 64 + i0; stg4(d, o1); stg4((d + 32), o2);
                        bf16_t* k = KR + (size_t)row * 64 + i0; st_bf16x4(k, o1); st_bf16x4(k + 32, o2);
                    }
                }
        }
    }
};

struct EpiQ {
    static constexpr bool PERM = false, AFTER_DRAIN = false;
    const float* sscq; const float* rope; bf16_t* QM;
    __device__ __forceinline__ void operator()(const f32x4 (&acc)[2][2][4][2], const Unit& u, int wr, int wc, int fr, int fq) const {
        const int pn = u.pn;
        LOAD_RS8(rs8, sscq, 1.f / 384.f, QS_MLA)
#pragma unroll
        for (int ai = 0; ai < 2; ++ai)
#pragma unroll
            for (int m = 0; m < 4; ++m) { if ((m & 1) == 0) asm volatile("" ::: "memory");
                const int row = row_of(u, ai, wr, m, fr); const float rs = rs8[ai][m];
                bf16_t* q = QM + (size_t)row * 1536;
                if (pn < 4) {
#pragma unroll
                    for (int bj = 0; bj < 2; ++bj)
#pragma unroll
                        for (int n = 0; n < 2; ++n) st_bf16x4(q + (2 * pn + bj) * 192 + 32 * wc + 16 * n + 4 * fq, acc[ai][bj][m][n] * rs);
                } else {
                    const int pos = row >= MP ? 2048 + ((row - MP) & 31) : (row & 2047); const float* rt = rope + (size_t)pos * 64;
                    bf16_t* qh = q + (4 * (pn - 4) + wc) * 192 + 128;
#pragma unroll
                    for (int n = 0; n < 2; ++n) {
                        const int i0 = 16 * n + 4 * fq; const f32x4 cs = ldg4(rt + i0), sn = ldg4(rt + 32 + i0);
                        const f32x4 x1 = acc[ai][0][m][n] * rs, x2 = acc[ai][1][m][n] * rs;
                        st_bf16x4(qh + i0, x1 * cs - x2 * sn); st_bf16x4(qh + 32 + i0, x2 * cs + x1 * sn);
                    }
                }
            }
    }
};

template <bool HAS_SS> struct EpiKV {
    static constexpr bool PERM = false, AFTER_DRAIN = false;
    const float* ss; bf16_t *O0, *O1;
    __device__ __forceinline__ void operator()(const f32x4 (&acc)[2][2][4][2], const Unit& u, int wr, int wc, int fr, int fq) const {
        bf16_t* base = (u.pn < 4 ? O0 : O1) + 256 * (u.pn & 3) + 32 * wc + 4 * fq;
        float rs8[2][4];
        if constexpr (HAS_SS) { LOAD_RS8(t8, ss, 1.f / 256.f, 1.f) _Pragma("unroll") for (int a = 0; a < 2; ++a) _Pragma("unroll") for (int b = 0; b < 4; ++b) rs8[a][b] = t8[a][b]; }
#pragma unroll
        for (int ai = 0; ai < 2; ++ai)
#pragma unroll
            for (int m = 0; m < 4; ++m) { if ((m & 1) == 0) asm volatile("" ::: "memory");
                const int row = row_of(u, ai, wr, m, fr); const float rs = HAS_SS ? rs8[ai][m] : 1.f;
                bf16_t* o = base + (size_t)row * 1024;
#pragma unroll
                for (int bj = 0; bj < 2; ++bj)
#pragma unroll
                    for (int n = 0; n < 2; ++n) st_bf16x4(o + 128 * bj + 16 * n, acc[ai][bj][m][n] * rs);
            }
    }
};

struct EpiRes {
    static constexpr bool PERM = false, AFTER_DRAIN = false;
    const float* xp; const float* xs; float* X; bf16_t* HX; float* ssn;
    __device__ __forceinline__ void operator()(const f32x4 (&acc)[2][2][4][2], const Unit& u, int wr, int wc, int fr, int fq) const {
        const int cb = 256 * u.pn + 32 * wc + 4 * fq;
#pragma unroll
        for (int ai = 0; ai < 2; ++ai)
#pragma unroll
            for (int m = 0; m < 4; ++m) { if ((m & 1) == 0) asm volatile("" ::: "memory");
                const int row = row_of(u, ai, wr, m, fr);
                bf16_t* h = HX + (size_t)row * 1024 + cb; float s = 0.f;
                f32x4 xo[2][2];
                if (xp) { const float* xi = (row >= MP ? xs + (size_t)(row - MP) * 1024 : xp + (size_t)row * 1024) + cb;
#pragma unroll
                    for (int bj = 0; bj < 2; ++bj)
#pragma unroll
                        for (int n = 0; n < 2; ++n) xo[bj][n] = ldg4(xi + 128 * bj + 16 * n); }
                else {
#pragma unroll
                    for (int bj = 0; bj < 2; ++bj)
#pragma unroll
                        for (int n = 0; n < 2; ++n) { const u32x2 w = ldgu2(h + 128 * bj + 16 * n);
                            xo[bj][n] = (f32x4){__uint_as_float(w.x << 16), __uint_as_float(w.x & 0xffff0000u), __uint_as_float(w.y << 16), __uint_as_float(w.y & 0xffff0000u)}; } }
#pragma unroll
                for (int bj = 0; bj < 2; ++bj)
#pragma unroll
                    for (int n = 0; n < 2; ++n) { const f32x4 x = xo[bj][n] + acc[ai][bj][m][n]; s += sq4(x); st_bf16x4(h + 128 * bj + 16 * n, x);
                        if (X) stg4((X + (size_t)row * 1024 + cb + 128 * bj + 16 * n), x); }
                s = add_x16(s); s = add_x32(s);
                if (fq == 0) unsafeAtomicAdd(ssn + row, s);
            }
    }
};

template <int CTRL> __device__ __forceinline__ float dpp_f(float old, float src) { return __int_as_float(__builtin_amdgcn_update_dpp(__float_as_int(old), __float_as_int(src), CTRL, 0xf, 0xf, false)); }
struct EpiUp {
    static constexpr bool PERM = false, AFTER_DRAIN = false;
    const float* ssx; bf16_t* ACT; bf16_t* UH; float* cvp; float* cvs; const float* wc; const float* bc; const float* stc;
    __device__ __forceinline__ void operator()(const f32x4 (&acc)[2][2][4][2], const Unit& u, int wr, int wc_, int fr, int fq) const {
        const int cb = 128 * u.pn + 32 * wc_ + 4 * fq;
        const bool samp = u.pm >= 256;
        LOAD_RS8(rs8, ssx, 1.f / 1024.f, 1.f)
#pragma unroll
        for (int ai = 0; ai < 2; ++ai)
#pragma unroll
            for (int m = 0; m < 4; ++m) { asm volatile("" ::: "memory");
                const int row = row_of(u, ai, wr, m, fr); const float rs = rs8[ai][m];
                const bool from_prev = samp ? (m & 1) : (m > 0);
                const bool seq0 = !samp && m == 0 && ((row - fr) & 2047) == 0;
                const bool defer = !samp && m == 0 && !seq0 && fr < 2;
                float* cv = nullptr;
                if (samp) { const int r = row - MP, sq = r & 31; if (sq >= 30) cv = cvs + ((size_t)(r >> 5) * 2 + (sq - 30)) * NUP + cb; }
                else { const int sq = row & 2047; if (sq >= 2046) cv = cvp + ((size_t)(row >> 11) * 2 + (sq - 2046)) * NUP + cb; }
                bf16_t* uh = nullptr;
                if (!samp) { if (m == 0 && fr < 2) uh = UH + ((size_t)(row >> 6) * 4 + fr) * NUP + cb; else if (m == 3 && fr >= 14) uh = UH + ((size_t)(row >> 6) * 4 + 2 + (fr - 14)) * NUP + cb; }
                const float* st0 = stc + (size_t)(samp ? (row - MP) >> 5 : 0) * 2 * NUP + cb;
#pragma unroll
                for (int n = 0; n < 2; ++n) {
                    f32x4 cc[2];
#pragma unroll
                    for (int bj = 0; bj < 2; ++bj) {
                        const int co = DFF * bj + 16 * n;
                        const f32x4 x = acc[ai][bj][m][n] * rs;
                        if (cv) stg4(cv + co, x);
                        if (uh) st_bf16x4(uh + co, x);
                        f32x4 c1, c2;
                        if (from_prev) { const f32x4 xp = acc[ai][bj][m > 0 ? m - 1 : 0][n] * rs8[ai][m > 0 ? m - 1 : 0];
#pragma unroll
                            for (int j = 0; j < 4; ++j) { c1[j] = dpp_f<0x121>(0.f, xp[j]); c2[j] = dpp_f<0x122>(0.f, xp[j]); } }
                        else if (samp) { c1 = ldg4(st0 + NUP + co); c2 = ldg4(st0 + (size_t)(fr & 1) * NUP + co); }
                        else { c1 = (f32x4){0.f, 0.f, 0.f, 0.f}; c2 = c1; }
                        const f32x4 w0 = ldg4(wc + cb + co), w1 = ldg4(wc + NUP + cb + co), w2 = ldg4(wc + 2 * NUP + cb + co), bb = ldg4(bc + cb + co);
#pragma unroll
                        for (int j = 0; j < 4; ++j) { const float p1 = dpp_f<0x111>(c1[j], x[j]), p2 = dpp_f<0x112>(c2[j], x[j]); cc[bj][j] = bb[j] + w0[j] * p2 + w1[j] * p1 + w2[j] * x[j]; }
                    }
                    if (!defer) { f32x4 r;
#pragma unroll
                        for (int j = 0; j < 4; ++j) r[j] = cc[0][j] * sigmoidf_(cc[0][j]) * cc[1][j];
                        st_bf16x4(ACT + (size_t)row * DFF + cb + 16 * n, r); }
                }
            }
    }
};
struct KVD { const bf16_t* k; const bf16_t* k2; const bf16_t* v; };
constexpr int ATT_KBUF = 64 * 400, ATT_VOFF = 2 * ATT_KBUF, ATT_VIMG = 32 * 320, ATT_VBUF = 2 * ATT_VIMG;

template <int DQK>
__device__ __forceinline__ void attn_pass(LAS unsigned char* lds, const int wid, const bf16_t* qrow, const KVD& dm, const KVD& dl, int nmain, int ntw, int ntc, f32x16 (&o)[4], float& linv) {
    constexpr int NCH = DQK / 8, KST = DQK * 2 + 16, NKI = NCH / 8, NS = DQK / 16;
    const int lane = LANE_ID(), tid = (wid << 6) | lane, r32 = lane & 31, hi = lane >> 5;
    bf16x8 q[NS];
#pragma unroll
    for (int s = 0; s < NS; ++s) q[s] = __builtin_bit_cast(bf16x8, ldgu4(qrow + 16 * s + 8 * hi));
    u32x4 kr[NKI], vr[2];
#define ATT_GLOADK(t) do { const bool lastt = (t) >= nmain; const KVD& d = lastt ? dl : dm; const int rb = lastt ? 0 : (t) * 64; const int rm = lastt ? 31 : 63; \
        _Pragma("unroll") for (int i = 0; i < NKI; ++i) { const int id = tid + 512 * i, kro = id / NCH, kc = id - kro * NCH; const int r = rb + (kro & rm); \
            kr[i] = (DQK == 64 || kc < 16) ? ldgu4(d.k + (size_t)r * 1024 + kc * 8) : ldgu4(d.k2 + (size_t)r * 64 + (kc - 16) * 8); } } while (0)
#define ATT_GLOADV(t) do { const bool lastt = (t) >= nmain; const KVD& d = lastt ? dl : dm; const int rb = lastt ? 0 : (t) * 64; const int rm = lastt ? 31 : 63; \
        _Pragma("unroll") for (int i = 0; i < 2; ++i) { const int r = rb + (((tid >> 4) + 32 * i) & rm); vr[i] = ldgu4(d.v + (size_t)r * 1024 + (tid & 15) * 8); } } while (0)
#define ATT_LSTORE(b) do { \
        _Pragma("unroll") for (int i = 0; i < NKI; ++i) { const int id = tid + 512 * i, kro = id / NCH, kc = id - kro * NCH; *(LAS u32x4*)(lds + (b) * ATT_KBUF + kro * KST + kc * 16) = kr[i]; } \
        _Pragma("unroll") for (int i = 0; i < 2; ++i) *(LAS u32x4*)(lds + ATT_VOFF + (b) * ATT_VBUF + i * ATT_VIMG + (tid >> 4) * 320 + (tid & 15) * 16) = vr[i]; } while (0)
    ATT_GLOADK(0); ATT_GLOADV(0); ATT_LSTORE(0); __syncthreads();
    float m_run = 0.f, l_run = 0.f;
#pragma unroll
    for (int c = 0; c < 4; ++c)
#pragma unroll
        for (int r = 0; r < 16; ++r) o[c][r] = 0.f;
    const int vlane = (4 * hi + ((lane & 15) >> 2)) * 320 + (2 * ((lane >> 4) & 1) + ((lane & 3) >> 1)) * 16 + 8 * (lane & 1);
    for (int t = 0; t < ntw; ++t) {
        if (t + 1 < ntw) ATT_GLOADK(t + 1);
        bool vloaded = false;
        if (t < ntc) {
            const LAS unsigned char* kb = lds + (t & 1) * ATT_KBUF + r32 * KST + hi * 16;
            const LAS unsigned char* vb = lds + ATT_VOFF + (t & 1) * ATT_VBUF;
            f32x16 p0, p1;
#pragma unroll
            for (int r = 0; r < 16; ++r) { p0[r] = 0.f; p1[r] = 0.f; }
            constexpr int KCH = (DQK == 64) ? 2 : 1, NG = NS / KCH;
            bf16x8 kf[2][2 * KCH];
#define ATT_LDK(ch, b) do { _Pragma("unroll") for (int j_ = 0; j_ < KCH; ++j_) { kf[b][2 * j_] = *(const LAS bf16x8*)(kb + (KCH * (ch) + j_) * 32); kf[b][2 * j_ + 1] = *(const LAS bf16x8*)(kb + 32 * KST + (KCH * (ch) + j_) * 32); } } while (0)
            ATT_LDK(0, 0); __builtin_amdgcn_sched_barrier(0);
#pragma unroll
            for (int ch = 0; ch < NG; ++ch) {
                if (ch + 1 < NG) ATT_LDK(ch + 1, (ch + 1) & 1);
                __builtin_amdgcn_sched_barrier(0);
#pragma unroll
                for (int j = 0; j < KCH; ++j) {
                    p0 = __builtin_amdgcn_mfma_f32_32x32x16_bf16(kf[ch & 1][2 * j], q[KCH * ch + j], p0, 0, 0, 0);
                    p1 = __builtin_amdgcn_mfma_f32_32x32x16_bf16(kf[ch & 1][2 * j + 1], q[KCH * ch + j], p1, 0, 0, 0);
                }
                __builtin_amdgcn_sched_barrier(0);
            }
#undef ATT_LDK
            bf16x8 vf[2][4];
#define ATT_LDV(cmb, b) do { _Pragma("unroll") for (int c_ = 0; c_ < 4; ++c_) { const LAS unsigned char* a0_ = vb + vlane + ((cmb) >> 1) * ATT_VIMG + (16 * ((cmb) & 1)) * 320 + c_ * 64; \
                const v4i16_t t0_ = __builtin_amdgcn_ds_read_tr16_b64_v4i16((LAS v4i16_t*)a0_), t1_ = __builtin_amdgcn_ds_read_tr16_b64_v4i16((LAS v4i16_t*)(a0_ + 8 * 320)); \
                vf[b][c_] = (bf16x8){t0_[0], t0_[1], t0_[2], t0_[3], t1_[0], t1_[1], t1_[2], t1_[3]}; } } while (0)
#pragma unroll
            for (int r = 0; r < 16; ++r) { p0[r] -= m_run; p1[r] -= m_run; }
            if (t >= nmain) { asm volatile("" ::: "memory");
#pragma unroll
                for (int r = 0; r < 16; ++r) p1[r] = -INFINITY;
            }
            float mt = __builtin_fmaxf(__builtin_fmaxf(p0[0], p1[0]), p0[1]);
#pragma unroll
            for (int r = 1; r < 15; r += 2) { mt = __builtin_fmaxf(__builtin_fmaxf(mt, p1[r]), p0[r + 1]); mt = __builtin_fmaxf(__builtin_fmaxf(mt, p1[r + 1]), p0[r + 2 < 16 ? r + 2 : 15]); }
            mt = __builtin_fmaxf(mt, p1[15]);
            mt = max_x32(mt);
            const float dref = (t == 0 || mt > 8.f) ? mt : 0.f;
            if (__builtin_amdgcn_ballot_w64(dref != 0.f) != 0ull) {
                m_run += dref;
#pragma unroll
                for (int r = 0; r < 16; ++r) { p0[r] -= dref; p1[r] -= dref; }
                if (t > 0) { const float f = fast_exp2(-dref); l_run *= f;
#pragma unroll
                    for (int c = 0; c < 4; ++c)
#pragma unroll
                        for (int r = 0; r < 16; ++r) o[c][r] *= f; }
            }
            float rs = 0.f;
#pragma unroll
            for (int r = 0; r < 16; ++r) { p0[r] = fast_exp2(p0[r]); p1[r] = fast_exp2(p1[r]); rs += p0[r] + p1[r]; }
            l_run += rs;
            asm volatile("" ::: "memory");
            if (t + 1 < ntw) { ATT_GLOADV(t + 1); vloaded = true; }
            bf16x8 pf[2][2];
#pragma unroll
            for (int ks = 0; ks < 2; ++ks) {
                u32x4 a, b;
                a.x = cvt_pk_bf16(p0[8 * ks + 0], p0[8 * ks + 1]); a.y = cvt_pk_bf16(p0[8 * ks + 2], p0[8 * ks + 3]); a.z = cvt_pk_bf16(p0[8 * ks + 4], p0[8 * ks + 5]); a.w = cvt_pk_bf16(p0[8 * ks + 6], p0[8 * ks + 7]);
                b.x = cvt_pk_bf16(p1[8 * ks + 0], p1[8 * ks + 1]); b.y = cvt_pk_bf16(p1[8 * ks + 2], p1[8 * ks + 3]); b.z = cvt_pk_bf16(p1[8 * ks + 4], p1[8 * ks + 5]); b.w = cvt_pk_bf16(p1[8 * ks + 6], p1[8 * ks + 7]);
                pf[0][ks] = __builtin_bit_cast(bf16x8, a); pf[1][ks] = __builtin_bit_cast(bf16x8, b);
            }
            __builtin_amdgcn_sched_barrier(0);
            ATT_LDV(0, 0); __builtin_amdgcn_sched_barrier(0);
#pragma unroll
            for (int cmb = 0; cmb < 4; ++cmb) {
                if (cmb + 1 < 4) ATT_LDV(cmb + 1, (cmb + 1) & 1);
                __builtin_amdgcn_sched_barrier(0);
#pragma unroll
                for (int c = 0; c < 4; ++c) o[c] = __builtin_amdgcn_mfma_f32_32x32x16_bf16(vf[cmb & 1][c], pf[cmb >> 1][cmb & 1], o[c], 0, 0, 0);
                __builtin_amdgcn_sched_barrier(0);
            }
#undef ATT_LDV
        }
        if (t + 1 < ntw) { if (!vloaded) ATT_GLOADV(t + 1); ATT_LSTORE((t + 1) & 1); }
        __syncthreads();
    }
    const float lt = add_x32(l_run);
    linv = fast_rcp(lt);
#undef ATT_GLOADK
#undef ATT_GLOADV
#undef ATT_LSTORE
}

struct AttnCtx { unsigned char* ws; const float* gda; float lam, lam1m; unsigned* counter; int l; };
constexpr int ATT_NUNITS = 128 + 2048;
__device__ __forceinline__ void attn_phase(LAS unsigned char* lds, const AttnCtx& C, const int wid) {
#define TID_NOW() LANE_ID()
    LAS unsigned* ubox = (LAS unsigned*)(lds + 131072);
    if (wid < 4) __builtin_amdgcn_s_setprio(3); else __builtin_amdgcn_s_setprio(0);
    const bf16_t* QDA = (const bf16_t*)(C.ws + W_QDA); const bf16_t* KDA = (const bf16_t*)(C.ws + W_KDA); const bf16_t* VDA = (const bf16_t*)(C.ws + W_VDA);
    const bf16_t* GG = (const bf16_t*)(C.ws + W_G); bf16_t* MRG = (bf16_t*)(C.ws + W_MRG);
    for (;;) {
        if (wid == 0 && TID_NOW() == 0) ubox[0] = atomicAdd(C.counter, 1u);
        __syncthreads();
        const int un = (int)ubox[0];
        __syncthreads();
        if (un >= ATT_NUNITS) break;
        const bool samp = un < 128;
        int b, h, qb = 0;
        if (samp) { b = un >> 3; h = un & 7; } else { const int v = un - 128; qb = 7 - (v >> 8); b = (v & 255) >> 3; h = v & 7; }
        const int row = samp ? MP + b * 32 + (TID_NOW() & 31) : b * 2048 + qb * 256 + wid * 32 + (TID_NOW() & 31);
        const int ntw = samp ? 33 : 4 * qb + 4, nmain = samp ? 32 : ntw, ntc = samp ? (wid == 0 ? 33 : 0) : 4 * qb + (wid >> 1) + 1;
        const size_t kr0 = (size_t)b * 2048;
        const size_t fr0 = (size_t)MP + b * 32;
        const size_t coff = (size_t)C.l * MC;
        f32x16 o[4]; float linv;
#ifndef NO_DIFF
        {
            unsigned o1[32];
#pragma unroll 1
            for (int st = 0; st < 2; ++st) {
                KVD dm, dl;
                const bf16_t* Kb = samp ? (const bf16_t*)(C.ws + W_KC) + coff * 1024 : KDA; const bf16_t* Vb = samp ? (const bf16_t*)(C.ws + W_VC) + coff * 1024 : VDA;
                dm.k = Kb + kr0 * 1024 + h * 128 + st * 64; dm.k2 = dm.k; dm.v = Vb + kr0 * 1024 + h * 128;
                dl.k = KDA + fr0 * 1024 + h * 128 + st * 64; dl.k2 = dl.k; dl.v = VDA + fr0 * 1024 + h * 128;
                attn_pass<64>(lds, wid, QDA + (size_t)row * 1024 + h * 128 + st * 64, dm, dl, nmain, ntw, ntc, o, linv);
                if (st == 0) {
#pragma unroll
                    for (int c = 0; c < 4; ++c)
#pragma unroll
                        for (int r = 0; r < 16; r += 2) o1[c * 8 + (r >> 1)] = cvt_pk_bf16(o[c][r] * linv, o[c][r + 1] * linv);
                }
            }
            if (ntc > 0) {
                int rowe = row; asm volatile("" : "+v"(rowe));
                const int hi = (TID_NOW() >> 5) & 1;
                const float ll = C.lam * linv; float ss = 0.f;
#pragma unroll
                for (int c = 0; c < 4; ++c)
#pragma unroll
                    for (int r = 0; r < 16; r += 2) { const unsigned w = o1[c * 8 + (r >> 1)];
                        const float x0 = __uint_as_float(w << 16) - ll * o[c][r], x1 = __uint_as_float(w & 0xffff0000u) - ll * o[c][r + 1]; o[c][r] = x0; o[c][r + 1] = x1; ss += x0 * x0 + x1 * x1; }
                ss = add_x32(ss);
                const float rn = rsqrtf(ss * (1.f / 128.f) + EPS) * C.lam1m;
                const bf16_t* ga = GG + (size_t)rowe * 2048 + h * 128; bf16_t* mo = MRG + (size_t)rowe * 1024 + h * 128;
#pragma unroll
                for (int c = 0; c < 4; ++c)
#pragma unroll
                    for (int g = 0; g < 4; ++g) {
                        const int d0 = 32 * c + 8 * g + 4 * hi;
                        const u32x2 gw = ldgu2(ga + d0); const f32x4 gd = ldg4(C.gda + d0);
                        const float g0 = __uint_as_float(gw.x << 16), g1 = __uint_as_float(gw.x & 0xffff0000u), g2 = __uint_as_float(gw.y << 16), g3 = __uint_as_float(gw.y & 0xffff0000u);
                        f32x4 r; r[0] = o[c][4 * g + 0] * rn * gd[0] * g0; r[1] = o[c][4 * g + 1] * rn * gd[1] * g1; r[2] = o[c][4 * g + 2] * rn * gd[2] * g2; r[3] = o[c][4 * g + 3] * rn * gd[3] * g3;
                        st_bf16x4(mo + d0, r);
                    }
            }
        }
#endif
#ifndef NO_MLA
        {
            KVD dm, dl;
            const bf16_t* KN = (const bf16_t*)(C.ws + W_KN); const bf16_t* VM = (const bf16_t*)(C.ws + W_VM); const bf16_t* KR = (const bf16_t*)(C.ws + W_KR);
            dm.k = (samp ? (const bf16_t*)(C.ws + W_KNC) + coff * 1024 : KN) + kr0 * 1024 + h * 128; dm.k2 = (samp ? (const bf16_t*)(C.ws + W_KRC) + coff * 64 : KR) + kr0 * 64;
            dm.v = (samp ? (const bf16_t*)(C.ws + W_VMC) + coff * 1024 : VM) + kr0 * 1024 + h * 128;
            dl.k = KN + fr0 * 1024 + h * 128; dl.k2 = KR + fr0 * 64; dl.v = VM + fr0 * 1024 + h * 128;
            attn_pass<192>(lds, wid, (const bf16_t*)(C.ws + W_QM) + (size_t)row * 1536 + h * 192, dm, dl, nmain, ntw, ntc, o, linv);
            if (ntc > 0) {
                int rowe = row; asm volatile("" : "+v"(rowe));
                const int hi = (TID_NOW() >> 5) & 1;
                const bf16_t* gb = GG + (size_t)rowe * 2048 + 1024 + h * 128; bf16_t* mo = MRG + (size_t)rowe * 1024 + h * 128;
#pragma unroll
                for (int c = 0; c < 4; ++c)
#pragma unroll
                    for (int g = 0; g < 4; ++g) {
                        const int d0 = 32 * c + 8 * g + 4 * hi;
                        const u32x2 gw = ldgu2(gb + d0); const u32x2 xw = ldgu2(mo + d0);
                        const float g0 = __uint_as_float(gw.x << 16), g1 = __uint_as_float(gw.x & 0xffff0000u), g2 = __uint_as_float(gw.y << 16), g3 = __uint_as_float(gw.y & 0xffff0000u);
                        f32x4 r;
                        r[0] = __uint_as_float(xw.x << 16) + g0 * o[c][4 * g + 0] * linv; r[1] = __uint_as_float(xw.x & 0xffff0000u) + g1 * o[c][4 * g + 1] * linv;
                        r[2] = __uint_as_float(xw.y << 16) + g2 * o[c][4 * g + 2] * linv; r[3] = __uint_as_float(xw.y & 0xffff0000u) + g3 * o[c][4 * g + 3] * linv;
                        st_bf16x4(mo + d0, r);
                    }
            }
        }
#endif
    }
    __builtin_amdgcn_s_setprio(0);
}
__device__ __forceinline__ float wave_sum(float v) {
#pragma unroll
    for (int o = 1; o < 64; o <<= 1) v += __shfl_xor(v, o);
    return v;
}
__device__ __forceinline__ unsigned f2bf(float f) { unsigned u = __float_as_uint(f); return (u + 0x7fffu + ((u >> 16) & 1u)) >> 16; }
__device__ __forceinline__ unsigned pk2(float lo, float hi) { return f2bf(lo) | (f2bf(hi) << 16); }
__device__ __forceinline__ int ropemap(int v) { return 64 * ((v >> 5) & 3) + 32 * (v >> 7) + (v & 31); }

__device__ __forceinline__ void prep_weights(const Params& P, LAS unsigned char* lds, int gw, int ngw, int wave, int lane) {
    LAS float* scr = (LAS float*)(lds + wave * 8704);
    constexpr int IT0 = 16 * (NIN / 32), IT1 = 6 * (NQ / 32), IT2 = 4 * (NKV / 32), IT4 = 16 * 32, IT5 = 16 * (NUP / 32), IT6 = 44 * 32;
    constexpr int ITL = IT0 + IT1 + 2 * IT2 + IT4 + IT5 + IT6;
    for (int it = gw; it < 2 * ITL; it += ngw) {
        const int l = it / ITL; int r = it - l * ITL;
        int mat;
        if (r < IT0) mat = 0; else if ((r -= IT0) < IT1) mat = 1; else if ((r -= IT1) < IT2) mat = 2; else if ((r -= IT2) < IT2) mat = 3;
        else if ((r -= IT2) < IT4) mat = 4; else if ((r -= IT4) < IT5) mat = 5; else { r -= IT5; mat = 6; }
        const float* W; const float* gk = nullptr; bf16_t* WT; int K, NN; long stride;
        switch (mat) {
            case 0: W = P.in[8] + (size_t)l * 1024 * INC; gk = P.in[7] + l * 1024; WT = (bf16_t*)(P.ws + W_WIN) + (size_t)l * NIN * 1024; K = 1024; NN = NIN; stride = INC; break;
            case 1: W = P.in[16] + (size_t)l * QL * NQ; gk = P.in[15] + l * QL; WT = (bf16_t*)(P.ws + W_WQ) + (size_t)l * NQ * QL; K = QL; NN = NQ; stride = NQ; break;
            case 2: W = nullptr; gk = P.in[17] + l * KVL; WT = (bf16_t*)(P.ws + W_WKV) + (size_t)l * NKV * KVL; K = KVL; NN = NKV; stride = 128; break;
            case 3: W = nullptr; WT = (bf16_t*)(P.ws + W_WKVC) + (size_t)l * NKV * KVL; K = KVL; NN = NKV; stride = 128; break;
            case 4: W = P.in[20] + (size_t)l * 1024 * 1024; WT = (bf16_t*)(P.ws + W_WO) + (size_t)l * 1024 * 1024; K = 1024; NN = 1024; stride = 1024; break;
            case 5: W = P.in[22] + (size_t)l * 1024 * NUP; gk = P.in[21] + l * 1024; WT = (bf16_t*)(P.ws + W_WUP) + (size_t)l * NUP * 1024; K = 1024; NN = NUP; stride = NUP; break;
            default: W = P.in[25] + (size_t)l * DFF * 1024; WT = (bf16_t*)(P.ws + W_WDN) + (size_t)l * 1024 * DFF; K = DFF; NN = 1024; stride = 1024; break;
        }
        const int nblk = NN / 32, kb = r / nblk, nb = r - kb * nblk, k0 = 64 * kb, n0 = 32 * nb;
        const int np = n0 + (lane & 31); long off = -1;
        {
            const int tile = np >> 8, v = np & 255;
            switch (mat) {
                case 0:
                    if (tile < 4) off = 256 * tile + ropemap(v);
                    else if (tile < 8) off = 1024 + 256 * (tile - 4) + ropemap(v);
                    else if (tile < 12) off = 2048 + 256 * (tile - 8) + v;
                    else if (tile < 20) off = 3776 + 256 * (tile - 12) + v;
                    else if (tile == 20) off = 3456 + v;
                    else if (tile == 21) off = 3072 + v;
                    else { if (v < 128) off = 3072 + 256 + v; else { const int w = v - 128, wc = w >> 5; if (wc < 2) off = 3712 + 32 * ((w >> 4) & 1) + 16 * wc + (w & 15); } }
                    break;
                case 1:
                    if (tile < 4) off = (np >> 7) * 192 + (np & 127);
                    else { const int hh = 4 * (tile - 4) + ((v >> 5) & 3); off = hh * 192 + 128 + 32 * (v >> 7) + (v & 31); }
                    break;
                case 2: case 3: {
                    const int c = np & 1023, hh = c >> 7, n = c & 127;
                    W = (np < 1024 ? P.in[18] : P.in[19]) + (size_t)l * 8 * 256 * 128; off = (long)hh * 32768 + n; } break;
                case 5: off = (v < 128) ? 128 * tile + v : DFF + 128 * tile + (v - 128); break;
                default: off = np; break;
            }
        }
#pragma unroll 8
        for (int i = 0; i < 32; ++i) { const int kk = 2 * i + (lane >> 5); float v = 0.f;
            if (off >= 0) { v = W[(size_t)(k0 + kk) * stride + off]; if (gk) v *= gk[k0 + kk]; }
            scr[kk * 33 + (lane & 31)] = v; }
        asm volatile("s_waitcnt lgkmcnt(0)" ::: "memory");
        const int c = lane & 7;
#pragma unroll
        for (int j = 0; j < 4; ++j) { const int n = (lane >> 3) + 8 * j; const LAS float* s = scr + (8 * c) * 33 + n;
            u32x4 o; o.x = pk2(s[0 * 33], s[1 * 33]); o.y = pk2(s[2 * 33], s[3 * 33]); o.z = pk2(s[4 * 33], s[5 * 33]); o.w = pk2(s[6 * 33], s[7 * 33]);
            *(u32x4*)(WT + (size_t)(n0 + n) * K + k0 + 8 * c) = o; }
        asm volatile("s_waitcnt lgkmcnt(0)" ::: "memory");
    }
}

__device__ __forceinline__ void sincos_f(float a, float& s, float& c) {
    const float n = rintf(a * 0.6366197723675814f);
    float r = fmaf(-n, 1.5703125f, a); r = fmaf(-n, 4.837512969970703125e-4f, r); r = fmaf(-n, 7.54978995489188e-8f, r);
    const float r2 = r * r;
    const float sp = r + r * r2 * (-1.6666666667e-1f + r2 * (8.3333333333e-3f + r2 * (-1.9841269841e-4f + r2 * 2.7557319224e-6f)));
    const float cp = 1.f + r2 * (-0.5f + r2 * (4.1666666667e-2f + r2 * (-1.3888888889e-3f + r2 * (2.4801587302e-5f + r2 * -2.7557319224e-7f))));
    const int qd = ((int)n) & 3;
    s = (qd == 0) ? sp : (qd == 1) ? cp : (qd == 2) ? -sp : -cp;
    c = (qd == 0) ? cp : (qd == 1) ? -sp : (qd == 2) ? -cp : sp;
}

__device__ __forceinline__ void cvt_stream(const float* src, bf16_t* dst, size_t n8, size_t gt, size_t ngt) {
    for (size_t i = gt; i < n8; i += ngt) { const f32x4 a = *(const f32x4*)(src + i * 8), b = *(const f32x4*)(src + i * 8 + 4);
        u32x4 o; o.x = cvt_pk_bf16(a[0], a[1]); o.y = cvt_pk_bf16(a[2], a[3]); o.z = cvt_pk_bf16(b[0], b[1]); o.w = cvt_pk_bf16(b[2], b[3]); *(u32x4*)(dst + i * 8) = o; }
}

__device__ __forceinline__ void conv_fix_phase(const Params& P, int l, size_t gt, size_t ngt) {
    const bf16_t* UH = (const bf16_t*)(P.ws + W_U); bf16_t* ACT = (bf16_t*)(P.ws + W_ACT);
    const float* wc = P.in[23] + (size_t)l * 3 * NUP; const float* bc = P.in[24] + (size_t)l * NUP;
    constexpr int NCC = DFF / 8;
    for (size_t it = gt; it < (size_t)1024 * NCC; it += ngt) {
        const int sl = (int)(it / NCC), cc = (int)(it - (size_t)sl * NCC), j0 = cc * 8;
        if ((sl & 31) == 0) continue;
        float uu[4][2][8];
#pragma unroll
        for (int k = 0; k < 4; ++k)
#pragma unroll
            for (int gv = 0; gv < 2; ++gv) { const u32x4 a = ldgu4(UH + ((size_t)(k < 2 ? sl - 1 : sl) * 4 + (k < 2 ? 2 + k : k - 2)) * NUP + gv * DFF + j0);
#pragma unroll
                for (int e = 0; e < 4; ++e) { uu[k][gv][2 * e] = __uint_as_float(a[e] << 16); uu[k][gv][2 * e + 1] = __uint_as_float(a[e] & 0xffff0000u); } }
#pragma unroll
        for (int rr = 0; rr < 2; ++rr) {
            float res[8];
#pragma unroll
            for (int hf = 0; hf < 2; ++hf) {
                f32x4 w[2][4];
#pragma unroll
                for (int gv = 0; gv < 2; ++gv)
#pragma unroll
                    for (int k = 0; k < 4; ++k) w[gv][k] = ldg4((k < 3 ? wc + (size_t)k * NUP : bc) + gv * DFF + j0 + 4 * hf);
#pragma unroll
                for (int e = 0; e < 4; ++e) { const int q = 4 * hf + e;
                    const float cg = w[0][3][e] + w[0][0][e] * uu[rr][0][q] + w[0][1][e] * uu[rr + 1][0][q] + w[0][2][e] * uu[rr + 2][0][q];
                    const float cv = w[1][3][e] + w[1][0][e] * uu[rr][1][q] + w[1][1][e] * uu[rr + 1][1][q] + w[1][2][e] * uu[rr + 2][1][q];
                    res[q] = cg * sigmoidf_(cg) * cv; }
            }
            u32x4 o; o.x = cvt_pk_bf16(res[0], res[1]); o.y = cvt_pk_bf16(res[2], res[3]); o.z = cvt_pk_bf16(res[4], res[5]); o.w = cvt_pk_bf16(res[6], res[7]);
            *(GAS u32x4*)(ACT + ((size_t)(64 * sl + rr) * DFF + j0)) = o;
        }
    }
}
constexpr int LDS_BYTES = 147456;
template <class Epi> __device__ __forceinline__ void run_gemm(LAS unsigned char* lds, const int wid, const bf16_t* A, const bf16_t* Bt, int M, int N, int K, const Epi& E) {
    int gx = (int)gridDim.x, bx = (int)blockIdx.x, wv = wid; asm volatile("" : "+s"(gx), "+s"(bx), "+s"(wv));
    pg8::Gemm g{A, Bt, M, N, K}; pg8::StaticOrder S; S.init(M, N, gx, bx);
#ifndef NO_GEMM
    pg8::gemm_phase<Epi, pg8::StaticOrder, PG8_ALIGN, PG8_SP2>(lds, g, S, E, wv);
#endif
}

__global__ void __launch_bounds__(512, 2) fwd_megakernel(Params P) {
    extern __shared__ __attribute__((aligned(16))) unsigned char lds_raw[];
    LAS unsigned char* lds = (LAS unsigned char*)lds_raw;
    cg::grid_group grid = cg::this_grid();
    const int wave_s = __builtin_amdgcn_readfirstlane((int)threadIdx.x >> 6);
#define TID_DEFS const int lane = LANE_ID(), wave = wave_s, tid = (wave << 6) | lane; \
    const int G = gridDim.x, gw = blockIdx.x * 8 + wave, ngw = G * 8; const size_t gt = (size_t)blockIdx.x * 512 + tid, ngt = (size_t)G * 512; (void)lane; (void)gw; (void)ngw; (void)gt; (void)ngt;
    unsigned char* ws = P.ws; float* out = P.out;
#define gbar() do { asm volatile("s_waitcnt vmcnt(0) lgkmcnt(0)" ::: "memory"); __syncthreads(); bar_gen += gridDim.x; \
        if (wave_s == 0 && LANE_ID() == 0) { asm volatile("buffer_wbl2 sc1\n\ts_waitcnt vmcnt(0) lgkmcnt(0)" ::: "memory"); __threadfence(); asm volatile("s_waitcnt vmcnt(0) lgkmcnt(0)" ::: "memory"); \
            __hip_atomic_fetch_add(ctl + 128, 1u, __ATOMIC_RELAXED, __HIP_MEMORY_SCOPE_AGENT); \
            while (__hip_atomic_load(ctl + 128, __ATOMIC_RELAXED, __HIP_MEMORY_SCOPE_AGENT) < bar_gen) __builtin_amdgcn_s_sleep(2); } \
        __syncthreads(); __threadfence(); asm volatile("buffer_inv sc1\n\ts_waitcnt vmcnt(0) lgkmcnt(0)" ::: "memory"); } while (0)
#ifdef PROBE_SEL
    unsigned long long pr_acc = 0, pr_t0 = 0;
#define PR_BEGIN(c) do { if ((PROBE_SEL >> (c)) & 1) pr_t0 = __builtin_amdgcn_s_memrealtime(); } while (0)
#define PR_END(c) do { if ((PROBE_SEL >> (c)) & 1) pr_acc += __builtin_amdgcn_s_memrealtime() - pr_t0; } while (0)
#else
#define PR_BEGIN(c)
#define PR_END(c)
#endif
#define OPAQ() do { unsigned a_ = (unsigned)(uintptr_t)P.ws, b_ = (unsigned)((uintptr_t)P.ws >> 32), c_ = (unsigned)(uintptr_t)P.out, d_ = (unsigned)((uintptr_t)P.out >> 32); \
        asm volatile("" : "+s"(a_), "+s"(b_), "+s"(c_), "+s"(d_)); ws = (unsigned char*)(((uintptr_t)b_ << 32) | a_); out = (float*)(((uintptr_t)d_ << 32) | c_); } while (0)
    unsigned* ctl = (unsigned*)(ws + W_CTL); float* ctlf = (float*)(ws + W_CTL);
    float* rope = (float*)(ws + W_ROPE); float* SS = (float*)(ws + W_SS);
#define B_HX ((bf16_t*)(ws + W_HX))
#define B_X ((float*)(ws + W_X))
#define B_QDA ((bf16_t*)(ws + W_QDA))
#define B_KDA ((bf16_t*)(ws + W_KDA))
#define B_VDA ((bf16_t*)(ws + W_VDA))
#define B_GG ((bf16_t*)(ws + W_G))
#define B_CKV ((bf16_t*)(ws + W_CKV))
#define B_CQ ((bf16_t*)(ws + W_CQ))
#define B_KR ((bf16_t*)(ws + W_KR))
#define B_QM ((bf16_t*)(ws + W_QM))
#define B_KN ((bf16_t*)(ws + W_KN))
#define B_VM ((bf16_t*)(ws + W_VM))
#define B_MRG ((bf16_t*)(ws + W_MRG))
#define B_U ((bf16_t*)(ws + W_U))
#define B_ACT ((bf16_t*)(ws + W_ACT))
#define B_KC ((bf16_t*)(ws + W_KC))
#define B_VC ((bf16_t*)(ws + W_VC))
#define B_KRC ((bf16_t*)(ws + W_KRC))
#define B_CKVC ((bf16_t*)(ws + W_CKVC))
#define B_KNC ((bf16_t*)(ws + W_KNC))
#define B_VMC ((bf16_t*)(ws + W_VMC))
    PR_BEGIN(0);
    {
    TID_DEFS
#ifndef NO_PREP
    prep_weights(P, lds, gw, ngw, wave, lane);
#endif
    for (size_t idx = gt; idx < (size_t)2080 * 32; idx += ngt) {
        const int pos = (int)(idx >> 5), i = (int)(idx & 31);
        double inv = 1.0; for (int k = 0; k < i; ++k) inv *= 0.74989420933245582730;
        const double ang = (double)pos * inv; const double n = __builtin_rint(ang * 0.63661977236758134308);
        double r = __builtin_fma(-n, 1.57079632679489655800, ang); r = __builtin_fma(-n, 6.12323399573676603587e-17, r);
        const float rf = (float)r, r2 = rf * rf;
        const float sp = rf + rf * r2 * (-1.6666666667e-1f + r2 * (8.3333333333e-3f + r2 * (-1.9841269841e-4f + r2 * 2.7557319224e-6f)));
        const float cp = 1.f + r2 * (-0.5f + r2 * (4.1666666667e-2f + r2 * (-1.3888888889e-3f + r2 * (2.4801587302e-5f + r2 * -2.7557319224e-7f))));
        const int qd = ((int)n) & 3;
        rope[(size_t)pos * 64 + 32 + i] = (qd == 0) ? sp : (qd == 1) ? cp : (qd == 2) ? -sp : -cp;
        rope[(size_t)pos * 64 + i] = (qd == 0) ? cp : (qd == 1) ? -sp : (qd == 2) ? -cp : sp;
    }
    for (size_t idx = gt; idx < (size_t)8 * MT; idx += ngt) SS[MT + idx] = 0.f;
    if (blockIdx.x == 0 && tid < 64) {
        if (tid < 5) __hip_atomic_store(ctl + (tid == 4 ? 128 : tid * 16), 0u, __ATOMIC_RELAXED, __HIP_MEMORY_SCOPE_AGENT);
        for (int l = 0; l < 2; ++l) {
        OPAQ();
            const float a = wave_sum(P.in[10][l * 64 + lane] * P.in[11][l * 64 + lane]), b = wave_sum(P.in[12][l * 64 + lane] * P.in[13][l * 64 + lane]);
            const float li = 0.8f - 0.6f * expf(-0.3f * (float)l);
            if (lane == 0) { ctlf[64 + 2 * l] = expf(a) - expf(b) + li; ctlf[65 + 2 * l] = 1.f - li; }
        }
    }
    for (int row = gw; row < MT; row += ngw) {
        const float* xr = (row >= MP ? P.in[1] + (size_t)(row - MP) * 1024 : P.in[0] + (size_t)row * 1024); float s = 0.f;
#pragma unroll
        for (int j = 0; j < 4; ++j) { const f32x4 v = *(const f32x4*)(xr + 256 * j + 4 * lane); s += sq4(v); st_bf16x4(B_HX + (size_t)row * 1024 + 256 * j + 4 * lane, v); }
        s = wave_sum(s); if (lane == 0) SS[row] = s;
    }
    cvt_stream(P.in[2], B_KC, (size_t)2 * MC * 1024 / 8, gt, ngt);
    cvt_stream(P.in[3], B_VC, (size_t)2 * MC * 1024 / 8, gt, ngt);
    cvt_stream(P.in[4], B_CKVC, (size_t)2 * MC * 256 / 8, gt, ngt);
    cvt_stream(P.in[5], B_KRC, (size_t)2 * MC * 64 / 8, gt, ngt);
    }
    __threadfence(); asm volatile("buffer_wbl2 sc1\n\ts_waitcnt vmcnt(0) lgkmcnt(0)" ::: "memory");
    grid.sync();
    __threadfence(); asm volatile("buffer_inv sc1\n\ts_waitcnt vmcnt(0) lgkmcnt(0)" ::: "memory");
    unsigned bar_gen = 0;
    PR_END(0);

#pragma unroll 1
    for (int l = 0; l < 2; ++l) {
        OPAQ();
        float* ssx_attn = SS + (size_t)(2 * l) * MT; float* ssx_ffn = SS + (size_t)(2 * l + 1) * MT; float* ssx_next = SS + (size_t)(2 * l + 2) * MT;
        float* sscq = SS + (size_t)(5 + l) * MT; float* ssckv = SS + (size_t)(7 + l) * MT;
        float* ckp = out + O_CKVP + (size_t)l * MP * 256; float* cks = out + O_CKVS + (size_t)l * MSMP * 256;
        PR_BEGIN(1);
        {
            EpiInProj E; E.ws = ws; E.out = out; E.bgate = P.in[9] + (size_t)l * 2048; E.l = l;
            run_gemm(lds, wave_s, B_HX, (const bf16_t*)(ws + W_WIN) + (size_t)l * NIN * 1024, MT, NIN, 1024, E);
        }
        gbar(); OPAQ();
        PR_END(1);
        PR_BEGIN(2);
        {
            EpiQ E; E.sscq = sscq; E.rope = rope; E.QM = B_QM;
            run_gemm(lds, wave_s, B_CQ, (const bf16_t*)(ws + W_WQ) + (size_t)l * NQ * QL, MT, NQ, QL, E);
        }
        {
            EpiKV<true> E; E.ss = ssckv; E.O0 = B_KN; E.O1 = B_VM;
            run_gemm(lds, wave_s, B_CKV, (const bf16_t*)(ws + W_WKV) + (size_t)l * NKV * KVL, MT, NKV, KVL, E);
        }
        if (l == 0) {
#pragma unroll 1
            for (int l2 = 0; l2 < 2; ++l2) {
                EpiKV<false> E; E.ss = nullptr; E.O0 = B_KNC + (size_t)l2 * MC * 1024; E.O1 = B_VMC + (size_t)l2 * MC * 1024;
                run_gemm(lds, wave_s, B_CKVC + (size_t)l2 * MC * 256, (const bf16_t*)(ws + W_WKVC) + (size_t)l2 * NKV * KVL, MC, NKV, KVL, E);
            }
        }
        {
            TID_DEFS
            const float* gk = P.in[17] + (size_t)l * 256;
            for (size_t idx = gt; idx < (size_t)MT * 64; idx += ngt) {
                const int row = (int)(idx >> 6), c4 = (int)(idx & 63);
                float* p = (row >= MP ? cks + (size_t)(row - MP) * 256 : ckp + (size_t)row * 256) + 4 * c4;
                const float rs = rsqrtf(ssckv[row] * (1.f / 256.f) + EPS); const f32x4 g = *(const f32x4*)(gk + 4 * c4);
                *(f32x4*)p = *(const f32x4*)p * rs * g;
            }
        }
        gbar(); OPAQ();
        PR_END(2);
        PR_BEGIN(3);
        {
            AttnCtx C; C.ws = ws; C.gda = P.in[14] + (size_t)l * 128; C.lam = __int_as_float(__builtin_amdgcn_readfirstlane(__float_as_int(ctlf[64 + 2 * l]))); C.lam1m = __int_as_float(__builtin_amdgcn_readfirstlane(__float_as_int(ctlf[65 + 2 * l]))); C.counter = ctl + 16 * l; C.l = l;
#ifndef NO_ATTN
            { int wv = wave_s; asm volatile("" : "+s"(wv)); attn_phase(lds, C, wv); }
#ifdef PROBE_ATTN2
            gbar(); OPAQ(); C.counter = ctl + 32 + 16 * l; { int wv = wave_s; asm volatile("" : "+s"(wv)); attn_phase(lds, C, wv); }
#endif
#endif
        }
        gbar(); OPAQ();
        PR_END(3);
        PR_BEGIN(4);
        {
            EpiRes E; E.xp = (l == 0) ? P.in[0] : nullptr; E.xs = P.in[1]; E.X = nullptr; E.HX = B_HX; E.ssn = ssx_ffn;
            run_gemm(lds, wave_s, B_MRG, (const bf16_t*)(ws + W_WO) + (size_t)l * 1024 * 1024, MT, 1024, 1024, E);
        }
        gbar(); OPAQ();
        PR_END(4);
        PR_BEGIN(5);
        {
            EpiUp E; E.ssx = ssx_ffn; E.ACT = B_ACT; E.UH = B_U; E.cvp = out + O_CVP + (size_t)l * 32 * 2 * NUP; E.cvs = out + O_CVS + (size_t)l * 16 * 2 * NUP;
            E.wc = P.in[23] + (size_t)l * 3 * NUP; E.bc = P.in[24] + (size_t)l * NUP; E.stc = P.in[6] + (size_t)l * 16 * 2 * NUP;
            run_gemm(lds, wave_s, B_HX, (const bf16_t*)(ws + W_WUP) + (size_t)l * NUP * 1024, MT, NUP, 1024, E);
        }
        gbar(); OPAQ();
        PR_END(5);
#ifndef NO_CONV
        PR_BEGIN(6);
        { TID_DEFS conv_fix_phase(P, l, gt, ngt); }
#endif
        gbar(); OPAQ();
        PR_END(6);
        PR_BEGIN(7);
        {
            EpiRes E; E.xp = nullptr; E.xs = nullptr; E.X = (l == 1) ? B_X : nullptr; E.HX = B_HX; E.ssn = ssx_next;
            run_gemm(lds, wave_s, B_ACT, (const bf16_t*)(ws + W_WDN) + (size_t)l * 1024 * DFF, MT, 1024, DFF, E);
        }
        gbar(); OPAQ();
        PR_END(7);
    }
    PR_BEGIN(8);
    {
        TID_DEFS
        const float* ssf = SS + (size_t)4 * MT; const float* gf = P.in[26];
        for (size_t idx = gt; idx < (size_t)MT * 256; idx += ngt) {
            const int row = (int)(idx >> 8), c4 = (int)(idx & 255);
            const float rs = rsqrtf(ssf[row] * (1.f / 1024.f) + EPS);
            *(f32x4*)(out + (size_t)row * 1024 + 4 * c4) = *(const f32x4*)(B_X + (size_t)row * 1024 + 4 * c4) * rs * *(const f32x4*)(gf + 4 * c4);
        }
    }
#ifdef PROBE_SEL
    PR_END(8);
    if (blockIdx.x == 0) { const unsigned long long s0 = __builtin_amdgcn_s_memrealtime(); while (__builtin_amdgcn_s_memrealtime() - s0 < pr_acc) __builtin_amdgcn_s_sleep(32); }
#endif
}

extern "C" void kernel_launch(void* const* d_in, const int* in_sizes, int n_in, void* d_out, int out_size, void* d_ws, size_t ws_size, hipStream_t stream) {
    static int grid_blocks = 0;
    if (grid_blocks == 0) {
        if (n_in != 27 || (size_t)out_size != O_END || ws_size < W_END) { fprintf(stderr, "kernel_launch: unexpected problem (n_in %d, out %d vs %zu, ws %zu vs %zu)\n", n_in, out_size, (size_t)O_END, ws_size, (size_t)W_END); grid_blocks = -1; return; }
        int dev = 0, cus = 0, per_cu = 0;
        (void)hipGetDevice(&dev); (void)hipDeviceGetAttribute(&cus, hipDeviceAttributeMultiprocessorCount, dev);
        (void)hipFuncSetAttribute((const void*)fwd_megakernel, hipFuncAttributeMaxDynamicSharedMemorySize, LDS_BYTES);
        (void)hipOccupancyMaxActiveBlocksPerMultiprocessor(&per_cu, (const void*)fwd_megakernel, 512, LDS_BYTES);
        if (per_cu < 1) per_cu = 1;
        grid_blocks = cus * per_cu;
    }
    if (grid_blocks < 0) return;
    Params p{};
    for (int i = 0; i < 27; ++i) p.in[i] = (const float*)d_in[i];
    p.out = (float*)d_out; p.ws = (unsigned char*)d_ws;
    void* args[] = {&p};
    hipError_t e = hipLaunchCooperativeKernel((void*)fwd_megakernel, dim3(grid_blocks), dim3(512), args, LDS_BYTES, stream);
    if (e != hipSuccess) fprintf(stderr, "cooperative launch failed: %s (grid %d)\n", hipGetErrorString(e), grid_blocks);
}
```

```cpp
#include <hip/hip_runtime.h>
#include <hip/hip_cooperative_groups.h>
#include <cstdio>
#include <cstdint>
namespace cg = cooperative_groups;
#define LANE_ID() ({ int l_ = (int)__builtin_amdgcn_mbcnt_hi(~0u, __builtin_amdgcn_mbcnt_lo(~0u, 0u)); asm volatile("" : "+v"(l_)); l_; })
namespace pg8 {
#define PG8_LAS __attribute__((address_space(3)))
typedef unsigned short bf16_t;
typedef short bf16x8 __attribute__((ext_vector_type(8)));
typedef float f32x4 __attribute__((ext_vector_type(4)));
typedef unsigned u32x4 __attribute__((ext_vector_type(4)));
constexpr int BM = 256, BK = 64, HALF = 128, HTB = HALF * BK * 2  , STAGE_BYTES = 8 * HTB, NXCD = 8, WGM = 8;

__host__ __device__ __forceinline__ int lds_byte(int r, int c) { const int st = (r >> 4) * 2 + (c >> 5), rr = r & 15, cc = c & 31, ob = rr * 64 + cc * 2; return st * 1024 + (ob ^ (((ob >> 9) & 1) << 5)); }
__host__ __device__ __forceinline__ void stage_rc(int b, int& R, int& C) { const int st = b / 1024, sb = b % 1024, swz = sb ^ (((sb >> 9) & 1) << 5); R = (st >> 1) * 16 + swz / 64; C = (st & 1) * 32 + (swz % 64) / 2; }
__host__ __device__ __forceinline__ int perm32(int rho) { const int n = rho >> 4, i = rho & 15; return 8 * (i >> 2) + 4 * n + (i & 3); }

struct Unit { int pm, pn; };
struct Gemm { const bf16_t* A; const bf16_t* Bt; int M, N, K; };

struct StaticOrder {
    int nM, nN, nwg, G, c;
    __host__ __device__ void init(int M, int N, int G_, int c_) { nM = M / BM; nN = N / BM; nwg = nM * nN; G = G_; c = c_; }
    __host__ __device__ bool next(int i, Unit& u) const {
        const long L = (long)i * G + c; if (L >= nwg) return false;
        int wgid = (int)L; { const int q = nwg / NXCD, r = nwg % NXCD, xcd = wgid % NXCD, off = wgid / NXCD; wgid = (xcd < r ? xcd * (q + 1) : r * (q + 1) + (xcd - r) * q) + off; }
        const int nig = WGM * nN, gid = wgid / nig, fm = gid * WGM, gsz = (nM - fm) < WGM ? (nM - fm) : WGM;
        u.pm = fm + ((wgid % nig) % gsz); u.pn = (wgid % nig) / gsz; return true;
    }
    __device__ __forceinline__ void a_ready(const Unit&) const {}
    __device__ __forceinline__ void done(const Unit&) const {}
};

typedef float f32x2_cv __attribute__((ext_vector_type(2))); typedef __bf16 bf16x2_cv __attribute__((ext_vector_type(2)));
__device__ __forceinline__ unsigned cvt_pk_bf16(float lo, float hi) { f32x2_cv v = {lo, hi}; bf16x2_cv b = __builtin_convertvector(v, bf16x2_cv); return __builtin_bit_cast(unsigned, b); }
template <class Epi, class Sched, bool ALIGN_EPI = false, bool SP2 = false>
__device__ __forceinline__ void gemm_phase(PG8_LAS unsigned char* lds, const Gemm g, const Sched& S, const Epi& E, const int wid_in) {
    const int wid = wid_in, lane = LANE_ID(), tid = (wid << 6) | lane, wr = wid >> 2, wc = wid & 3, fr = lane & 15, fq = lane >> 4;
    const int K = g.K, nt = K / BK;
    unsigned voffA[2], voffB[2];
#pragma unroll
    for (int i = 0; i < 2; ++i) { int R, C; stage_rc(tid * 16 + i * 8192, R, C); const int Rb = Epi::PERM ? ((R & ~31) + perm32(R & 31)) : R;
        voffA[i] = (unsigned)(R * K + C) * 2u; voffB[i] = (unsigned)(Rb * K + C) * 2u; }
    const size_t kstep = (size_t)(BK * 2);
    const size_t hstep = (size_t)HALF * K * 2;
    const size_t tstep = 2 * hstep;
    const unsigned ldsw = (unsigned)wid * 1024u;
    const int aoff = lds_byte(wr * 64 + fr, fq * 8), boff = lds_byte(wc * 32 + fr, fq * 8);
#define PG8_SA(b, h) (((b) * 2 + (h)) * HTB)
#define PG8_SB(b, h) ((4 + (b) * 2 + (h)) * HTB)
#define PG8_STAGE(bufoff, gbase, voff) do { _Pragma("unroll") for (int _i = 0; _i < 2; ++_i) \
        __builtin_amdgcn_global_load_lds((const unsigned*)((const char*)(gbase) + (voff)[_i]), (PG8_LAS unsigned*)(lds + (bufoff) + ldsw + _i * 8192), 16, 0, 0); } while (0)
#define PG8_LDA(dst, b, h) do { _Pragma("unroll") for (int m = 0; m < 4; ++m) _Pragma("unroll") for (int k = 0; k < 2; ++k) dst[m][k] = *(const PG8_LAS bf16x8*)(lds + PG8_SA(b, h) + aoff + m * 2048 + k * 1024); } while (0)
#define PG8_LDB(dst, b, h) do { _Pragma("unroll") for (int n = 0; n < 2; ++n) _Pragma("unroll") for (int k = 0; k < 2; ++k) dst[n][k] = *(const PG8_LAS bf16x8*)(lds + PG8_SB(b, h) + boff + n * 2048 + k * 1024); } while (0)
#define PG8_MMA(ai, bj, At, Bt) do { __builtin_amdgcn_s_setprio(1); _Pragma("unroll") for (int m = 0; m < 4; ++m) _Pragma("unroll") for (int n = 0; n < 2; ++n) _Pragma("unroll") for (int k = 0; k < 2; ++k) \
        acc[ai][bj][m][n] = __builtin_amdgcn_mfma_f32_16x16x32_bf16(Bt[n][k], At[m][k], acc[ai][bj][m][n], 0, 0, 0); __builtin_amdgcn_s_setprio(0); } while (0)
#define PG8_WAIT_V(n) asm volatile("s_waitcnt vmcnt(" #n ")" ::: "memory")
#define PG8_WAIT_L(n) asm volatile("s_waitcnt lgkmcnt(" #n ")" ::: "memory")
#define PG8_BAR __builtin_amdgcn_s_barrier()
#define PG8_SCHED __builtin_amdgcn_sched_barrier(0)
    Unit cur, nxt; int ui = 0;
    if (!S.next(0, cur)) return;
    f32x4 acc[2][2][4][2];
#pragma unroll
    for (int a = 0; a < 2; ++a)
#pragma unroll
        for (int b = 0; b < 2; ++b)
#pragma unroll
            for (int m = 0; m < 4; ++m)
#pragma unroll
                for (int n = 0; n < 2; ++n) acc[a][b][m][n] = (f32x4){0.f, 0.f, 0.f, 0.f};
    bf16x8 At[4][2], B0[2][2], B1[2][2];
    const char* cA = (const char*)g.A + (size_t)cur.pm * tstep; const char* cB = (const char*)g.Bt + (size_t)cur.pn * tstep;
    S.a_ready(cur);
    if constexpr (SP2) {
        PG8_STAGE(PG8_SB(0, 0), cB, voffB); PG8_STAGE(PG8_SB(0, 1), cB + hstep, voffB); PG8_STAGE(PG8_SA(0, 0), cA, voffA); PG8_STAGE(PG8_SA(0, 1), cA + hstep, voffA);
        if (wr == 1) PG8_BAR;
        PG8_WAIT_V(2); PG8_BAR;
        PG8_STAGE(PG8_SB(1, 0), cB + kstep, voffB); PG8_STAGE(PG8_SA(1, 0), cA + kstep, voffA); PG8_STAGE(PG8_SB(1, 1), cB + hstep + kstep, voffB);
        PG8_WAIT_V(6); PG8_BAR;
    } else {
        PG8_STAGE(PG8_SB(0, 0), cB, voffB); PG8_STAGE(PG8_SA(0, 0), cA, voffA); PG8_STAGE(PG8_SB(0, 1), cB + hstep, voffB); PG8_STAGE(PG8_SA(0, 1), cA + hstep, voffA);
        if (wr == 1) PG8_BAR;
        PG8_WAIT_V(4); PG8_BAR;
        PG8_STAGE(PG8_SB(1, 0), cB + kstep, voffB); PG8_STAGE(PG8_SA(1, 0), cA + kstep, voffA); PG8_STAGE(PG8_SB(1, 1), cB + hstep + kstep, voffB);
        PG8_WAIT_V(6); PG8_BAR;
    }
    for (;;) {
        const bool has_next = S.next(ui + 1, nxt);
        const char* nA = has_next ? (const char*)g.A + (size_t)nxt.pm * tstep : cA; const char* nB = has_next ? (const char*)g.Bt + (size_t)nxt.pn * tstep : cB;
        for (int t = 0; t < nt; t += 2) {
            const bool last = (t == nt - 2);
            const char* a1 = cA + (size_t)(t + 1) * kstep;
            const char* a2 = last ? nA : cA + (size_t)(t + 2) * kstep; const char* b2 = last ? nB : cB + (size_t)(t + 2) * kstep;
            const char* a3 = a2 + kstep; const char* b3 = b2 + kstep;
            if (last && has_next) S.a_ready(nxt);
            if constexpr (SP2) {
            PG8_LDB(B0, 0, 0); PG8_LDB(B1, 0, 1); PG8_SCHED; PG8_LDA(At, 0, 0); PG8_STAGE(PG8_SA(1, 1), a1 + hstep, voffA);
            PG8_WAIT_V(8); PG8_WAIT_L(0); PG8_BAR; PG8_MMA(0, 0, At, B0); PG8_MMA(0, 1, At, B1); PG8_BAR; PG8_SCHED;
            PG8_LDA(At, 0, 1); PG8_STAGE(PG8_SB(0, 0), b2, voffB); PG8_STAGE(PG8_SB(0, 1), b2 + hstep, voffB); PG8_STAGE(PG8_SA(0, 0), a2, voffA);
            PG8_WAIT_V(8); PG8_WAIT_L(0); PG8_BAR; PG8_MMA(1, 0, At, B0); PG8_MMA(1, 1, At, B1); PG8_BAR; PG8_SCHED;
            PG8_LDB(B0, 1, 0); PG8_LDB(B1, 1, 1); PG8_SCHED; PG8_LDA(At, 1, 0); PG8_STAGE(PG8_SA(0, 1), a2 + hstep, voffA);
            PG8_WAIT_V(8); PG8_WAIT_L(0); PG8_BAR; PG8_MMA(0, 0, At, B0); PG8_MMA(0, 1, At, B1); PG8_BAR; PG8_SCHED;
            PG8_LDA(At, 1, 1); PG8_STAGE(PG8_SB(1, 0), b3, voffB); PG8_STAGE(PG8_SB(1, 1), b3 + hstep, voffB); PG8_STAGE(PG8_SA(1, 0), a3, voffA);
            PG8_WAIT_V(8); PG8_WAIT_L(0); PG8_BAR; PG8_MMA(1, 0, At, B0); PG8_MMA(1, 1, At, B1); PG8_BAR; PG8_SCHED;
            } else {
            PG8_LDB(B0, 0, 0); PG8_SCHED; PG8_LDA(At, 0, 0); PG8_STAGE(PG8_SA(1, 1), a1 + hstep, voffA);
            PG8_WAIT_L(8); PG8_BAR; PG8_WAIT_L(0); PG8_MMA(0, 0, At, B0); PG8_BAR; PG8_SCHED;
            PG8_LDB(B1, 0, 1); PG8_STAGE(PG8_SB(0, 0), b2, voffB);
            PG8_BAR; PG8_WAIT_L(0); PG8_MMA(0, 1, At, B1); PG8_BAR;
            PG8_LDA(At, 0, 1); PG8_STAGE(PG8_SA(0, 0), a2, voffA);
            PG8_BAR; PG8_WAIT_L(0); PG8_MMA(1, 0, At, B0); PG8_BAR; PG8_SCHED;
            PG8_STAGE(PG8_SB(0, 1), b2 + hstep, voffB);
            PG8_WAIT_V(6); PG8_BAR; PG8_MMA(1, 1, At, B1); PG8_BAR;
            PG8_LDB(B0, 1, 0); PG8_SCHED; PG8_LDA(At, 1, 0); PG8_STAGE(PG8_SA(0, 1), a2 + hstep, voffA);
            PG8_WAIT_L(8); PG8_BAR; PG8_WAIT_L(0); PG8_MMA(0, 0, At, B0); PG8_BAR; PG8_SCHED;
            PG8_LDB(B1, 1, 1); PG8_STAGE(PG8_SB(1, 0), b3, voffB);
            PG8_BAR; PG8_WAIT_L(0); PG8_MMA(0, 1, At, B1); PG8_BAR;
            PG8_LDA(At, 1, 1); PG8_STAGE(PG8_SA(1, 0), a3, voffA);
            PG8_BAR; PG8_WAIT_L(0); PG8_MMA(1, 0, At, B0); PG8_BAR; PG8_SCHED;
            PG8_STAGE(PG8_SB(1, 1), b3 + hstep, voffB);
            PG8_WAIT_V(6); PG8_BAR; PG8_MMA(1, 1, At, B1); PG8_BAR;
            }
        }
        if constexpr (ALIGN_EPI) { if (wr == 0) PG8_BAR; }
        if constexpr (!Epi::AFTER_DRAIN) { const int le = LANE_ID(); E(acc, cur, wr, wc, le & 15, le >> 4); S.done(cur); }
        if (!has_next) break;
#pragma unroll
        for (int a = 0; a < 2; ++a)
#pragma unroll
            for (int b = 0; b < 2; ++b)
#pragma unroll
                for (int m = 0; m < 4; ++m)
#pragma unroll
                    for (int n = 0; n < 2; ++n) acc[a][b][m][n] = (f32x4){0.f, 0.f, 0.f, 0.f};
        cur = nxt; cA = nA; cB = nB; ++ui;
        if constexpr (ALIGN_EPI) { if (wr == 1) PG8_BAR; }
    }
    PG8_WAIT_V(0);
    if constexpr (!ALIGN_EPI) { if (wr == 0) PG8_BAR; }
    PG8_BAR;
    if constexpr (Epi::AFTER_DRAIN) { E.fused(acc, cur, wr, wc, fr, fq, lds, wid, lane); S.done(cur); }
#undef PG8_SA
#undef PG8_SB
#undef PG8_STAGE
#undef PG8_LDA
#undef PG8_LDB
#undef PG8_MMA
#undef PG8_WAIT_V
#undef PG8_WAIT_L
#undef PG8_BAR
#undef PG8_SCHED
}
}
#define PG8_SP2 true
#define PG8_ALIGN true
using pg8::bf16_t; using pg8::bf16x8; using pg8::f32x4; using pg8::Unit; using pg8::cvt_pk_bf16;
#define LAS __attribute__((address_space(3)))
typedef float f32x16 __attribute__((ext_vector_type(16)));
typedef unsigned u32x2 __attribute__((ext_vector_type(2)));
typedef unsigned u32x4 __attribute__((ext_vector_type(4)));
typedef short v4i16_t __attribute__((ext_vector_type(4)));

constexpr int MP = 65536, MSMP = 512, MT = MP + MSMP, MC = 32768;
constexpr int INC = 5824, NIN = 5888, QL = 384, KVL = 256, NQ = 1536, NKV = 2048, DFF = 2816, NUP = 5632;
constexpr float EPS = 1e-6f, LOG2E = 1.4426950408889634f;
constexpr float QS_DA = 0.125f * LOG2E;
constexpr float QS_MLA = 0.07216878364870322f * LOG2E;
constexpr size_t O_DKP = (size_t)MT * 1024;
constexpr size_t O_DVP = O_DKP + 2 * (size_t)MP * 1024;
constexpr size_t O_CKVP = O_DVP + 2 * (size_t)MP * 1024;
constexpr size_t O_KRP = O_CKVP + 2 * (size_t)MP * 256;
constexpr size_t O_CVP = O_KRP + 2 * (size_t)MP * 64;
constexpr size_t O_DKS = O_CVP + 2 * 32 * 2 * 5632;
constexpr size_t O_DVS = O_DKS + 2 * 512 * 1024;
constexpr size_t O_CKVS = O_DVS + 2 * 512 * 1024;
constexpr size_t O_KRS = O_CKVS + 2 * 512 * 256;
constexpr size_t O_CVS = O_KRS + 2 * 512 * 64;
constexpr size_t O_END = O_CVS + 2 * 16 * 2 * 5632;
constexpr size_t A256(size_t x) { return (x + 255) & ~(size_t)255; }
constexpr size_t W_CTL = 0;
constexpr size_t W_ROPE = 4096;
constexpr size_t W_SS = A256(W_ROPE + (size_t)2080 * 64 * 4);
constexpr size_t W_WIN = A256(W_SS + (size_t)9 * MT * 4);
constexpr size_t W_WQ = A256(W_WIN + (size_t)2 * NIN * 1024 * 2);
constexpr size_t W_WKV = A256(W_WQ + (size_t)2 * NQ * QL * 2);
constexpr size_t W_WKVC = A256(W_WKV + (size_t)2 * NKV * KVL * 2);
constexpr size_t W_WO = A256(W_WKVC + (size_t)2 * NKV * KVL * 2);
constexpr size_t W_WUP = A256(W_WO + (size_t)2 * 1024 * 1024 * 2);
constexpr size_t W_WDN = A256(W_WUP + (size_t)2 * NUP * 1024 * 2);
constexpr size_t W_HX = A256(W_WDN + (size_t)2 * 1024 * DFF * 2);
constexpr size_t W_X = A256(W_HX + (size_t)MT * 1024 * 2);
constexpr size_t W_QDA = A256(W_X + (size_t)MT * 1024 * 4);
constexpr size_t W_KDA = A256(W_QDA + (size_t)MT * 1024 * 2);
constexpr size_t W_VDA = A256(W_KDA + (size_t)MT * 1024 * 2);
constexpr size_t W_G = A256(W_VDA + (size_t)MT * 1024 * 2);
constexpr size_t W_CKV = A256(W_G + (size_t)MT * 2048 * 2);
constexpr size_t W_CQ = A256(W_CKV + (size_t)MT * 256 * 2);
constexpr size_t W_KR = A256(W_CQ + (size_t)MT * 384 * 2);
constexpr size_t W_QM = A256(W_KR + (size_t)MT * 64 * 2);
constexpr size_t W_KN = A256(W_QM + (size_t)MT * 1536 * 2);
constexpr size_t W_VM = A256(W_KN + (size_t)MT * 1024 * 2);
constexpr size_t W_MRG = A256(W_VM + (size_t)MT * 1024 * 2);
constexpr size_t W_U = A256(W_MRG + (size_t)MT * 1024 * 2);
constexpr size_t W_ACT = A256(W_U + (size_t)MT * NUP * 2);
constexpr size_t W_KC = A256(W_ACT + (size_t)MT * DFF * 2);
constexpr size_t W_VC = A256(W_KC + (size_t)2 * MC * 1024 * 2);
constexpr size_t W_KRC = A256(W_VC + (size_t)2 * MC * 1024 * 2);
constexpr size_t W_CKVC = A256(W_KRC + (size_t)2 * MC * 64 * 2);
constexpr size_t W_KNC = A256(W_CKVC + (size_t)2 * MC * 256 * 2);
constexpr size_t W_VMC = A256(W_KNC + (size_t)2 * MC * 1024 * 2);
constexpr size_t W_END = A256(W_VMC + (size_t)2 * MC * 1024 * 2);

struct Params { const float* in[27]; float* out; unsigned char* ws; };

#define GAS __attribute__((address_space(1)))
__device__ __forceinline__ void st_bf16x4(bf16_t* p, f32x4 v) { u32x2 w; w.x = cvt_pk_bf16(v[0], v[1]); w.y = cvt_pk_bf16(v[2], v[3]); *(GAS u32x2*)p = w; }
__device__ __forceinline__ f32x4 ldg4(const float* p) { return *(const GAS f32x4*)p; }
__device__ __forceinline__ void stg4(float* p, f32x4 v) { *(GAS f32x4*)p = v; }
__device__ __forceinline__ u32x4 ldgu4(const void* p) { return *(const GAS u32x4*)p; }
__device__ __forceinline__ u32x2 ldgu2(const void* p) { return *(const GAS u32x2*)p; }
__device__ __forceinline__ float ldg1(const float* p) { return *(const GAS float*)p; }
__device__ __forceinline__ float fast_rcp(float x) { return __builtin_amdgcn_rcpf(x); }
__device__ __forceinline__ float fast_exp2(float x) { return __builtin_amdgcn_exp2f(x); }
__device__ __forceinline__ float sigmoidf_(float x) { return fast_rcp(1.f + fast_exp2(-x * LOG2E)); }
__device__ __forceinline__ float bf2f(unsigned short b) { return __uint_as_float((unsigned)b << 16); }
__device__ __forceinline__ int row_of(const Unit& u, int ai, int wr, int m, int fr) { return u.pm * 256 + ai * 128 + wr * 64 + m * 16 + fr; }
__device__ __forceinline__ float sq4(f32x4 v) { return (v[0] * v[0] + v[1] * v[1]) + (v[2] * v[2] + v[3] * v[3]); }

__device__ __forceinline__ float add_x16(float s) { return s + __int_as_float(__builtin_amdgcn_ds_swizzle(__float_as_int(s), 0x401F)); }
__device__ __forceinline__ float add_x32(float s) { auto rr = __builtin_amdgcn_permlane32_swap(__float_as_uint(s), __float_as_uint(s), false, false); return __uint_as_float(rr[0]) + __uint_as_float(rr[1]); }
__device__ __forceinline__ float max_x32(float s) { auto rr = __builtin_amdgcn_permlane32_swap(__float_as_uint(s), __float_as_uint(s), false, false); return fmaxf(__uint_as_float(rr[0]), __uint_as_float(rr[1])); }
#define LOAD_RS8(name, ptr, scale, mul) float name[2][4]; { _Pragma("unroll") for (int ai_ = 0; ai_ < 2; ++ai_) _Pragma("unroll") for (int m_ = 0; m_ < 4; ++m_) name[ai_][m_] = ldg1((ptr) + row_of(u, ai_, wr, m_, fr)); \
    _Pragma("unroll") for (int ai_ = 0; ai_ < 2; ++ai_) _Pragma("unroll") for (int m_ = 0; m_ < 4; ++m_) name[ai_][m_] = rsqrtf(name[ai_][m_] * (scale) + EPS) * (mul); }
struct EpiInProj {
    static constexpr bool PERM = false, AFTER_DRAIN = false;
    unsigned char* ws; float* out; const float* bgate; int l;
    __device__ __forceinline__ void operator()(const f32x4 (&acc)[2][2][4][2], const Unit& u, int wr, int wc, int fr, int fq) const {
        const int pn = u.pn;
        const float* SSb = (const float*)(ws + W_SS); const float* ssx = SSb + (size_t)(2 * l) * MT; const float* rope = (const float*)(ws + W_ROPE);
        float* sscq = (float*)(ws + W_SS) + (size_t)(5 + l) * MT; float* ssckv = (float*)(ws + W_SS) + (size_t)(7 + l) * MT;
        bf16_t* QDA = (bf16_t*)(ws + W_QDA); bf16_t* KDA = (bf16_t*)(ws + W_KDA); bf16_t* VDA = (bf16_t*)(ws + W_VDA); bf16_t* G = (bf16_t*)(ws + W_G);
        bf16_t* CKV = (bf16_t*)(ws + W_CKV); bf16_t* CQ = (bf16_t*)(ws + W_CQ); bf16_t* KR = (bf16_t*)(ws + W_KR);
        float* dkp = out + O_DKP + (size_t)l * MP * 1024; float* dks = out + O_DKS + (size_t)l * MSMP * 1024; float* dvp = out + O_DVP + (size_t)l * MP * 1024; float* dvs = out + O_DVS + (size_t)l * MSMP * 1024;
        float* ckp = out + O_CKVP + (size_t)l * MP * 256; float* cks = out + O_CKVS + (size_t)l * MSMP * 256; float* krp = out + O_KRP + (size_t)l * MP * 64; float* krs = out + O_KRS + (size_t)l * MSMP * 64;
        LOAD_RS8(rs8, ssx, 1.f / 1024.f, 1.f)
        if (pn < 8) {
            const bool isk = pn >= 4; const int cb = 256 * (pn & 3) + 64 * wc;
#pragma unroll
            for (int ai = 0; ai < 2; ++ai)
#pragma unroll
                for (int m = 0; m < 4; ++m) { if ((m & 1) == 0) asm volatile("" ::: "memory");
                    const int row = row_of(u, ai, wr, m, fr); const float rstd = rs8[ai][m];
                    const bool samp = row >= MP; const int orow = samp ? row - MP : row; const int pos = samp ? 2048 + (orow & 31) : (row & 2047);
                    const float* rt = rope + (size_t)pos * 64;
#pragma unroll
                    for (int n = 0; n < 2; ++n) {
                        const int i0 = 16 * n + 4 * fq; const f32x4 cs = ldg4(rt + i0), sn = ldg4(rt + 32 + i0);
                        const f32x4 x1 = acc[ai][0][m][n] * rstd, x2 = acc[ai][1][m][n] * rstd;
                        f32x4 o1 = x1 * cs - x2 * sn, o2 = x2 * cs + x1 * sn;
                        if (!isk) { o1 = o1 * QS_DA; o2 = o2 * QS_DA; bf16_t* q = QDA + (size_t)row * 1024 + cb + i0; st_bf16x4(q, o1); st_bf16x4(q + 32, o2); }
                        else { bf16_t* k = KDA + (size_t)row * 1024 + cb + i0; st_bf16x4(k, o1); st_bf16x4(k + 32, o2);
                               float* d = (samp ? dks : dkp) + (size_t)orow * 1024 + cb + i0; stg4(d, o1); stg4((d + 32), o2); }
                    }
                }
        } else if (pn < 12) {
            const int cb = 256 * (pn - 8) + 32 * wc + 4 * fq;
#pragma unroll
            for (int ai = 0; ai < 2; ++ai)
#pragma unroll
                for (int m = 0; m < 4; ++m) { if ((m & 1) == 0) asm volatile("" ::: "memory");
                    const int row = row_of(u, ai, wr, m, fr); const float rstd = rs8[ai][m];
                    const bool samp = row >= MP; const int orow = samp ? row - MP : row;
                    float* d = (samp ? dvs : dvp) + (size_t)orow * 1024 + cb; bf16_t* v = VDA + (size_t)row * 1024 + cb;
#pragma unroll
                    for (int bj = 0; bj < 2; ++bj)
#pragma unroll
                        for (int n = 0; n < 2; ++n) { const f32x4 x = acc[ai][bj][m][n] * rstd; stg4((d + 128 * bj + 16 * n), x); st_bf16x4(v + 128 * bj + 16 * n, x); }
                }
        } else if (pn < 20) {
            const int cb = 256 * (pn - 12) + 32 * wc + 4 * fq;
            f32x4 bv[2][2];
#pragma unroll
            for (int bj = 0; bj < 2; ++bj)
#pragma unroll
                for (int n = 0; n < 2; ++n) bv[bj][n] = ldg4(bgate + cb + 128 * bj + 16 * n);
#pragma unroll
            for (int ai = 0; ai < 2; ++ai)
#pragma unroll
                for (int m = 0; m < 4; ++m) { if ((m & 1) == 0) asm volatile("" ::: "memory");
                    const int row = row_of(u, ai, wr, m, fr); const float rstd = rs8[ai][m];
                    bf16_t* g = G + (size_t)row * 2048 + cb;
#pragma unroll
                    for (int bj = 0; bj < 2; ++bj)
#pragma unroll
                        for (int n = 0; n < 2; ++n) { f32x4 x = acc[ai][bj][m][n] * rstd + bv[bj][n];
                            x[0] = sigmoidf_(x[0]); x[1] = sigmoidf_(x[1]); x[2] = sigmoidf_(x[2]); x[3] = sigmoidf_(x[3]); st_bf16x4(g + 128 * bj + 16 * n, x); }
                }
        } else if (pn == 20) {
            const int cb = 32 * wc + 4 * fq;
#pragma unroll
            for (int ai = 0; ai < 2; ++ai)
#pragma unroll
                for (int m = 0; m < 4; ++m) { if ((m & 1) == 0) asm volatile("" ::: "memory");
                    const int row = row_of(u, ai, wr, m, fr); const float rstd = rs8[ai][m];
                    const bool samp = row >= MP; const int orow = samp ? row - MP : row;
                    float* d = (samp ? cks : ckp) + (size_t)orow * 256 + cb; bf16_t* c = CKV + (size_t)row * 256 + cb; float s = 0.f;
#pragma unroll
                    for (int bj = 0; bj < 2; ++bj)
#pragma unroll
                        for (int n = 0; n < 2; ++n) { const f32x4 x = acc[ai][bj][m][n] * rstd; s += sq4(x); stg4((d + 128 * bj + 16 * n), x); st_bf16x4(c + 128 * bj + 16 * n, x); }
                    s = add_x16(s); s = add_x32(s);
                    if (fq == 0) unsafeAtomicAdd(ssckv + row, s);
                }
        } else if (pn == 21) {
            const int cb = 32 * wc + 4 * fq;
#pragma unroll
            for (int ai = 0; ai < 2; ++ai)
#pragma unroll
                for (int m = 0; m < 4; ++m) { if ((m & 1) == 0) asm volatile("" ::: "memory");
                    const int row = row_of(u, ai, wr, m, fr); const float rstd = rs8[ai][m];
                    bf16_t* c = CQ + (size_t)row * 384 + cb; float s = 0.f;
#pragma unroll
                    for (int bj = 0; bj < 2; ++bj)
#pragma unroll
                        for (int n = 0; n < 2; ++n) { const f32x4 x = acc[ai][bj][m][n] * rstd; s += sq4(x); st_bf16x4(c + 128 * bj + 16 * n, x); }
                    s = add_x16(s); s = add_x32(s);
                    if (fq == 0) unsafeAtomicAdd(sscq + row, s);
                }
        } else {
#pragma unroll
            for (int ai = 0; ai < 2; ++ai)
#pragma unroll
                for (int m = 0; m < 4; ++m) { if ((m & 1) == 0) asm volatile("" ::: "memory");
                    const int row = row_of(u, ai, wr, m, fr); const float rstd = rs8[ai][m];
                    const bool samp = row >= MP; const int orow = samp ? row - MP : row; const int pos = samp ? 2048 + (orow & 31) : (row & 2047);
                    bf16_t* c = CQ + (size_t)row * 384 + 256 + 32 * wc + 4 * fq; float s = 0.f;
#pragma unroll
                    for (int n = 0; n < 2; ++n) { const f32x4 x = acc[ai][0][m][n] * rstd; s += sq4(x); st_bf16x4(c + 16 * n, x); }
                    s = add_x16(s); s = add_x32(s);
                    if (fq == 0) unsafeAtomicAdd(sscq + row, s);
                    if (wc < 2) {
                        const int i0 = 16 * wc + 4 * fq; const float* rt = rope + (size_t)pos * 64;
                        const f32x4 cs = ldg4(rt + i0), sn = ldg4(rt + 32 + i0);
                        const f32x4 x1 = acc[ai][1][m][0] * rstd, x2 = acc[ai][1][m][1] * rstd;
                        const f32x4 o1 = x1 * cs - x2 * sn, o2 = x2 * cs + x1 * sn;
                        float* d = (samp ? krs : krp) + (size_t)orow * 64 + i0; stg4(d, o1); stg4((d + 32), o2);
                        bf16_t* k = KR + (size_t)row * 64 + i0; st_bf16x4(k, o1); st_bf16x4(k + 32, o2);
                    }
                }
        }
    }
};

struct EpiQ {
    static constexpr bool PERM = false, AFTER_DRAIN = false;
    const float* sscq; const float* rope; bf16_t* QM;
    __device__ __forceinline__ void operator()(const f32x4 (&acc)[2][2][4][2], const Unit& u, int wr, int wc, int fr, int fq) const {
        const int pn = u.pn;
        LOAD_RS8(rs8, sscq, 1.f / 384.f, QS_MLA)
#pragma unroll
        for (int ai = 0; ai < 2; ++ai)
#pragma unroll
            for (int m = 0; m < 4; ++m) { if ((m & 1) == 0) asm volatile("" ::: "memory");
                const int row = row_of(u, ai, wr, m, fr); const float rs = rs8[ai][m];
                bf16_t* q = QM + (size_t)row * 1536;
                if (pn < 4) {
#pragma unroll
                    for (int bj = 0; bj < 2; ++bj)
#pragma unroll
                        for (int n = 0; n < 2; ++n) st_bf16x4(q + (2 * pn + bj) * 192 + 32 * wc + 16 * n + 4 * fq, acc[ai][bj][m][n] * rs);
                } else {
                    const int pos = row >= MP ? 2048 + ((row - MP) & 31) : (row & 2047); const float* rt = rope + (size_t)pos * 64;
                    bf16_t* qh = q + (4 * (pn - 4) + wc) * 192 + 128;
#pragma unroll
                    for (int n = 0; n < 2; ++n) {
                        const int i0 = 16 * n + 4 * fq; const f32x4 cs = ldg4(rt + i0), sn = ldg4(rt + 32 + i0);
                        const f32x4 x1 = acc[ai][0][m][n] * rs, x2 = acc[ai][1][m][n] * rs;
                        st_bf16x4(qh + i0, x1 * cs - x2 * sn); st_bf16x4(qh + 32 + i0, x2 * cs + x1 * sn);
                    }
                }
            }
    }
};

template <bool HAS_SS> struct EpiKV {
    static constexpr bool PERM = false, AFTER_DRAIN = false;
    const float* ss; bf16_t *O0, *O1;
    __device__ __forceinline__ void operator()(const f32x4 (&acc)[2][2][4][2], const Unit& u, int wr, int wc, int fr, int fq) const {
        bf16_t* base = (u.pn < 4 ? O0 : O1) + 256 * (u.pn & 3) + 32 * wc + 4 * fq;
        float rs8[2][4];
        if constexpr (HAS_SS) { LOAD_RS8(t8, ss, 1.f / 256.f, 1.f) _Pragma("unroll") for (int a = 0; a < 2; ++a) _Pragma("unroll") for (int b = 0; b < 4; ++b) rs8[a][b] = t8[a][b]; }
#pragma unroll
        for (int ai = 0; ai < 2; ++ai)
#pragma unroll
            for (int m = 0; m < 4; ++m) { if ((m & 1) == 0) asm volatile("" ::: "memory");
                const int row = row_of(u, ai, wr, m, fr); const float rs = HAS_SS ? rs8[ai][m] : 1.f;
                bf16_t* o = base + (size_t)row * 1024;
#pragma unroll
                for (int bj = 0; bj < 2; ++bj)
#pragma unroll
                    for (int n = 0; n < 2; ++n) st_bf16x4(o + 128 * bj + 16 * n, acc[ai][bj][m][n] * rs);
            }
    }
};

struct EpiRes {
    static constexpr bool PERM = false, AFTER_DRAIN = false;
    const float* xp; const float* xs; float* X; bf16_t* HX; float* ssn;
    __device__ __forceinline__ void operator()(const f32x4 (&acc)[2][2][4][2], const Unit& u, int wr, int wc, int fr, int fq) const {
        const int cb = 256 * u.pn + 32 * wc + 4 * fq;
#pragma unroll
        for (int ai = 0; ai < 2; ++ai)
#pragma unroll
            for (int m = 0; m < 4; ++m) { if ((m & 1) == 0) asm volatile("" ::: "memory");
                const int row = row_of(u, ai, wr, m, fr);
                bf16_t* h = HX + (size_t)row * 1024 + cb; float s = 0.f;
                f32x4 xo[2][2];
                if (xp) { const float* xi = (row >= MP ? xs + (size_t)(row - MP) * 1024 : xp + (size_t)row * 1024) + cb;
#pragma unroll
                    for (int bj = 0; bj < 2; ++bj)
#pragma unroll
                        for (int n = 0; n < 2; ++n) xo[bj][n] = ldg4(xi + 128 * bj + 16 * n); }
                else {
#pragma unroll
                    for (int bj = 0; bj < 2; ++bj)
#pragma unroll
                        for (int n = 0; n < 2; ++n) { const u32x2 w = ldgu2(h + 128 * bj + 16 * n);
                            xo[bj][n] = (f32x4){__uint_as_float(w.x << 16), __uint_as_float(w.x & 0xffff0000u), __uint_as_float(w.y << 16), __uint_as_float(w.y & 0xffff0000u)}; } }
#pragma unroll
                for (int bj = 0; bj < 2; ++bj)
#pragma unroll
                    for (int n = 0; n < 2; ++n) { const f32x4 x = xo[bj][n] + acc[ai][bj][m][n]; s += sq4(x); st_bf16x4(h + 128 * bj + 16 * n, x);
                        if (X) stg4((X + (size_t)row * 1024 + cb + 128 * bj + 16 * n), x); }
                s = add_x16(s); s = add_x32(s);
                if (fq == 0) unsafeAtomicAdd(ssn + row, s);
            }
    }
};

template <int CTRL> __device__ __forceinline__ float dpp_f(float old, float src) { return __int_as_float(__builtin_amdgcn_update_dpp(__float_as_int(old), __float_as_int(src), CTRL, 0xf, 0xf, false)); }
struct EpiUp {
    static constexpr bool PERM = false, AFTER_DRAIN = false;
    const float* ssx; bf16_t* ACT; bf16_t* UH; float* cvp; float* cvs; const float* wc; const float* bc; const float* stc;
    __device__ __forceinline__ void operator()(const f32x4 (&acc)[2][2][4][2], const Unit& u, int wr, int wc_, int fr, int fq) const {
        const int cb = 128 * u.pn + 32 * wc_ + 4 * fq;
        const bool samp = u.pm >= 256;
        LOAD_RS8(rs8, ssx, 1.f / 1024.f, 1.f)
#pragma unroll
        for (int ai = 0; ai < 2; ++ai)
#pragma unroll
            for (int m = 0; m < 4; ++m) { asm volatile("" ::: "memory");
                const int row = row_of(u, ai, wr, m, fr); const float rs = rs8[ai][m];
                const bool from_prev = samp ? (m & 1) : (m > 0);
                const bool seq0 = !samp && m == 0 && ((row - fr) & 2047) == 0;
                const bool defer = !samp && m == 0 && !seq0 && fr < 2;
                float* cv = nullptr;
                if (samp) { const int r = row - MP, sq = r & 31; if (sq >= 30) cv = cvs + ((size_t)(r >> 5) * 2 + (sq - 30)) * NUP + cb; }
                else { const int sq = row & 2047; if (sq >= 2046) cv = cvp + ((size_t)(row >> 11) * 2 + (sq - 2046)) * NUP + cb; }
                bf16_t* uh = nullptr;
                if (!samp) { if (m == 0 && fr < 2) uh = UH + ((size_t)(row >> 6) * 4 + fr) * NUP + cb; else if (m == 3 && fr >= 14) uh = UH + ((size_t)(row >> 6) * 4 + 2 + (fr - 14)) * NUP + cb; }
                const float* st0 = stc + (size_t)(samp ? (row - MP) >> 5 : 0) * 2 * NUP + cb;
#pragma unroll
                for (int n = 0; n < 2; ++n) {
                    f32x4 cc[2];
#pragma unroll
                    for (int bj = 0; bj < 2; ++bj) {
                        const int co = DFF * bj + 16 * n;
                        const f32x4 x = acc[ai][bj][m][n] * rs;
                        if (cv) stg4(cv + co, x);
                        if (uh) st_bf16x4(uh + co, x);
                        f32x4 c1, c2;
                        if (from_prev) { const f32x4 xp = acc[ai][bj][m > 0 ? m - 1 : 0][n] * rs8[ai][m > 0 ? m - 1 : 0];
#pragma unroll
                            for (int j = 0; j < 4; ++j) { c1[j] = dpp_f<0x121>(0.f, xp[j]); c2[j] = dpp_f<0x122>(0.f, xp[j]); } }
                        else if (samp) { c1 = ldg4(st0 + NUP + co); c2 = ldg4(st0 + (size_t)(fr & 1) * NUP + co); }
                        else { c1 = (f32x4){0.f, 0.f, 0.f, 0.f}; c2 = c1; }
                        const f32x4 w0 = ldg4(wc + cb + co), w1 = ldg4(wc + NUP + cb + co), w2 = ldg4(wc + 2 * NUP + cb + co), bb = ldg4(bc + cb + co);
#pragma unroll
                        for (int j = 0; j < 4; ++j) { const float p1 = dpp_f<0x111>(c1[j], x[j]), p2 = dpp_f<0x112>(c2[j], x[j]); cc[bj][j] = bb[j] + w0[j] * p2 + w1[j] * p1 + w2[j] * x[j]; }
                    }
                    if (!defer) { f32x4 r;
#pragma unroll
                        for (int j = 0; j < 4; ++j) r[j] = cc[0][j] * sigmoidf_(cc[0][j]) * cc[1][j];
                        st_bf16x4(ACT + (size_t)row * DFF + cb + 16 * n, r); }
                }
            }
    }
};
struct KVD { const bf16_t* k; const bf16_t* k2; const bf16_t* v; };
constexpr int ATT_KBUF = 64 * 400, ATT_VOFF = 2 * ATT_KBUF, ATT_VIMG = 32 * 320, ATT_VBUF = 2 * ATT_VIMG;

template <int DQK>
__device__ __forceinline__ void attn_pass(LAS unsigned char* lds, const int wid, const bf16_t* qrow, const KVD& dm, const KVD& dl, int nmain, int ntw, int ntc, f32x16 (&o)[4], float& linv) {
    constexpr int NCH = DQK / 8, KST = DQK * 2 + 16, NKI = NCH / 8, NS = DQK / 16;
    const int lane = LANE_ID(), tid = (wid << 6) | lane, r32 = lane & 31, hi = lane >> 5;
    bf16x8 q[NS];
#pragma unroll
    for (int s = 0; s < NS; ++s) q[s] = __builtin_bit_cast(bf16x8, ldgu4(qrow + 16 * s + 8 * hi));
    u32x4 kr[NKI], vr[2];
#define ATT_GLOADK(t) do { const bool lastt = (t) >= nmain; const KVD& d = lastt ? dl : dm; const int rb = lastt ? 0 : (t) * 64; const int rm = lastt ? 31 : 63; \
        _Pragma("unroll") for (int i = 0; i < NKI; ++i) { const int id = tid + 512 * i, kro = id / NCH, kc = id - kro * NCH; const int r = rb + (kro & rm); \
            kr[i] = (DQK == 64 || kc < 16) ? ldgu4(d.k + (size_t)r * 1024 + kc * 8) : ldgu4(d.k2 + (size_t)r * 64 + (kc - 16) * 8); } } while (0)
#define ATT_GLOADV(t) do { const bool lastt = (t) >= nmain; const KVD& d = lastt ? dl : dm; const int rb = lastt ? 0 : (t) * 64; const int rm = lastt ? 31 : 63; \
        _Pragma("unroll") for (int i = 0; i < 2; ++i) { const int r = rb + (((tid >> 4) + 32 * i) & rm); vr[i] = ldgu4(d.v + (size_t)r * 1024 + (tid & 15) * 8); } } while (0)
#define ATT_LSTORE(b) do { \
        _Pragma("unroll") for (int i = 0; i < NKI; ++i) { const int id = tid + 512 * i, kro = id / NCH, kc = id - kro * NCH; *(LAS u32x4*)(lds + (b) * ATT_KBUF + kro * KST + kc * 16) = kr[i]; } \
        _Pragma("unroll") for (int i = 0; i < 2; ++i) *(LAS u32x4*)(lds + ATT_VOFF + (b) * ATT_VBUF + i * ATT_VIMG + (tid >> 4) * 320 + (tid & 15) * 16) = vr[i]; } while (0)
    ATT_GLOADK(0); ATT_GLOADV(0); ATT_LSTORE(0); __syncthreads();
    float m_run = 0.f, l_run = 0.f;
#pragma unroll
    for (int c = 0; c < 4; ++c)
#pragma unroll
        for (int r = 0; r < 16; ++r) o[c][r] = 0.f;
    const int vlane = (4 * hi + ((lane & 15) >> 2)) * 320 + (2 * ((lane >> 4) & 1) + ((lane & 3) >> 1)) * 16 + 8 * (lane & 1);
    for (int t = 0; t < ntw; ++t) {
        if (t + 1 < ntw) ATT_GLOADK(t + 1);
        bool vloaded = false;
        if (t < ntc) {
            const LAS unsigned char* kb = lds + (t & 1) * ATT_KBUF + r32 * KST + hi * 16;
            const LAS unsigned char* vb = lds + ATT_VOFF + (t & 1) * ATT_VBUF;
            f32x16 p0, p1;
#pragma unroll
            for (int r = 0; r < 16; ++r) { p0[r] = 0.f; p1[r] = 0.f; }
            constexpr int KCH = (DQK == 64) ? 2 : 1, NG = NS / KCH;
            bf16x8 kf[2][2 * KCH];
#define ATT_LDK(ch, b) do { _Pragma("unroll") for (int j_ = 0; j_ < KCH; ++j_) { kf[b][2 * j_] = *(const LAS bf16x8*)(kb + (KCH * (ch) + j_) * 32); kf[b][2 * j_ + 1] = *(const LAS bf16x8*)(kb + 32 * KST + (KCH * (ch) + j_) * 32); } } while (0)
            ATT_LDK(0, 0); __builtin_amdgcn_sched_barrier(0);
#pragma unroll
            for (int ch = 0; ch < NG; ++ch) {
                if (ch + 1 < NG) ATT_LDK(ch + 1, (ch + 1) & 1);
                __builtin_amdgcn_sched_barrier(0);
#pragma unroll
                for (int j = 0; j < KCH; ++j) {
                    p0 = __builtin_amdgcn_mfma_f32_32x32x16_bf16(kf[ch & 1][2 * j], q[KCH * ch + j], p0, 0, 0, 0);
                    p1 = __builtin_amdgcn_mfma_f32_32x32x16_bf16(kf[ch & 1][2 * j + 1], q[KCH * ch + j], p1, 0, 0, 0);
                }
                __builtin_amdgcn_sched_barrier(0);
            }
#undef ATT_LDK
            bf16x8 vf[2][4];
#define ATT_LDV(cmb, b) do { _Pragma("unroll") for (int c_ = 0; c_ < 4; ++c_) { const LAS unsigned char* a0_ = vb + vlane + ((cmb) >> 1) * ATT_VIMG + (16 * ((cmb) & 1)) * 320 + c_ * 64; \
                const v4i16_t t0_ = __builtin_amdgcn_ds_read_tr16_b64_v4i16((LAS v4i16_t*)a0_), t1_ = __builtin_amdgcn_ds_read_tr16_b64_v4i16((LAS v4i16_t*)(a0_ + 8 * 320)); \
                vf[b][c_] = (bf16x8){t0_[0], t0_[1], t0_[2], t0_[3], t1_[0], t1_[1], t1_[2], t1_[3]}; } } while (0)
#pragma unroll
            for (int r = 0; r < 16; ++r) { p0[r] -= m_run; p1[r] -= m_run; }
            if (t >= nmain) { asm volatile("" ::: "memory");
#pragma unroll
                for (int r = 0; r < 16; ++r) p1[r] = -INFINITY;
            }
            float mt = __builtin_fmaxf(__builtin_fmaxf(p0[0], p1[0]), p0[1]);
#pragma unroll
            for (int r = 1; r < 15; r += 2) { mt = __builtin_fmaxf(__builtin_fmaxf(mt, p1[r]), p0[r + 1]); mt = __builtin_fmaxf(__builtin_fmaxf(mt, p1[r + 1]), p0[r + 2 < 16 ? r + 2 : 15]); }
            mt = __builtin_fmaxf(mt, p1[15]);
            mt = max_x32(mt);
            const float dref = (t == 0 || mt > 8.f) ? mt : 0.f;
            if (__builtin_amdgcn_ballot_w64(dref != 0.f) != 0ull) {
                m_run += dref;
#pragma unroll
                for (int r = 0; r < 16; ++r) { p0[r] -= dref; p1[r] -= dref; }
                if (t > 0) { const float f = fast_exp2(-dref); l_run *= f;
#pragma unroll
                    for (int c = 0; c < 4; ++c)
#pragma unroll
                        for (int r = 0; r < 16; ++r) o[c][r] *= f; }
            }
            float rs = 0.f;
#pragma unroll
            for (int r = 0; r < 16; ++r) { p0[r] = fast_exp2(p0[r]); p1[r] = fast_exp2(p1[r]); rs += p0[r] + p1[r]; }
            l_run += rs;
            asm volatile("" ::: "memory");
            if (t + 1 < ntw) { ATT_GLOADV(t + 1); vloaded = true; }
            bf16x8 pf[2][2];
#pragma unroll
            for (int ks = 0; ks < 2; ++ks) {
                u32x4 a, b;
                a.x = cvt_pk_bf16(p0[8 * ks + 0], p0[8 * ks + 1]); a.y = cvt_pk_bf16(p0[8 * ks + 2], p0[8 * ks + 3]); a.z = cvt_pk_bf16(p0[8 * ks + 4], p0[8 * ks + 5]); a.w = cvt_pk_bf16(p0[8 * ks + 6], p0[8 * ks + 7]);
                b.x = cvt_pk_bf16(p1[8 * ks + 0], p1[8 * ks + 1]); b.y = cvt_pk_bf16(p1[8 * ks + 2], p1[8 * ks + 3]); b.z = cvt_pk_bf16(p1[8 * ks + 4], p1[8 * ks + 5]); b.w = cvt_pk_bf16(p1[8 * ks + 6], p1[8 * ks + 7]);
                pf[0][ks] = __builtin_bit_cast(bf16x8, a); pf[1][ks] = __builtin_bit_cast(bf16x8, b);
            }
            __builtin_amdgcn_sched_barrier(0);
            ATT_LDV(0, 0); __builtin_amdgcn_sched_barrier(0);
#pragma unroll
            for (int cmb = 0; cmb < 4; ++cmb) {
                if (cmb + 1 < 4) ATT_LDV(cmb + 1, (cmb + 1) & 1);
                __builtin_amdgcn_sched_barrier(0);
#pragma unroll
                for (int c = 0; c < 4; ++c) o[c] = __builtin_amdgcn_mfma_f32_32x32x16_bf16(vf[cmb & 1][c], pf[cmb >> 1][cmb & 1], o[c], 0, 0, 0);
                __builtin_amdgcn_sched_barrier(0);
            }
#undef ATT_LDV
        }
        if (t + 1 < ntw) { if (!vloaded) ATT_GLOADV(t + 1); ATT_LSTORE((t + 1) & 1); }
        __syncthreads();
    }
    const float lt = add_x32(l_run);
    linv = fast_rcp(lt);
#undef ATT_GLOADK
#undef ATT_GLOADV
#undef ATT_LSTORE
}

struct AttnCtx { unsigned char* ws; const float* gda; float lam, lam1m; unsigned* counter; int l; };
constexpr int ATT_NUNITS = 128 + 2048;
__device__ __forceinline__ void attn_phase(LAS unsigned char* lds, const AttnCtx& C, const int wid) {
#define TID_NOW() LANE_ID()
    LAS unsigned* ubox = (LAS unsigned*)(lds + 131072);
    if (wid < 4) __builtin_amdgcn_s_setprio(3); else __builtin_amdgcn_s_setprio(0);
    const bf16_t* QDA = (const bf16_t*)(C.ws + W_QDA); const bf16_t* KDA = (const bf16_t*)(C.ws + W_KDA); const bf16_t* VDA = (const bf16_t*)(C.ws + W_VDA);
    const bf16_t* GG = (const bf16_t*)(C.ws + W_G); bf16_t* MRG = (bf16_t*)(C.ws + W_MRG);
    for (;;) {
        if (wid == 0 && TID_NOW() == 0) ubox[0] = atomicAdd(C.counter, 1u);
        __syncthreads();
        const int un = (int)ubox[0];
        __syncthreads();
        if (un >= ATT_NUNITS) break;
        const bool samp = un < 128;
        int b, h, qb = 0;
        if (samp) { b = un >> 3; h = un & 7; } else { const int v = un - 128; qb = 7 - (v >> 8); b = (v & 255) >> 3; h = v & 7; }
        const int row = samp ? MP + b * 32 + (TID_NOW() & 31) : b * 2048 + qb * 256 + wid * 32 + (TID_NOW() & 31);
        const int ntw = samp ? 33 : 4 * qb + 4, nmain = samp ? 32 : ntw, ntc = samp ? (wid == 0 ? 33 : 0) : 4 * qb + (wid >> 1) + 1;
        const size_t kr0 = (size_t)b * 2048;
        const size_t fr0 = (size_t)MP + b * 32;
        const size_t coff = (size_t)C.l * MC;
        f32x16 o[4]; float linv;
#ifndef NO_DIFF
        {
            unsigned o1[32];
#pragma unroll 1
            for (int st = 0; st < 2; ++st) {
                KVD dm, dl;
                const bf16_t* Kb = samp ? (const bf16_t*)(C.ws + W_KC) + coff * 1024 : KDA; const bf16_t* Vb = samp ? (const bf16_t*)(C.ws + W_VC) + coff * 1024 : VDA;
                dm.k = Kb + kr0 * 1024 + h * 128 + st * 64; dm.k2 = dm.k; dm.v = Vb + kr0 * 1024 + h * 128;
                dl.k = KDA + fr0 * 1024 + h * 128 + st * 64; dl.k2 = dl.k; dl.v = VDA + fr0 * 1024 + h * 128;
                attn_pass<64>(lds, wid, QDA + (size_t)row * 1024 + h * 128 + st * 64, dm, dl, nmain, ntw, ntc, o, linv);
                if (st == 0) {
#pragma unroll
                    for (int c = 0; c < 4; ++c)
#pragma unroll
                        for (int r = 0; r < 16; r += 2) o1[c * 8 + (r >> 1)] = cvt_pk_bf16(o[c][r] * linv, o[c][r + 1] * linv);
                }
            }
            if (ntc > 0) {
                int rowe = row; asm volatile("" : "+v"(rowe));
                const int hi = (TID_NOW() >> 5) & 1;
                const float ll = C.lam * linv; float ss = 0.f;
#pragma unroll
                for (int c = 0; c < 4; ++c)
#pragma unroll
                    for (int r = 0; r < 16; r += 2) { const unsigned w = o1[c * 8 + (r >> 1)];
                        const float x0 = __uint_as_float(w << 16) - ll * o[c][r], x1 = __uint_as_float(w & 0xffff0000u) - ll * o[c][r + 1]; o[c][r] = x0; o[c][r + 1] = x1; ss += x0 * x0 + x1 * x1; }
                ss = add_x32(ss);
                const float rn = rsqrtf(ss * (1.f / 128.f) + EPS) * C.lam1m;
                const bf16_t* ga = GG + (size_t)rowe * 2048 + h * 128; bf16_t* mo = MRG + (size_t)rowe * 1024 + h * 128;
#pragma unroll
                for (int c = 0; c < 4; ++c)
#pragma unroll
                    for (int g = 0; g < 4; ++g) {
                        const int d0 = 32 * c + 8 * g + 4 * hi;
                        const u32x2 gw = ldgu2(ga + d0); const f32x4 gd = ldg4(C.gda + d0);
                        const float g0 = __uint_as_float(gw.x << 16), g1 = __uint_as_float(gw.x & 0xffff0000u), g2 = __uint_as_float(gw.y << 16), g3 = __uint_as_float(gw.y & 0xffff0000u);
                        f32x4 r; r[0] = o[c][4 * g + 0] * rn * gd[0] * g0; r[1] = o[c][4 * g + 1] * rn * gd[1] * g1; r[2] = o[c][4 * g + 2] * rn * gd[2] * g2; r[3] = o[c][4 * g + 3] * rn * gd[3] * g3;
                        st_bf16x4(mo + d0, r);
                    }
            }
        }
#endif
#ifndef NO_MLA
        {
            KVD dm, dl;
            const bf16_t* KN = (const bf16_t*)(C.ws + W_KN); const bf16_t* VM = (const bf16_t*)(C.ws + W_VM); const bf16_t* KR = (const bf16_t*)(C.ws + W_KR);
            dm.k = (samp ? (const bf16_t*)(C.ws + W_KNC) + coff * 1024 : KN) + kr0 * 1024 + h * 128; dm.k2 = (samp ? (const bf16_t*)(C.ws + W_KRC) + coff * 64 : KR) + kr0 * 64;
            dm.v = (samp ? (const bf16_t*)(C.ws + W_VMC) + coff * 1024 : VM) + kr0 * 1024 + h * 128;
            dl.k = KN + fr0 * 1024 + h * 128; dl.k2 = KR + fr0 * 64; dl.v = VM + fr0 * 1024 + h * 128;
            attn_pass<192>(lds, wid, (const bf16_t*)(C.ws + W_QM) + (size_t)row * 1536 + h * 192, dm, dl, nmain, ntw, ntc, o, linv);
            if (ntc > 0) {
                int rowe = row; asm volatile("" : "+v"(rowe));
                const int hi = (TID_NOW() >> 5) & 1;
                const bf16_t* gb = GG + (size_t)rowe * 2048 + 1024 + h * 128; bf16_t* mo = MRG + (size_t)rowe * 1024 + h * 128;
#pragma unroll
                for (int c = 0; c < 4; ++c)
#pragma unroll
                    for (int g = 0; g < 4; ++g) {
                        const int d0 = 32 * c + 8 * g + 4 * hi;
                        const u32x2 gw = ldgu2(gb + d0); const u32x2 xw = ldgu2(mo + d0);
                        const float g0 = __uint_as_float(gw.x << 16), g1 = __uint_as_float(gw.x & 0xffff0000u), g2 = __uint_as_float(gw.y << 16), g3 = __uint_as_float(gw.y & 0xffff0000u);
                        f32x4 r;
                        r[0] = __uint_as_float(xw.x << 16) + g0 * o[c][4 * g + 0] * linv; r[1] = __uint_as_float(xw.x & 0xffff0000u) + g1 * o[c][4 * g + 1] * linv;
                        r[2] = __uint_as_float(xw.y << 16) + g2 * o[c][4 * g + 2] * linv; r[3] = __uint_as_float(xw.y & 0xffff0000u) + g3 * o[c][4 * g + 3] * linv;
                        st_bf16x4(mo + d0, r);
                    }
            }
        }
#endif
    }
    __builtin_amdgcn_s_setprio(0);
}
__device__ __forceinline__ float wave_sum(float v) {
#pragma unroll
    for (int o = 1; o < 64; o <<= 1) v += __shfl_xor(v, o);
    return v;
}
__device__ __forceinline__ unsigned f2bf(float f) { unsigned u = __float_as_uint(f); return (u + 0x7fffu + ((u >> 16) & 1u)) >> 16; }
__device__ __forceinline__ unsigned pk2(float lo, float hi) { return f2bf(lo) | (f2bf(hi) << 16); }
__device__ __forceinline__ int ropemap(int v) { return 64 * ((v >> 5) & 3) + 32 * (v >> 7) + (v & 31); }

__device__ __forceinline__ void prep_weights(const Params& P, LAS unsigned char* lds, int gw, int ngw, int wave, int lane) {
    LAS float* scr = (LAS float*)(lds + wave * 8704);
    constexpr int IT0 = 16 * (NIN / 32), IT1 = 6 * (NQ / 32), IT2 = 4 * (NKV / 32), IT4 = 16 * 32, IT5 = 16 * (NUP / 32), IT6 = 44 * 32;
    constexpr int ITL = IT0 + IT1 + 2 * IT2 + IT4 + IT5 + IT6;
    for (int it = gw; it < 2 * ITL; it += ngw) {
        const int l = it / ITL; int r = it - l * ITL;
        int mat;
        if (r < IT0) mat = 0; else if ((r -= IT0) < IT1) mat = 1; else if ((r -= IT1) < IT2) mat = 2; else if ((r -= IT2) < IT2) mat = 3;
        else if ((r -= IT2) < IT4) mat = 4; else if ((r -= IT4) < IT5) mat = 5; else { r -= IT5; mat = 6; }
        const float* W; const float* gk = nullptr; bf16_t* WT; int K, NN; long stride;
        switch (mat) {
            case 0: W = P.in[8] + (size_t)l * 1024 * INC; gk = P.in[7] + l * 1024; WT = (bf16_t*)(P.ws + W_WIN) + (size_t)l * NIN * 1024; K = 1024; NN = NIN; stride = INC; break;
            case 1: W = P.in[16] + (size_t)l * QL * NQ; gk = P.in[15] + l * QL; WT = (bf16_t*)(P.ws + W_WQ) + (size_t)l * NQ * QL; K = QL; NN = NQ; stride = NQ; break;
            case 2: W = nullptr; gk = P.in[17] + l * KVL; WT = (bf16_t*)(P.ws + W_WKV) + (size_t)l * NKV * KVL; K = KVL; NN = NKV; stride = 128; break;
            case 3: W = nullptr; WT = (bf16_t*)(P.ws + W_WKVC) + (size_t)l * NKV * KVL; K = KVL; NN = NKV; stride = 128; break;
            case 4: W = P.in[20] + (size_t)l * 1024 * 1024; WT = (bf16_t*)(P.ws + W_WO) + (size_t)l * 1024 * 1024; K = 1024; NN = 1024; stride = 1024; break;
            case 5: W = P.in[22] + (size_t)l * 1024 * NUP; gk = P.in[21] + l * 1024; WT = (bf16_t*)(P.ws + W_WUP) + (size_t)l * NUP * 1024; K = 1024; NN = NUP; stride = NUP; break;
            default: W = P.in[25] + (size_t)l * DFF * 1024; WT = (bf16_t*)(P.ws + W_WDN) + (size_t)l * 1024 * DFF; K = DFF; NN = 1024; stride = 1024; break;
        }
        const int nblk = NN / 32, kb = r / nblk, nb = r - kb * nblk, k0 = 64 * kb, n0 = 32 * nb;
        const int np = n0 + (lane & 31); long off = -1;
        {
            const int tile = np >> 8, v = np & 255;
            switch (mat) {
                case 0:
                    if (tile < 4) off = 256 * tile + ropemap(v);
                    else if (tile < 8) off = 1024 + 256 * (tile - 4) + ropemap(v);
                    else if (tile < 12) off = 2048 + 256 * (tile - 8) + v;
                    else if (tile < 20) off = 3776 + 256 * (tile - 12) + v;
                    else if (tile == 20) off = 3456 + v;
                    else if (tile == 21) off = 3072 + v;
                    else { if (v < 128) off = 3072 + 256 + v; else { const int w = v - 128, wc = w >> 5; if (wc < 2) off = 3712 + 32 * ((w >> 4) & 1) + 16 * wc + (w & 15); } }
                    break;
                case 1:
                    if (tile < 4) off = (np >> 7) * 192 + (np & 127);
                    else { const int hh = 4 * (tile - 4) + ((v >> 5) & 3); off = hh * 192 + 128 + 32 * (v >> 7) + (v & 31); }
                    break;
                case 2: case 3: {
                    const int c = np & 1023, hh = c >> 7, n = c & 127;
                    W = (np < 1024 ? P.in[18] : P.in[19]) + (size_t)l * 8 * 256 * 128; off = (long)hh * 32768 + n; } break;
                case 5: off = (v < 128) ? 128 * tile + v : DFF + 128 * tile + (v - 128); break;
                default: off = np; break;
            }
        }
#pragma unroll 8
        for (int i = 0; i < 32; ++i) { const int kk = 2 * i + (lane >> 5); float v = 0.f;
            if (off >= 0) { v = W[(size_t)(k0 + kk) * stride + off]; if (gk) v *= gk[k0 + kk]; }
            scr[kk * 33 + (lane & 31)] = v; }
        asm volatile("s_waitcnt lgkmcnt(0)" ::: "memory");
        const int c = lane & 7;
#pragma unroll
        for (int j = 0; j < 4; ++j) { const int n = (lane >> 3) + 8 * j; const LAS float* s = scr + (8 * c) * 33 + n;
            u32x4 o; o.x = pk2(s[0 * 33], s[1 * 33]); o.y = pk2(s[2 * 33], s[3 * 33]); o.z = pk2(s[4 * 33], s[5 * 33]); o.w = pk2(s[6 * 33], s[7 * 33]);
            *(u32x4*)(WT + (size_t)(n0 + n) * K + k0 + 8 * c) = o; }
        asm volatile("s_waitcnt lgkmcnt(0)" ::: "memory");
    }
}

__device__ __forceinline__ void sincos_f(float a, float& s, float& c) {
    const float n = rintf(a * 0.6366197723675814f);
    float r = fmaf(-n, 1.5703125f, a); r = fmaf(-n, 4.837512969970703125e-4f, r); r = fmaf(-n, 7.54978995489188e-8f, r);
    const float r2 = r * r;
    const float sp = r + r * r2 * (-1.6666666667e-1f + r2 * (8.3333333333e-3f + r2 * (-1.9841269841e-4f + r2 * 2.7557319224e-6f)));
    const float cp = 1.f + r2 * (-0.5f + r2 * (4.1666666667e-2f + r2 * (-1.3888888889e-3f + r2 * (2.4801587302e-5f + r2 * -2.7557319224e-7f))));
    const int qd = ((int)n) & 3;
    s = (qd == 0) ? sp : (qd == 1) ? cp : (qd == 2) ? -sp : -cp;
    c = (qd == 0) ? cp : (qd == 1) ? -sp : (qd == 2) ? -cp : sp;
}

__device__ __forceinline__ void cvt_stream(const float* src, bf16_t* dst, size_t n8, size_t gt, size_t ngt) {
    for (size_t i = gt; i < n8; i += ngt) { const f32x4 a = *(const f32x4*)(src + i * 8), b = *(const f32x4*)(src + i * 8 + 4);
        u32x4 o; o.x = cvt_pk_bf16(a[0], a[1]); o.y = cvt_pk_bf16(a[2], a[3]); o.z = cvt_pk_bf16(b[0], b[1]); o.w = cvt_pk_bf16(b[2], b[3]); *(u32x4*)(dst + i * 8) = o; }
}

__device__ __forceinline__ void conv_fix_phase(const Params& P, int l, size_t gt, size_t ngt) {
    const bf16_t* UH = (const bf16_t*)(P.ws + W_U); bf16_t* ACT = (bf16_t*)(P.ws + W_ACT);
    const float* wc = P.in[23] + (size_t)l * 3 * NUP; const float* bc = P.in[24] + (size_t)l * NUP;
    constexpr int NCC = DFF / 8;
    for (size_t it = gt; it < (size_t)1024 * NCC; it += ngt) {
        const int sl = (int)(it / NCC), cc = (int)(it - (size_t)sl * NCC), j0 = cc * 8;
        if ((sl & 31) == 0) continue;
        float uu[4][2][8];
#pragma unroll
        for (int k = 0; k < 4; ++k)
#pragma unroll
            for (int gv = 0; gv < 2; ++gv) { const u32x4 a = ldgu4(UH + ((size_t)(k < 2 ? sl - 1 : sl) * 4 + (k < 2 ? 2 + k : k - 2)) * NUP + gv * DFF + j0);
#pragma unroll
                for (int e = 0; e < 4; ++e) { uu[k][gv][2 * e] = __uint_as_float(a[e] << 16); uu[k][gv][2 * e + 1] = __uint_as_float(a[e] & 0xffff0000u); } }
#pragma unroll
        for (int rr = 0; rr < 2; ++rr) {
            float res[8];
#pragma unroll
            for (int hf = 0; hf < 2; ++hf) {
                f32x4 w[2][4];
#pragma unroll
                for (int gv = 0; gv < 2; ++gv)
#pragma unroll
                    for (int k = 0; k < 4; ++k) w[gv][k] = ldg4((k < 3 ? wc + (size_t)k * NUP : bc) + gv * DFF + j0 + 4 * hf);
#pragma unroll
                for (int e = 0; e < 4; ++e) { const int q = 4 * hf + e;
                    const float cg = w[0][3][e] + w[0][0][e] * uu[rr][0][q] + w[0][1][e] * uu[rr + 1][0][q] + w[0][2][e] * uu[rr + 2][0][q];
                    const float cv = w[1][3][e] + w[1][0][e] * uu[rr][1][q] + w[1][1][e] * uu[rr + 1][1][q] + w[1][2][e] * uu[rr + 2][1][q];
                    res[q] = cg * sigmoidf_(cg) * cv; }
            }
            u32x4 o; o.x = cvt_pk_bf16(res[0], res[1]); o.y = cvt_pk_bf16(res[2], res[3]); o.z = cvt_pk_bf16(res[4], res[5]); o.w = cvt_pk_bf16(res[6], res[7]);
            *(GAS u32x4*)(ACT + ((size_t)(64 * sl + rr) * DFF + j0)) = o;
        }
    }
}
constexpr int LDS_BYTES = 147456;
template <class Epi> __device__ __forceinline__ void run_gemm(LAS unsigned char* lds, const int wid, const bf16_t* A, const bf16_t* Bt, int M, int N, int K, const Epi& E) {
    int gx = (int)gridDim.x, bx = (int)blockIdx.x, wv = wid; asm volatile("" : "+s"(gx), "+s"(bx), "+s"(wv));
    pg8::Gemm g{A, Bt, M, N, K}; pg8::StaticOrder S; S.init(M, N, gx, bx);
#ifndef NO_GEMM
    pg8::gemm_phase<Epi, pg8::StaticOrder, PG8_ALIGN, PG8_SP2>(lds, g, S, E, wv);
#endif
}

__global__ void __launch_bounds__(512, 2) fwd_megakernel(Params P) {
    extern __shared__ __attribute__((aligned(16))) unsigned char lds_raw[];
    LAS unsigned char* lds = (LAS unsigned char*)lds_raw;
    cg::grid_group grid = cg::this_grid();
    const int wave_s = __builtin_amdgcn_readfirstlane((int)threadIdx.x >> 6);
#define TID_DEFS const int lane = LANE_ID(), wave = wave_s, tid = (wave << 6) | lane; \
    const int G = gridDim.x, gw = blockIdx.x * 8 + wave, ngw = G * 8; const size_t gt = (size_t)blockIdx.x * 512 + tid, ngt = (size_t)G * 512; (void)lane; (void)gw; (void)ngw; (void)gt; (void)ngt;
    unsigned char* ws = P.ws; float* out = P.out;
#define gbar() do { asm volatile("s_waitcnt vmcnt(0) lgkmcnt(0)" ::: "memory"); __syncthreads(); bar_gen += gridDim.x; \
        if (wave_s == 0 && LANE_ID() == 0) { asm volatile("buffer_wbl2 sc1\n\ts_waitcnt vmcnt(0) lgkmcnt(0)" ::: "memory");     \
            __hip_atomic_fetch_add(ctl + 128, 1u, __ATOMIC_RELAXED, __HIP_MEMORY_SCOPE_AGENT); \
            while (__hip_atomic_load(ctl + 128, __ATOMIC_RELAXED, __HIP_MEMORY_SCOPE_AGENT) < bar_gen) __builtin_amdgcn_s_sleep(1); } \
        __syncthreads(); asm volatile("buffer_inv sc1\n\ts_waitcnt vmcnt(0) lgkmcnt(0)" ::: "memory");     } while (0)
#ifdef PROBE_SEL
    unsigned long long pr_acc = 0, pr_t0 = 0;
#define PR_BEGIN(c) do { if ((PROBE_SEL >> (c)) & 1) pr_t0 = __builtin_amdgcn_s_memrealtime(); } while (0)
#define PR_END(c) do { if ((PROBE_SEL >> (c)) & 1) pr_acc += __builtin_amdgcn_s_memrealtime() - pr_t0; } while (0)
#else
#define PR_BEGIN(c)
#define PR_END(c)
#endif
#define OPAQ() do { unsigned a_ = (unsigned)(uintptr_t)P.ws, b_ = (unsigned)((uintptr_t)P.ws >> 32), c_ = (unsigned)(uintptr_t)P.out, d_ = (unsigned)((uintptr_t)P.out >> 32); \
        asm volatile("" : "+s"(a_), "+s"(b_), "+s"(c_), "+s"(d_)); ws = (unsigned char*)(((uintptr_t)b_ << 32) | a_); out = (float*)(((uintptr_t)d_ << 32) | c_); } while (0)
    unsigned* ctl = (unsigned*)(ws + W_CTL); float* ctlf = (float*)(ws + W_CTL);
    float* rope = (float*)(ws + W_ROPE); float* SS = (float*)(ws + W_SS);
#define B_HX ((bf16_t*)(ws + W_HX))
#define B_X ((float*)(ws + W_X))
#define B_QDA ((bf16_t*)(ws + W_QDA))
#define B_KDA ((bf16_t*)(ws + W_KDA))
#define B_VDA ((bf16_t*)(ws + W_VDA))
#define B_GG ((bf16_t*)(ws + W_G))
#define B_CKV ((bf16_t*)(ws + W_CKV))
#define B_CQ ((bf16_t*)(ws + W_CQ))
#define B_KR ((bf16_t*)(ws + W_KR))
#define B_QM ((bf16_t*)(ws + W_QM))
#define B_KN ((bf16_t*)(ws + W_KN))
#define B_VM ((bf16_t*)(ws + W_VM))
#define B_MRG ((bf16_t*)(ws + W_MRG))
#define B_U ((bf16_t*)(ws + W_U))
#define B_ACT ((bf16_t*)(ws + W_ACT))
#define B_KC ((bf16_t*)(ws + W_KC))
#define B_VC ((bf16_t*)(ws + W_VC))
#define B_KRC ((bf16_t*)(ws + W_KRC))
#define B_CKVC ((bf16_t*)(ws + W_CKVC))
#define B_KNC ((bf16_t*)(ws + W_KNC))
#define B_VMC ((bf16_t*)(ws + W_VMC))
    PR_BEGIN(0);
    {
    TID_DEFS
#ifndef NO_PREP
    prep_weights(P, lds, gw, ngw, wave, lane);
#endif
    for (size_t idx = gt; idx < (size_t)2080 * 32; idx += ngt) {
        const int pos = (int)(idx >> 5), i = (int)(idx & 31);
        double inv = 1.0; for (int k = 0; k < i; ++k) inv *= 0.74989420933245582730;
        const double ang = (double)pos * inv; const double n = __builtin_rint(ang * 0.63661977236758134308);
        double r = __builtin_fma(-n, 1.57079632679489655800, ang); r = __builtin_fma(-n, 6.12323399573676603587e-17, r);
        const float rf = (float)r, r2 = rf * rf;
        const float sp = rf + rf * r2 * (-1.6666666667e-1f + r2 * (8.3333333333e-3f + r2 * (-1.9841269841e-4f + r2 * 2.7557319224e-6f)));
        const float cp = 1.f + r2 * (-0.5f + r2 * (4.1666666667e-2f + r2 * (-1.3888888889e-3f + r2 * (2.4801587302e-5f + r2 * -2.7557319224e-7f))));
        const int qd = ((int)n) & 3;
        rope[(size_t)pos * 64 + 32 + i] = (qd == 0) ? sp : (qd == 1) ? cp : (qd == 2) ? -sp : -cp;
        rope[(size_t)pos * 64 + i] = (qd == 0) ? cp : (qd == 1) ? -sp : (qd == 2) ? -cp : sp;
    }
    for (size_t idx = gt; idx < (size_t)8 * MT; idx += ngt) SS[MT + idx] = 0.f;
    if (blockIdx.x == 0 && tid < 64) {
        if (tid < 5) __hip_atomic_store(ctl + (tid == 4 ? 128 : tid * 16), 0u, __ATOMIC_RELAXED, __HIP_MEMORY_SCOPE_AGENT);
        for (int l = 0; l < 2; ++l) {
        OPAQ();
            const float a = wave_sum(P.in[10][l * 64 + lane] * P.in[11][l * 64 + lane]), b = wave_sum(P.in[12][l * 64 + lane] * P.in[13][l * 64 + lane]);
            const float li = 0.8f - 0.6f * expf(-0.3f * (float)l);
            if (lane == 0) { ctlf[64 + 2 * l] = expf(a) - expf(b) + li; ctlf[65 + 2 * l] = 1.f - li; }
        }
    }
    for (int row = gw; row < MT; row += ngw) {
        const float* xr = (row >= MP ? P.in[1] + (size_t)(row - MP) * 1024 : P.in[0] + (size_t)row * 1024); float s = 0.f;
#pragma unroll
        for (int j = 0; j < 4; ++j) { const f32x4 v = *(const f32x4*)(xr + 256 * j + 4 * lane); s += sq4(v); st_bf16x4(B_HX + (size_t)row * 1024 + 256 * j + 4 * lane, v); }
        s = wave_sum(s); if (lane == 0) SS[row] = s;
    }
    cvt_stream(P.in[2], B_KC, (size_t)2 * MC * 1024 / 8, gt, ngt);
    cvt_stream(P.in[3], B_VC, (size_t)2 * MC * 1024 / 8, gt, ngt);
    cvt_stream(P.in[4], B_CKVC, (size_t)2 * MC * 256 / 8, gt, ngt);
    cvt_stream(P.in[5], B_KRC, (size_t)2 * MC * 64 / 8, gt, ngt);
    }
    __threadfence(); asm volatile("buffer_wbl2 sc1\n\ts_waitcnt vmcnt(0) lgkmcnt(0)" ::: "memory");
    grid.sync();
    __threadfence(); asm volatile("buffer_inv sc1\n\ts_waitcnt vmcnt(0) lgkmcnt(0)" ::: "memory");
    unsigned bar_gen = 0;
    PR_END(0);

#pragma unroll 1
    for (int l = 0; l < 2; ++l) {
        OPAQ();
        float* ssx_attn = SS + (size_t)(2 * l) * MT; float* ssx_ffn = SS + (size_t)(2 * l + 1) * MT; float* ssx_next = SS + (size_t)(2 * l + 2) * MT;
        float* sscq = SS + (size_t)(5 + l) * MT; float* ssckv = SS + (size_t)(7 + l) * MT;
        float* ckp = out + O_CKVP + (size_t)l * MP * 256; float* cks = out + O_CKVS + (size_t)l * MSMP * 256;
        PR_BEGIN(1);
        {
            EpiInProj E; E.ws = ws; E.out = out; E.bgate = P.in[9] + (size_t)l * 2048; E.l = l;
            run_gemm(lds, wave_s, B_HX, (const bf16_t*)(ws + W_WIN) + (size_t)l * NIN * 1024, MT, NIN, 1024, E);
        }
        gbar(); OPAQ();
        PR_END(1);
        PR_BEGIN(2);
        {
            EpiQ E; E.sscq = sscq; E.rope = rope; E.QM = B_QM;
            run_gemm(lds, wave_s, B_CQ, (const bf16_t*)(ws + W_WQ) + (size_t)l * NQ * QL, MT, NQ, QL, E);
        }
        {
            EpiKV<true> E; E.ss = ssckv; E.O0 = B_KN; E.O1 = B_VM;
            run_gemm(lds, wave_s, B_CKV, (const bf16_t*)(ws + W_WKV) + (size_t)l * NKV * KVL, MT, NKV, KVL, E);
        }
        if (l == 0) {
#pragma unroll 1
            for (int l2 = 0; l2 < 2; ++l2) {
                EpiKV<false> E; E.ss = nullptr; E.O0 = B_KNC + (size_t)l2 * MC * 1024; E.O1 = B_VMC + (size_t)l2 * MC * 1024;
                run_gemm(lds, wave_s, B_CKVC + (size_t)l2 * MC * 256, (const bf16_t*)(ws + W_WKVC) + (size_t)l2 * NKV * KVL, MC, NKV, KVL, E);
            }
        }
        {
            TID_DEFS
            const float* gk = P.in[17] + (size_t)l * 256;
            for (size_t idx = gt; idx < (size_t)MT * 64; idx += ngt) {
                const int row = (int)(idx >> 6), c4 = (int)(idx & 63);
                float* p = (row >= MP ? cks + (size_t)(row - MP) * 256 : ckp + (size_t)row * 256) + 4 * c4;
                const float rs = rsqrtf(ssckv[row] * (1.f / 256.f) + EPS); const f32x4 g = *(const f32x4*)(gk + 4 * c4);
                *(f32x4*)p = *(const f32x4*)p * rs * g;
            }
        }
        gbar(); OPAQ();
        PR_END(2);
        PR_BEGIN(3);
        {
            AttnCtx C; C.ws = ws; C.gda = P.in[14] + (size_t)l * 128; C.lam = __int_as_float(__builtin_amdgcn_readfirstlane(__float_as_int(ctlf[64 + 2 * l]))); C.lam1m = __int_as_float(__builtin_amdgcn_readfirstlane(__float_as_int(ctlf[65 + 2 * l]))); C.counter = ctl + 16 * l; C.l = l;
#ifndef NO_ATTN
            { int wv = wave_s; asm volatile("" : "+s"(wv)); attn_phase(lds, C, wv); }
#ifdef PROBE_ATTN2
            gbar(); OPAQ(); C.counter = ctl + 32 + 16 * l; { int wv = wave_s; asm volatile("" : "+s"(wv)); attn_phase(lds, C, wv); }
#endif
#endif
        }
        gbar(); OPAQ();
        PR_END(3);
        PR_BEGIN(4);
        {
            EpiRes E; E.xp = (l == 0) ? P.in[0] : nullptr; E.xs = P.in[1]; E.X = nullptr; E.HX = B_HX; E.ssn = ssx_ffn;
            run_gemm(lds, wave_s, B_MRG, (const bf16_t*)(ws + W_WO) + (size_t)l * 1024 * 1024, MT, 1024, 1024, E);
        }
        gbar(); OPAQ();
        PR_END(4);
        PR_BEGIN(5);
        {
            EpiUp E; E.ssx = ssx_ffn; E.ACT = B_ACT; E.UH = B_U; E.cvp = out + O_CVP + (size_t)l * 32 * 2 * NUP; E.cvs = out + O_CVS + (size_t)l * 16 * 2 * NUP;
            E.wc = P.in[23] + (size_t)l * 3 * NUP; E.bc = P.in[24] + (size_t)l * NUP; E.stc = P.in[6] + (size_t)l * 16 * 2 * NUP;
            run_gemm(lds, wave_s, B_HX, (const bf16_t*)(ws + W_WUP) + (size_t)l * NUP * 1024, MT, NUP, 1024, E);
        }
        gbar(); OPAQ();
        PR_END(5);
#ifndef NO_CONV
        PR_BEGIN(6);
        { TID_DEFS conv_fix_phase(P, l, gt, ngt); }
#endif
        gbar(); OPAQ();
        PR_END(6);
        PR_BEGIN(7);
        {
            EpiRes E; E.xp = nullptr; E.xs = nullptr; E.X = nullptr; E.HX = B_HX; E.ssn = ssx_next;
            run_gemm(lds, wave_s, B_ACT, (const bf16_t*)(ws + W_WDN) + (size_t)l * 1024 * DFF, MT, 1024, DFF, E);
        }
        gbar(); OPAQ();
        PR_END(7);
    }
    PR_BEGIN(8);
    {
        TID_DEFS
        const float* ssf = SS + (size_t)4 * MT; const float* gf = P.in[26];
        for (size_t idx = gt; idx < (size_t)MT * 256; idx += ngt) {
            const int row = (int)(idx >> 8), c4 = (int)(idx & 255);
            const float rs = rsqrtf(ssf[row] * (1.f / 1024.f) + EPS);
            const u32x2 hw = ldgu2(B_HX + (size_t)row * 1024 + 4 * c4);
            const f32x4 xv = (f32x4){__uint_as_float(hw.x << 16), __uint_as_float(hw.x & 0xffff0000u), __uint_as_float(hw.y << 16), __uint_as_float(hw.y & 0xffff0000u)};
            stg4(out + (size_t)row * 1024 + 4 * c4, xv * rs * ldg4(gf + 4 * c4));
        }
    }
#ifdef PROBE_SEL
    PR_END(8);
    if (blockIdx.x == 0) { const unsigned long long s0 = __builtin_amdgcn_s_memrealtime(); while (__builtin_amdgcn_s_memrealtime() - s0 < pr_acc) __builtin_amdgcn_s_sleep(32); }
#endif
}

extern "C" void kernel_launch(void* const* d_in, const int* in_sizes, int n_in, void* d_out, int out_size, void* d_ws, size_t ws_size, hipStream_t stream) {
    static int grid_blocks = 0;
    if (grid_blocks == 0) {
        if (n_in != 27 || (size_t)out_size != O_END || ws_size < W_END) { fprintf(stderr, "kernel_launch: unexpected problem (n_in %d, out %d vs %zu, ws %zu vs %zu)\n", n_in, out_size, (size_t)O_END, ws_size, (size_t)W_END); grid_blocks = -1; return; }
        int dev = 0, cus = 0, per_cu = 0;
        (void)hipGetDevice(&dev); (void)hipDeviceGetAttribute(&cus, hipDeviceAttributeMultiprocessorCount, dev);
        (void)hipFuncSetAttribute((const void*)fwd_megakernel, hipFuncAttributeMaxDynamicSharedMemorySize, LDS_BYTES);
        (void)hipOccupancyMaxActiveBlocksPerMultiprocessor(&per_cu, (const void*)fwd_megakernel, 512, LDS_BYTES);
        if (per_cu < 1) per_cu = 1;
        grid_blocks = cus * per_cu;
    }
    if (grid_blocks < 0) return;
    Params p{};
    for (int i = 0; i < 27; ++i) p.in[i] = (const float*)d_in[i];
    p.out = (float*)d_out; p.ws = (unsigned char*)d_ws;
    void* args[] = {&p};
    hipError_t e = hipLaunchCooperativeKernel((void*)fwd_megakernel, dim3(grid_blocks), dim3(512), args, LDS_BYTES, stream);
    if (e != hipSuccess) fprintf(stderr, "cooperative launch failed: %s (grid %d)\n", hipGetErrorString(e), grid_blocks);
}
```

```cpp
#include <hip/hip_runtime.h>
#include <hip/hip_cooperative_groups.h>
#include <cstdio>
#include <cstdint>
namespace cg = cooperative_groups;
#define LANE_ID() ({ int l_ = (int)__builtin_amdgcn_mbcnt_hi(~0u, __builtin_amdgcn_mbcnt_lo(~0u, 0u)); asm volatile("" : "+v"(l_)); l_; })
namespace pg8 {
#define PG8_LAS __attribute__((address_space(3)))
typedef unsigned short bf16_t;
typedef short bf16x8 __attribute__((ext_vector_type(8)));
typedef float f32x4 __attribute__((ext_vector_type(4)));
typedef unsigned u32x4 __attribute__((ext_vector_type(4)));
constexpr int BM = 256, BK = 64, HALF = 128, HTB = HALF * BK * 2  , STAGE_BYTES = 8 * HTB, NXCD = 8, WGM = 8;

__host__ __device__ __forceinline__ int lds_byte(int r, int c) { const int st = (r >> 4) * 2 + (c >> 5), rr = r & 15, cc = c & 31, ob = rr * 64 + cc * 2; return st * 1024 + (ob ^ (((ob >> 9) & 1) << 5)); }
__host__ __device__ __forceinline__ void stage_rc(int b, int& R, int& C) { const int st = b / 1024, sb = b % 1024, swz = sb ^ (((sb >> 9) & 1) << 5); R = (st >> 1) * 16 + swz / 64; C = (st & 1) * 32 + (swz % 64) / 2; }
__host__ __device__ __forceinline__ int perm32(int rho) { const int n = rho >> 4, i = rho & 15; return 8 * (i >> 2) + 4 * n + (i & 3); }

struct Unit { int pm, pn; };
struct Gemm { const bf16_t* A; const bf16_t* Bt; int M, N, K; };

struct StaticOrder {
    int nM, nN, nwg, G, c;
    __host__ __device__ void init(int M, int N, int G_, int c_) { nM = M / BM; nN = N / BM; nwg = nM * nN; G = G_; c = c_; }
    __host__ __device__ bool next(int i, Unit& u) const {
        const long L = (long)i * G + c; if (L >= nwg) return false;
        int wgid = (int)L; { const int q = nwg / NXCD, r = nwg % NXCD, xcd = wgid % NXCD, off = wgid / NXCD; wgid = (xcd < r ? xcd * (q + 1) : r * (q + 1) + (xcd - r) * q) + off; }
        const int nig = WGM * nN, gid = wgid / nig, fm = gid * WGM, gsz = (nM - fm) < WGM ? (nM - fm) : WGM;
        u.pm = fm + ((wgid % nig) % gsz); u.pn = (wgid % nig) / gsz; return true;
    }
    __device__ __forceinline__ void a_ready(const Unit&) const {}
    __device__ __forceinline__ void done(const Unit&) const {}
};

typedef float f32x2_cv __attribute__((ext_vector_type(2))); typedef __bf16 bf16x2_cv __attribute__((ext_vector_type(2)));
__device__ __forceinline__ unsigned cvt_pk_bf16(float lo, float hi) { f32x2_cv v = {lo, hi}; bf16x2_cv b = __builtin_convertvector(v, bf16x2_cv); return __builtin_bit_cast(unsigned, b); }
template <class Epi, class Sched, bool ALIGN_EPI = false, bool SP2 = false>
__device__ __forceinline__ void gemm_phase(PG8_LAS unsigned char* lds, const Gemm g, const Sched& S, const Epi& E, const int wid_in) {
    const int wid = wid_in, lane = LANE_ID(), tid = (wid << 6) | lane, wr = wid >> 2, wc = wid & 3, fr = lane & 15, fq = lane >> 4;
    const int K = g.K, nt = K / BK;
    unsigned voffA[2], voffB[2];
#pragma unroll
    for (int i = 0; i < 2; ++i) { int R, C; stage_rc(tid * 16 + i * 8192, R, C); const int Rb = Epi::PERM ? ((R & ~31) + perm32(R & 31)) : R;
        voffA[i] = (unsigned)(R * K + C) * 2u; voffB[i] = (unsigned)(Rb * K + C) * 2u; }
    const size_t kstep = (size_t)(BK * 2);
    const size_t hstep = (size_t)HALF * K * 2;
    const size_t tstep = 2 * hstep;
    const unsigned ldsw = (unsigned)wid * 1024u;
    const int aoff = lds_byte(wr * 64 + fr, fq * 8), boff = lds_byte(wc * 32 + fr, fq * 8);
#define PG8_SA(b, h) (((b) * 2 + (h)) * HTB)
#define PG8_SB(b, h) ((4 + (b) * 2 + (h)) * HTB)
#define PG8_STAGE(bufoff, gbase, voff) do { _Pragma("unroll") for (int _i = 0; _i < 2; ++_i) \
        __builtin_amdgcn_global_load_lds((const unsigned*)((const char*)(gbase) + (voff)[_i]), (PG8_LAS unsigned*)(lds + (bufoff) + ldsw + _i * 8192), 16, 0, 0); } while (0)
#define PG8_LDA(dst, b, h) do { _Pragma("unroll") for (int m = 0; m < 4; ++m) _Pragma("unroll") for (int k = 0; k < 2; ++k) dst[m][k] = *(const PG8_LAS bf16x8*)(lds + PG8_SA(b, h) + aoff + m * 2048 + k * 1024); } while (0)
#define PG8_LDB(dst, b, h) do { _Pragma("unroll") for (int n = 0; n < 2; ++n) _Pragma("unroll") for (int k = 0; k < 2; ++k) dst[n][k] = *(const PG8_LAS bf16x8*)(lds + PG8_SB(b, h) + boff + n * 2048 + k * 1024); } while (0)
#define PG8_MMA(ai, bj, At, Bt) do { __builtin_amdgcn_s_setprio(1); _Pragma("unroll") for (int m = 0; m < 4; ++m) _Pragma("unroll") for (int n = 0; n < 2; ++n) _Pragma("unroll") for (int k = 0; k < 2; ++k) \
        acc[ai][bj][m][n] = __builtin_amdgcn_mfma_f32_16x16x32_bf16(Bt[n][k], At[m][k], acc[ai][bj][m][n], 0, 0, 0); __builtin_amdgcn_s_setprio(0); } while (0)
#define PG8_WAIT_V(n) asm volatile("s_waitcnt vmcnt(" #n ")" ::: "memory")
#define PG8_WAIT_L(n) asm volatile("s_waitcnt lgkmcnt(" #n ")" ::: "memory")
#define PG8_BAR __builtin_amdgcn_s_barrier()
#define PG8_SCHED __builtin_amdgcn_sched_barrier(0)
    Unit cur, nxt; int ui = 0;
    if (!S.next(0, cur)) return;
    f32x4 acc[2][2][4][2];
#pragma unroll
    for (int a = 0; a < 2; ++a)
#pragma unroll
        for (int b = 0; b < 2; ++b)
#pragma unroll
            for (int m = 0; m < 4; ++m)
#pragma unroll
                for (int n = 0; n < 2; ++n) acc[a][b][m][n] = (f32x4){0.f, 0.f, 0.f, 0.f};
    bf16x8 At[4][2], B0[2][2], B1[2][2];
    const char* cA = (const char*)g.A + (size_t)cur.pm * tstep; const char* cB = (const char*)g.Bt + (size_t)cur.pn * tstep;
    S.a_ready(cur);
    if constexpr (SP2) {
        PG8_STAGE(PG8_SB(0, 0), cB, voffB); PG8_STAGE(PG8_SB(0, 1), cB + hstep, voffB); PG8_STAGE(PG8_SA(0, 0), cA, voffA); PG8_STAGE(PG8_SA(0, 1), cA + hstep, voffA);
        if (wr == 1) PG8_BAR;
        PG8_WAIT_V(2); PG8_BAR;
        PG8_STAGE(PG8_SB(1, 0), cB + kstep, voffB); PG8_STAGE(PG8_SA(1, 0), cA + kstep, voffA); PG8_STAGE(PG8_SB(1, 1), cB + hstep + kstep, voffB);
        PG8_WAIT_V(6); PG8_BAR;
    } else {
        PG8_STAGE(PG8_SB(0, 0), cB, voffB); PG8_STAGE(PG8_SA(0, 0), cA, voffA); PG8_STAGE(PG8_SB(0, 1), cB + hstep, voffB); PG8_STAGE(PG8_SA(0, 1), cA + hstep, voffA);
        if (wr == 1) PG8_BAR;
        PG8_WAIT_V(4); PG8_BAR;
        PG8_STAGE(PG8_SB(1, 0), cB + kstep, voffB); PG8_STAGE(PG8_SA(1, 0), cA + kstep, voffA); PG8_STAGE(PG8_SB(1, 1), cB + hstep + kstep, voffB);
        PG8_WAIT_V(6); PG8_BAR;
    }
    for (;;) {
        const bool has_next = S.next(ui + 1, nxt);
        const char* nA = has_next ? (const char*)g.A + (size_t)nxt.pm * tstep : cA; const char* nB = has_next ? (const char*)g.Bt + (size_t)nxt.pn * tstep : cB;
        for (int t = 0; t < nt; t += 2) {
            const bool last = (t == nt - 2);
            const char* a1 = cA + (size_t)(t + 1) * kstep;
            const char* a2 = last ? nA : cA + (size_t)(t + 2) * kstep; const char* b2 = last ? nB : cB + (size_t)(t + 2) * kstep;
            const char* a3 = a2 + kstep; const char* b3 = b2 + kstep;
            if (last && has_next) S.a_ready(nxt);
            if constexpr (SP2) {
            PG8_LDB(B0, 0, 0); PG8_LDB(B1, 0, 1); PG8_SCHED; PG8_LDA(At, 0, 0); PG8_STAGE(PG8_SA(1, 1), a1 + hstep, voffA);
            PG8_WAIT_V(8); PG8_WAIT_L(0); PG8_BAR; PG8_MMA(0, 0, At, B0); PG8_MMA(0, 1, At, B1); PG8_BAR; PG8_SCHED;
            PG8_LDA(At, 0, 1); PG8_STAGE(PG8_SB(0, 0), b2, voffB); PG8_STAGE(PG8_SB(0, 1), b2 + hstep, voffB); PG8_STAGE(PG8_SA(0, 0), a2, voffA);
            PG8_WAIT_V(8); PG8_WAIT_L(0); PG8_BAR; PG8_MMA(1, 0, At, B0); PG8_MMA(1, 1, At, B1); PG8_BAR; PG8_SCHED;
            PG8_LDB(B0, 1, 0); PG8_LDB(B1, 1, 1); PG8_SCHED; PG8_LDA(At, 1, 0); PG8_STAGE(PG8_SA(0, 1), a2 + hstep, voffA);
            PG8_WAIT_V(8); PG8_WAIT_L(0); PG8_BAR; PG8_MMA(0, 0, At, B0); PG8_MMA(0, 1, At, B1); PG8_BAR; PG8_SCHED;
            PG8_LDA(At, 1, 1); PG8_STAGE(PG8_SB(1, 0), b3, voffB); PG8_STAGE(PG8_SB(1, 1), b3 + hstep, voffB); PG8_STAGE(PG8_SA(1, 0), a3, voffA);
            PG8_WAIT_V(8); PG8_WAIT_L(0); PG8_BAR; PG8_MMA(1, 0, At, B0); PG8_MMA(1, 1, At, B1); PG8_BAR; PG8_SCHED;
            } else {
            PG8_LDB(B0, 0, 0); PG8_SCHED; PG8_LDA(At, 0, 0); PG8_STAGE(PG8_SA(1, 1), a1 + hstep, voffA);
            PG8_WAIT_L(8); PG8_BAR; PG8_WAIT_L(0); PG8_MMA(0, 0, At, B0); PG8_BAR; PG8_SCHED;
            PG8_LDB(B1, 0, 1); PG8_STAGE(PG8_SB(0, 0), b2, voffB);
            PG8_BAR; PG8_WAIT_L(0); PG8_MMA(0, 1, At, B1); PG8_BAR;
            PG8_LDA(At, 0, 1); PG8_STAGE(PG8_SA(0, 0), a2, voffA);
            PG8_BAR; PG8_WAIT_L(0); PG8_MMA(1, 0, At, B0); PG8_BAR; PG8_SCHED;
            PG8_STAGE(PG8_SB(0, 1), b2 + hstep, voffB);
            PG8_WAIT_V(6); PG8_BAR; PG8_MMA(1, 1, At, B1); PG8_BAR;
            PG8_LDB(B0, 1, 0); PG8_SCHED; PG8_LDA(At, 1, 0); PG8_STAGE(PG8_SA(0, 1), a2 + hstep, voffA);
            PG8_WAIT_L(8); PG8_BAR; PG8_WAIT_L(0); PG8_MMA(0, 0, At, B0); PG8_BAR; PG8_SCHED;
            PG8_LDB(B1, 1, 1); PG8_STAGE(PG8_SB(1, 0), b3, voffB);
            PG8_BAR; PG8_WAIT_L(0); PG8_MMA(0, 1, At, B1); PG8_BAR;
            PG8_LDA(At, 1, 1); PG8_STAGE(PG8_SA(1, 0), a3, voffA);
            PG8_BAR; PG8_WAIT_L(0); PG8_MMA(1, 0, At, B0); PG8_BAR; PG8_SCHED;
            PG8_STAGE(PG8_SB(1, 1), b3 + hstep, voffB);
            PG8_WAIT_V(6); PG8_BAR; PG8_MMA(1, 1, At, B1); PG8_BAR;
            }
        }
        if constexpr (ALIGN_EPI) { if (wr == 0) PG8_BAR; }
        if constexpr (!Epi::AFTER_DRAIN) { const int le = LANE_ID(); E(acc, cur, wr, wc, le & 15, le >> 4); S.done(cur); }
        if (!has_next) break;
#pragma unroll
        for (int a = 0; a < 2; ++a)
#pragma unroll
            for (int b = 0; b < 2; ++b)
#pragma unroll
                for (int m = 0; m < 4; ++m)
#pragma unroll
                    for (int n = 0; n < 2; ++n) acc[a][b][m][n] = (f32x4){0.f, 0.f, 0.f, 0.f};
        cur = nxt; cA = nA; cB = nB; ++ui;
        if constexpr (ALIGN_EPI) { if (wr == 1) PG8_BAR; }
    }
    PG8_WAIT_V(0);
    if constexpr (!ALIGN_EPI) { if (wr == 0) PG8_BAR; }
    PG8_BAR;
    if constexpr (Epi::AFTER_DRAIN) { E.fused(acc, cur, wr, wc, fr, fq, lds, wid, lane); S.done(cur); }
#undef PG8_SA
#undef PG8_SB
#undef PG8_STAGE
#undef PG8_LDA
#undef PG8_LDB
#undef PG8_MMA
#undef PG8_WAIT_V
#undef PG8_WAIT_L
#undef PG8_BAR
#undef PG8_SCHED
}
}
#define PG8_SP2 true
#define PG8_ALIGN true
using pg8::bf16_t; using pg8::bf16x8; using pg8::f32x4; using pg8::Unit; using pg8::cvt_pk_bf16;
#define LAS __attribute__((address_space(3)))
typedef float f32x16 __attribute__((ext_vector_type(16)));
typedef unsigned u32x2 __attribute__((ext_vector_type(2)));
typedef unsigned u32x4 __attribute__((ext_vector_type(4)));
typedef short v4i16_t __attribute__((ext_vector_type(4)));

constexpr int MP = 65536, MSMP = 512, MT = MP + MSMP, MC = 32768;
constexpr int INC = 5824, NIN = 5888, QL = 384, KVL = 256, NQ = 1536, NKV = 2048, DFF = 2816, NUP = 5632;
constexpr float EPS = 1e-6f, LOG2E = 1.4426950408889634f;
constexpr float QS_DA = 0.125f * LOG2E;
constexpr float QS_MLA = 0.07216878364870322f * LOG2E;
constexpr size_t O_DKP = (size_t)MT * 1024;
constexpr size_t O_DVP = O_DKP + 2 * (size_t)MP * 1024;
constexpr size_t O_CKVP = O_DVP + 2 * (size_t)MP * 1024;
constexpr size_t O_KRP = O_CKVP + 2 * (size_t)MP * 256;
constexpr size_t O_CVP = O_KRP + 2 * (size_t)MP * 64;
constexpr size_t O_DKS = O_CVP + 2 * 32 * 2 * 5632;
constexpr size_t O_DVS = O_DKS + 2 * 512 * 1024;
constexpr size_t O_CKVS = O_DVS + 2 * 512 * 1024;
constexpr size_t O_KRS = O_CKVS + 2 * 512 * 256;
constexpr size_t O_CVS = O_KRS + 2 * 512 * 64;
constexpr size_t O_END = O_CVS + 2 * 16 * 2 * 5632;
constexpr size_t A256(size_t x) { return (x + 255) & ~(size_t)255; }
constexpr size_t W_CTL = 0;
constexpr size_t W_ROPE = 4096;
constexpr size_t W_SS = A256(W_ROPE + (size_t)2080 * 64 * 4);
constexpr size_t W_WIN = A256(W_SS + (size_t)9 * MT * 4);
constexpr size_t W_WQ = A256(W_WIN + (size_t)2 * NIN * 1024 * 2);
constexpr size_t W_WKV = A256(W_WQ + (size_t)2 * NQ * QL * 2);
constexpr size_t W_WKVC = A256(W_WKV + (size_t)2 * NKV * KVL * 2);
constexpr size_t W_WO = A256(W_WKVC + (size_t)2 * NKV * KVL * 2);
constexpr size_t W_WUP = A256(W_WO + (size_t)2 * 1024 * 1024 * 2);
constexpr size_t W_WDN = A256(W_WUP + (size_t)2 * NUP * 1024 * 2);
constexpr size_t W_HX = A256(W_WDN + (size_t)2 * 1024 * DFF * 2);
constexpr size_t W_X = A256(W_HX + (size_t)MT * 1024 * 2);
constexpr size_t W_QDA = A256(W_X + (size_t)MT * 1024 * 4);
constexpr size_t W_KDA = A256(W_QDA + (size_t)MT * 1024 * 2);
constexpr size_t W_VDA = A256(W_KDA + (size_t)MT * 1024 * 2);
constexpr size_t W_G = A256(W_VDA + (size_t)MT * 1024 * 2);
constexpr size_t W_CKV = A256(W_G + (size_t)MT * 2048 * 2);
constexpr size_t W_CQ = A256(W_CKV + (size_t)MT * 256 * 2);
constexpr size_t W_KR = A256(W_CQ + (size_t)MT * 384 * 2);
constexpr size_t W_QM = A256(W_KR + (size_t)MT * 64 * 2);
constexpr size_t W_KN = A256(W_QM + (size_t)MT * 1536 * 2);
constexpr size_t W_VM = A256(W_KN + (size_t)MT * 1024 * 2);
constexpr size_t W_MRG = A256(W_VM + (size_t)MT * 1024 * 2);
constexpr size_t W_U = A256(W_MRG + (size_t)MT * 1024 * 2);
constexpr size_t W_ACT = A256(W_U + (size_t)MT * NUP * 2);
constexpr size_t W_KC = A256(W_ACT + (size_t)MT * DFF * 2);
constexpr size_t W_VC = A256(W_KC + (size_t)2 * MC * 1024 * 2);
constexpr size_t W_KRC = A256(W_VC + (size_t)2 * MC * 1024 * 2);
constexpr size_t W_CKVC = A256(W_KRC + (size_t)2 * MC * 64 * 2);
constexpr size_t W_KNC = A256(W_CKVC + (size_t)2 * MC * 256 * 2);
constexpr size_t W_VMC = A256(W_KNC + (size_t)2 * MC * 1024 * 2);
constexpr size_t W_END = A256(W_VMC + (size_t)2 * MC * 1024 * 2);

struct Params { const float* in[27]; float* out; unsigned char* ws; };

#define GAS __attribute__((address_space(1)))
__device__ __forceinline__ void st_bf16x4(bf16_t* p, f32x4 v) { u32x2 w; w.x = cvt_pk_bf16(v[0], v[1]); w.y = cvt_pk_bf16(v[2], v[3]); *(GAS u32x2*)p = w; }
__device__ __forceinline__ f32x4 ldg4(const float* p) { return *(const GAS f32x4*)p; }
__device__ __forceinline__ void stg4(float* p, f32x4 v) { *(GAS f32x4*)p = v; }
__device__ __forceinline__ u32x4 ldgu4(const void* p) { return *(const GAS u32x4*)p; }
__device__ __forceinline__ u32x2 ldgu2(const void* p) { return *(const GAS u32x2*)p; }
__device__ __forceinline__ float ldg1(const float* p) { return *(const GAS float*)p; }
__device__ __forceinline__ float fast_rcp(float x) { return __builtin_amdgcn_rcpf(x); }
__device__ __forceinline__ float fast_exp2(float x) { return __builtin_amdgcn_exp2f(x); }
__device__ __forceinline__ float sigmoidf_(float x) { return fast_rcp(1.f + fast_exp2(-x * LOG2E)); }
__device__ __forceinline__ float bf2f(unsigned short b) { return __uint_as_float((unsigned)b << 16); }
__device__ __forceinline__ int row_of(const Unit& u, int ai, int wr, int m, int fr) { return u.pm * 256 + ai * 128 + wr * 64 + m * 16 + fr; }
__device__ __forceinline__ float sq4(f32x4 v) { return (v[0] * v[0] + v[1] * v[1]) + (v[2] * v[2] + v[3] * v[3]); }

__device__ __forceinline__ float add_x16(float s) { return s + __int_as_float(__builtin_amdgcn_ds_swizzle(__float_as_int(s), 0x401F)); }
__device__ __forceinline__ float add_x32(float s) { auto rr = __builtin_amdgcn_permlane32_swap(__float_as_uint(s), __float_as_uint(s), false, false); return __uint_as_float(rr[0]) + __uint_as_float(rr[1]); }
__device__ __forceinline__ float max_x32(float s) { auto rr = __builtin_amdgcn_permlane32_swap(__float_as_uint(s), __float_as_uint(s), false, false); return fmaxf(__uint_as_float(rr[0]), __uint_as_float(rr[1])); }
#define LOAD_RS8(name, ptr, scale, mul) float name[2][4]; { _Pragma("unroll") for (int ai_ = 0; ai_ < 2; ++ai_) _Pragma("unroll") for (int m_ = 0; m_ < 4; ++m_) name[ai_][m_] = ldg1((ptr) + row_of(u, ai_, wr, m_, fr)); \
    _Pragma("unroll") for (int ai_ = 0; ai_ < 2; ++ai_) _Pragma("unroll") for (int m_ = 0; m_ < 4; ++m_) name[ai_][m_] = rsqrtf(name[ai_][m_] * (scale) + EPS) * (mul); }
struct EpiInProj {
    static constexpr bool PERM = false, AFTER_DRAIN = false;
    unsigned char* ws; float* out; const float* bgate; int l;
    __device__ __forceinline__ void operator()(const f32x4 (&acc)[2][2][4][2], const Unit& u, int wr, int wc, int fr, int fq) const {
        const int pn = u.pn;
        const float* SSb = (const float*)(ws + W_SS); const float* ssx = SSb + (size_t)(2 * l) * MT; const float* rope = (const float*)(ws + W_ROPE);
        float* sscq = (float*)(ws + W_SS) + (size_t)(5 + l) * MT; float* ssckv = (float*)(ws + W_SS) + (size_t)(7 + l) * MT;
        bf16_t* QDA = (bf16_t*)(ws + W_QDA); bf16_t* KDA = (bf16_t*)(ws + W_KDA); bf16_t* VDA = (bf16_t*)(ws + W_VDA); bf16_t* G = (bf16_t*)(ws + W_G);
        bf16_t* CKV = (bf16_t*)(ws + W_CKV); bf16_t* CQ = (bf16_t*)(ws + W_CQ); bf16_t* KR = (bf16_t*)(ws + W_KR);
        float* dkp = out + O_DKP + (size_t)l * MP * 1024; float* dks = out + O_DKS + (size_t)l * MSMP * 1024; float* dvp = out + O_DVP + (size_t)l * MP * 1024; float* dvs = out + O_DVS + (size_t)l * MSMP * 1024;
        float* ckp = out + O_CKVP + (size_t)l * MP * 256; float* cks = out + O_CKVS + (size_t)l * MSMP * 256; float* krp = out + O_KRP + (size_t)l * MP * 64; float* krs = out + O_KRS + (size_t)l * MSMP * 64;
        LOAD_RS8(rs8, ssx, 1.f / 1024.f, 1.f)
        if (pn < 8) {
            const bool isk = pn >= 4; const int cb = 256 * (pn & 3) + 64 * wc;
#pragma unroll
            for (int ai = 0; ai < 2; ++ai)
#pragma unroll
                for (int m = 0; m < 4; ++m) { if ((m & 1) == 0) asm volatile("" ::: "memory");
                    const int row = row_of(u, ai, wr, m, fr); const float rstd = rs8[ai][m];
                    const bool samp = row >= MP; const int orow = samp ? row - MP : row; const int pos = samp ? 2048 + (orow & 31) : (row & 2047);
                    const float* rt = rope + (size_t)pos * 64;
#pragma unroll
                    for (int n = 0; n < 2; ++n) {
                        const int i0 = 16 * n + 4 * fq; const f32x4 cs = ldg4(rt + i0), sn = ldg4(rt + 32 + i0);
                        const f32x4 x1 = acc[ai][0][m][n] * rstd, x2 = acc[ai][1][m][n] * rstd;
                        f32x4 o1 = x1 * cs - x2 * sn, o2 = x2 * cs + x1 * sn;
                        if (!isk) { o1 = o1 * QS_DA; o2 = o2 * QS_DA; bf16_t* q = QDA + (size_t)row * 1024 + cb + i0; st_bf16x4(q, o1); st_bf16x4(q + 32, o2); }
                        else { bf16_t* k = KDA + (size_t)row * 1024 + cb + i0; st_bf16x4(k, o1); st_bf16x4(k + 32, o2);
                               float* d = (samp ? dks : dkp) + (size_t)orow * 1024 + cb + i0; stg4(d, o1); stg4((d + 32), o2); }
                    }
                }
        } else if (pn < 12) {
            const int cb = 256 * (pn - 8) + 32 * wc + 4 * fq;
#pragma unroll
            for (int ai = 0; ai < 2; ++ai)
#pragma unroll
                for (int m = 0; m < 4; ++m) { if ((m & 1) == 0) asm volatile("" ::: "memory");
                    const int row = row_of(u, ai, wr, m, fr); const float rstd = rs8[ai][m];
                    const bool samp = row >= MP; const int orow = samp ? row - MP : row;
                    float* d = (samp ? dvs : dvp) + (size_t)orow * 1024 + cb; bf16_t* v = VDA + (size_t)row * 1024 + cb;
#pragma unroll
                    for (int bj = 0; bj < 2; ++bj)
#pragma unroll
                        for (int n = 0; n < 2; ++n) { const f32x4 x = acc[ai][bj][m][n] * rstd; stg4((d + 128 * bj + 16 * n), x); st_bf16x4(v + 128 * bj + 16 * n, x); }
                }
        } else if (pn < 20) {
            const int cb = 256 * (pn - 12) + 32 * wc + 4 * fq;
            f32x4 bv[2][2];
#pragma unroll
            for (int bj = 0; bj < 2; ++bj)
#pragma unroll
                for (int n = 0; n < 2; ++n) bv[bj][n] = ldg4(bgate + cb + 128 * bj + 16 * n);
#pragma unroll
            for (int ai = 0; ai < 2; ++ai)
#pragma unroll
                for (int m = 0; m < 4; ++m) { if ((m & 1) == 0) asm volatile("" ::: "memory");
                    const int row = row_of(u, ai, wr, m, fr); const float rstd = rs8[ai][m];
                    bf16_t* g = G + (size_t)row * 2048 + cb;
#pragma unroll
                    for (int bj = 0; bj < 2; ++bj)
#pragma unroll
                        for (int n = 0; n < 2; ++n) { f32x4 x = acc[ai][bj][m][n] * rstd + bv[bj][n];
                            x[0] = sigmoidf_(x[0]); x[1] = sigmoidf_(x[1]); x[2] = sigmoidf_(x[2]); x[3] = sigmoidf_(x[3]); st_bf16x4(g + 128 * bj + 16 * n, x); }
                }
        } else if (pn == 20) {
            const int cb = 32 * wc + 4 * fq;
#pragma unroll
            for (int ai = 0; ai < 2; ++ai)
#pragma unroll
                for (int m = 0; m < 4; ++m) { if ((m & 1) == 0) asm volatile("" ::: "memory");
                    const int row = row_of(u, ai, wr, m, fr); const float rstd = rs8[ai][m];
                    const bool samp = row >= MP; const int orow = samp ? row - MP : row;
                    float* d = (samp ? cks : ckp) + (size_t)orow * 256 + cb; bf16_t* c = CKV + (size_t)row * 256 + cb; float s = 0.f;
#pragma unroll
                    for (int bj = 0; bj < 2; ++bj)
#pragma unroll
                        for (int n = 0; n < 2; ++n) { const f32x4 x = acc[ai][bj][m][n] * rstd; s += sq4(x); stg4((d + 128 * bj + 16 * n), x); st_bf16x4(c + 128 * bj + 16 * n, x); }
                    s = add_x16(s); s = add_x32(s);
                    if (fq == 0) unsafeAtomicAdd(ssckv + row, s);
                }
        } else if (pn == 21) {
            const int cb = 32 * wc + 4 * fq;
#pragma unroll
            for (int ai = 0; ai < 2; ++ai)
#pragma unroll
                for (int m = 0; m < 4; ++m) { if ((m & 1) == 0) asm volatile("" ::: "memory");
                    const int row = row_of(u, ai, wr, m, fr); const float rstd = rs8[ai][m];
                    bf16_t* c = CQ + (size_t)row * 384 + cb; float s = 0.f;
#pragma unroll
                    for (int bj = 0; bj < 2; ++bj)
#pragma unroll
                        for (int n = 0; n < 2; ++n) { const f32x4 x = acc[ai][bj][m][n] * rstd; s += sq4(x); st_bf16x4(c + 128 * bj + 16 * n, x); }
                    s = add_x16(s); s = add_x32(s);
                    if (fq == 0) unsafeAtomicAdd(sscq + row, s);
                }
        } else {
#pragma unroll
            for (int ai = 0; ai < 2; ++ai)
#pragma unroll
                for (int m = 0; m < 4; ++m) { if ((m & 1) == 0) asm volatile("" ::: "memory");
                    const int row = row_of(u, ai, wr, m, fr); const float rstd = rs8[ai][m];
                    const bool samp = row >= MP; const int orow = samp ? row - MP : row; const int pos = samp ? 2048 + (orow & 31) : (row & 2047);
                    bf16_t* c = CQ + (size_t)row * 384 + 256 + 32 * wc + 4 * fq; float s = 0.f;
#pragma unroll
                    for (int n = 0; n < 2; ++n) { const f32x4 x = acc[ai][0][m][n] * rstd; s += sq4(x); st_bf16x4(c + 16 * n, x); }
                    s = add_x16(s); s = add_x32(s);
                    if (fq == 0) unsafeAtomicAdd(sscq + row, s);
                    if (wc < 2) {
                        const int i0 = 16 * wc + 4 * fq; const float* rt = rope + (size_t)pos * 64;
                        const f32x4 cs = ldg4(rt + i0), sn = ldg4(rt + 32 + i0);
                        const f32x4 x1 = acc[ai][1][m][0] * rstd, x2 = acc[ai][1][m][1] * rstd;
                        const f32x4 o1 = x1 * cs - x2 * sn, o2 = x2 * cs + x1 * sn;
                        float* d = (samp ? krs : krp) + (size_t)orow * 64 + i0; stg4(d, o1); stg4((d + 32), o2);
                        bf16_t* k = KR + (size_t)row * 64 + i0; st_bf16x4(k, o1); st_bf16x4(k + 32, o2);
                    }
                }
        }
    }
};

struct EpiQ {
    static constexpr bool PERM = false, AFTER_DRAIN = false;
    const float* sscq; const float* rope; bf16_t* QM;
    __device__ __forceinline__ void operator()(const f32x4 (&acc)[2][2][4][2], const Unit& u, int wr, int wc, int fr, int fq) const {
        const int pn = u.pn;
        LOAD_RS8(rs8, sscq, 1.f / 384.f, QS_MLA)
#pragma unroll
        for (int ai = 0; ai < 2; ++ai)
#pragma unroll
            for (int m = 0; m < 4; ++m) { if ((m & 1) == 0) asm volatile("" ::: "memory");
                const int row = row_of(u, ai, wr, m, fr); const float rs = rs8[ai][m];
                bf16_t* q = QM + (size_t)row * 1536;
                if (pn < 4) {
#pragma unroll
                    for (int bj = 0; bj < 2; ++bj)
#pragma unroll
                        for (int n = 0; n < 2; ++n) st_bf16x4(q + (2 * pn + bj) * 192 + 32 * wc + 16 * n + 4 * fq, acc[ai][bj][m][n] * rs);
                } else {
                    const int pos = row >= MP ? 2048 + ((row - MP) & 31) : (row & 2047); const float* rt = rope + (size_t)pos * 64;
                    bf16_t* qh = q + (4 * (pn - 4) + wc) * 192 + 128;
#pragma unroll
                    for (int n = 0; n < 2; ++n) {
                        const int i0 = 16 * n + 4 * fq; const f32x4 cs = ldg4(rt + i0), sn = ldg4(rt + 32 + i0);
                        const f32x4 x1 = acc[ai][0][m][n] * rs, x2 = acc[ai][1][m][n] * rs;
                        st_bf16x4(qh + i0, x1 * cs - x2 * sn); st_bf16x4(qh + 32 + i0, x2 * cs + x1 * sn);
                    }
                }
            }
    }
};

template <bool HAS_SS> struct EpiKV {
    static constexpr bool PERM = false, AFTER_DRAIN = false;
    const float* ss; bf16_t *O0, *O1;
    __device__ __forceinline__ void operator()(const f32x4 (&acc)[2][2][4][2], const Unit& u, int wr, int wc, int fr, int fq) const {
        bf16_t* base = (u.pn < 4 ? O0 : O1) + 256 * (u.pn & 3) + 32 * wc + 4 * fq;
        float rs8[2][4];
        if constexpr (HAS_SS) { LOAD_RS8(t8, ss, 1.f / 256.f, 1.f) _Pragma("unroll") for (int a = 0; a < 2; ++a) _Pragma("unroll") for (int b = 0; b < 4; ++b) rs8[a][b] = t8[a][b]; }
#pragma unroll
        for (int ai = 0; ai < 2; ++ai)
#pragma unroll
            for (int m = 0; m < 4; ++m) { if ((m & 1) == 0) asm volatile("" ::: "memory");
                const int row = row_of(u, ai, wr, m, fr); const float rs = HAS_SS ? rs8[ai][m] : 1.f;
                bf16_t* o = base + (size_t)row * 1024;
#pragma unroll
                for (int bj = 0; bj < 2; ++bj)
#pragma unroll
                    for (int n = 0; n < 2; ++n) st_bf16x4(o + 128 * bj + 16 * n, acc[ai][bj][m][n] * rs);
            }
    }
};

struct EpiRes {
    static constexpr bool PERM = false, AFTER_DRAIN = false;
    const float* xp; const float* xs; float* X; bf16_t* HX; float* ssn;
    __device__ __forceinline__ void operator()(const f32x4 (&acc)[2][2][4][2], const Unit& u, int wr, int wc, int fr, int fq) const {
        const int cb = 256 * u.pn + 32 * wc + 4 * fq;
#pragma unroll
        for (int ai = 0; ai < 2; ++ai)
#pragma unroll
            for (int m = 0; m < 4; ++m) { if ((m & 1) == 0) asm volatile("" ::: "memory");
                const int row = row_of(u, ai, wr, m, fr);
                bf16_t* h = HX + (size_t)row * 1024 + cb; float s = 0.f;
                f32x4 xo[2][2];
                if (xp) { const float* xi = (row >= MP ? xs + (size_t)(row - MP) * 1024 : xp + (size_t)row * 1024) + cb;
#pragma unroll
                    for (int bj = 0; bj < 2; ++bj)
#pragma unroll
                        for (int n = 0; n < 2; ++n) xo[bj][n] = ldg4(xi + 128 * bj + 16 * n); }
                else {
#pragma unroll
                    for (int bj = 0; bj < 2; ++bj)
#pragma unroll
                        for (int n = 0; n < 2; ++n) { const u32x2 w = ldgu2(h + 128 * bj + 16 * n);
                            xo[bj][n] = (f32x4){__uint_as_float(w.x << 16), __uint_as_float(w.x & 0xffff0000u), __uint_as_float(w.y << 16), __uint_as_float(w.y & 0xffff0000u)}; } }
#pragma unroll
                for (int bj = 0; bj < 2; ++bj)
#pragma unroll
                    for (int n = 0; n < 2; ++n) { const f32x4 x = xo[bj][n] + acc[ai][bj][m][n]; s += sq4(x); st_bf16x4(h + 128 * bj + 16 * n, x);
                        if (X) stg4((X + (size_t)row * 1024 + cb + 128 * bj + 16 * n), x); }
                s = add_x16(s); s = add_x32(s);
                if (fq == 0) unsafeAtomicAdd(ssn + row, s);
            }
    }
};

template <int CTRL> __device__ __forceinline__ float dpp_f(float old, float src) { return __int_as_float(__builtin_amdgcn_update_dpp(__float_as_int(old), __float_as_int(src), CTRL, 0xf, 0xf, false)); }
struct EpiUp {
    static constexpr bool PERM = false, AFTER_DRAIN = false;
    const float* ssx; bf16_t* ACT; bf16_t* UH; float* cvp; float* cvs; const float* wc; const float* bc; const float* stc;
    __device__ __forceinline__ void operator()(const f32x4 (&acc)[2][2][4][2], const Unit& u, int wr, int wc_, int fr, int fq) const {
        const int cb = 128 * u.pn + 32 * wc_ + 4 * fq;
        const bool samp = u.pm >= 256;
        LOAD_RS8(rs8, ssx, 1.f / 1024.f, 1.f)
#pragma unroll
        for (int ai = 0; ai < 2; ++ai)
#pragma unroll
            for (int m = 0; m < 4; ++m) { asm volatile("" ::: "memory");
                const int row = row_of(u, ai, wr, m, fr); const float rs = rs8[ai][m];
                const bool from_prev = samp ? (m & 1) : (m > 0);
                const bool seq0 = !samp && m == 0 && ((row - fr) & 2047) == 0;
                const bool defer = !samp && m == 0 && !seq0 && fr < 2;
                float* cv = nullptr;
                if (samp) { const int r = row - MP, sq = r & 31; if (sq >= 30) cv = cvs + ((size_t)(r >> 5) * 2 + (sq - 30)) * NUP + cb; }
                else { const int sq = row & 2047; if (sq >= 2046) cv = cvp + ((size_t)(row >> 11) * 2 + (sq - 2046)) * NUP + cb; }
                bf16_t* uh = nullptr;
                if (!samp) { if (m == 0 && fr < 2) uh = UH + ((size_t)(row >> 6) * 4 + fr) * NUP + cb; else if (m == 3 && fr >= 14) uh = UH + ((size_t)(row >> 6) * 4 + 2 + (fr - 14)) * NUP + cb; }
                const float* st0 = stc + (size_t)(samp ? (row - MP) >> 5 : 0) * 2 * NUP + cb;
#pragma unroll
                for (int n = 0; n < 2; ++n) {
                    f32x4 cc[2];
#pragma unroll
                    for (int bj = 0; bj < 2; ++bj) {
                        const int co = DFF * bj + 16 * n;
                        const f32x4 x = acc[ai][bj][m][n] * rs;
                        if (cv) stg4(cv + co, x);
                        if (uh) st_bf16x4(uh + co, x);
                        f32x4 c1, c2;
                        if (from_prev) { const f32x4 xp = acc[ai][bj][m > 0 ? m - 1 : 0][n] * rs8[ai][m > 0 ? m - 1 : 0];
#pragma unroll
                            for (int j = 0; j < 4; ++j) { c1[j] = dpp_f<0x121>(0.f, xp[j]); c2[j] = dpp_f<0x122>(0.f, xp[j]); } }
                        else if (samp) { c1 = ldg4(st0 + NUP + co); c2 = ldg4(st0 + (size_t)(fr & 1) * NUP + co); }
                        else { c1 = (f32x4){0.f, 0.f, 0.f, 0.f}; c2 = c1; }
                        const f32x4 w0 = ldg4(wc + cb + co), w1 = ldg4(wc + NUP + cb + co), w2 = ldg4(wc + 2 * NUP + cb + co), bb = ldg4(bc + cb + co);
#pragma unroll
                        for (int j = 0; j < 4; ++j) { const float p1 = dpp_f<0x111>(c1[j], x[j]), p2 = dpp_f<0x112>(c2[j], x[j]); cc[bj][j] = bb[j] + w0[j] * p2 + w1[j] * p1 + w2[j] * x[j]; }
                    }
                    if (!defer) { f32x4 r;
#pragma unroll
                        for (int j = 0; j < 4; ++j) r[j] = cc[0][j] * sigmoidf_(cc[0][j]) * cc[1][j];
                        st_bf16x4(ACT + (size_t)row * DFF + cb + 16 * n, r); }
                }
            }
    }
};
struct KVD { const bf16_t* k; const bf16_t* k2; const bf16_t* v; const float* kf; const float* vf; };
constexpr int ATT_KBUF = 64 * 400, ATT_VOFF = 2 * ATT_KBUF, ATT_VIMG = 32 * 320, ATT_VBUF = 2 * ATT_VIMG;

template <int DQK, bool F32M>
__device__ __forceinline__ void attn_pass(LAS unsigned char* lds, const int wid, const bf16_t* qrow, const KVD& dm, const KVD& dl, int nmain, int ntw, int ntc, f32x16 (&o)[4], float& linv) {
    constexpr int NCH = DQK / 8, KST = DQK * 2 + 16, NKI = NCH / 8, NS = DQK / 16;
    const int lane = LANE_ID(), tid = (wid << 6) | lane, r32 = lane & 31, hi = lane >> 5;
    bf16x8 q[NS];
#pragma unroll
    for (int s = 0; s < NS; ++s) q[s] = __builtin_bit_cast(bf16x8, ldgu4(qrow + 16 * s + 8 * hi));
    u32x4 kr[NKI], vr[2], kr2[F32M ? NKI : 1], vr2[F32M ? 2 : 1];
#define ATT_GLOADK(t) do { const bool lastt = (t) >= nmain; const KVD& d = lastt ? dl : dm; const int rb = lastt ? 0 : (t) * 64; const int rm = lastt ? 31 : 63; \
        _Pragma("unroll") for (int i = 0; i < NKI; ++i) { const int id = tid + 512 * i, kro = id / NCH, kc = id - kro * NCH; const int r = rb + (kro & rm); \
            if (F32M && !lastt) { const float* p_ = d.kf + (size_t)r * 1024 + kc * 8; kr[i] = ldgu4(p_); kr2[F32M ? i : 0] = ldgu4(p_ + 4); } \
            else kr[i] = (DQK == 64 || kc < 16) ? ldgu4(d.k + (size_t)r * 1024 + kc * 8) : ldgu4(d.k2 + (size_t)r * 64 + (kc - 16) * 8); } } while (0)
#define ATT_GLOADV(t) do { const bool lastt = (t) >= nmain; const KVD& d = lastt ? dl : dm; const int rb = lastt ? 0 : (t) * 64; const int rm = lastt ? 31 : 63; \
        _Pragma("unroll") for (int i = 0; i < 2; ++i) { const int r = rb + (((tid >> 4) + 32 * i) & rm); \
            if (F32M && !lastt) { const float* p_ = d.vf + (size_t)r * 1024 + (tid & 15) * 8; vr[i] = ldgu4(p_); vr2[F32M ? i : 0] = ldgu4(p_ + 4); } \
            else vr[i] = ldgu4(d.v + (size_t)r * 1024 + (tid & 15) * 8); } } while (0)
#define ATT_PK8(a_, b_) (u32x4){cvt_pk_bf16(__uint_as_float((a_).x), __uint_as_float((a_).y)), cvt_pk_bf16(__uint_as_float((a_).z), __uint_as_float((a_).w)), cvt_pk_bf16(__uint_as_float((b_).x), __uint_as_float((b_).y)), cvt_pk_bf16(__uint_as_float((b_).z), __uint_as_float((b_).w))}
#define ATT_LSTORE(b, tt) do { const bool cvt_ = F32M && (tt) < nmain; \
        _Pragma("unroll") for (int i = 0; i < NKI; ++i) { const int id = tid + 512 * i, kro = id / NCH, kc = id - kro * NCH; *(LAS u32x4*)(lds + (b) * ATT_KBUF + kro * KST + kc * 16) = cvt_ ? ATT_PK8(kr[i], kr2[F32M ? i : 0]) : kr[i]; } \
        _Pragma("unroll") for (int i = 0; i < 2; ++i) *(LAS u32x4*)(lds + ATT_VOFF + (b) * ATT_VBUF + i * ATT_VIMG + (tid >> 4) * 320 + (tid & 15) * 16) = cvt_ ? ATT_PK8(vr[i], vr2[F32M ? i : 0]) : vr[i]; } while (0)
    ATT_GLOADK(0); ATT_GLOADV(0); ATT_LSTORE(0, 0); __syncthreads();
    float m_run = 0.f, l_run = 0.f;
#pragma unroll
    for (int c = 0; c < 4; ++c)
#pragma unroll
        for (int r = 0; r < 16; ++r) o[c][r] = 0.f;
    const int vlane = (4 * hi + ((lane & 15) >> 2)) * 320 + (2 * ((lane >> 4) & 1) + ((lane & 3) >> 1)) * 16 + 8 * (lane & 1);
    for (int t = 0; t < ntw; ++t) {
        if (t + 1 < ntw) ATT_GLOADK(t + 1);
        bool vloaded = false;
        if (t < ntc) {
            const LAS unsigned char* kb = lds + (t & 1) * ATT_KBUF + r32 * KST + hi * 16;
            const LAS unsigned char* vb = lds + ATT_VOFF + (t & 1) * ATT_VBUF;
            f32x16 p0, p1;
#pragma unroll
            for (int r = 0; r < 16; ++r) { p0[r] = 0.f; p1[r] = 0.f; }
            constexpr int KCH = 2, NG = NS / KCH, NB = (DQK == 64) ? 2 : 1;
            bf16x8 kf[NB][2 * KCH];
#define ATT_LDK(ch, b) do { _Pragma("unroll") for (int j_ = 0; j_ < KCH; ++j_) { kf[b][2 * j_] = *(const LAS bf16x8*)(kb + (KCH * (ch) + j_) * 32); kf[b][2 * j_ + 1] = *(const LAS bf16x8*)(kb + 32 * KST + (KCH * (ch) + j_) * 32); } } while (0)
            ATT_LDK(0, 0); __builtin_amdgcn_sched_barrier(0);
#pragma unroll
            for (int ch = 0; ch < NG; ++ch) {
                if (NB == 2 && ch + 1 < NG) ATT_LDK(ch + 1, NB == 2 ? ((ch + 1) & 1) : 0);
                __builtin_amdgcn_sched_barrier(0);
#pragma unroll
                for (int j = 0; j < KCH; ++j) {
                    p0 = __builtin_amdgcn_mfma_f32_32x32x16_bf16(kf[NB == 2 ? (ch & 1) : 0][2 * j], q[KCH * ch + j], p0, 0, 0, 0);
                    p1 = __builtin_amdgcn_mfma_f32_32x32x16_bf16(kf[NB == 2 ? (ch & 1) : 0][2 * j + 1], q[KCH * ch + j], p1, 0, 0, 0);
                }
                __builtin_amdgcn_sched_barrier(0);
                if (NB == 1 && ch + 1 < NG) { ATT_LDK(ch + 1, 0); __builtin_amdgcn_sched_barrier(0); }
            }
#undef ATT_LDK
            bf16x8 vf[2][4];
#define ATT_LDV(cmb, b) do { _Pragma("unroll") for (int c_ = 0; c_ < 4; ++c_) { const LAS unsigned char* a0_ = vb + vlane + ((cmb) >> 1) * ATT_VIMG + (16 * ((cmb) & 1)) * 320 + c_ * 64; \
                const v4i16_t t0_ = __builtin_amdgcn_ds_read_tr16_b64_v4i16((LAS v4i16_t*)a0_), t1_ = __builtin_amdgcn_ds_read_tr16_b64_v4i16((LAS v4i16_t*)(a0_ + 8 * 320)); \
                vf[b][c_] = (bf16x8){t0_[0], t0_[1], t0_[2], t0_[3], t1_[0], t1_[1], t1_[2], t1_[3]}; } } while (0)
#pragma unroll
            for (int r = 0; r < 16; ++r) { p0[r] -= m_run; p1[r] -= m_run; }
            if (t >= nmain) { asm volatile("" ::: "memory");
#pragma unroll
                for (int r = 0; r < 16; ++r) p1[r] = -INFINITY;
            }
            float mt = __builtin_fmaxf(__builtin_fmaxf(p0[0], p1[0]), p0[1]);
#pragma unroll
            for (int r = 1; r < 15; r += 2) { mt = __builtin_fmaxf(__builtin_fmaxf(mt, p1[r]), p0[r + 1]); mt = __builtin_fmaxf(__builtin_fmaxf(mt, p1[r + 1]), p0[r + 2 < 16 ? r + 2 : 15]); }
            mt = __builtin_fmaxf(mt, p1[15]);
            mt = max_x32(mt);
            const float dref = (t == 0 || mt > 8.f) ? mt : 0.f;
            if (__builtin_amdgcn_ballot_w64(dref != 0.f) != 0ull) {
                m_run += dref;
#pragma unroll
                for (int r = 0; r < 16; ++r) { p0[r] -= dref; p1[r] -= dref; }
                if (t > 0) { const float f = fast_exp2(-dref); l_run *= f;
#pragma unroll
                    for (int c = 0; c < 4; ++c)
#pragma unroll
                        for (int r = 0; r < 16; ++r) o[c][r] *= f; }
            }
            float rs = 0.f;
#pragma unroll
            for (int r = 0; r < 16; ++r) { p0[r] = fast_exp2(p0[r]); p1[r] = fast_exp2(p1[r]); rs += p0[r] + p1[r]; }
            l_run += rs;
            asm volatile("" ::: "memory");
            if (t + 1 < ntw) { ATT_GLOADV(t + 1); vloaded = true; }
            bf16x8 pf[2][2];
#pragma unroll
            for (int ks = 0; ks < 2; ++ks) {
                u32x4 a, b;
                a.x = cvt_pk_bf16(p0[8 * ks + 0], p0[8 * ks + 1]); a.y = cvt_pk_bf16(p0[8 * ks + 2], p0[8 * ks + 3]); a.z = cvt_pk_bf16(p0[8 * ks + 4], p0[8 * ks + 5]); a.w = cvt_pk_bf16(p0[8 * ks + 6], p0[8 * ks + 7]);
                b.x = cvt_pk_bf16(p1[8 * ks + 0], p1[8 * ks + 1]); b.y = cvt_pk_bf16(p1[8 * ks + 2], p1[8 * ks + 3]); b.z = cvt_pk_bf16(p1[8 * ks + 4], p1[8 * ks + 5]); b.w = cvt_pk_bf16(p1[8 * ks + 6], p1[8 * ks + 7]);
                pf[0][ks] = __builtin_bit_cast(bf16x8, a); pf[1][ks] = __builtin_bit_cast(bf16x8, b);
            }
            __builtin_amdgcn_sched_barrier(0);
            ATT_LDV(0, 0); __builtin_amdgcn_sched_barrier(0);
#pragma unroll
            for (int cmb = 0; cmb < 4; ++cmb) {
                if (cmb + 1 < 4) ATT_LDV(cmb + 1, (cmb + 1) & 1);
                __builtin_amdgcn_sched_barrier(0);
#pragma unroll
                for (int c = 0; c < 4; ++c) o[c] = __builtin_amdgcn_mfma_f32_32x32x16_bf16(vf[cmb & 1][c], pf[cmb >> 1][cmb & 1], o[c], 0, 0, 0);
                __builtin_amdgcn_sched_barrier(0);
            }
#undef ATT_LDV
        }
        if (t + 1 < ntw) { if (!vloaded) ATT_GLOADV(t + 1); ATT_LSTORE((t + 1) & 1, t + 1); }
        __syncthreads();
    }
    const float lt = add_x32(l_run);
    linv = fast_rcp(lt);
#undef ATT_GLOADK
#undef ATT_PK8
#undef ATT_GLOADV
#undef ATT_LSTORE
}

struct AttnCtx { unsigned char* ws; const float* cdk; const float* cdv; const float* gda; float lam, lam1m; unsigned* counter; int l; };
constexpr int ATT_NUNITS = 128 + 2048;
__device__ __forceinline__ void attn_phase(LAS unsigned char* lds, const AttnCtx& C, const int wid) {
#define TID_NOW() LANE_ID()
    LAS unsigned* ubox = (LAS unsigned*)(lds + 131072);
    if (wid < 4) __builtin_amdgcn_s_setprio(3); else __builtin_amdgcn_s_setprio(0);
    const bf16_t* QDA = (const bf16_t*)(C.ws + W_QDA); const bf16_t* KDA = (const bf16_t*)(C.ws + W_KDA); const bf16_t* VDA = (const bf16_t*)(C.ws + W_VDA);
    const bf16_t* GG = (const bf16_t*)(C.ws + W_G); bf16_t* MRG = (bf16_t*)(C.ws + W_MRG);
    for (;;) {
        if (wid == 0 && TID_NOW() == 0) ubox[0] = atomicAdd(C.counter, 1u);
        __syncthreads();
        const int un = (int)ubox[0];
        __syncthreads();
        if (un >= ATT_NUNITS) break;
        const bool samp = un < 128;
        int b, h, qb = 0;
        if (samp) { b = un >> 3; h = un & 7; } else { const int v = un - 128; qb = 7 - (v >> 8); b = (v & 255) >> 3; h = v & 7; }
        const int row = samp ? MP + b * 32 + (TID_NOW() & 31) : b * 2048 + qb * 256 + wid * 32 + (TID_NOW() & 31);
        const int ntw = samp ? 33 : 4 * qb + 4, nmain = samp ? 32 : ntw, ntc = samp ? (wid == 0 ? 33 : 0) : 4 * qb + (wid >> 1) + 1;
        const size_t kr0 = (size_t)b * 2048;
        const size_t fr0 = (size_t)MP + b * 32;
        const size_t coff = (size_t)C.l * MC;
        f32x16 o[4]; float linv;
#ifndef NO_DIFF
        {
            unsigned o1[32];
#pragma unroll 1
            for (int st = 0; st < 2; ++st) {
                KVD dm, dl;
                const bf16_t* Kb = KDA; const bf16_t* Vb = VDA;
                dm.k = Kb + kr0 * 1024 + h * 128 + st * 64; dm.k2 = dm.k; dm.v = Vb + kr0 * 1024 + h * 128;
                dl.k = KDA + fr0 * 1024 + h * 128 + st * 64; dl.k2 = dl.k; dl.v = VDA + fr0 * 1024 + h * 128;
                dm.kf = C.cdk + (coff + kr0) * 1024 + h * 128 + st * 64; dm.vf = C.cdv + (coff + kr0) * 1024 + h * 128; dl.kf = nullptr; dl.vf = nullptr;
                if (samp) attn_pass<64, true>(lds, wid, QDA + (size_t)row * 1024 + h * 128 + st * 64, dm, dl, nmain, ntw, ntc, o, linv);
                else attn_pass<64, false>(lds, wid, QDA + (size_t)row * 1024 + h * 128 + st * 64, dm, dl, nmain, ntw, ntc, o, linv);
                if (st == 0) {
#pragma unroll
                    for (int c = 0; c < 4; ++c)
#pragma unroll
                        for (int r = 0; r < 16; r += 2) o1[c * 8 + (r >> 1)] = cvt_pk_bf16(o[c][r] * linv, o[c][r + 1] * linv);
                }
            }
            if (ntc > 0) {
                int rowe = row; asm volatile("" : "+v"(rowe));
                const int hi = (TID_NOW() >> 5) & 1;
                const float ll = C.lam * linv; float ss = 0.f;
#pragma unroll
                for (int c = 0; c < 4; ++c)
#pragma unroll
                    for (int r = 0; r < 16; r += 2) { const unsigned w = o1[c * 8 + (r >> 1)];
                        const float x0 = __uint_as_float(w << 16) - ll * o[c][r], x1 = __uint_as_float(w & 0xffff0000u) - ll * o[c][r + 1]; o[c][r] = x0; o[c][r + 1] = x1; ss += x0 * x0 + x1 * x1; }
                ss = add_x32(ss);
                const float rn = rsqrtf(ss * (1.f / 128.f) + EPS) * C.lam1m;
                const bf16_t* ga = GG + (size_t)rowe * 2048 + h * 128; bf16_t* mo = MRG + (size_t)rowe * 1024 + h * 128;
#pragma unroll
                for (int c = 0; c < 4; ++c)
#pragma unroll
                    for (int g = 0; g < 4; ++g) {
                        const int d0 = 32 * c + 8 * g + 4 * hi;
                        const u32x2 gw = ldgu2(ga + d0); const f32x4 gd = ldg4(C.gda + d0);
                        const float g0 = __uint_as_float(gw.x << 16), g1 = __uint_as_float(gw.x & 0xffff0000u), g2 = __uint_as_float(gw.y << 16), g3 = __uint_as_float(gw.y & 0xffff0000u);
                        f32x4 r; r[0] = o[c][4 * g + 0] * rn * gd[0] * g0; r[1] = o[c][4 * g + 1] * rn * gd[1] * g1; r[2] = o[c][4 * g + 2] * rn * gd[2] * g2; r[3] = o[c][4 * g + 3] * rn * gd[3] * g3;
                        st_bf16x4(mo + d0, r);
                    }
            }
        }
#endif
#ifndef NO_MLA
        {
            KVD dm, dl;
            const bf16_t* KN = (const bf16_t*)(C.ws + W_KN); const bf16_t* VM = (const bf16_t*)(C.ws + W_VM); const bf16_t* KR = (const bf16_t*)(C.ws + W_KR);
            dm.k = (samp ? (const bf16_t*)(C.ws + W_KNC) + coff * 1024 : KN) + kr0 * 1024 + h * 128; dm.k2 = (samp ? (const bf16_t*)(C.ws + W_KRC) + coff * 64 : KR) + kr0 * 64;
            dm.v = (samp ? (const bf16_t*)(C.ws + W_VMC) + coff * 1024 : VM) + kr0 * 1024 + h * 128;
            dl.k = KN + fr0 * 1024 + h * 128; dl.k2 = KR + fr0 * 64; dl.v = VM + fr0 * 1024 + h * 128;
            dm.kf = nullptr; dm.vf = nullptr; dl.kf = nullptr; dl.vf = nullptr;
            attn_pass<192, false>(lds, wid, (const bf16_t*)(C.ws + W_QM) + (size_t)row * 1536 + h * 192, dm, dl, nmain, ntw, ntc, o, linv);
            if (ntc > 0) {
                int rowe = row; asm volatile("" : "+v"(rowe));
                const int hi = (TID_NOW() >> 5) & 1;
                const bf16_t* gb = GG + (size_t)rowe * 2048 + 1024 + h * 128; bf16_t* mo = MRG + (size_t)rowe * 1024 + h * 128;
#pragma unroll
                for (int c = 0; c < 4; ++c)
#pragma unroll
                    for (int g = 0; g < 4; ++g) {
                        const int d0 = 32 * c + 8 * g + 4 * hi;
                        const u32x2 gw = ldgu2(gb + d0); const u32x2 xw = ldgu2(mo + d0);
                        const float g0 = __uint_as_float(gw.x << 16), g1 = __uint_as_float(gw.x & 0xffff0000u), g2 = __uint_as_float(gw.y << 16), g3 = __uint_as_float(gw.y & 0xffff0000u);
                        f32x4 r;
                        r[0] = __uint_as_float(xw.x << 16) + g0 * o[c][4 * g + 0] * linv; r[1] = __uint_as_float(xw.x & 0xffff0000u) + g1 * o[c][4 * g + 1] * linv;
                        r[2] = __uint_as_float(xw.y << 16) + g2 * o[c][4 * g + 2] * linv; r[3] = __uint_as_float(xw.y & 0xffff0000u) + g3 * o[c][4 * g + 3] * linv;
                        st_bf16x4(mo + d0, r);
                    }
            }
        }
#endif
    }
    __builtin_amdgcn_s_setprio(0);
}
__device__ __forceinline__ float wave_sum(float v) {
#pragma unroll
    for (int o = 1; o < 64; o <<= 1) v += __shfl_xor(v, o);
    return v;
}
__device__ __forceinline__ unsigned f2bf(float f) { unsigned u = __float_as_uint(f); return (u + 0x7fffu + ((u >> 16) & 1u)) >> 16; }
__device__ __forceinline__ unsigned pk2(float lo, float hi) { return f2bf(lo) | (f2bf(hi) << 16); }
__device__ __forceinline__ int ropemap(int v) { return 64 * ((v >> 5) & 3) + 32 * (v >> 7) + (v & 31); }

__device__ __forceinline__ void prep_weights(const Params& P, LAS unsigned char* lds, int gw, int ngw, int wave, int lane) {
    LAS float* scr = (LAS float*)(lds + wave * 8704);
    constexpr int IT0 = 16 * (NIN / 32), IT1 = 6 * (NQ / 32), IT2 = 4 * (NKV / 32), IT4 = 16 * 32, IT5 = 16 * (NUP / 32), IT6 = 44 * 32;
    constexpr int ITL = IT0 + IT1 + 2 * IT2 + IT4 + IT5 + IT6;
    for (int it = gw; it < 2 * ITL; it += ngw) {
        const int l = it / ITL; int r = it - l * ITL;
        int mat;
        if (r < IT0) mat = 0; else if ((r -= IT0) < IT1) mat = 1; else if ((r -= IT1) < IT2) mat = 2; else if ((r -= IT2) < IT2) mat = 3;
        else if ((r -= IT2) < IT4) mat = 4; else if ((r -= IT4) < IT5) mat = 5; else { r -= IT5; mat = 6; }
        const float* W; const float* gk = nullptr; bf16_t* WT; int K, NN; long stride;
        switch (mat) {
            case 0: W = P.in[8] + (size_t)l * 1024 * INC; gk = P.in[7] + l * 1024; WT = (bf16_t*)(P.ws + W_WIN) + (size_t)l * NIN * 1024; K = 1024; NN = NIN; stride = INC; break;
            case 1: W = P.in[16] + (size_t)l * QL * NQ; gk = P.in[15] + l * QL; WT = (bf16_t*)(P.ws + W_WQ) + (size_t)l * NQ * QL; K = QL; NN = NQ; stride = NQ; break;
            case 2: W = nullptr; gk = P.in[17] + l * KVL; WT = (bf16_t*)(P.ws + W_WKV) + (size_t)l * NKV * KVL; K = KVL; NN = NKV; stride = 128; break;
            case 3: W = nullptr; WT = (bf16_t*)(P.ws + W_WKVC) + (size_t)l * NKV * KVL; K = KVL; NN = NKV; stride = 128; break;
            case 4: W = P.in[20] + (size_t)l * 1024 * 1024; WT = (bf16_t*)(P.ws + W_WO) + (size_t)l * 1024 * 1024; K = 1024; NN = 1024; stride = 1024; break;
            case 5: W = P.in[22] + (size_t)l * 1024 * NUP; gk = P.in[21] + l * 1024; WT = (bf16_t*)(P.ws + W_WUP) + (size_t)l * NUP * 1024; K = 1024; NN = NUP; stride = NUP; break;
            default: W = P.in[25] + (size_t)l * DFF * 1024; WT = (bf16_t*)(P.ws + W_WDN) + (size_t)l * 1024 * DFF; K = DFF; NN = 1024; stride = 1024; break;
        }
        const int nblk = NN / 32, kb = r / nblk, nb = r - kb * nblk, k0 = 64 * kb, n0 = 32 * nb;
        const int np = n0 + (lane & 31); long off = -1;
        {
            const int tile = np >> 8, v = np & 255;
            switch (mat) {
                case 0:
                    if (tile < 4) off = 256 * tile + ropemap(v);
                    else if (tile < 8) off = 1024 + 256 * (tile - 4) + ropemap(v);
                    else if (tile < 12) off = 2048 + 256 * (tile - 8) + v;
                    else if (tile < 20) off = 3776 + 256 * (tile - 12) + v;
                    else if (tile == 20) off = 3456 + v;
                    else if (tile == 21) off = 3072 + v;
                    else { if (v < 128) off = 3072 + 256 + v; else { const int w = v - 128, wc = w >> 5; if (wc < 2) off = 3712 + 32 * ((w >> 4) & 1) + 16 * wc + (w & 15); } }
                    break;
                case 1:
                    if (tile < 4) off = (np >> 7) * 192 + (np & 127);
                    else { const int hh = 4 * (tile - 4) + ((v >> 5) & 3); off = hh * 192 + 128 + 32 * (v >> 7) + (v & 31); }
                    break;
                case 2: case 3: {
                    const int c = np & 1023, hh = c >> 7, n = c & 127;
                    W = (np < 1024 ? P.in[18] : P.in[19]) + (size_t)l * 8 * 256 * 128; off = (long)hh * 32768 + n; } break;
                case 5: off = (v < 128) ? 128 * tile + v : DFF + 128 * tile + (v - 128); break;
                default: off = np; break;
            }
        }
#pragma unroll 8
        for (int i = 0; i < 32; ++i) { const int kk = 2 * i + (lane >> 5); float v = 0.f;
            if (off >= 0) { v = W[(size_t)(k0 + kk) * stride + off]; if (gk) v *= gk[k0 + kk]; }
            scr[kk * 33 + (lane & 31)] = v; }
        asm volatile("s_waitcnt lgkmcnt(0)" ::: "memory");
        const int c = lane & 7;
#pragma unroll
        for (int j = 0; j < 4; ++j) { const int n = (lane >> 3) + 8 * j; const LAS float* s = scr + (8 * c) * 33 + n;
            u32x4 o; o.x = pk2(s[0 * 33], s[1 * 33]); o.y = pk2(s[2 * 33], s[3 * 33]); o.z = pk2(s[4 * 33], s[5 * 33]); o.w = pk2(s[6 * 33], s[7 * 33]);
            *(u32x4*)(WT + (size_t)(n0 + n) * K + k0 + 8 * c) = o; }
        asm volatile("s_waitcnt lgkmcnt(0)" ::: "memory");
    }
}

__device__ __forceinline__ void sincos_f(float a, float& s, float& c) {
    const float n = rintf(a * 0.6366197723675814f);
    float r = fmaf(-n, 1.5703125f, a); r = fmaf(-n, 4.837512969970703125e-4f, r); r = fmaf(-n, 7.54978995489188e-8f, r);
    const float r2 = r * r;
    const float sp = r + r * r2 * (-1.6666666667e-1f + r2 * (8.3333333333e-3f + r2 * (-1.9841269841e-4f + r2 * 2.7557319224e-6f)));
    const float cp = 1.f + r2 * (-0.5f + r2 * (4.1666666667e-2f + r2 * (-1.3888888889e-3f + r2 * (2.4801587302e-5f + r2 * -2.7557319224e-7f))));
    const int qd = ((int)n) & 3;
    s = (qd == 0) ? sp : (qd == 1) ? cp : (qd == 2) ? -sp : -cp;
    c = (qd == 0) ? cp : (qd == 1) ? -sp : (qd == 2) ? -cp : sp;
}

__device__ __forceinline__ void cvt_stream(const float* src, bf16_t* dst, size_t n8, size_t gt, size_t ngt) {
    for (size_t i = gt; i < n8; i += ngt) { const f32x4 a = *(const f32x4*)(src + i * 8), b = *(const f32x4*)(src + i * 8 + 4);
        u32x4 o; o.x = cvt_pk_bf16(a[0], a[1]); o.y = cvt_pk_bf16(a[2], a[3]); o.z = cvt_pk_bf16(b[0], b[1]); o.w = cvt_pk_bf16(b[2], b[3]); *(u32x4*)(dst + i * 8) = o; }
}

__device__ __forceinline__ void conv_fix_phase(const Params& P, int l, size_t gt, size_t ngt) {
    const bf16_t* UH = (const bf16_t*)(P.ws + W_U); bf16_t* ACT = (bf16_t*)(P.ws + W_ACT);
    const float* wc = P.in[23] + (size_t)l * 3 * NUP; const float* bc = P.in[24] + (size_t)l * NUP;
    constexpr int NCC = DFF / 8;
    for (size_t it = gt; it < (size_t)1024 * NCC; it += ngt) {
        const int sl = (int)(it / NCC), cc = (int)(it - (size_t)sl * NCC), j0 = cc * 8;
        if ((sl & 31) == 0) continue;
        float uu[4][2][8];
#pragma unroll
        for (int k = 0; k < 4; ++k)
#pragma unroll
            for (int gv = 0; gv < 2; ++gv) { const u32x4 a = ldgu4(UH + ((size_t)(k < 2 ? sl - 1 : sl) * 4 + (k < 2 ? 2 + k : k - 2)) * NUP + gv * DFF + j0);
#pragma unroll
                for (int e = 0; e < 4; ++e) { uu[k][gv][2 * e] = __uint_as_float(a[e] << 16); uu[k][gv][2 * e + 1] = __uint_as_float(a[e] & 0xffff0000u); } }
#pragma unroll
        for (int rr = 0; rr < 2; ++rr) {
            float res[8];
#pragma unroll
            for (int hf = 0; hf < 2; ++hf) {
                f32x4 w[2][4];
#pragma unroll
                for (int gv = 0; gv < 2; ++gv)
#pragma unroll
                    for (int k = 0; k < 4; ++k) w[gv][k] = ldg4((k < 3 ? wc + (size_t)k * NUP : bc) + gv * DFF + j0 + 4 * hf);
#pragma unroll
                for (int e = 0; e < 4; ++e) { const int q = 4 * hf + e;
                    const float cg = w[0][3][e] + w[0][0][e] * uu[rr][0][q] + w[0][1][e] * uu[rr + 1][0][q] + w[0][2][e] * uu[rr + 2][0][q];
                    const float cv = w[1][3][e] + w[1][0][e] * uu[rr][1][q] + w[1][1][e] * uu[rr + 1][1][q] + w[1][2][e] * uu[rr + 2][1][q];
                    res[q] = cg * sigmoidf_(cg) * cv; }
            }
            u32x4 o; o.x = cvt_pk_bf16(res[0], res[1]); o.y = cvt_pk_bf16(res[2], res[3]); o.z = cvt_pk_bf16(res[4], res[5]); o.w = cvt_pk_bf16(res[6], res[7]);
            *(GAS u32x4*)(ACT + ((size_t)(64 * sl + rr) * DFF + j0)) = o;
        }
    }
}
constexpr int LDS_BYTES = 147456;
template <class Epi> __device__ __forceinline__ void run_gemm(LAS unsigned char* lds, const int wid, const bf16_t* A, const bf16_t* Bt, int M, int N, int K, const Epi& E) {
    int gx = (int)gridDim.x, bx = (int)blockIdx.x, wv = wid; asm volatile("" : "+s"(gx), "+s"(bx), "+s"(wv));
    pg8::Gemm g{A, Bt, M, N, K}; pg8::StaticOrder S; S.init(M, N, gx, bx);
#ifndef NO_GEMM
    pg8::gemm_phase<Epi, pg8::StaticOrder, PG8_ALIGN, PG8_SP2>(lds, g, S, E, wv);
#endif
}

__global__ void __launch_bounds__(512, 2) fwd_megakernel(Params P) {
    extern __shared__ __attribute__((aligned(16))) unsigned char lds_raw[];
    LAS unsigned char* lds = (LAS unsigned char*)lds_raw;
    cg::grid_group grid = cg::this_grid();
    const int wave_s = __builtin_amdgcn_readfirstlane((int)threadIdx.x >> 6);
#define TID_DEFS const int lane = LANE_ID(), wave = wave_s, tid = (wave << 6) | lane; \
    const int G = gridDim.x, gw = blockIdx.x * 8 + wave, ngw = G * 8; const size_t gt = (size_t)blockIdx.x * 512 + tid, ngt = (size_t)G * 512; (void)lane; (void)gw; (void)ngw; (void)gt; (void)ngt;
    unsigned char* ws = P.ws; float* out = P.out;
#define gbar() do { asm volatile("s_waitcnt vmcnt(0) lgkmcnt(0)" ::: "memory"); __syncthreads(); bar_gen += gridDim.x; \
        if (wave_s == 0 && LANE_ID() == 0) { asm volatile("buffer_wbl2 sc1\n\ts_waitcnt vmcnt(0) lgkmcnt(0)" ::: "memory");     \
            __hip_atomic_fetch_add(ctl + 128, 1u, __ATOMIC_RELAXED, __HIP_MEMORY_SCOPE_AGENT); \
            while (__hip_atomic_load(ctl + 128, __ATOMIC_RELAXED, __HIP_MEMORY_SCOPE_AGENT) < bar_gen) __builtin_amdgcn_s_sleep(1); } \
        __syncthreads(); asm volatile("buffer_inv sc1\n\ts_waitcnt vmcnt(0) lgkmcnt(0)" ::: "memory");     } while (0)
#ifdef PROBE_SEL
    unsigned long long pr_acc = 0, pr_t0 = 0;
#define PR_BEGIN(c) do { if ((PROBE_SEL >> (c)) & 1) pr_t0 = __builtin_amdgcn_s_memrealtime(); } while (0)
#define PR_END(c) do { if ((PROBE_SEL >> (c)) & 1) pr_acc += __builtin_amdgcn_s_memrealtime() - pr_t0; } while (0)
#else
#define PR_BEGIN(c)
#define PR_END(c)
#endif
#define OPAQ() do { unsigned a_ = (unsigned)(uintptr_t)P.ws, b_ = (unsigned)((uintptr_t)P.ws >> 32), c_ = (unsigned)(uintptr_t)P.out, d_ = (unsigned)((uintptr_t)P.out >> 32); \
        asm volatile("" : "+s"(a_), "+s"(b_), "+s"(c_), "+s"(d_)); ws = (unsigned char*)(((uintptr_t)b_ << 32) | a_); out = (float*)(((uintptr_t)d_ << 32) | c_); } while (0)
    unsigned* ctl = (unsigned*)(ws + W_CTL); float* ctlf = (float*)(ws + W_CTL);
    float* rope = (float*)(ws + W_ROPE); float* SS = (float*)(ws + W_SS);
#define B_HX ((bf16_t*)(ws + W_HX))
#define B_X ((float*)(ws + W_X))
#define B_QDA ((bf16_t*)(ws + W_QDA))
#define B_KDA ((bf16_t*)(ws + W_KDA))
#define B_VDA ((bf16_t*)(ws + W_VDA))
#define B_GG ((bf16_t*)(ws + W_G))
#define B_CKV ((bf16_t*)(ws + W_CKV))
#define B_CQ ((bf16_t*)(ws + W_CQ))
#define B_KR ((bf16_t*)(ws + W_KR))
#define B_QM ((bf16_t*)(ws + W_QM))
#define B_KN ((bf16_t*)(ws + W_KN))
#define B_VM ((bf16_t*)(ws + W_VM))
#define B_MRG ((bf16_t*)(ws + W_MRG))
#define B_U ((bf16_t*)(ws + W_U))
#define B_ACT ((bf16_t*)(ws + W_ACT))
#define B_KC ((bf16_t*)(ws + W_KC))
#define B_VC ((bf16_t*)(ws + W_VC))
#define B_KRC ((bf16_t*)(ws + W_KRC))
#define B_CKVC ((bf16_t*)(ws + W_CKVC))
#define B_KNC ((bf16_t*)(ws + W_KNC))
#define B_VMC ((bf16_t*)(ws + W_VMC))
    PR_BEGIN(0);
    {
    TID_DEFS
#ifndef NO_PREP
    prep_weights(P, lds, gw, ngw, wave, lane);
#endif
    for (size_t idx = gt; idx < (size_t)2080 * 32; idx += ngt) {
        const int pos = (int)(idx >> 5), i = (int)(idx & 31);
        double inv = 1.0; for (int k = 0; k < i; ++k) inv *= 0.74989420933245582730;
        const double ang = (double)pos * inv; const double n = __builtin_rint(ang * 0.63661977236758134308);
        double r = __builtin_fma(-n, 1.57079632679489655800, ang); r = __builtin_fma(-n, 6.12323399573676603587e-17, r);
        const float rf = (float)r, r2 = rf * rf;
        const float sp = rf + rf * r2 * (-1.6666666667e-1f + r2 * (8.3333333333e-3f + r2 * (-1.9841269841e-4f + r2 * 2.7557319224e-6f)));
        const float cp = 1.f + r2 * (-0.5f + r2 * (4.1666666667e-2f + r2 * (-1.3888888889e-3f + r2 * (2.4801587302e-5f + r2 * -2.7557319224e-7f))));
        const int qd = ((int)n) & 3;
        rope[(size_t)pos * 64 + 32 + i] = (qd == 0) ? sp : (qd == 1) ? cp : (qd == 2) ? -sp : -cp;
        rope[(size_t)pos * 64 + i] = (qd == 0) ? cp : (qd == 1) ? -sp : (qd == 2) ? -cp : sp;
    }
    for (size_t idx = gt; idx < (size_t)8 * MT; idx += ngt) SS[MT + idx] = 0.f;
    if (blockIdx.x == 0 && tid < 64) {
        if (tid < 5) __hip_atomic_store(ctl + (tid == 4 ? 128 : tid * 16), 0u, __ATOMIC_RELAXED, __HIP_MEMORY_SCOPE_AGENT);
        for (int l = 0; l < 2; ++l) {
        OPAQ();
            const float a = wave_sum(P.in[10][l * 64 + lane] * P.in[11][l * 64 + lane]), b = wave_sum(P.in[12][l * 64 + lane] * P.in[13][l * 64 + lane]);
            const float li = 0.8f - 0.6f * expf(-0.3f * (float)l);
            if (lane == 0) { ctlf[64 + 2 * l] = expf(a) - expf(b) + li; ctlf[65 + 2 * l] = 1.f - li; }
        }
    }
    for (int row = gw; row < MT; row += ngw) {
        const float* xr = (row >= MP ? P.in[1] + (size_t)(row - MP) * 1024 : P.in[0] + (size_t)row * 1024); float s = 0.f;
#pragma unroll
        for (int j = 0; j < 4; ++j) { const f32x4 v = *(const f32x4*)(xr + 256 * j + 4 * lane); s += sq4(v); st_bf16x4(B_HX + (size_t)row * 1024 + 256 * j + 4 * lane, v); }
        s = wave_sum(s); if (lane == 0) SS[row] = s;
    }
    cvt_stream(P.in[4], B_CKVC, (size_t)2 * MC * 256 / 8, gt, ngt);
    cvt_stream(P.in[5], B_KRC, (size_t)2 * MC * 64 / 8, gt, ngt);
    }
    __threadfence(); asm volatile("buffer_wbl2 sc1\n\ts_waitcnt vmcnt(0) lgkmcnt(0)" ::: "memory");
    grid.sync();
    __threadfence(); asm volatile("buffer_inv sc1\n\ts_waitcnt vmcnt(0) lgkmcnt(0)" ::: "memory");
    unsigned bar_gen = 0;
    PR_END(0);

#pragma unroll 1
    for (int l = 0; l < 2; ++l) {
        OPAQ();
        float* ssx_attn = SS + (size_t)(2 * l) * MT; float* ssx_ffn = SS + (size_t)(2 * l + 1) * MT; float* ssx_next = SS + (size_t)(2 * l + 2) * MT;
        float* sscq = SS + (size_t)(5 + l) * MT; float* ssckv = SS + (size_t)(7 + l) * MT;
        float* ckp = out + O_CKVP + (size_t)l * MP * 256; float* cks = out + O_CKVS + (size_t)l * MSMP * 256;
        PR_BEGIN(1);
        {
            EpiInProj E; E.ws = ws; E.out = out; E.bgate = P.in[9] + (size_t)l * 2048; E.l = l;
            run_gemm(lds, wave_s, B_HX, (const bf16_t*)(ws + W_WIN) + (size_t)l * NIN * 1024, MT, NIN, 1024, E);
        }
        gbar(); OPAQ();
        PR_END(1);
        PR_BEGIN(2);
        {
            EpiQ E; E.sscq = sscq; E.rope = rope; E.QM = B_QM;
            run_gemm(lds, wave_s, B_CQ, (const bf16_t*)(ws + W_WQ) + (size_t)l * NQ * QL, MT, NQ, QL, E);
        }
        {
            EpiKV<true> E; E.ss = ssckv; E.O0 = B_KN; E.O1 = B_VM;
            run_gemm(lds, wave_s, B_CKV, (const bf16_t*)(ws + W_WKV) + (size_t)l * NKV * KVL, MT, NKV, KVL, E);
        }
        if (l == 0) {
#pragma unroll 1
            for (int l2 = 0; l2 < 2; ++l2) {
                EpiKV<false> E; E.ss = nullptr; E.O0 = B_KNC + (size_t)l2 * MC * 1024; E.O1 = B_VMC + (size_t)l2 * MC * 1024;
                run_gemm(lds, wave_s, B_CKVC + (size_t)l2 * MC * 256, (const bf16_t*)(ws + W_WKVC) + (size_t)l2 * NKV * KVL, MC, NKV, KVL, E);
            }
        }
        {
            TID_DEFS
            const float* gk = P.in[17] + (size_t)l * 256;
            for (size_t idx = gt; idx < (size_t)MT * 64; idx += ngt) {
                const int row = (int)(idx >> 6), c4 = (int)(idx & 63);
                float* p = (row >= MP ? cks + (size_t)(row - MP) * 256 : ckp + (size_t)row * 256) + 4 * c4;
                const float rs = rsqrtf(ssckv[row] * (1.f / 256.f) + EPS); const f32x4 g = *(const f32x4*)(gk + 4 * c4);
                *(f32x4*)p = *(const f32x4*)p * rs * g;
            }
        }
        gbar(); OPAQ();
        PR_END(2);
        PR_BEGIN(3);
        {
            AttnCtx C; C.ws = ws; C.cdk = P.in[2]; C.cdv = P.in[3]; C.gda = P.in[14] + (size_t)l * 128; C.lam = __int_as_float(__builtin_amdgcn_readfirstlane(__float_as_int(ctlf[64 + 2 * l]))); C.lam1m = __int_as_float(__builtin_amdgcn_readfirstlane(__float_as_int(ctlf[65 + 2 * l]))); C.counter = ctl + 16 * l; C.l = l;
#ifndef NO_ATTN
            { int wv = wave_s; asm volatile("" : "+s"(wv)); attn_phase(lds, C, wv); }
#ifdef PROBE_ATTN2
            gbar(); OPAQ(); C.counter = ctl + 32 + 16 * l; { int wv = wave_s; asm volatile("" : "+s"(wv)); attn_phase(lds, C, wv); }
#endif
#endif
        }
        gbar(); OPAQ();
        PR_END(3);
        PR_BEGIN(4);
        {
            EpiRes E; E.xp = (l == 0) ? P.in[0] : nullptr; E.xs = P.in[1]; E.X = nullptr; E.HX = B_HX; E.ssn = ssx_ffn;
            run_gemm(lds, wave_s, B_MRG, (const bf16_t*)(ws + W_WO) + (size_t)l * 1024 * 1024, MT, 1024, 1024, E);
        }
        gbar(); OPAQ();
        PR_END(4);
        PR_BEGIN(5);
        {
            EpiUp E; E.ssx = ssx_ffn; E.ACT = B_ACT; E.UH = B_U; E.cvp = out + O_CVP + (size_t)l * 32 * 2 * NUP; E.cvs = out + O_CVS + (size_t)l * 16 * 2 * NUP;
            E.wc = P.in[23] + (size_t)l * 3 * NUP; E.bc = P.in[24] + (size_t)l * NUP; E.stc = P.in[6] + (size_t)l * 16 * 2 * NUP;
            run_gemm(lds, wave_s, B_HX, (const bf16_t*)(ws + W_WUP) + (size_t)l * NUP * 1024, MT, NUP, 1024, E);
        }
        gbar(); OPAQ();
        PR_END(5);
#ifndef NO_CONV
        PR_BEGIN(6);
        { TID_DEFS conv_fix_phase(P, l, gt, ngt); }
#endif
        gbar(); OPAQ();
        PR_END(6);
        PR_BEGIN(7);
        {
            EpiRes E; E.xp = nullptr; E.xs = nullptr; E.X = nullptr; E.HX = B_HX; E.ssn = ssx_next;
            run_gemm(lds, wave_s, B_ACT, (const bf16_t*)(ws + W_WDN) + (size_t)l * 1024 * DFF, MT, 1024, DFF, E);
        }
        gbar(); OPAQ();
        PR_END(7);
    }
    PR_BEGIN(8);
    {
        TID_DEFS
        const float* ssf = SS + (size_t)4 * MT; const float* gf = P.in[26];
        for (size_t idx = gt; idx < (size_t)MT * 256; idx += ngt) {
            const int row = (int)(idx >> 8), c4 = (int)(idx & 255);
            const float rs = rsqrtf(ssf[row] * (1.f / 1024.f) + EPS);
            const u32x2 hw = ldgu2(B_HX + (size_t)row * 1024 + 4 * c4);
            const f32x4 xv = (f32x4){__uint_as_float(hw.x << 16), __uint_as_float(hw.x & 0xffff0000u), __uint_as_float(hw.y << 16), __uint_as_float(hw.y & 0xffff0000u)};
            stg4(out + (size_t)row * 1024 + 4 * c4, xv * rs * ldg4(gf + 4 * c4));
        }
    }
#ifdef PROBE_SEL
    PR_END(8);
    if (blockIdx.x == 0) { const unsigned long long s0 = __builtin_amdgcn_s_memrealtime(); while (__builtin_amdgcn_s_memrealtime() - s0 < pr_acc) __builtin_amdgcn_s_sleep(32); }
#endif
}

extern "C" void kernel_launch(void* const* d_in, const int* in_sizes, int n_in, void* d_out, int out_size, void* d_ws, size_t ws_size, hipStream_t stream) {
    static int grid_blocks = 0;
    if (grid_blocks == 0) {
        if (n_in != 27 || (size_t)out_size != O_END || ws_size < W_END) { fprintf(stderr, "kernel_launch: unexpected problem (n_in %d, out %d vs %zu, ws %zu vs %zu)\n", n_in, out_size, (size_t)O_END, ws_size, (size_t)W_END); grid_blocks = -1; return; }
        int dev = 0, cus = 0, per_cu = 0;
        (void)hipGetDevice(&dev); (void)hipDeviceGetAttribute(&cus, hipDeviceAttributeMultiprocessorCount, dev);
        (void)hipFuncSetAttribute((const void*)fwd_megakernel, hipFuncAttributeMaxDynamicSharedMemorySize, LDS_BYTES);
        (void)hipOccupancyMaxActiveBlocksPerMultiprocessor(&per_cu, (const void*)fwd_megakernel, 512, LDS_BYTES);
        if (per_cu < 1) per_cu = 1;
        grid_blocks = cus * per_cu;
    }
    if (grid_blocks < 0) return;
    Params p{};
    for (int i = 0; i < 27; ++i) p.in[i] = (const float*)d_in[i];
    p.out = (float*)d_out; p.ws = (unsigned char*)d_ws;
    void* args[] = {&p};
    hipError_t e = hipLaunchCooperativeKernel((void*)fwd_megakernel, dim3(grid_blocks), dim3(512), args, LDS_BYTES, stream);
    if (e != hipSuccess) fprintf(stderr, "cooperative launch failed: %s (grid %d)\n", hipGetErrorString(e), grid_blocks);
}
```

```cpp
#include <hip/hip_runtime.h>
#include <hip/hip_cooperative_groups.h>
#include <cstdio>
#include <cstdint>
namespace cg = cooperative_groups;
#define LANE_ID() ({ int l_ = (int)__builtin_amdgcn_mbcnt_hi(~0u, __builtin_amdgcn_mbcnt_lo(~0u, 0u)); asm volatile("" : "+v"(l_)); l_; })
namespace pg8 {
#define PG8_LAS __attribute__((address_space(3)))
typedef unsigned short bf16_t;
typedef short bf16x8 __attribute__((ext_vector_type(8)));
typedef float f32x4 __attribute__((ext_vector_type(4)));
typedef unsigned u32x4 __attribute__((ext_vector_type(4)));
constexpr int BM = 256, BK = 64, HALF = 128, HTB = HALF * BK * 2  , STAGE_BYTES = 8 * HTB, NXCD = 8, WGM = 8;

__host__ __device__ __forceinline__ int lds_byte(int r, int c) { const int st = (r >> 4) * 2 + (c >> 5), rr = r & 15, cc = c & 31, ob = rr * 64 + cc * 2; return st * 1024 + (ob ^ (((ob >> 9) & 1) << 5)); }
__host__ __device__ __forceinline__ void stage_rc(int b, int& R, int& C) { const int st = b / 1024, sb = b % 1024, swz = sb ^ (((sb >> 9) & 1) << 5); R = (st >> 1) * 16 + swz / 64; C = (st & 1) * 32 + (swz % 64) / 2; }
__host__ __device__ __forceinline__ int perm32(int rho) { const int n = rho >> 4, i = rho & 15; return 8 * (i >> 2) + 4 * n + (i & 3); }

struct Unit { int pm, pn; };
struct Gemm { const bf16_t* A; const bf16_t* Bt; int M, N, K; };

struct StaticOrder {
    int nM, nN, nwg, G, c;
    __host__ __device__ void init(int M, int N, int G_, int c_) { nM = M / BM; nN = N / BM; nwg = nM * nN; G = G_; c = c_; }
    __host__ __device__ bool next(int i, Unit& u) const {
        const long L = (long)i * G + c; if (L >= nwg) return false;
        int wgid = (int)L; { const int q = nwg / NXCD, r = nwg % NXCD, xcd = wgid % NXCD, off = wgid / NXCD; wgid = (xcd < r ? xcd * (q + 1) : r * (q + 1) + (xcd - r) * q) + off; }
        const int nig = WGM * nN, gid = wgid / nig, fm = gid * WGM, gsz = (nM - fm) < WGM ? (nM - fm) : WGM;
        u.pm = fm + ((wgid % nig) % gsz); u.pn = (wgid % nig) / gsz; return true;
    }
    __device__ __forceinline__ void a_ready(const Unit&) const {}
    __device__ __forceinline__ void done(const Unit&) const {}
};

typedef float f32x2_cv __attribute__((ext_vector_type(2))); typedef __bf16 bf16x2_cv __attribute__((ext_vector_type(2)));
__device__ __forceinline__ unsigned cvt_pk_bf16(float lo, float hi) { f32x2_cv v = {lo, hi}; bf16x2_cv b = __builtin_convertvector(v, bf16x2_cv); return __builtin_bit_cast(unsigned, b); }
template <class Epi, class Sched, bool ALIGN_EPI = false, bool SP2 = false>
__device__ __forceinline__ void gemm_phase(PG8_LAS unsigned char* lds, const Gemm g, const Sched& S, const Epi& E, const int wid_in) {
    const int wid = wid_in, lane = LANE_ID(), tid = (wid << 6) | lane, wr = wid >> 2, wc = wid & 3, fr = lane & 15, fq = lane >> 4;
    const int K = g.K, nt = K / BK;
    unsigned voffA[2], voffB[2];
#pragma unroll
    for (int i = 0; i < 2; ++i) { int R, C; stage_rc(tid * 16 + i * 8192, R, C); const int Rb = Epi::PERM ? ((R & ~31) + perm32(R & 31)) : R;
        voffA[i] = (unsigned)(R * K + C) * 2u; voffB[i] = (unsigned)(Rb * K + C) * 2u; }
    const size_t kstep = (size_t)(BK * 2);
    const size_t hstep = (size_t)HALF * K * 2;
    const size_t tstep = 2 * hstep;
    const unsigned ldsw = (unsigned)wid * 1024u;
    const int aoff = lds_byte(wr * 64 + fr, fq * 8), boff = lds_byte(wc * 32 + fr, fq * 8);
#define PG8_SA(b, h) (((b) * 2 + (h)) * HTB)
#define PG8_SB(b, h) ((4 + (b) * 2 + (h)) * HTB)
#define PG8_STAGE(bufoff, gbase, voff) do { _Pragma("unroll") for (int _i = 0; _i < 2; ++_i) \
        __builtin_amdgcn_global_load_lds((const unsigned*)((const char*)(gbase) + (voff)[_i]), (PG8_LAS unsigned*)(lds + (bufoff) + ldsw + _i * 8192), 16, 0, 0); } while (0)
#define PG8_LDA(dst, b, h) do { _Pragma("unroll") for (int m = 0; m < 4; ++m) _Pragma("unroll") for (int k = 0; k < 2; ++k) dst[m][k] = *(const PG8_LAS bf16x8*)(lds + PG8_SA(b, h) + aoff + m * 2048 + k * 1024); } while (0)
#define PG8_LDB(dst, b, h) do { _Pragma("unroll") for (int n = 0; n < 2; ++n) _Pragma("unroll") for (int k = 0; k < 2; ++k) dst[n][k] = *(const PG8_LAS bf16x8*)(lds + PG8_SB(b, h) + boff + n * 2048 + k * 1024); } while (0)
#define PG8_MMA(ai, bj, At, Bt) do { __builtin_amdgcn_s_setprio(1); _Pragma("unroll") for (int m = 0; m < 4; ++m) _Pragma("unroll") for (int n = 0; n < 2; ++n) _Pragma("unroll") for (int k = 0; k < 2; ++k) \
        acc[ai][bj][m][n] = __builtin_amdgcn_mfma_f32_16x16x32_bf16(Bt[n][k], At[m][k], acc[ai][bj][m][n], 0, 0, 0); __builtin_amdgcn_s_setprio(0); } while (0)
#define PG8_WAIT_V(n) asm volatile("s_waitcnt vmcnt(" #n ")" ::: "memory")
#define PG8_WAIT_L(n) asm volatile("s_waitcnt lgkmcnt(" #n ")" ::: "memory")
#define PG8_BAR __builtin_amdgcn_s_barrier()
#define PG8_SCHED __builtin_amdgcn_sched_barrier(0)
    Unit cur, nxt; int ui = 0;
    if (!S.next(0, cur)) return;
    f32x4 acc[2][2][4][2];
#pragma unroll
    for (int a = 0; a < 2; ++a)
#pragma unroll
        for (int b = 0; b < 2; ++b)
#pragma unroll
            for (int m = 0; m < 4; ++m)
#pragma unroll
                for (int n = 0; n < 2; ++n) acc[a][b][m][n] = (f32x4){0.f, 0.f, 0.f, 0.f};
    bf16x8 At[4][2], B0[2][2], B1[2][2];
    const char* cA = (const char*)g.A + (size_t)cur.pm * tstep; const char* cB = (const char*)g.Bt + (size_t)cur.pn * tstep;
    S.a_ready(cur);
    if constexpr (SP2) {
        PG8_STAGE(PG8_SB(0, 0), cB, voffB); PG8_STAGE(PG8_SB(0, 1), cB + hstep, voffB); PG8_STAGE(PG8_SA(0, 0), cA, voffA); PG8_STAGE(PG8_SA(0, 1), cA + hstep, voffA);
        if (wr == 1) PG8_BAR;
        PG8_WAIT_V(2); PG8_BAR;
        PG8_STAGE(PG8_SB(1, 0), cB + kstep, voffB); PG8_STAGE(PG8_SA(1, 0), cA + kstep, voffA); PG8_STAGE(PG8_SB(1, 1), cB + hstep + kstep, voffB);
        PG8_WAIT_V(6); PG8_BAR;
    } else {
        PG8_STAGE(PG8_SB(0, 0), cB, voffB); PG8_STAGE(PG8_SA(0, 0), cA, voffA); PG8_STAGE(PG8_SB(0, 1), cB + hstep, voffB); PG8_STAGE(PG8_SA(0, 1), cA + hstep, voffA);
        if (wr == 1) PG8_BAR;
        PG8_WAIT_V(4); PG8_BAR;
        PG8_STAGE(PG8_SB(1, 0), cB + kstep, voffB); PG8_STAGE(PG8_SA(1, 0), cA + kstep, voffA); PG8_STAGE(PG8_SB(1, 1), cB + hstep + kstep, voffB);
        PG8_WAIT_V(6); PG8_BAR;
    }
    for (;;) {
        const bool has_next = S.next(ui + 1, nxt);
        const char* nA = has_next ? (const char*)g.A + (size_t)nxt.pm * tstep : cA; const char* nB = has_next ? (const char*)g.Bt + (size_t)nxt.pn * tstep : cB;
        for (int t = 0; t < nt; t += 2) {
            const bool last = (t == nt - 2);
            const char* a1 = cA + (size_t)(t + 1) * kstep;
            const char* a2 = last ? nA : cA + (size_t)(t + 2) * kstep; const char* b2 = last ? nB : cB + (size_t)(t + 2) * kstep;
            const char* a3 = a2 + kstep; const char* b3 = b2 + kstep;
            if (last && has_next) S.a_ready(nxt);
            if constexpr (SP2) {
            PG8_LDB(B0, 0, 0); PG8_LDB(B1, 0, 1); PG8_SCHED; PG8_LDA(At, 0, 0); PG8_STAGE(PG8_SA(1, 1), a1 + hstep, voffA);
            PG8_WAIT_V(8); PG8_WAIT_L(0); PG8_BAR; PG8_MMA(0, 0, At, B0); PG8_MMA(0, 1, At, B1); PG8_BAR; PG8_SCHED;
            PG8_LDA(At, 0, 1); PG8_STAGE(PG8_SB(0, 0), b2, voffB); PG8_STAGE(PG8_SB(0, 1), b2 + hstep, voffB); PG8_STAGE(PG8_SA(0, 0), a2, voffA);
            PG8_WAIT_V(8); PG8_WAIT_L(0); PG8_BAR; PG8_MMA(1, 0, At, B0); PG8_MMA(1, 1, At, B1); PG8_BAR; PG8_SCHED;
            PG8_LDB(B0, 1, 0); PG8_LDB(B1, 1, 1); PG8_SCHED; PG8_LDA(At, 1, 0); PG8_STAGE(PG8_SA(0, 1), a2 + hstep, voffA);
            PG8_WAIT_V(8); PG8_WAIT_L(0); PG8_BAR; PG8_MMA(0, 0, At, B0); PG8_MMA(0, 1, At, B1); PG8_BAR; PG8_SCHED;
            PG8_LDA(At, 1, 1); PG8_STAGE(PG8_SB(1, 0), b3, voffB); PG8_STAGE(PG8_SB(1, 1), b3 + hstep, voffB); PG8_STAGE(PG8_SA(1, 0), a3, voffA);
            PG8_WAIT_V(8); PG8_WAIT_L(0); PG8_BAR; PG8_MMA(1, 0, At, B0); PG8_MMA(1, 1, At, B1); PG8_BAR; PG8_SCHED;
            } else {
            PG8_LDB(B0, 0, 0); PG8_SCHED; PG8_LDA(At, 0, 0); PG8_STAGE(PG8_SA(1, 1), a1 + hstep, voffA);
            PG8_WAIT_L(8); PG8_BAR; PG8_WAIT_L(0); PG8_MMA(0, 0, At, B0); PG8_BAR; PG8_SCHED;
            PG8_LDB(B1, 0, 1); PG8_STAGE(PG8_SB(0, 0), b2, voffB);
            PG8_BAR; PG8_WAIT_L(0); PG8_MMA(0, 1, At, B1); PG8_BAR;
            PG8_LDA(At, 0, 1); PG8_STAGE(PG8_SA(0, 0), a2, voffA);
            PG8_BAR; PG8_WAIT_L(0); PG8_MMA(1, 0, At, B0); PG8_BAR; PG8_SCHED;
            PG8_STAGE(PG8_SB(0, 1), b2 + hstep, voffB);
            PG8_WAIT_V(6); PG8_BAR; PG8_MMA(1, 1, At, B1); PG8_BAR;
            PG8_LDB(B0, 1, 0); PG8_SCHED; PG8_LDA(At, 1, 0); PG8_STAGE(PG8_SA(0, 1), a2 + hstep, voffA);
            PG8_WAIT_L(8); PG8_BAR; PG8_WAIT_L(0); PG8_MMA(0, 0, At, B0); PG8_BAR; PG8_SCHED;
            PG8_LDB(B1, 1, 1); PG8_STAGE(PG8_SB(1, 0), b3, voffB);
            PG8_BAR; PG8_WAIT_L(0); PG8_MMA(0, 1, At, B1); PG8_BAR;
            PG8_LDA(At, 1, 1); PG8_STAGE(PG8_SA(1, 0), a3, voffA);
            PG8_BAR; PG8_WAIT_L(0); PG8_MMA(1, 0, At, B0); PG8_BAR; PG8_SCHED;
            PG8_STAGE(PG8_SB(1, 1), b3 + hstep, voffB);
            PG8_WAIT_V(6); PG8_BAR; PG8_MMA(1, 1, At, B1); PG8_BAR;
            }
        }
        if constexpr (ALIGN_EPI) { if (wr == 0) PG8_BAR; }
        if constexpr (!Epi::AFTER_DRAIN) { const int le = LANE_ID(); E(acc, cur, wr, wc, le & 15, le >> 4); S.done(cur); }
        if (!has_next) break;
#pragma unroll
        for (int a = 0; a < 2; ++a)
#pragma unroll
            for (int b = 0; b < 2; ++b)
#pragma unroll
                for (int m = 0; m < 4; ++m)
#pragma unroll
                    for (int n = 0; n < 2; ++n) acc[a][b][m][n] = (f32x4){0.f, 0.f, 0.f, 0.f};
        cur = nxt; cA = nA; cB = nB; ++ui;
        if constexpr (ALIGN_EPI) { if (wr == 1) PG8_BAR; }
    }
    PG8_WAIT_V(0);
    if constexpr (!ALIGN_EPI) { if (wr == 0) PG8_BAR; }
    PG8_BAR;
    if constexpr (Epi::AFTER_DRAIN) { E.fused(acc, cur, wr, wc, fr, fq, lds, wid, lane); S.done(cur); }
#undef PG8_SA
#undef PG8_SB
#undef PG8_STAGE
#undef PG8_LDA
#undef PG8_LDB
#undef PG8_MMA
#undef PG8_WAIT_V
#undef PG8_WAIT_L
#undef PG8_BAR
#undef PG8_SCHED
}
}
#define PG8_SP2 true
#define PG8_ALIGN true
using pg8::bf16_t; using pg8::bf16x8; using pg8::f32x4; using pg8::Unit; using pg8::cvt_pk_bf16;
#define LAS __attribute__((address_space(3)))
typedef float f32x16 __attribute__((ext_vector_type(16)));
typedef unsigned u32x2 __attribute__((ext_vector_type(2)));
typedef unsigned u32x4 __attribute__((ext_vector_type(4)));
typedef short v4i16_t __attribute__((ext_vector_type(4)));

constexpr int MP = 65536, MSMP = 512, MT = MP + MSMP, MC = 32768;
constexpr int INC = 5824, NIN = 5888, QL = 384, KVL = 256, NQ = 1536, NKV = 2048, DFF = 2816, NUP = 5632;
constexpr float EPS = 1e-6f, LOG2E = 1.4426950408889634f;
constexpr float QS_DA = 0.125f * LOG2E;
constexpr float QS_MLA = 0.07216878364870322f * LOG2E;
constexpr size_t O_DKP = (size_t)MT * 1024;
constexpr size_t O_DVP = O_DKP + 2 * (size_t)MP * 1024;
constexpr size_t O_CKVP = O_DVP + 2 * (size_t)MP * 1024;
constexpr size_t O_KRP = O_CKVP + 2 * (size_t)MP * 256;
constexpr size_t O_CVP = O_KRP + 2 * (size_t)MP * 64;
constexpr size_t O_DKS = O_CVP + 2 * 32 * 2 * 5632;
constexpr size_t O_DVS = O_DKS + 2 * 512 * 1024;
constexpr size_t O_CKVS = O_DVS + 2 * 512 * 1024;
constexpr size_t O_KRS = O_CKVS + 2 * 512 * 256;
constexpr size_t O_CVS = O_KRS + 2 * 512 * 64;
constexpr size_t O_END = O_CVS + 2 * 16 * 2 * 5632;
constexpr size_t A256(size_t x) { return (x + 255) & ~(size_t)255; }
constexpr size_t W_CTL = 0;
constexpr size_t W_ROPE = 4096;
constexpr size_t W_SS = A256(W_ROPE + (size_t)2080 * 64 * 4);
constexpr size_t W_WIN = A256(W_SS + (size_t)9 * MT * 4);
constexpr size_t W_WQ = A256(W_WIN + (size_t)2 * NIN * 1024 * 2);
constexpr size_t W_WKV = A256(W_WQ + (size_t)2 * NQ * QL * 2);
constexpr size_t W_WKVC = A256(W_WKV + (size_t)2 * NKV * KVL * 2);
constexpr size_t W_WO = A256(W_WKVC + (size_t)2 * NKV * KVL * 2);
constexpr size_t W_WUP = A256(W_WO + (size_t)2 * 1024 * 1024 * 2);
constexpr size_t W_WDN = A256(W_WUP + (size_t)2 * NUP * 1024 * 2);
constexpr size_t W_HX = A256(W_WDN + (size_t)2 * 1024 * DFF * 2);
constexpr size_t W_X = A256(W_HX + (size_t)MT * 1024 * 2);
constexpr size_t W_QDA = A256(W_X + (size_t)MT * 1024 * 4);
constexpr size_t W_KDA = A256(W_QDA + (size_t)MT * 1024 * 2);
constexpr size_t W_VDA = A256(W_KDA + (size_t)MT * 1024 * 2);
constexpr size_t W_G = A256(W_VDA + (size_t)MT * 1024 * 2);
constexpr size_t W_CKV = A256(W_G + (size_t)MT * 2048 * 2);
constexpr size_t W_CQ = A256(W_CKV + (size_t)MT * 256 * 2);
constexpr size_t W_KR = A256(W_CQ + (size_t)MT * 384 * 2);
constexpr size_t W_QM = A256(W_KR + (size_t)MT * 64 * 2);
constexpr size_t W_KN = A256(W_QM + (size_t)MT * 1536 * 2);
constexpr size_t W_VM = A256(W_KN + (size_t)MT * 1024 * 2);
constexpr size_t W_MRG = A256(W_VM + (size_t)MT * 1024 * 2);
constexpr size_t W_U = A256(W_MRG + (size_t)MT * 1024 * 2);
constexpr size_t W_ACT = A256(W_U + (size_t)MT * NUP * 2);
constexpr size_t W_KC = A256(W_ACT + (size_t)MT * DFF * 2);
constexpr size_t W_VC = A256(W_KC + (size_t)2 * MC * 1024 * 2);
constexpr size_t W_KRC = A256(W_VC + (size_t)2 * MC * 1024 * 2);
constexpr size_t W_CKVC = A256(W_KRC + (size_t)2 * MC * 64 * 2);
constexpr size_t W_KNC = A256(W_CKVC + (size_t)2 * MC * 256 * 2);
constexpr size_t W_VMC = A256(W_KNC + (size_t)2 * MC * 1024 * 2);
constexpr size_t W_END = A256(W_VMC + (size_t)2 * MC * 1024 * 2);

struct Params { const float* in[27]; float* out; unsigned char* ws; };

#define GAS __attribute__((address_space(1)))
__device__ __forceinline__ void st_bf16x4(bf16_t* p, f32x4 v) { u32x2 w; w.x = cvt_pk_bf16(v[0], v[1]); w.y = cvt_pk_bf16(v[2], v[3]); *(GAS u32x2*)p = w; }
__device__ __forceinline__ f32x4 ldg4(const float* p) { return *(const GAS f32x4*)p; }
__device__ __forceinline__ void stg4(float* p, f32x4 v) { *(GAS f32x4*)p = v; }
__device__ __forceinline__ u32x4 ldgu4(const void* p) { return *(const GAS u32x4*)p; }
__device__ __forceinline__ u32x2 ldgu2(const void* p) { return *(const GAS u32x2*)p; }
__device__ __forceinline__ float ldg1(const float* p) { return *(const GAS float*)p; }
__device__ __forceinline__ float fast_rcp(float x) { return __builtin_amdgcn_rcpf(x); }
__device__ __forceinline__ float fast_exp2(float x) { return __builtin_amdgcn_exp2f(x); }
__device__ __forceinline__ float sigmoidf_(float x) { return fast_rcp(1.f + fast_exp2(-x * LOG2E)); }
__device__ __forceinline__ float bf2f(unsigned short b) { return __uint_as_float((unsigned)b << 16); }
__device__ __forceinline__ int row_of(const Unit& u, int ai, int wr, int m, int fr) { return u.pm * 256 + ai * 128 + wr * 64 + m * 16 + fr; }
__device__ __forceinline__ float sq4(f32x4 v) { return (v[0] * v[0] + v[1] * v[1]) + (v[2] * v[2] + v[3] * v[3]); }

__device__ __forceinline__ float add_x16(float s) { return s + __int_as_float(__builtin_amdgcn_ds_swizzle(__float_as_int(s), 0x401F)); }
__device__ __forceinline__ float add_x32(float s) { auto rr = __builtin_amdgcn_permlane32_swap(__float_as_uint(s), __float_as_uint(s), false, false); return __uint_as_float(rr[0]) + __uint_as_float(rr[1]); }
__device__ __forceinline__ float max_x32(float s) { auto rr = __builtin_amdgcn_permlane32_swap(__float_as_uint(s), __float_as_uint(s), false, false); return fmaxf(__uint_as_float(rr[0]), __uint_as_float(rr[1])); }
#define LOAD_RS8(name, ptr, scale, mul) float name[2][4]; { _Pragma("unroll") for (int ai_ = 0; ai_ < 2; ++ai_) _Pragma("unroll") for (int m_ = 0; m_ < 4; ++m_) name[ai_][m_] = ldg1((ptr) + row_of(u, ai_, wr, m_, fr)); \
    _Pragma("unroll") for (int ai_ = 0; ai_ < 2; ++ai_) _Pragma("unroll") for (int m_ = 0; m_ < 4; ++m_) name[ai_][m_] = rsqrtf(name[ai_][m_] * (scale) + EPS) * (mul); }
struct EpiInProj {
    static constexpr bool PERM = false, AFTER_DRAIN = false;
    unsigned char* ws; float* out; const float* bgate; int l;
    __device__ __forceinline__ void operator()(const f32x4 (&acc)[2][2][4][2], const Unit& u, int wr, int wc, int fr, int fq) const {
        const int pn = u.pn;
        const float* SSb = (const float*)(ws + W_SS); const float* ssx = SSb + (size_t)(2 * l) * MT; const float* rope = (const float*)(ws + W_ROPE);
        float* sscq = (float*)(ws + W_SS) + (size_t)(5 + l) * MT; float* ssckv = (float*)(ws + W_SS) + (size_t)(7 + l) * MT;
        bf16_t* QDA = (bf16_t*)(ws + W_QDA); bf16_t* KDA = (bf16_t*)(ws + W_KDA); bf16_t* VDA = (bf16_t*)(ws + W_VDA); bf16_t* G = (bf16_t*)(ws + W_G);
        bf16_t* CKV = (bf16_t*)(ws + W_CKV); bf16_t* CQ = (bf16_t*)(ws + W_CQ); bf16_t* KR = (bf16_t*)(ws + W_KR);
        float* dkp = out + O_DKP + (size_t)l * MP * 1024; float* dks = out + O_DKS + (size_t)l * MSMP * 1024; float* dvp = out + O_DVP + (size_t)l * MP * 1024; float* dvs = out + O_DVS + (size_t)l * MSMP * 1024;
        float* ckp = out + O_CKVP + (size_t)l * MP * 256; float* cks = out + O_CKVS + (size_t)l * MSMP * 256; float* krp = out + O_KRP + (size_t)l * MP * 64; float* krs = out + O_KRS + (size_t)l * MSMP * 64;
        LOAD_RS8(rs8, ssx, 1.f / 1024.f, 1.f)
        if (pn < 8) {
            const bool isk = pn >= 4; const int cb = 256 * (pn & 3) + 64 * wc;
#pragma unroll
            for (int ai = 0; ai < 2; ++ai)
#pragma unroll
                for (int m = 0; m < 4; ++m) { if ((m & 1) == 0) asm volatile("" ::: "memory");
                    const int row = row_of(u, ai, wr, m, fr); const float rstd = rs8[ai][m];
                    const bool samp = row >= MP; const int orow = samp ? row - MP : row; const int pos = samp ? 2048 + (orow & 31) : (row & 2047);
                    const float* rt = rope + (size_t)pos * 64;
#pragma unroll
                    for (int n = 0; n < 2; ++n) {
                        const int i0 = 16 * n + 4 * fq; const f32x4 cs = ldg4(rt + i0), sn = ldg4(rt + 32 + i0);
                        const f32x4 x1 = acc[ai][0][m][n] * rstd, x2 = acc[ai][1][m][n] * rstd;
                        f32x4 o1 = x1 * cs - x2 * sn, o2 = x2 * cs + x1 * sn;
                        if (!isk) { o1 = o1 * QS_DA; o2 = o2 * QS_DA; bf16_t* q = QDA + (size_t)row * 1024 + cb + i0; st_bf16x4(q, o1); st_bf16x4(q + 32, o2); }
                        else { bf16_t* k = KDA + (size_t)row * 1024 + cb + i0; st_bf16x4(k, o1); st_bf16x4(k + 32, o2);
                               float* d = (samp ? dks : dkp) + (size_t)orow * 1024 + cb + i0; stg4(d, o1); stg4((d + 32), o2); }
                    }
                }
        } else if (pn < 12) {
            const int cb = 256 * (pn - 8) + 32 * wc + 4 * fq;
#pragma unroll
            for (int ai = 0; ai < 2; ++ai)
#pragma unroll
                for (int m = 0; m < 4; ++m) { if ((m & 1) == 0) asm volatile("" ::: "memory");
                    const int row = row_of(u, ai, wr, m, fr); const float rstd = rs8[ai][m];
                    const bool samp = row >= MP; const int orow = samp ? row - MP : row;
                    float* d = (samp ? dvs : dvp) + (size_t)orow * 1024 + cb; bf16_t* v = VDA + (size_t)row * 1024 + cb;
#pragma unroll
                    for (int bj = 0; bj < 2; ++bj)
#pragma unroll
                        for (int n = 0; n < 2; ++n) { const f32x4 x = acc[ai][bj][m][n] * rstd; stg4((d + 128 * bj + 16 * n), x); st_bf16x4(v + 128 * bj + 16 * n, x); }
                }
        } else if (pn < 20) {
            const int cb = 256 * (pn - 12) + 32 * wc + 4 * fq;
            f32x4 bv[2][2];
#pragma unroll
            for (int bj = 0; bj < 2; ++bj)
#pragma unroll
                for (int n = 0; n < 2; ++n) bv[bj][n] = ldg4(bgate + cb + 128 * bj + 16 * n);
#pragma unroll
            for (int ai = 0; ai < 2; ++ai)
#pragma unroll
                for (int m = 0; m < 4; ++m) { if ((m & 1) == 0) asm volatile("" ::: "memory");
                    const int row = row_of(u, ai, wr, m, fr); const float rstd = rs8[ai][m];
                    bf16_t* g = G + (size_t)row * 2048 + cb;
#pragma unroll
                    for (int bj = 0; bj < 2; ++bj)
#pragma unroll
                        for (int n = 0; n < 2; ++n) { f32x4 x = acc[ai][bj][m][n] * rstd + bv[bj][n];
                            x[0] = sigmoidf_(x[0]); x[1] = sigmoidf_(x[1]); x[2] = sigmoidf_(x[2]); x[3] = sigmoidf_(x[3]); st_bf16x4(g + 128 * bj + 16 * n, x); }
                }
        } else if (pn == 20) {
            const int cb = 32 * wc + 4 * fq;
#pragma unroll
            for (int ai = 0; ai < 2; ++ai)
#pragma unroll
                for (int m = 0; m < 4; ++m) { if ((m & 1) == 0) asm volatile("" ::: "memory");
                    const int row = row_of(u, ai, wr, m, fr); const float rstd = rs8[ai][m];
                    const bool samp = row >= MP; const int orow = samp ? row - MP : row;
                    float* d = (samp ? cks : ckp) + (size_t)orow * 256 + cb; bf16_t* c = CKV + (size_t)row * 256 + cb; float s = 0.f;
#pragma unroll
                    for (int bj = 0; bj < 2; ++bj)
#pragma unroll
                        for (int n = 0; n < 2; ++n) { const f32x4 x = acc[ai][bj][m][n] * rstd; s += sq4(x); stg4((d + 128 * bj + 16 * n), x); st_bf16x4(c + 128 * bj + 16 * n, x); }
                    s = add_x16(s); s = add_x32(s);
                    if (fq == 0) unsafeAtomicAdd(ssckv + row, s);
                }
        } else if (pn == 21) {
            const int cb = 32 * wc + 4 * fq;
#pragma unroll
            for (int ai = 0; ai < 2; ++ai)
#pragma unroll
                for (int m = 0; m < 4; ++m) { if ((m & 1) == 0) asm volatile("" ::: "memory");
                    const int row = row_of(u, ai, wr, m, fr); const float rstd = rs8[ai][m];
                    bf16_t* c = CQ + (size_t)row * 384 + cb; float s = 0.f;
#pragma unroll
                    for (int bj = 0; bj < 2; ++bj)
#pragma unroll
                        for (int n = 0; n < 2; ++n) { const f32x4 x = acc[ai][bj][m][n] * rstd; s += sq4(x); st_bf16x4(c + 128 * bj + 16 * n, x); }
                    s = add_x16(s); s = add_x32(s);
                    if (fq == 0) unsafeAtomicAdd(sscq + row, s);
                }
        } else {
#pragma unroll
            for (int ai = 0; ai < 2; ++ai)
#pragma unroll
                for (int m = 0; m < 4; ++m) { if ((m & 1) == 0) asm volatile("" ::: "memory");
                    const int row = row_of(u, ai, wr, m, fr); const float rstd = rs8[ai][m];
                    const bool samp = row >= MP; const int orow = samp ? row - MP : row; const int pos = samp ? 2048 + (orow & 31) : (row & 2047);
                    bf16_t* c = CQ + (size_t)row * 384 + 256 + 32 * wc + 4 * fq; float s = 0.f;
#pragma unroll
                    for (int n = 0; n < 2; ++n) { const f32x4 x = acc[ai][0][m][n] * rstd; s += sq4(x); st_bf16x4(c + 16 * n, x); }
                    s = add_x16(s); s = add_x32(s);
                    if (fq == 0) unsafeAtomicAdd(sscq + row, s);
                    if (wc < 2) {
                        const int i0 = 16 * wc + 4 * fq; const float* rt = rope + (size_t)pos * 64;
                        const f32x4 cs = ldg4(rt + i0), sn = ldg4(rt + 32 + i0);
                        const f32x4 x1 = acc[ai][1][m][0] * rstd, x2 = acc[ai][1][m][1] * rstd;
                        const f32x4 o1 = x1 * cs - x2 * sn, o2 = x2 * cs + x1 * sn;
                        float* d = (samp ? krs : krp) + (size_t)orow * 64 + i0; stg4(d, o1); stg4((d + 32), o2);
                        bf16_t* k = KR + (size_t)row * 64 + i0; st_bf16x4(k, o1); st_bf16x4(k + 32, o2);
                    }
                }
        }
    }
};

struct EpiQ {
    static constexpr bool PERM = false, AFTER_DRAIN = false;
    const float* sscq; const float* rope; bf16_t* QM;
    __device__ __forceinline__ void operator()(const f32x4 (&acc)[2][2][4][2], const Unit& u, int wr, int wc, int fr, int fq) const {
        const int pn = u.pn;
        LOAD_RS8(rs8, sscq, 1.f / 384.f, QS_MLA)
#pragma unroll
        for (int ai = 0; ai < 2; ++ai)
#pragma unroll
            for (int m = 0; m < 4; ++m) { if ((m & 1) == 0) asm volatile("" ::: "memory");
                const int row = row_of(u, ai, wr, m, fr); const float rs = rs8[ai][m];
                bf16_t* q = QM + (size_t)row * 1536;
                if (pn < 4) {
#pragma unroll
                    for (int bj = 0; bj < 2; ++bj)
#pragma unroll
                        for (int n = 0; n < 2; ++n) st_bf16x4(q + (2 * pn + bj) * 192 + 32 * wc + 16 * n + 4 * fq, acc[ai][bj][m][n] * rs);
                } else {
                    const int pos = row >= MP ? 2048 + ((row - MP) & 31) : (row & 2047); const float* rt = rope + (size_t)pos * 64;
                    bf16_t* qh = q + (4 * (pn - 4) + wc) * 192 + 128;
#pragma unroll
                    for (int n = 0; n < 2; ++n) {
                        const int i0 = 16 * n + 4 * fq; const f32x4 cs = ldg4(rt + i0), sn = ldg4(rt + 32 + i0);
                        const f32x4 x1 = acc[ai][0][m][n] * rs, x2 = acc[ai][1][m][n] * rs;
                        st_bf16x4(qh + i0, x1 * cs - x2 * sn); st_bf16x4(qh + 32 + i0, x2 * cs + x1 * sn);
                    }
                }
            }
    }
};

template <bool HAS_SS> struct EpiKV {
    static constexpr bool PERM = false, AFTER_DRAIN = false;
    const float* ss; bf16_t *O0, *O1;
    __device__ __forceinline__ void operator()(const f32x4 (&acc)[2][2][4][2], const Unit& u, int wr, int wc, int fr, int fq) const {
        bf16_t* base = (u.pn < 4 ? O0 : O1) + 256 * (u.pn & 3) + 32 * wc + 4 * fq;
        float rs8[2][4];
        if constexpr (HAS_SS) { LOAD_RS8(t8, ss, 1.f / 256.f, 1.f) _Pragma("unroll") for (int a = 0; a < 2; ++a) _Pragma("unroll") for (int b = 0; b < 4; ++b) rs8[a][b] = t8[a][b]; }
#pragma unroll
        for (int ai = 0; ai < 2; ++ai)
#pragma unroll
            for (int m = 0; m < 4; ++m) { if ((m & 1) == 0) asm volatile("" ::: "memory");
                const int row = row_of(u, ai, wr, m, fr); const float rs = HAS_SS ? rs8[ai][m] : 1.f;
                bf16_t* o = base + (size_t)row * 1024;
#pragma unroll
                for (int bj = 0; bj < 2; ++bj)
#pragma unroll
                    for (int n = 0; n < 2; ++n) st_bf16x4(o + 128 * bj + 16 * n, acc[ai][bj][m][n] * rs);
            }
    }
};

struct EpiRes {
    static constexpr bool PERM = false, AFTER_DRAIN = false;
    const float* xp; const float* xs; float* X; bf16_t* HX; float* ssn;
    __device__ __forceinline__ void operator()(const f32x4 (&acc)[2][2][4][2], const Unit& u, int wr, int wc, int fr, int fq) const {
        const int cb = 256 * u.pn + 32 * wc + 4 * fq;
#pragma unroll
        for (int ai = 0; ai < 2; ++ai)
#pragma unroll
            for (int m = 0; m < 4; ++m) { if ((m & 1) == 0) asm volatile("" ::: "memory");
                const int row = row_of(u, ai, wr, m, fr);
                bf16_t* h = HX + (size_t)row * 1024 + cb; float s = 0.f;
                f32x4 xo[2][2];
                if (xp) { const float* xi = (row >= MP ? xs + (size_t)(row - MP) * 1024 : xp + (size_t)row * 1024) + cb;
#pragma unroll
                    for (int bj = 0; bj < 2; ++bj)
#pragma unroll
                        for (int n = 0; n < 2; ++n) xo[bj][n] = ldg4(xi + 128 * bj + 16 * n); }
                else {
#pragma unroll
                    for (int bj = 0; bj < 2; ++bj)
#pragma unroll
                        for (int n = 0; n < 2; ++n) { const u32x2 w = ldgu2(h + 128 * bj + 16 * n);
                            xo[bj][n] = (f32x4){__uint_as_float(w.x << 16), __uint_as_float(w.x & 0xffff0000u), __uint_as_float(w.y << 16), __uint_as_float(w.y & 0xffff0000u)}; } }
#pragma unroll
                for (int bj = 0; bj < 2; ++bj)
#pragma unroll
                    for (int n = 0; n < 2; ++n) { const f32x4 x = xo[bj][n] + acc[ai][bj][m][n]; s += sq4(x); st_bf16x4(h + 128 * bj + 16 * n, x);
                        if (X) stg4((X + (size_t)row * 1024 + cb + 128 * bj + 16 * n), x); }
                s = add_x16(s); s = add_x32(s);
                if (fq == 0) unsafeAtomicAdd(ssn + row, s);
            }
    }
};

template <int CTRL> __device__ __forceinline__ float dpp_f(float old, float src) { return __int_as_float(__builtin_amdgcn_update_dpp(__float_as_int(old), __float_as_int(src), CTRL, 0xf, 0xf, false)); }
struct EpiUp {
    static constexpr bool PERM = false, AFTER_DRAIN = false;
    const float* ssx; bf16_t* ACT; bf16_t* UH; float* cvp; float* cvs; const float* wc; const float* bc; const float* stc;
    __device__ __forceinline__ void operator()(const f32x4 (&acc)[2][2][4][2], const Unit& u, int wr, int wc_, int fr, int fq) const {
        const int cb = 128 * u.pn + 32 * wc_ + 4 * fq;
        const bool samp = u.pm >= 256;
        LOAD_RS8(rs8, ssx, 1.f / 1024.f, 1.f)
#pragma unroll
        for (int ai = 0; ai < 2; ++ai)
#pragma unroll
            for (int m = 0; m < 4; ++m) { asm volatile("" ::: "memory");
                const int row = row_of(u, ai, wr, m, fr); const float rs = rs8[ai][m];
                const bool from_prev = samp ? (m & 1) : (m > 0);
                const bool seq0 = !samp && m == 0 && ((row - fr) & 2047) == 0;
                const bool defer = !samp && m == 0 && !seq0 && fr < 2;
                float* cv = nullptr;
                if (samp) { const int r = row - MP, sq = r & 31; if (sq >= 30) cv = cvs + ((size_t)(r >> 5) * 2 + (sq - 30)) * NUP + cb; }
                else { const int sq = row & 2047; if (sq >= 2046) cv = cvp + ((size_t)(row >> 11) * 2 + (sq - 2046)) * NUP + cb; }
                bf16_t* uh = nullptr;
                if (!samp) { if (m == 0 && fr < 2) uh = UH + ((size_t)(row >> 6) * 4 + fr) * NUP + cb; else if (m == 3 && fr >= 14) uh = UH + ((size_t)(row >> 6) * 4 + 2 + (fr - 14)) * NUP + cb; }
                const float* st0 = stc + (size_t)(samp ? (row - MP) >> 5 : 0) * 2 * NUP + cb;
#pragma unroll
                for (int n = 0; n < 2; ++n) {
                    f32x4 cc[2];
#pragma unroll
                    for (int bj = 0; bj < 2; ++bj) {
                        const int co = DFF * bj + 16 * n;
                        const f32x4 x = acc[ai][bj][m][n] * rs;
                        if (cv) stg4(cv + co, x);
                        if (uh) st_bf16x4(uh + co, x);
                        f32x4 c1, c2;
                        if (from_prev) { const f32x4 xp = acc[ai][bj][m > 0 ? m - 1 : 0][n] * rs8[ai][m > 0 ? m - 1 : 0];
#pragma unroll
                            for (int j = 0; j < 4; ++j) { c1[j] = dpp_f<0x121>(0.f, xp[j]); c2[j] = dpp_f<0x122>(0.f, xp[j]); } }
                        else if (samp) { c1 = ldg4(st0 + NUP + co); c2 = ldg4(st0 + (size_t)(fr & 1) * NUP + co); }
                        else { c1 = (f32x4){0.f, 0.f, 0.f, 0.f}; c2 = c1; }
                        const f32x4 w0 = ldg4(wc + cb + co), w1 = ldg4(wc + NUP + cb + co), w2 = ldg4(wc + 2 * NUP + cb + co), bb = ldg4(bc + cb + co);
#pragma unroll
                        for (int j = 0; j < 4; ++j) { const float p1 = dpp_f<0x111>(c1[j], x[j]), p2 = dpp_f<0x112>(c2[j], x[j]); cc[bj][j] = bb[j] + w0[j] * p2 + w1[j] * p1 + w2[j] * x[j]; }
                    }
                    if (!defer) { f32x4 r;
#pragma unroll
                        for (int j = 0; j < 4; ++j) r[j] = cc[0][j] * sigmoidf_(cc[0][j]) * cc[1][j];
                        st_bf16x4(ACT + (size_t)row * DFF + cb + 16 * n, r); }
                }
            }
    }
};
struct KVD { const bf16_t* k; const bf16_t* k2; const bf16_t* v; const float* kf; const float* vf; };
constexpr int ATT_KBUF = 64 * 400, ATT_VOFF = 2 * ATT_KBUF, ATT_VIMG = 32 * 320, ATT_VBUF = 2 * ATT_VIMG;

template <int DQK, bool F32M>
__device__ __forceinline__ void attn_pass(LAS unsigned char* lds, const int wid, const bf16_t* qrow, const KVD& dm, const KVD& dl, int nmain, int ntw, int ntc, f32x16 (&o)[4], float& linv) {
    constexpr int NCH = DQK / 8, KST = DQK * 2 + 16, NKI = NCH / 8, NS = DQK / 16;
    const int lane = LANE_ID(), tid = (wid << 6) | lane, r32 = lane & 31, hi = lane >> 5;
    bf16x8 q[NS];
#pragma unroll
    for (int s = 0; s < NS; ++s) q[s] = __builtin_bit_cast(bf16x8, ldgu4(qrow + 16 * s + 8 * hi));
    u32x4 kr[NKI], vr[2], kr2[F32M ? NKI : 1], vr2[F32M ? 2 : 1];
#define ATT_GLOADK(t) do { const bool lastt = (t) >= nmain; const KVD& d = lastt ? dl : dm; const int rb = lastt ? 0 : (t) * 64; const int rm = lastt ? 31 : 63; \
        _Pragma("unroll") for (int i = 0; i < NKI; ++i) { const int id = tid + 512 * i, kro = id / NCH, kc = id - kro * NCH; const int r = rb + (kro & rm); \
            if (F32M && !lastt) { const float* p_ = d.kf + (size_t)r * 1024 + kc * 8; kr[i] = ldgu4(p_); kr2[F32M ? i : 0] = ldgu4(p_ + 4); } \
            else kr[i] = (DQK == 64 || kc < 16) ? ldgu4(d.k + (size_t)r * 1024 + kc * 8) : ldgu4(d.k2 + (size_t)r * 64 + (kc - 16) * 8); } } while (0)
#define ATT_GLOADV(t) do { const bool lastt = (t) >= nmain; const KVD& d = lastt ? dl : dm; const int rb = lastt ? 0 : (t) * 64; const int rm = lastt ? 31 : 63; \
        _Pragma("unroll") for (int i = 0; i < 2; ++i) { const int r = rb + (((tid >> 4) + 32 * i) & rm); \
            if (F32M && !lastt) { const float* p_ = d.vf + (size_t)r * 1024 + (tid & 15) * 8; vr[i] = ldgu4(p_); vr2[F32M ? i : 0] = ldgu4(p_ + 4); } \
            else vr[i] = ldgu4(d.v + (size_t)r * 1024 + (tid & 15) * 8); } } while (0)
#define ATT_PK8(a_, b_) (u32x4){cvt_pk_bf16(__uint_as_float((a_).x), __uint_as_float((a_).y)), cvt_pk_bf16(__uint_as_float((a_).z), __uint_as_float((a_).w)), cvt_pk_bf16(__uint_as_float((b_).x), __uint_as_float((b_).y)), cvt_pk_bf16(__uint_as_float((b_).z), __uint_as_float((b_).w))}
#define ATT_LSTORE(b, tt) do { const bool cvt_ = F32M && (tt) < nmain; \
        _Pragma("unroll") for (int i = 0; i < NKI; ++i) { const int id = tid + 512 * i, kro = id / NCH, kc = id - kro * NCH; *(LAS u32x4*)(lds + (b) * ATT_KBUF + kro * KST + kc * 16) = cvt_ ? ATT_PK8(kr[i], kr2[F32M ? i : 0]) : kr[i]; } \
        _Pragma("unroll") for (int i = 0; i < 2; ++i) *(LAS u32x4*)(lds + ATT_VOFF + (b) * ATT_VBUF + i * ATT_VIMG + (tid >> 4) * 320 + (tid & 15) * 16) = cvt_ ? ATT_PK8(vr[i], vr2[F32M ? i : 0]) : vr[i]; } while (0)
    ATT_GLOADK(0); ATT_GLOADV(0); ATT_LSTORE(0, 0); __syncthreads();
    float m_run = 0.f, l_run = 0.f;
#pragma unroll
    for (int c = 0; c < 4; ++c)
#pragma unroll
        for (int r = 0; r < 16; ++r) o[c][r] = 0.f;
    const int vlane = (4 * hi + ((lane & 15) >> 2)) * 320 + (2 * ((lane >> 4) & 1) + ((lane & 3) >> 1)) * 16 + 8 * (lane & 1);
    for (int t = 0; t < ntw; ++t) {
        if (t + 1 < ntw) ATT_GLOADK(t + 1);
        bool vloaded = false;
        if (t < ntc) {
            const LAS unsigned char* kb = lds + (t & 1) * ATT_KBUF + r32 * KST + hi * 16;
            const LAS unsigned char* vb = lds + ATT_VOFF + (t & 1) * ATT_VBUF;
            f32x16 p0, p1;
#pragma unroll
            for (int r = 0; r < 16; ++r) { p0[r] = 0.f; p1[r] = 0.f; }
            constexpr int KCH = 2, NG = NS / KCH, NB = (DQK == 64) ? 2 : 1;
            bf16x8 kf[NB][2 * KCH];
#define ATT_LDK(ch, b) do { _Pragma("unroll") for (int j_ = 0; j_ < KCH; ++j_) { kf[b][2 * j_] = *(const LAS bf16x8*)(kb + (KCH * (ch) + j_) * 32); kf[b][2 * j_ + 1] = *(const LAS bf16x8*)(kb + 32 * KST + (KCH * (ch) + j_) * 32); } } while (0)
            ATT_LDK(0, 0); __builtin_amdgcn_sched_barrier(0);
#pragma unroll
            for (int ch = 0; ch < NG; ++ch) {
                if (NB == 2 && ch + 1 < NG) ATT_LDK(ch + 1, NB == 2 ? ((ch + 1) & 1) : 0);
                __builtin_amdgcn_sched_barrier(0);
#pragma unroll
                for (int j = 0; j < KCH; ++j) {
                    p0 = __builtin_amdgcn_mfma_f32_32x32x16_bf16(kf[NB == 2 ? (ch & 1) : 0][2 * j], q[KCH * ch + j], p0, 0, 0, 0);
                    p1 = __builtin_amdgcn_mfma_f32_32x32x16_bf16(kf[NB == 2 ? (ch & 1) : 0][2 * j + 1], q[KCH * ch + j], p1, 0, 0, 0);
                }
                __builtin_amdgcn_sched_barrier(0);
                if (NB == 1 && ch + 1 < NG) { ATT_LDK(ch + 1, 0); __builtin_amdgcn_sched_barrier(0); }
            }
#undef ATT_LDK
            bf16x8 vf[2][4];
#define ATT_LDV(cmb, b) do { _Pragma("unroll") for (int c_ = 0; c_ < 4; ++c_) { const LAS unsigned char* a0_ = vb + vlane + ((cmb) >> 1) * ATT_VIMG + (16 * ((cmb) & 1)) * 320 + c_ * 64; \
                const v4i16_t t0_ = __builtin_amdgcn_ds_read_tr16_b64_v4i16((LAS v4i16_t*)a0_), t1_ = __builtin_amdgcn_ds_read_tr16_b64_v4i16((LAS v4i16_t*)(a0_ + 8 * 320)); \
                vf[b][c_] = (bf16x8){t0_[0], t0_[1], t0_[2], t0_[3], t1_[0], t1_[1], t1_[2], t1_[3]}; } } while (0)
#pragma unroll
            for (int r = 0; r < 16; ++r) { p0[r] -= m_run; p1[r] -= m_run; }
            if (t >= nmain) { asm volatile("" ::: "memory");
#pragma unroll
                for (int r = 0; r < 16; ++r) p1[r] = -INFINITY;
            }
            float mt = __builtin_fmaxf(__builtin_fmaxf(p0[0], p1[0]), p0[1]);
#pragma unroll
            for (int r = 1; r < 15; r += 2) { mt = __builtin_fmaxf(__builtin_fmaxf(mt, p1[r]), p0[r + 1]); mt = __builtin_fmaxf(__builtin_fmaxf(mt, p1[r + 1]), p0[r + 2 < 16 ? r + 2 : 15]); }
            mt = __builtin_fmaxf(mt, p1[15]);
            mt = max_x32(mt);
            const float dref = (t == 0 || mt > 8.f) ? mt : 0.f;
            if (__builtin_amdgcn_ballot_w64(dref != 0.f) != 0ull) {
                m_run += dref;
#pragma unroll
                for (int r = 0; r < 16; ++r) { p0[r] -= dref; p1[r] -= dref; }
                if (t > 0) { const float f = fast_exp2(-dref); l_run *= f;
#pragma unroll
                    for (int c = 0; c < 4; ++c)
#pragma unroll
                        for (int r = 0; r < 16; ++r) o[c][r] *= f; }
            }
            float rs = 0.f;
#pragma unroll
            for (int r = 0; r < 16; ++r) { p0[r] = fast_exp2(p0[r]); p1[r] = fast_exp2(p1[r]); rs += p0[r] + p1[r]; }
            l_run += rs;
            asm volatile("" ::: "memory");
            if (t + 1 < ntw) { ATT_GLOADV(t + 1); vloaded = true; }
            bf16x8 pf[2][2];
#pragma unroll
            for (int ks = 0; ks < 2; ++ks) {
                u32x4 a, b;
                a.x = cvt_pk_bf16(p0[8 * ks + 0], p0[8 * ks + 1]); a.y = cvt_pk_bf16(p0[8 * ks + 2], p0[8 * ks + 3]); a.z = cvt_pk_bf16(p0[8 * ks + 4], p0[8 * ks + 5]); a.w = cvt_pk_bf16(p0[8 * ks + 6], p0[8 * ks + 7]);
                b.x = cvt_pk_bf16(p1[8 * ks + 0], p1[8 * ks + 1]); b.y = cvt_pk_bf16(p1[8 * ks + 2], p1[8 * ks + 3]); b.z = cvt_pk_bf16(p1[8 * ks + 4], p1[8 * ks + 5]); b.w = cvt_pk_bf16(p1[8 * ks + 6], p1[8 * ks + 7]);
                pf[0][ks] = __builtin_bit_cast(bf16x8, a); pf[1][ks] = __builtin_bit_cast(bf16x8, b);
            }
            __builtin_amdgcn_sched_barrier(0);
            ATT_LDV(0, 0); __builtin_amdgcn_sched_barrier(0);
#pragma unroll
            for (int cmb = 0; cmb < 4; ++cmb) {
                if (cmb + 1 < 4) ATT_LDV(cmb + 1, (cmb + 1) & 1);
                __builtin_amdgcn_sched_barrier(0);
#pragma unroll
                for (int c = 0; c < 4; ++c) o[c] = __builtin_amdgcn_mfma_f32_32x32x16_bf16(vf[cmb & 1][c], pf[cmb >> 1][cmb & 1], o[c], 0, 0, 0);
                __builtin_amdgcn_sched_barrier(0);
            }
#undef ATT_LDV
        }
        if (t + 1 < ntw) { if (!vloaded) ATT_GLOADV(t + 1); ATT_LSTORE((t + 1) & 1, t + 1); }
        __syncthreads();
    }
    const float lt = add_x32(l_run);
    linv = fast_rcp(lt);
#undef ATT_GLOADK
#undef ATT_PK8
#undef ATT_GLOADV
#undef ATT_LSTORE
}

struct AttnCtx { unsigned char* ws; const float* cdk; const float* cdv; const float* gda; float lam, lam1m; unsigned* counter; int l; };
constexpr int ATT_NUNITS = 128 + 2048;
__device__ __forceinline__ void attn_phase(LAS unsigned char* lds, const AttnCtx& C, const int wid) {
#define TID_NOW() LANE_ID()
    LAS unsigned* ubox = (LAS unsigned*)(lds + 131072);
    if (wid < 4) __builtin_amdgcn_s_setprio(3); else __builtin_amdgcn_s_setprio(0);
    const bf16_t* QDA = (const bf16_t*)(C.ws + W_QDA); const bf16_t* KDA = (const bf16_t*)(C.ws + W_KDA); const bf16_t* VDA = (const bf16_t*)(C.ws + W_VDA);
    const bf16_t* GG = (const bf16_t*)(C.ws + W_G); bf16_t* MRG = (bf16_t*)(C.ws + W_MRG);
    for (;;) {
        if (wid == 0 && TID_NOW() == 0) ubox[0] = atomicAdd(C.counter, 1u);
        __syncthreads();
        const int un = (int)ubox[0];
        __syncthreads();
        if (un >= ATT_NUNITS) break;
        const bool samp = un < 128;
        int b, h, qb = 0;
        if (samp) { b = un >> 3; h = un & 7; } else { const int v = un - 128; qb = 7 - (v >> 8); b = (v & 255) >> 3; h = v & 7; }
        const int row = samp ? MP + b * 32 + (TID_NOW() & 31) : b * 2048 + qb * 256 + wid * 32 + (TID_NOW() & 31);
        const int ntw = samp ? 33 : 4 * qb + 4, nmain = samp ? 32 : ntw, ntc = samp ? (wid == 0 ? 33 : 0) : 4 * qb + (wid >> 1) + 1;
        const size_t kr0 = (size_t)b * 2048;
        const size_t fr0 = (size_t)MP + b * 32;
        const size_t coff = (size_t)C.l * MC;
        f32x16 o[4]; float linv;
#ifndef NO_DIFF
        {
            unsigned o1[32];
#pragma unroll 1
            for (int st = 0; st < 2; ++st) {
                KVD dm, dl;
                const bf16_t* Kb = KDA; const bf16_t* Vb = VDA;
                dm.k = Kb + kr0 * 1024 + h * 128 + st * 64; dm.k2 = dm.k; dm.v = Vb + kr0 * 1024 + h * 128;
                dl.k = KDA + fr0 * 1024 + h * 128 + st * 64; dl.k2 = dl.k; dl.v = VDA + fr0 * 1024 + h * 128;
                dm.kf = C.cdk + (coff + kr0) * 1024 + h * 128 + st * 64; dm.vf = C.cdv + (coff + kr0) * 1024 + h * 128; dl.kf = nullptr; dl.vf = nullptr;
                if (samp) attn_pass<64, true>(lds, wid, QDA + (size_t)row * 1024 + h * 128 + st * 64, dm, dl, nmain, ntw, ntc, o, linv);
                else attn_pass<64, false>(lds, wid, QDA + (size_t)row * 1024 + h * 128 + st * 64, dm, dl, nmain, ntw, ntc, o, linv);
                if (st == 0) {
#pragma unroll
                    for (int c = 0; c < 4; ++c)
#pragma unroll
                        for (int r = 0; r < 16; r += 2) o1[c * 8 + (r >> 1)] = cvt_pk_bf16(o[c][r] * linv, o[c][r + 1] * linv);
                }
            }
            if (ntc > 0) {
                int rowe = row; asm volatile("" : "+v"(rowe));
                const int hi = (TID_NOW() >> 5) & 1;
                const float ll = C.lam * linv; float ss = 0.f;
#pragma unroll
                for (int c = 0; c < 4; ++c)
#pragma unroll
                    for (int r = 0; r < 16; r += 2) { const unsigned w = o1[c * 8 + (r >> 1)];
                        const float x0 = __uint_as_float(w << 16) - ll * o[c][r], x1 = __uint_as_float(w & 0xffff0000u) - ll * o[c][r + 1]; o[c][r] = x0; o[c][r + 1] = x1; ss += x0 * x0 + x1 * x1; }
                ss = add_x32(ss);
                const float rn = rsqrtf(ss * (1.f / 128.f) + EPS) * C.lam1m;
                const bf16_t* ga = GG + (size_t)rowe * 2048 + h * 128; bf16_t* mo = MRG + (size_t)rowe * 1024 + h * 128;
#pragma unroll
                for (int c = 0; c < 4; ++c)
#pragma unroll
                    for (int g = 0; g < 4; ++g) {
                        const int d0 = 32 * c + 8 * g + 4 * hi;
                        const u32x2 gw = ldgu2(ga + d0); const f32x4 gd = ldg4(C.gda + d0);
                        const float g0 = __uint_as_float(gw.x << 16), g1 = __uint_as_float(gw.x & 0xffff0000u), g2 = __uint_as_float(gw.y << 16), g3 = __uint_as_float(gw.y & 0xffff0000u);
                        f32x4 r; r[0] = o[c][4 * g + 0] * rn * gd[0] * g0; r[1] = o[c][4 * g + 1] * rn * gd[1] * g1; r[2] = o[c][4 * g + 2] * rn * gd[2] * g2; r[3] = o[c][4 * g + 3] * rn * gd[3] * g3;
                        st_bf16x4(mo + d0, r);
                    }
            }
        }
#endif
#ifndef NO_MLA
        {
            KVD dm, dl;
            const bf16_t* KN = (const bf16_t*)(C.ws + W_KN); const bf16_t* VM = (const bf16_t*)(C.ws + W_VM); const bf16_t* KR = (const bf16_t*)(C.ws + W_KR);
            dm.k = (samp ? (const bf16_t*)(C.ws + W_KNC) + coff * 1024 : KN) + kr0 * 1024 + h * 128; dm.k2 = (samp ? (const bf16_t*)(C.ws + W_KRC) + coff * 64 : KR) + kr0 * 64;
            dm.v = (samp ? (const bf16_t*)(C.ws + W_VMC) + coff * 1024 : VM) + kr0 * 1024 + h * 128;
            dl.k = KN + fr0 * 1024 + h * 128; dl.k2 = KR + fr0 * 64; dl.v = VM + fr0 * 1024 + h * 128;
            dm.kf = nullptr; dm.vf = nullptr; dl.kf = nullptr; dl.vf = nullptr;
            attn_pass<192, false>(lds, wid, (const bf16_t*)(C.ws + W_QM) + (size_t)row * 1536 + h * 192, dm, dl, nmain, ntw, ntc, o, linv);
            if (ntc > 0) {
                int rowe = row; asm volatile("" : "+v"(rowe));
                const int hi = (TID_NOW() >> 5) & 1;
                const bf16_t* gb = GG + (size_t)rowe * 2048 + 1024 + h * 128; bf16_t* mo = MRG + (size_t)rowe * 1024 + h * 128;
#pragma unroll
                for (int c = 0; c < 4; ++c)
#pragma unroll
                    for (int g = 0; g < 4; ++g) {
                        const int d0 = 32 * c + 8 * g + 4 * hi;
                        const u32x2 gw = ldgu2(gb + d0); const u32x2 xw = ldgu2(mo + d0);
                        const float g0 = __uint_as_float(gw.x << 16), g1 = __uint_as_float(gw.x & 0xffff0000u), g2 = __uint_as_float(gw.y << 16), g3 = __uint_as_float(gw.y & 0xffff0000u);
                        f32x4 r;
                        r[0] = __uint_as_float(xw.x << 16) + g0 * o[c][4 * g + 0] * linv; r[1] = __uint_as_float(xw.x & 0xffff0000u) + g1 * o[c][4 * g + 1] * linv;
                        r[2] = __uint_as_float(xw.y << 16) + g2 * o[c][4 * g + 2] * linv; r[3] = __uint_as_float(xw.y & 0xffff0000u) + g3 * o[c][4 * g + 3] * linv;
                        st_bf16x4(mo + d0, r);
                    }
            }
        }
#endif
    }
    __builtin_amdgcn_s_setprio(0);
}
__device__ __forceinline__ float wave_sum(float v) {
#pragma unroll
    for (int o = 1; o < 64; o <<= 1) v += __shfl_xor(v, o);
    return v;
}
__device__ __forceinline__ unsigned f2bf(float f) { unsigned u = __float_as_uint(f); return (u + 0x7fffu + ((u >> 16) & 1u)) >> 16; }
__device__ __forceinline__ unsigned pk2(float lo, float hi) { return f2bf(lo) | (f2bf(hi) << 16); }
__device__ __forceinline__ int ropemap(int v) { return 64 * ((v >> 5) & 3) + 32 * (v >> 7) + (v & 31); }

__device__ __forceinline__ void prep_weights(const Params& P, LAS unsigned char* lds, int gw, int ngw, int wave, int lane) {
    LAS float* scr = (LAS float*)(lds + wave * 8704);
    constexpr int IT0 = 16 * (NIN / 32), IT1 = 6 * (NQ / 32), IT2 = 4 * (NKV / 32), IT4 = 16 * 32, IT5 = 16 * (NUP / 32), IT6 = 44 * 32;
    constexpr int ITL = IT0 + IT1 + 2 * IT2 + IT4 + IT5 + IT6;
    for (int it = gw; it < 2 * ITL; it += ngw) {
        const int l = it / ITL; int r = it - l * ITL;
        int mat;
        if (r < IT0) mat = 0; else if ((r -= IT0) < IT1) mat = 1; else if ((r -= IT1) < IT2) mat = 2; else if ((r -= IT2) < IT2) mat = 3;
        else if ((r -= IT2) < IT4) mat = 4; else if ((r -= IT4) < IT5) mat = 5; else { r -= IT5; mat = 6; }
        const float* W; const float* gk = nullptr; bf16_t* WT; int K, NN; long stride;
        switch (mat) {
            case 0: W = P.in[8] + (size_t)l * 1024 * INC; gk = P.in[7] + l * 1024; WT = (bf16_t*)(P.ws + W_WIN) + (size_t)l * NIN * 1024; K = 1024; NN = NIN; stride = INC; break;
            case 1: W = P.in[16] + (size_t)l * QL * NQ; gk = P.in[15] + l * QL; WT = (bf16_t*)(P.ws + W_WQ) + (size_t)l * NQ * QL; K = QL; NN = NQ; stride = NQ; break;
            case 2: W = nullptr; gk = P.in[17] + l * KVL; WT = (bf16_t*)(P.ws + W_WKV) + (size_t)l * NKV * KVL; K = KVL; NN = NKV; stride = 128; break;
            case 3: W = nullptr; WT = (bf16_t*)(P.ws + W_WKVC) + (size_t)l * NKV * KVL; K = KVL; NN = NKV; stride = 128; break;
            case 4: W = P.in[20] + (size_t)l * 1024 * 1024; WT = (bf16_t*)(P.ws + W_WO) + (size_t)l * 1024 * 1024; K = 1024; NN = 1024; stride = 1024; break;
            case 5: W = P.in[22] + (size_t)l * 1024 * NUP; gk = P.in[21] + l * 1024; WT = (bf16_t*)(P.ws + W_WUP) + (size_t)l * NUP * 1024; K = 1024; NN = NUP; stride = NUP; break;
            default: W = P.in[25] + (size_t)l * DFF * 1024; WT = (bf16_t*)(P.ws + W_WDN) + (size_t)l * 1024 * DFF; K = DFF; NN = 1024; stride = 1024; break;
        }
        const int nblk = NN / 32, kb = r / nblk, nb = r - kb * nblk, k0 = 64 * kb, n0 = 32 * nb;
        const int np = n0 + (lane & 31); long off = -1;
        {
            const int tile = np >> 8, v = np & 255;
            switch (mat) {
                case 0:
                    if (tile < 4) off = 256 * tile + ropemap(v);
                    else if (tile < 8) off = 1024 + 256 * (tile - 4) + ropemap(v);
                    else if (tile < 12) off = 2048 + 256 * (tile - 8) + v;
                    else if (tile < 20) off = 3776 + 256 * (tile - 12) + v;
                    else if (tile == 20) off = 3456 + v;
                    else if (tile == 21) off = 3072 + v;
                    else { if (v < 128) off = 3072 + 256 + v; else { const int w = v - 128, wc = w >> 5; if (wc < 2) off = 3712 + 32 * ((w >> 4) & 1) + 16 * wc + (w & 15); } }
                    break;
                case 1:
                    if (tile < 4) off = (np >> 7) * 192 + (np & 127);
                    else { const int hh = 4 * (tile - 4) + ((v >> 5) & 3); off = hh * 192 + 128 + 32 * (v >> 7) + (v & 31); }
                    break;
                case 2: case 3: {
                    const int c = np & 1023, hh = c >> 7, n = c & 127;
                    W = (np < 1024 ? P.in[18] : P.in[19]) + (size_t)l * 8 * 256 * 128; off = (long)hh * 32768 + n; } break;
                case 5: off = (v < 128) ? 128 * tile + v : DFF + 128 * tile + (v - 128); break;
                default: off = np; break;
            }
        }
#pragma unroll 8
        for (int i = 0; i < 32; ++i) { const int kk = 2 * i + (lane >> 5); float v = 0.f;
            if (off >= 0) { v = W[(size_t)(k0 + kk) * stride + off]; if (gk) v *= gk[k0 + kk]; }
            scr[kk * 33 + (lane & 31)] = v; }
        asm volatile("s_waitcnt lgkmcnt(0)" ::: "memory");
        const int c = lane & 7;
#pragma unroll
        for (int j = 0; j < 4; ++j) { const int n = (lane >> 3) + 8 * j; const LAS float* s = scr + (8 * c) * 33 + n;
            u32x4 o; o.x = pk2(s[0 * 33], s[1 * 33]); o.y = pk2(s[2 * 33], s[3 * 33]); o.z = pk2(s[4 * 33], s[5 * 33]); o.w = pk2(s[6 * 33], s[7 * 33]);
            *(u32x4*)(WT + (size_t)(n0 + n) * K + k0 + 8 * c) = o; }
        asm volatile("s_waitcnt lgkmcnt(0)" ::: "memory");
    }
}

__device__ __forceinline__ void sincos_f(float a, float& s, float& c) {
    const float n = rintf(a * 0.6366197723675814f);
    float r = fmaf(-n, 1.5703125f, a); r = fmaf(-n, 4.837512969970703125e-4f, r); r = fmaf(-n, 7.54978995489188e-8f, r);
    const float r2 = r * r;
    const float sp = r + r * r2 * (-1.6666666667e-1f + r2 * (8.3333333333e-3f + r2 * (-1.9841269841e-4f + r2 * 2.7557319224e-6f)));
    const float cp = 1.f + r2 * (-0.5f + r2 * (4.1666666667e-2f + r2 * (-1.3888888889e-3f + r2 * (2.4801587302e-5f + r2 * -2.7557319224e-7f))));
    const int qd = ((int)n) & 3;
    s = (qd == 0) ? sp : (qd == 1) ? cp : (qd == 2) ? -sp : -cp;
    c = (qd == 0) ? cp : (qd == 1) ? -sp : (qd == 2) ? -cp : sp;
}

__device__ __forceinline__ void cvt_stream(const float* src, bf16_t* dst, size_t n8, size_t gt, size_t ngt) {
    for (size_t i = gt; i < n8; i += ngt) { const f32x4 a = *(const f32x4*)(src + i * 8), b = *(const f32x4*)(src + i * 8 + 4);
        u32x4 o; o.x = cvt_pk_bf16(a[0], a[1]); o.y = cvt_pk_bf16(a[2], a[3]); o.z = cvt_pk_bf16(b[0], b[1]); o.w = cvt_pk_bf16(b[2], b[3]); *(u32x4*)(dst + i * 8) = o; }
}

__device__ __forceinline__ void conv_fix_phase(const Params& P, int l, size_t gt, size_t ngt) {
    const bf16_t* UH = (const bf16_t*)(P.ws + W_U); bf16_t* ACT = (bf16_t*)(P.ws + W_ACT);
    const float* wc = P.in[23] + (size_t)l * 3 * NUP; const float* bc = P.in[24] + (size_t)l * NUP;
    constexpr int NCC = DFF / 8;
    for (size_t it = gt; it < (size_t)1024 * NCC; it += ngt) {
        const int sl = (int)(it / NCC), cc = (int)(it - (size_t)sl * NCC), j0 = cc * 8;
        if ((sl & 31) == 0) continue;
        float uu[4][2][8];
#pragma unroll
        for (int k = 0; k < 4; ++k)
#pragma unroll
            for (int gv = 0; gv < 2; ++gv) { const u32x4 a = ldgu4(UH + ((size_t)(k < 2 ? sl - 1 : sl) * 4 + (k < 2 ? 2 + k : k - 2)) * NUP + gv * DFF + j0);
#pragma unroll
                for (int e = 0; e < 4; ++e) { uu[k][gv][2 * e] = __uint_as_float(a[e] << 16); uu[k][gv][2 * e + 1] = __uint_as_float(a[e] & 0xffff0000u); } }
#pragma unroll
        for (int rr = 0; rr < 2; ++rr) {
            float res[8];
#pragma unroll
            for (int hf = 0; hf < 2; ++hf) {
                f32x4 w[2][4];
#pragma unroll
                for (int gv = 0; gv < 2; ++gv)
#pragma unroll
                    for (int k = 0; k < 4; ++k) w[gv][k] = ldg4((k < 3 ? wc + (size_t)k * NUP : bc) + gv * DFF + j0 + 4 * hf);
#pragma unroll
                for (int e = 0; e < 4; ++e) { const int q = 4 * hf + e;
                    const float cg = w[0][3][e] + w[0][0][e] * uu[rr][0][q] + w[0][1][e] * uu[rr + 1][0][q] + w[0][2][e] * uu[rr + 2][0][q];
                    const float cv = w[1][3][e] + w[1][0][e] * uu[rr][1][q] + w[1][1][e] * uu[rr + 1][1][q] + w[1][2][e] * uu[rr + 2][1][q];
                    res[q] = cg * sigmoidf_(cg) * cv; }
            }
            u32x4 o; o.x = cvt_pk_bf16(res[0], res[1]); o.y = cvt_pk_bf16(res[2], res[3]); o.z = cvt_pk_bf16(res[4], res[5]); o.w = cvt_pk_bf16(res[6], res[7]);
            *(GAS u32x4*)(ACT + ((size_t)(64 * sl + rr) * DFF + j0)) = o;
        }
    }
}
constexpr int LDS_BYTES = 147456;
template <class Epi> __device__ __forceinline__ void run_gemm(LAS unsigned char* lds, const int wid, const bf16_t* A, const bf16_t* Bt, int M, int N, int K, const Epi& E) {
    int gx = (int)gridDim.x, bx = (int)blockIdx.x, wv = wid; asm volatile("" : "+s"(gx), "+s"(bx), "+s"(wv));
    pg8::Gemm g{A, Bt, M, N, K}; pg8::StaticOrder S; S.init(M, N, gx, bx);
#ifndef NO_GEMM
    pg8::gemm_phase<Epi, pg8::StaticOrder, PG8_ALIGN, PG8_SP2>(lds, g, S, E, wv);
#endif
}

__global__ void __launch_bounds__(512, 2) fwd_megakernel(Params P) {
    extern __shared__ __attribute__((aligned(16))) unsigned char lds_raw[];
    LAS unsigned char* lds = (LAS unsigned char*)lds_raw;
    cg::grid_group grid = cg::this_grid();
    const int wave_s = __builtin_amdgcn_readfirstlane((int)threadIdx.x >> 6);
#define TID_DEFS const int lane = LANE_ID(), wave = wave_s, tid = (wave << 6) | lane; \
    const int G = gridDim.x, gw = blockIdx.x * 8 + wave, ngw = G * 8; const size_t gt = (size_t)blockIdx.x * 512 + tid, ngt = (size_t)G * 512; (void)lane; (void)gw; (void)ngw; (void)gt; (void)ngt;
    unsigned char* ws = P.ws; float* out = P.out;
#define gbar() do { asm volatile("s_waitcnt vmcnt(0) lgkmcnt(0)" ::: "memory"); __syncthreads(); bar_gen += gridDim.x; \
        if (wave_s == 0 && LANE_ID() == 0) { asm volatile("buffer_wbl2 sc1\n\ts_waitcnt vmcnt(0) lgkmcnt(0)" ::: "memory");     \
            __hip_atomic_fetch_add(ctl + 128, 1u, __ATOMIC_RELAXED, __HIP_MEMORY_SCOPE_AGENT); \
            while (__hip_atomic_load(ctl + 128, __ATOMIC_RELAXED, __HIP_MEMORY_SCOPE_AGENT) < bar_gen) __builtin_amdgcn_s_sleep(1); } \
        __syncthreads(); asm volatile("buffer_inv sc1\n\ts_waitcnt vmcnt(0) lgkmcnt(0)" ::: "memory");     } while (0)
#ifdef PROBE_SEL
    unsigned long long pr_acc = 0, pr_t0 = 0;
#define PR_BEGIN(c) do { if ((PROBE_SEL >> (c)) & 1) pr_t0 = __builtin_amdgcn_s_memrealtime(); } while (0)
#define PR_END(c) do { if ((PROBE_SEL >> (c)) & 1) pr_acc += __builtin_amdgcn_s_memrealtime() - pr_t0; } while (0)
#else
#define PR_BEGIN(c)
#define PR_END(c)
#endif
#define OPAQ() do { unsigned a_ = (unsigned)(uintptr_t)P.ws, b_ = (unsigned)((uintptr_t)P.ws >> 32), c_ = (unsigned)(uintptr_t)P.out, d_ = (unsigned)((uintptr_t)P.out >> 32); \
        asm volatile("" : "+s"(a_), "+s"(b_), "+s"(c_), "+s"(d_)); ws = (unsigned char*)(((uintptr_t)b_ << 32) | a_); out = (float*)(((uintptr_t)d_ << 32) | c_); } while (0)
    unsigned* ctl = (unsigned*)(ws + W_CTL); float* ctlf = (float*)(ws + W_CTL);
    float* rope = (float*)(ws + W_ROPE); float* SS = (float*)(ws + W_SS);
#define B_HX ((bf16_t*)(ws + W_HX))
#define B_X ((float*)(ws + W_X))
#define B_QDA ((bf16_t*)(ws + W_QDA))
#define B_KDA ((bf16_t*)(ws + W_KDA))
#define B_VDA ((bf16_t*)(ws + W_VDA))
#define B_GG ((bf16_t*)(ws + W_G))
#define B_CKV ((bf16_t*)(ws + W_CKV))
#define B_CQ ((bf16_t*)(ws + W_CQ))
#define B_KR ((bf16_t*)(ws + W_KR))
#define B_QM ((bf16_t*)(ws + W_QM))
#define B_KN ((bf16_t*)(ws + W_KN))
#define B_VM ((bf16_t*)(ws + W_VM))
#define B_MRG ((bf16_t*)(ws + W_MRG))
#define B_U ((bf16_t*)(ws + W_U))
#define B_ACT ((bf16_t*)(ws + W_ACT))
#define B_KC ((bf16_t*)(ws + W_KC))
#define B_VC ((bf16_t*)(ws + W_VC))
#define B_KRC ((bf16_t*)(ws + W_KRC))
#define B_CKVC ((bf16_t*)(ws + W_CKVC))
#define B_KNC ((bf16_t*)(ws + W_KNC))
#define B_VMC ((bf16_t*)(ws + W_VMC))
    PR_BEGIN(0);
    {
    TID_DEFS
#ifndef NO_PREP
    prep_weights(P, lds, gw, ngw, wave, lane);
#endif
    for (size_t idx = gt; idx < (size_t)2080 * 32; idx += ngt) {
        const int pos = (int)(idx >> 5), i = (int)(idx & 31);
        double inv = 1.0; for (int k = 0; k < i; ++k) inv *= 0.74989420933245582730;
        const double ang = (double)pos * inv; const double n = __builtin_rint(ang * 0.63661977236758134308);
        double r = __builtin_fma(-n, 1.57079632679489655800, ang); r = __builtin_fma(-n, 6.12323399573676603587e-17, r);
        const float rf = (float)r, r2 = rf * rf;
        const float sp = rf + rf * r2 * (-1.6666666667e-1f + r2 * (8.3333333333e-3f + r2 * (-1.9841269841e-4f + r2 * 2.7557319224e-6f)));
        const float cp = 1.f + r2 * (-0.5f + r2 * (4.1666666667e-2f + r2 * (-1.3888888889e-3f + r2 * (2.4801587302e-5f + r2 * -2.7557319224e-7f))));
        const int qd = ((int)n) & 3;
        rope[(size_t)pos * 64 + 32 + i] = (qd == 0) ? sp : (qd == 1) ? cp : (qd == 2) ? -sp : -cp;
        rope[(size_t)pos * 64 + i] = (qd == 0) ? cp : (qd == 1) ? -sp : (qd == 2) ? -cp : sp;
    }
    for (size_t idx = gt; idx < (size_t)8 * MT; idx += ngt) SS[MT + idx] = 0.f;
    if (blockIdx.x == 0 && tid < 64) {
        if (tid < 5) __hip_atomic_store(ctl + (tid == 4 ? 128 : tid * 16), 0u, __ATOMIC_RELAXED, __HIP_MEMORY_SCOPE_AGENT);
        for (int l = 0; l < 2; ++l) {
        OPAQ();
            const float a = wave_sum(P.in[10][l * 64 + lane] * P.in[11][l * 64 + lane]), b = wave_sum(P.in[12][l * 64 + lane] * P.in[13][l * 64 + lane]);
            const float li = 0.8f - 0.6f * expf(-0.3f * (float)l);
            if (lane == 0) { ctlf[64 + 2 * l] = expf(a) - expf(b) + li; ctlf[65 + 2 * l] = 1.f - li; }
        }
    }
    for (int row0 = 2 * gw; row0 < MT; row0 += 2 * ngw) {
        f32x4 v[2][4]; float s2[2] = {0.f, 0.f};
#pragma unroll
        for (int k = 0; k < 2; ++k) { const int row = row0 + k; const float* xr = (row >= MP ? P.in[1] + (size_t)(row - MP) * 1024 : P.in[0] + (size_t)row * 1024);
#pragma unroll
            for (int j = 0; j < 4; ++j) v[k][j] = ldg4(xr + 256 * j + 4 * lane); }
#pragma unroll
        for (int k = 0; k < 2; ++k) { const int row = row0 + k;
#pragma unroll
            for (int j = 0; j < 4; ++j) { s2[k] += sq4(v[k][j]); st_bf16x4(B_HX + (size_t)row * 1024 + 256 * j + 4 * lane, v[k][j]); }
            const float s = wave_sum(s2[k]); if (lane == 0) SS[row] = s; }
    }
    cvt_stream(P.in[4], B_CKVC, (size_t)2 * MC * 256 / 8, gt, ngt);
    cvt_stream(P.in[5], B_KRC, (size_t)2 * MC * 64 / 8, gt, ngt);
    }
    asm volatile("s_waitcnt vmcnt(0) lgkmcnt(0)" ::: "memory"); __syncthreads();
    if (wave_s == 0) asm volatile("buffer_wbl2 sc1\n\ts_waitcnt vmcnt(0) lgkmcnt(0)" ::: "memory");
    grid.sync();
    asm volatile("buffer_inv sc1\n\ts_waitcnt vmcnt(0) lgkmcnt(0)" ::: "memory");
    unsigned bar_gen = 0;
    PR_END(0);

#pragma unroll 1
    for (int l = 0; l < 2; ++l) {
        OPAQ();
        float* ssx_attn = SS + (size_t)(2 * l) * MT; float* ssx_ffn = SS + (size_t)(2 * l + 1) * MT; float* ssx_next = SS + (size_t)(2 * l + 2) * MT;
        float* sscq = SS + (size_t)(5 + l) * MT; float* ssckv = SS + (size_t)(7 + l) * MT;
        float* ckp = out + O_CKVP + (size_t)l * MP * 256; float* cks = out + O_CKVS + (size_t)l * MSMP * 256;
        PR_BEGIN(1);
        {
            EpiInProj E; E.ws = ws; E.out = out; E.bgate = P.in[9] + (size_t)l * 2048; E.l = l;
            run_gemm(lds, wave_s, B_HX, (const bf16_t*)(ws + W_WIN) + (size_t)l * NIN * 1024, MT, NIN, 1024, E);
        }
        gbar(); OPAQ();
        PR_END(1);
        PR_BEGIN(2);
        {
            EpiQ E; E.sscq = sscq; E.rope = rope; E.QM = B_QM;
            run_gemm(lds, wave_s, B_CQ, (const bf16_t*)(ws + W_WQ) + (size_t)l * NQ * QL, MT, NQ, QL, E);
        }
        {
            EpiKV<true> E; E.ss = ssckv; E.O0 = B_KN; E.O1 = B_VM;
            run_gemm(lds, wave_s, B_CKV, (const bf16_t*)(ws + W_WKV) + (size_t)l * NKV * KVL, MT, NKV, KVL, E);
        }
        if (l == 0) {
#pragma unroll 1
            for (int l2 = 0; l2 < 2; ++l2) {
                EpiKV<false> E; E.ss = nullptr; E.O0 = B_KNC + (size_t)l2 * MC * 1024; E.O1 = B_VMC + (size_t)l2 * MC * 1024;
                run_gemm(lds, wave_s, B_CKVC + (size_t)l2 * MC * 256, (const bf16_t*)(ws + W_WKVC) + (size_t)l2 * NKV * KVL, MC, NKV, KVL, E);
            }
        }
        {
            TID_DEFS
            const float* gk = P.in[17] + (size_t)l * 256;
            for (size_t idx = gt; idx < (size_t)MT * 64; idx += ngt) {
                const int row = (int)(idx >> 6), c4 = (int)(idx & 63);
                float* p = (row >= MP ? cks + (size_t)(row - MP) * 256 : ckp + (size_t)row * 256) + 4 * c4;
                const float rs = rsqrtf(ssckv[row] * (1.f / 256.f) + EPS); const f32x4 g = *(const f32x4*)(gk + 4 * c4);
                *(f32x4*)p = *(const f32x4*)p * rs * g;
            }
        }
        gbar(); OPAQ();
        PR_END(2);
        PR_BEGIN(3);
        {
            AttnCtx C; C.ws = ws; C.cdk = P.in[2]; C.cdv = P.in[3]; C.gda = P.in[14] + (size_t)l * 128; C.lam = __int_as_float(__builtin_amdgcn_readfirstlane(__float_as_int(ctlf[64 + 2 * l]))); C.lam1m = __int_as_float(__builtin_amdgcn_readfirstlane(__float_as_int(ctlf[65 + 2 * l]))); C.counter = ctl + 16 * l; C.l = l;
#ifndef NO_ATTN
            { int wv = wave_s; asm volatile("" : "+s"(wv)); attn_phase(lds, C, wv); }
#ifdef PROBE_ATTN2
            gbar(); OPAQ(); C.counter = ctl + 32 + 16 * l; { int wv = wave_s; asm volatile("" : "+s"(wv)); attn_phase(lds, C, wv); }
#endif
#endif
        }
        gbar(); OPAQ();
        PR_END(3);
        PR_BEGIN(4);
        {
            EpiRes E; E.xp = (l == 0) ? P.in[0] : nullptr; E.xs = P.in[1]; E.X = nullptr; E.HX = B_HX; E.ssn = ssx_ffn;
            run_gemm(lds, wave_s, B_MRG, (const bf16_t*)(ws + W_WO) + (size_t)l * 1024 * 1024, MT, 1024, 1024, E);
        }
        gbar(); OPAQ();
        PR_END(4);
        PR_BEGIN(5);
        {
            EpiUp E; E.ssx = ssx_ffn; E.ACT = B_ACT; E.UH = B_U; E.cvp = out + O_CVP + (size_t)l * 32 * 2 * NUP; E.cvs = out + O_CVS + (size_t)l * 16 * 2 * NUP;
            E.wc = P.in[23] + (size_t)l * 3 * NUP; E.bc = P.in[24] + (size_t)l * NUP; E.stc = P.in[6] + (size_t)l * 16 * 2 * NUP;
            run_gemm(lds, wave_s, B_HX, (const bf16_t*)(ws + W_WUP) + (size_t)l * NUP * 1024, MT, NUP, 1024, E);
        }
        gbar(); OPAQ();
        PR_END(5);
#ifndef NO_CONV
        PR_BEGIN(6);
        { TID_DEFS conv_fix_phase(P, l, gt, ngt); }
#endif
        gbar(); OPAQ();
        PR_END(6);
        PR_BEGIN(7);
        {
            EpiRes E; E.xp = nullptr; E.xs = nullptr; E.X = nullptr; E.HX = B_HX; E.ssn = ssx_next;
            run_gemm(lds, wave_s, B_ACT, (const bf16_t*)(ws + W_WDN) + (size_t)l * 1024 * DFF, MT, 1024, DFF, E);
        }
        gbar(); OPAQ();
        PR_END(7);
    }
    PR_BEGIN(8);
    {
        TID_DEFS
        const float* ssf = SS + (size_t)4 * MT; const float* gf = P.in[26];
        for (size_t idx = gt; idx < (size_t)MT * 256; idx += ngt) {
            const int row = (int)(idx >> 8), c4 = (int)(idx & 255);
            const float rs = rsqrtf(ssf[row] * (1.f / 1024.f) + EPS);
            const u32x2 hw = ldgu2(B_HX + (size_t)row * 1024 + 4 * c4);
            const f32x4 xv = (f32x4){__uint_as_float(hw.x << 16), __uint_as_float(hw.x & 0xffff0000u), __uint_as_float(hw.y << 16), __uint_as_float(hw.y & 0xffff0000u)};
            stg4(out + (size_t)row * 1024 + 4 * c4, xv * rs * ldg4(gf + 4 * c4));
        }
    }
#ifdef PROBE_SEL
    PR_END(8);
    if (blockIdx.x == 0) { const unsigned long long s0 = __builtin_amdgcn_s_memrealtime(); while (__builtin_amdgcn_s_memrealtime() - s0 < pr_acc) __builtin_amdgcn_s_sleep(32); }
#endif
}

extern "C" void kernel_launch(void* const* d_in, const int* in_sizes, int n_in, void* d_out, int out_size, void* d_ws, size_t ws_size, hipStream_t stream) {
    static int grid_blocks = 0;
    if (grid_blocks == 0) {
        if (n_in != 27 || (size_t)out_size != O_END || ws_size < W_END) { fprintf(stderr, "kernel_launch: unexpected problem (n_in %d, out %d vs %zu, ws %zu vs %zu)\n", n_in, out_size, (size_t)O_END, ws_size, (size_t)W_END); grid_blocks = -1; return; }
        int dev = 0, cus = 0, per_cu = 0;
        (void)hipGetDevice(&dev); (void)hipDeviceGetAttribute(&cus, hipDeviceAttributeMultiprocessorCount, dev);
        (void)hipFuncSetAttribute((const void*)fwd_megakernel, hipFuncAttributeMaxDynamicSharedMemorySize, LDS_BYTES);
        (void)hipOccupancyMaxActiveBlocksPerMultiprocessor(&per_cu, (const void*)fwd_megakernel, 512, LDS_BYTES);
        if (per_cu < 1) per_cu = 1;
        grid_blocks = cus * per_cu;
    }
    if (grid_blocks < 0) return;
    Params p{};
    for (int i = 0; i < 27; ++i) p.in[i] = (const float*)d_in[i];
    p.out = (float*)d_out; p.ws = (unsigned char*)d_ws;
    void* args[] = {&p};
    hipError_t e = hipLaunchCooperativeKernel((void*)fwd_megakernel, dim3(grid_blocks), dim3(512), args, LDS_BYTES, stream);
    if (e != hipSuccess) fprintf(stderr, "cooperative launch failed: %s (grid %d)\n", hipGetErrorString(e), grid_blocks);
}
```

```cpp
#include <hip/hip_runtime.h>
#include <hip/hip_cooperative_groups.h>
#include <cstdio>
#include <cstdint>
namespace cg = cooperative_groups;
#define LANE_ID() ({ int l_ = (int)__builtin_amdgcn_mbcnt_hi(~0u, __builtin_amdgcn_mbcnt_lo(~0u, 0u)); asm volatile("" : "+v"(l_)); l_; })
namespace pg8 {
#define PG8_LAS __attribute__((address_space(3)))
typedef unsigned short bf16_t;
typedef short bf16x8 __attribute__((ext_vector_type(8)));
typedef float f32x4 __attribute__((ext_vector_type(4)));
typedef unsigned u32x4 __attribute__((ext_vector_type(4)));
constexpr int BM = 256, BK = 64, HALF = 128, HTB = HALF * BK * 2  , STAGE_BYTES = 8 * HTB, NXCD = 8, WGM = 8;

__host__ __device__ __forceinline__ int lds_byte(int r, int c) { const int st = (r >> 4) * 2 + (c >> 5), rr = r & 15, cc = c & 31, ob = rr * 64 + cc * 2; return st * 1024 + (ob ^ (((ob >> 9) & 1) << 5)); }
__host__ __device__ __forceinline__ void stage_rc(int b, int& R, int& C) { const int st = b / 1024, sb = b % 1024, swz = sb ^ (((sb >> 9) & 1) << 5); R = (st >> 1) * 16 + swz / 64; C = (st & 1) * 32 + (swz % 64) / 2; }
__host__ __device__ __forceinline__ int perm32(int rho) { const int n = rho >> 4, i = rho & 15; return 8 * (i >> 2) + 4 * n + (i & 3); }

struct Unit { int pm, pn; };
struct Gemm { const bf16_t* A; const bf16_t* Bt; int M, N, K; };

struct StaticOrder {
    int nM, nN, nwg, G, c;
    __host__ __device__ void init(int M, int N, int G_, int c_) { nM = M / BM; nN = N / BM; nwg = nM * nN; G = G_; c = c_; }
    __host__ __device__ bool next(int i, Unit& u) const {
        const long L = (long)i * G + c; if (L >= nwg) return false;
        int wgid = (int)L; { const int q = nwg / NXCD, r = nwg % NXCD, xcd = wgid % NXCD, off = wgid / NXCD; wgid = (xcd < r ? xcd * (q + 1) : r * (q + 1) + (xcd - r) * q) + off; }
        const int nig = WGM * nN, gid = wgid / nig, fm = gid * WGM, gsz = (nM - fm) < WGM ? (nM - fm) : WGM;
        u.pm = fm + ((wgid % nig) % gsz); u.pn = (wgid % nig) / gsz; return true;
    }
    __device__ __forceinline__ void a_ready(const Unit&) const {}
    __device__ __forceinline__ void done(const Unit&) const {}
};

typedef float f32x2_cv __attribute__((ext_vector_type(2))); typedef __bf16 bf16x2_cv __attribute__((ext_vector_type(2)));
__device__ __forceinline__ unsigned cvt_pk_bf16(float lo, float hi) { f32x2_cv v = {lo, hi}; bf16x2_cv b = __builtin_convertvector(v, bf16x2_cv); return __builtin_bit_cast(unsigned, b); }
template <class Epi, class Sched, bool ALIGN_EPI = false, bool SP2 = false>
__device__ __forceinline__ void gemm_phase(PG8_LAS unsigned char* lds, const Gemm g, const Sched& S, const Epi& E, const int wid_in) {
    const int wid = wid_in, lane = LANE_ID(), tid = (wid << 6) | lane, wr = wid >> 2, wc = wid & 3, fr = lane & 15, fq = lane >> 4;
    const int K = g.K, nt = K / BK;
    unsigned voffA[2], voffB[2];
#pragma unroll
    for (int i = 0; i < 2; ++i) { int R, C; stage_rc(tid * 16 + i * 8192, R, C); const int Rb = Epi::PERM ? ((R & ~31) + perm32(R & 31)) : R;
        voffA[i] = (unsigned)(R * K + C) * 2u; voffB[i] = (unsigned)(Rb * K + C) * 2u; }
    const size_t kstep = (size_t)(BK * 2);
    const size_t hstep = (size_t)HALF * K * 2;
    const size_t tstep = 2 * hstep;
    const unsigned ldsw = (unsigned)wid * 1024u;
    const int aoff = lds_byte(wr * 64 + fr, fq * 8), boff = lds_byte(wc * 32 + fr, fq * 8);
#define PG8_SA(b, h) (((b) * 2 + (h)) * HTB)
#define PG8_SB(b, h) ((4 + (b) * 2 + (h)) * HTB)
#define PG8_STAGE(bufoff, gbase, voff) do { _Pragma("unroll") for (int _i = 0; _i < 2; ++_i) \
        __builtin_amdgcn_global_load_lds((const unsigned*)((const char*)(gbase) + (voff)[_i]), (PG8_LAS unsigned*)(lds + (bufoff) + ldsw + _i * 8192), 16, 0, 0); } while (0)
#define PG8_LDA(dst, b, h) do { _Pragma("unroll") for (int m = 0; m < 4; ++m) _Pragma("unroll") for (int k = 0; k < 2; ++k) dst[m][k] = *(const PG8_LAS bf16x8*)(lds + PG8_SA(b, h) + aoff + m * 2048 + k * 1024); } while (0)
#define PG8_LDB(dst, b, h) do { _Pragma("unroll") for (int n = 0; n < 2; ++n) _Pragma("unroll") for (int k = 0; k < 2; ++k) dst[n][k] = *(const PG8_LAS bf16x8*)(lds + PG8_SB(b, h) + boff + n * 2048 + k * 1024); } while (0)
#define PG8_MMA(ai, bj, At, Bt) do { __builtin_amdgcn_s_setprio(1); _Pragma("unroll") for (int m = 0; m < 4; ++m) _Pragma("unroll") for (int n = 0; n < 2; ++n) _Pragma("unroll") for (int k = 0; k < 2; ++k) \
        acc[ai][bj][m][n] = __builtin_amdgcn_mfma_f32_16x16x32_bf16(Bt[n][k], At[m][k], acc[ai][bj][m][n], 0, 0, 0); __builtin_amdgcn_s_setprio(0); } while (0)
#define PG8_WAIT_V(n) asm volatile("s_waitcnt vmcnt(" #n ")" ::: "memory")
#define PG8_WAIT_L(n) asm volatile("s_waitcnt lgkmcnt(" #n ")" ::: "memory")
#define PG8_BAR __builtin_amdgcn_s_barrier()
#define PG8_SCHED __builtin_amdgcn_sched_barrier(0)
    Unit cur, nxt; int ui = 0;
    if (!S.next(0, cur)) return;
    f32x4 acc[2][2][4][2];
#pragma unroll
    for (int a = 0; a < 2; ++a)
#pragma unroll
        for (int b = 0; b < 2; ++b)
#pragma unroll
            for (int m = 0; m < 4; ++m)
#pragma unroll
                for (int n = 0; n < 2; ++n) acc[a][b][m][n] = (f32x4){0.f, 0.f, 0.f, 0.f};
    bf16x8 At[4][2], B0[2][2], B1[2][2];
    const char* cA = (const char*)g.A + (size_t)cur.pm * tstep; const char* cB = (const char*)g.Bt + (size_t)cur.pn * tstep;
    S.a_ready(cur);
    if constexpr (SP2) {
        PG8_STAGE(PG8_SB(0, 0), cB, voffB); PG8_STAGE(PG8_SB(0, 1), cB + hstep, voffB); PG8_STAGE(PG8_SA(0, 0), cA, voffA); PG8_STAGE(PG8_SA(0, 1), cA + hstep, voffA);
        if (wr == 1) PG8_BAR;
        PG8_WAIT_V(2); PG8_BAR;
        PG8_STAGE(PG8_SB(1, 0), cB + kstep, voffB); PG8_STAGE(PG8_SA(1, 0), cA + kstep, voffA); PG8_STAGE(PG8_SB(1, 1), cB + hstep + kstep, voffB);
        PG8_WAIT_V(6); PG8_BAR;
    } else {
        PG8_STAGE(PG8_SB(0, 0), cB, voffB); PG8_STAGE(PG8_SA(0, 0), cA, voffA); PG8_STAGE(PG8_SB(0, 1), cB + hstep, voffB); PG8_STAGE(PG8_SA(0, 1), cA + hstep, voffA);
        if (wr == 1) PG8_BAR;
        PG8_WAIT_V(4); PG8_BAR;
        PG8_STAGE(PG8_SB(1, 0), cB + kstep, voffB); PG8_STAGE(PG8_SA(1, 0), cA + kstep, voffA); PG8_STAGE(PG8_SB(1, 1), cB + hstep + kstep, voffB);
        PG8_WAIT_V(6); PG8_BAR;
    }
    for (;;) {
        const bool has_next = S.next(ui + 1, nxt);
        const char* nA = has_next ? (const char*)g.A + (size_t)nxt.pm * tstep : cA; const char* nB = has_next ? (const char*)g.Bt + (size_t)nxt.pn * tstep : cB;
        for (int t = 0; t < nt; t += 2) {
            const bool last = (t == nt - 2);
            const char* a1 = cA + (size_t)(t + 1) * kstep;
            const char* a2 = last ? nA : cA + (size_t)(t + 2) * kstep; const char* b2 = last ? nB : cB + (size_t)(t + 2) * kstep;
            const char* a3 = a2 + kstep; const char* b3 = b2 + kstep;
            if (last && has_next) S.a_ready(nxt);
            if constexpr (SP2) {
            PG8_LDB(B0, 0, 0); PG8_LDB(B1, 0, 1); PG8_SCHED; PG8_LDA(At, 0, 0); PG8_STAGE(PG8_SA(1, 1), a1 + hstep, voffA);
            PG8_WAIT_V(8); PG8_WAIT_L(0); PG8_BAR; PG8_MMA(0, 0, At, B0); PG8_MMA(0, 1, At, B1); PG8_BAR; PG8_SCHED;
            PG8_LDA(At, 0, 1); PG8_STAGE(PG8_SB(0, 0), b2, voffB); PG8_STAGE(PG8_SB(0, 1), b2 + hstep, voffB); PG8_STAGE(PG8_SA(0, 0), a2, voffA);
            PG8_WAIT_V(8); PG8_WAIT_L(0); PG8_BAR; PG8_MMA(1, 0, At, B0); PG8_MMA(1, 1, At, B1); PG8_BAR; PG8_SCHED;
            PG8_LDB(B0, 1, 0); PG8_LDB(B1, 1, 1); PG8_SCHED; PG8_LDA(At, 1, 0); PG8_STAGE(PG8_SA(0, 1), a2 + hstep, voffA);
            PG8_WAIT_V(8); PG8_WAIT_L(0); PG8_BAR; PG8_MMA(0, 0, At, B0); PG8_MMA(0, 1, At, B1); PG8_BAR; PG8_SCHED;
            PG8_LDA(At, 1, 1); PG8_STAGE(PG8_SB(1, 0), b3, voffB); PG8_STAGE(PG8_SB(1, 1), b3 + hstep, voffB); PG8_STAGE(PG8_SA(1, 0), a3, voffA);
            PG8_WAIT_V(8); PG8_WAIT_L(0); PG8_BAR; PG8_MMA(1, 0, At, B0); PG8_MMA(1, 1, At, B1); PG8_BAR; PG8_SCHED;
            } else {
            PG8_LDB(B0, 0, 0); PG8_SCHED; PG8_LDA(At, 0, 0); PG8_STAGE(PG8_SA(1, 1), a1 + hstep, voffA);
            PG8_WAIT_L(8); PG8_BAR; PG8_WAIT_L(0); PG8_MMA(0, 0, At, B0); PG8_BAR; PG8_SCHED;
            PG8_LDB(B1, 0, 1); PG8_STAGE(PG8_SB(0, 0), b2, voffB);
            PG8_BAR; PG8_WAIT_L(0); PG8_MMA(0, 1, At, B1); PG8_BAR;
            PG8_LDA(At, 0, 1); PG8_STAGE(PG8_SA(0, 0), a2, voffA);
            PG8_BAR; PG8_WAIT_L(0); PG8_MMA(1, 0, At, B0); PG8_BAR; PG8_SCHED;
            PG8_STAGE(PG8_SB(0, 1), b2 + hstep, voffB);
            PG8_WAIT_V(6); PG8_BAR; PG8_MMA(1, 1, At, B1); PG8_BAR;
            PG8_LDB(B0, 1, 0); PG8_SCHED; PG8_LDA(At, 1, 0); PG8_STAGE(PG8_SA(0, 1), a2 + hstep, voffA);
            PG8_WAIT_L(8); PG8_BAR; PG8_WAIT_L(0); PG8_MMA(0, 0, At, B0); PG8_BAR; PG8_SCHED;
            PG8_LDB(B1, 1, 1); PG8_STAGE(PG8_SB(1, 0), b3, voffB);
            PG8_BAR; PG8_WAIT_L(0); PG8_MMA(0, 1, At, B1); PG8_BAR;
            PG8_LDA(At, 1, 1); PG8_STAGE(PG8_SA(1, 0), a3, voffA);
            PG8_BAR; PG8_WAIT_L(0); PG8_MMA(1, 0, At, B0); PG8_BAR; PG8_SCHED;
            PG8_STAGE(PG8_SB(1, 1), b3 + hstep, voffB);
            PG8_WAIT_V(6); PG8_BAR; PG8_MMA(1, 1, At, B1); PG8_BAR;
            }
        }
        if constexpr (ALIGN_EPI) { if (wr == 0) PG8_BAR; }
        if constexpr (!Epi::AFTER_DRAIN) { const int le = LANE_ID(); E(acc, cur, wr, wc, le & 15, le >> 4); S.done(cur); }
        if (!has_next) break;
#pragma unroll
        for (int a = 0; a < 2; ++a)
#pragma unroll
            for (int b = 0; b < 2; ++b)
#pragma unroll
                for (int m = 0; m < 4; ++m)
#pragma unroll
                    for (int n = 0; n < 2; ++n) acc[a][b][m][n] = (f32x4){0.f, 0.f, 0.f, 0.f};
        cur = nxt; cA = nA; cB = nB; ++ui;
        if constexpr (ALIGN_EPI) { if (wr == 1) PG8_BAR; }
    }
    PG8_WAIT_V(0);
    if constexpr (!ALIGN_EPI) { if (wr == 0) PG8_BAR; }
    PG8_BAR;
    if constexpr (Epi::AFTER_DRAIN) { E.fused(acc, cur, wr, wc, fr, fq, lds, wid, lane); S.done(cur); }
#undef PG8_SA
#undef PG8_SB
#undef PG8_STAGE
#undef PG8_LDA
#undef PG8_LDB
#undef PG8_MMA
#undef PG8_WAIT_V
#undef PG8_WAIT_L
#undef PG8_BAR
#undef PG8_SCHED
}
}
#define PG8_SP2 true
#define PG8_ALIGN true
using pg8::bf16_t; using pg8::bf16x8; using pg8::f32x4; using pg8::Unit; using pg8::cvt_pk_bf16;
#define LAS __attribute__((address_space(3)))
typedef float f32x16 __attribute__((ext_vector_type(16)));
typedef unsigned u32x2 __attribute__((ext_vector_type(2)));
typedef unsigned u32x4 __attribute__((ext_vector_type(4)));
typedef short v4i16_t __attribute__((ext_vector_type(4)));

constexpr int MP = 65536, MSMP = 512, MT = MP + MSMP, MC = 32768;
constexpr int INC = 5824, NIN = 5888, QL = 384, KVL = 256, NQ = 1536, NKV = 2048, DFF = 2816, NUP = 5632;
constexpr float EPS = 1e-6f, LOG2E = 1.4426950408889634f;
constexpr float QS_DA = 0.125f * LOG2E;
constexpr float QS_MLA = 0.07216878364870322f * LOG2E;
constexpr size_t O_DKP = (size_t)MT * 1024;
constexpr size_t O_DVP = O_DKP + 2 * (size_t)MP * 1024;
constexpr size_t O_CKVP = O_DVP + 2 * (size_t)MP * 1024;
constexpr size_t O_KRP = O_CKVP + 2 * (size_t)MP * 256;
constexpr size_t O_CVP = O_KRP + 2 * (size_t)MP * 64;
constexpr size_t O_DKS = O_CVP + 2 * 32 * 2 * 5632;
constexpr size_t O_DVS = O_DKS + 2 * 512 * 1024;
constexpr size_t O_CKVS = O_DVS + 2 * 512 * 1024;
constexpr size_t O_KRS = O_CKVS + 2 * 512 * 256;
constexpr size_t O_CVS = O_KRS + 2 * 512 * 64;
constexpr size_t O_END = O_CVS + 2 * 16 * 2 * 5632;
constexpr size_t A256(size_t x) { return (x + 255) & ~(size_t)255; }
constexpr size_t W_CTL = 0;
constexpr size_t W_ROPE = 4096;
constexpr size_t W_SS = A256(W_ROPE + (size_t)2080 * 64 * 4);
constexpr size_t W_WIN = A256(W_SS + (size_t)9 * MT * 4);
constexpr size_t W_WQ = A256(W_WIN + (size_t)2 * NIN * 1024 * 2);
constexpr size_t W_WKV = A256(W_WQ + (size_t)2 * NQ * QL * 2);
constexpr size_t W_WKVC = A256(W_WKV + (size_t)2 * NKV * KVL * 2);
constexpr size_t W_WO = A256(W_WKVC + (size_t)2 * NKV * KVL * 2);
constexpr size_t W_WUP = A256(W_WO + (size_t)2 * 1024 * 1024 * 2);
constexpr size_t W_WDN = A256(W_WUP + (size_t)2 * NUP * 1024 * 2);
constexpr size_t W_HX = A256(W_WDN + (size_t)2 * 1024 * DFF * 2);
constexpr size_t W_X = A256(W_HX + (size_t)MT * 1024 * 2);
constexpr size_t W_QDA = A256(W_X + (size_t)MT * 1024 * 4);
constexpr size_t W_KDA = A256(W_QDA + (size_t)MT * 1024 * 2);
constexpr size_t W_VDA = A256(W_KDA + (size_t)MT * 1024 * 2);
constexpr size_t W_G = A256(W_VDA + (size_t)MT * 1024 * 2);
constexpr size_t W_CKV = A256(W_G + (size_t)MT * 2048 * 2);
constexpr size_t W_CQ = A256(W_CKV + (size_t)MT * 256 * 2);
constexpr size_t W_KR = A256(W_CQ + (size_t)MT * 384 * 2);
constexpr size_t W_QM = A256(W_KR + (size_t)MT * 64 * 2);
constexpr size_t W_KN = A256(W_QM + (size_t)MT * 1536 * 2);
constexpr size_t W_VM = A256(W_KN + (size_t)MT * 1024 * 2);
constexpr size_t W_MRG = A256(W_VM + (size_t)MT * 1024 * 2);
constexpr size_t W_U = A256(W_MRG + (size_t)MT * 1024 * 2);
constexpr size_t W_ACT = A256(W_U + (size_t)MT * NUP * 2);
constexpr size_t W_KC = A256(W_ACT + (size_t)MT * DFF * 2);
constexpr size_t W_VC = A256(W_KC + (size_t)2 * MC * 1024 * 2);
constexpr size_t W_KRC = A256(W_VC + (size_t)2 * MC * 1024 * 2);
constexpr size_t W_CKVC = A256(W_KRC + (size_t)2 * MC * 64 * 2);
constexpr size_t W_KNC = A256(W_CKVC + (size_t)2 * MC * 256 * 2);
constexpr size_t W_VMC = A256(W_KNC + (size_t)2 * MC * 1024 * 2);
constexpr size_t W_END = A256(W_VMC + (size_t)2 * MC * 1024 * 2);

struct Params { const float* in[27]; float* out; unsigned char* ws; };

#define GAS __attribute__((address_space(1)))
__device__ __forceinline__ void st_bf16x4(bf16_t* p, f32x4 v) { u32x2 w; w.x = cvt_pk_bf16(v[0], v[1]); w.y = cvt_pk_bf16(v[2], v[3]); *(GAS u32x2*)p = w; }
__device__ __forceinline__ f32x4 ldg4(const float* p) { return *(const GAS f32x4*)p; }
__device__ __forceinline__ void stg4(float* p, f32x4 v) { *(GAS f32x4*)p = v; }
__device__ __forceinline__ u32x4 ldgu4(const void* p) { return *(const GAS u32x4*)p; }
__device__ __forceinline__ u32x2 ldgu2(const void* p) { return *(const GAS u32x2*)p; }
__device__ __forceinline__ float ldg1(const float* p) { return *(const GAS float*)p; }
__device__ __forceinline__ float fast_rcp(float x) { return __builtin_amdgcn_rcpf(x); }
__device__ __forceinline__ float fast_exp2(float x) { return __builtin_amdgcn_exp2f(x); }
__device__ __forceinline__ float sigmoidf_(float x) { return fast_rcp(1.f + fast_exp2(-x * LOG2E)); }
__device__ __forceinline__ float bf2f(unsigned short b) { return __uint_as_float((unsigned)b << 16); }
__device__ __forceinline__ int row_of(const Unit& u, int ai, int wr, int m, int fr) { return u.pm * 256 + ai * 128 + wr * 64 + m * 16 + fr; }
__device__ __forceinline__ float sq4(f32x4 v) { return (v[0] * v[0] + v[1] * v[1]) + (v[2] * v[2] + v[3] * v[3]); }

__device__ __forceinline__ float add_x16(float s) { return s + __int_as_float(__builtin_amdgcn_ds_swizzle(__float_as_int(s), 0x401F)); }
__device__ __forceinline__ float add_x32(float s) { auto rr = __builtin_amdgcn_permlane32_swap(__float_as_uint(s), __float_as_uint(s), false, false); return __uint_as_float(rr[0]) + __uint_as_float(rr[1]); }
__device__ __forceinline__ float max_x32(float s) { auto rr = __builtin_amdgcn_permlane32_swap(__float_as_uint(s), __float_as_uint(s), false, false); return fmaxf(__uint_as_float(rr[0]), __uint_as_float(rr[1])); }
#define LOAD_RS8(name, ptr, scale, mul) float name[2][4]; { _Pragma("unroll") for (int ai_ = 0; ai_ < 2; ++ai_) _Pragma("unroll") for (int m_ = 0; m_ < 4; ++m_) name[ai_][m_] = ldg1((ptr) + row_of(u, ai_, wr, m_, fr)); \
    _Pragma("unroll") for (int ai_ = 0; ai_ < 2; ++ai_) _Pragma("unroll") for (int m_ = 0; m_ < 4; ++m_) name[ai_][m_] = rsqrtf(name[ai_][m_] * (scale) + EPS) * (mul); }
struct EpiInProj {
    static constexpr bool PERM = false, AFTER_DRAIN = false;
    unsigned char* ws; float* out; const float* bgate; int l;
    __device__ __forceinline__ void operator()(const f32x4 (&acc)[2][2][4][2], const Unit& u, int wr, int wc, int fr, int fq) const {
        const int pn = u.pn;
        const float* SSb = (const float*)(ws + W_SS); const float* ssx = SSb + (size_t)(2 * l) * MT; const float* rope = (const float*)(ws + W_ROPE);
        float* sscq = (float*)(ws + W_SS) + (size_t)(5 + l) * MT; float* ssckv = (float*)(ws + W_SS) + (size_t)(7 + l) * MT;
        bf16_t* QDA = (bf16_t*)(ws + W_QDA); bf16_t* KDA = (bf16_t*)(ws + W_KDA); bf16_t* VDA = (bf16_t*)(ws + W_VDA); bf16_t* G = (bf16_t*)(ws + W_G);
        bf16_t* CKV = (bf16_t*)(ws + W_CKV); bf16_t* CQ = (bf16_t*)(ws + W_CQ); bf16_t* KR = (bf16_t*)(ws + W_KR);
        float* dkp = out + O_DKP + (size_t)l * MP * 1024; float* dks = out + O_DKS + (size_t)l * MSMP * 1024; float* dvp = out + O_DVP + (size_t)l * MP * 1024; float* dvs = out + O_DVS + (size_t)l * MSMP * 1024;
        float* ckp = out + O_CKVP + (size_t)l * MP * 256; float* cks = out + O_CKVS + (size_t)l * MSMP * 256; float* krp = out + O_KRP + (size_t)l * MP * 64; float* krs = out + O_KRS + (size_t)l * MSMP * 64;
        LOAD_RS8(rs8, ssx, 1.f / 1024.f, 1.f)
        if (pn < 8) {
            const bool isk = pn >= 4; const int cb = 256 * (pn & 3) + 64 * wc;
#pragma unroll
            for (int ai = 0; ai < 2; ++ai)
#pragma unroll
                for (int m = 0; m < 4; ++m) { if ((m & 1) == 0) asm volatile("" ::: "memory");
                    const int row = row_of(u, ai, wr, m, fr); const float rstd = rs8[ai][m];
                    const bool samp = row >= MP; const int orow = samp ? row - MP : row; const int pos = samp ? 2048 + (orow & 31) : (row & 2047);
                    const float* rt = rope + (size_t)pos * 64;
#pragma unroll
                    for (int n = 0; n < 2; ++n) {
                        const int i0 = 16 * n + 4 * fq; const f32x4 cs = ldg4(rt + i0), sn = ldg4(rt + 32 + i0);
                        const f32x4 x1 = acc[ai][0][m][n] * rstd, x2 = acc[ai][1][m][n] * rstd;
                        f32x4 o1 = x1 * cs - x2 * sn, o2 = x2 * cs + x1 * sn;
                        if (!isk) { o1 = o1 * QS_DA; o2 = o2 * QS_DA; bf16_t* q = QDA + (size_t)row * 1024 + cb + i0; st_bf16x4(q, o1); st_bf16x4(q + 32, o2); }
                        else { bf16_t* k = KDA + (size_t)row * 1024 + cb + i0; st_bf16x4(k, o1); st_bf16x4(k + 32, o2);
                               float* d = (samp ? dks : dkp) + (size_t)orow * 1024 + cb + i0; stg4(d, o1); stg4((d + 32), o2); }
                    }
                }
        } else if (pn < 12) {
            const int cb = 256 * (pn - 8) + 32 * wc + 4 * fq;
#pragma unroll
            for (int ai = 0; ai < 2; ++ai)
#pragma unroll
                for (int m = 0; m < 4; ++m) { if ((m & 1) == 0) asm volatile("" ::: "memory");
                    const int row = row_of(u, ai, wr, m, fr); const float rstd = rs8[ai][m];
                    const bool samp = row >= MP; const int orow = samp ? row - MP : row;
                    float* d = (samp ? dvs : dvp) + (size_t)orow * 1024 + cb; bf16_t* v = VDA + (size_t)row * 1024 + cb;
#pragma unroll
                    for (int bj = 0; bj < 2; ++bj)
#pragma unroll
                        for (int n = 0; n < 2; ++n) { const f32x4 x = acc[ai][bj][m][n] * rstd; stg4((d + 128 * bj + 16 * n), x); st_bf16x4(v + 128 * bj + 16 * n, x); }
                }
        } else if (pn < 20) {
            const int cb = 256 * (pn - 12) + 32 * wc + 4 * fq;
            f32x4 bv[2][2];
#pragma unroll
            for (int bj = 0; bj < 2; ++bj)
#pragma unroll
                for (int n = 0; n < 2; ++n) bv[bj][n] = ldg4(bgate + cb + 128 * bj + 16 * n);
#pragma unroll
            for (int ai = 0; ai < 2; ++ai)
#pragma unroll
                for (int m = 0; m < 4; ++m) { if ((m & 1) == 0) asm volatile("" ::: "memory");
                    const int row = row_of(u, ai, wr, m, fr); const float rstd = rs8[ai][m];
                    bf16_t* g = G + (size_t)row * 2048 + cb;
#pragma unroll
                    for (int bj = 0; bj < 2; ++bj)
#pragma unroll
                        for (int n = 0; n < 2; ++n) { f32x4 x = acc[ai][bj][m][n] * rstd + bv[bj][n];
                            x[0] = sigmoidf_(x[0]); x[1] = sigmoidf_(x[1]); x[2] = sigmoidf_(x[2]); x[3] = sigmoidf_(x[3]); st_bf16x4(g + 128 * bj + 16 * n, x); }
                }
        } else if (pn == 20) {
            const int cb = 32 * wc + 4 * fq;
#pragma unroll
            for (int ai = 0; ai < 2; ++ai)
#pragma unroll
                for (int m = 0; m < 4; ++m) { if ((m & 1) == 0) asm volatile("" ::: "memory");
                    const int row = row_of(u, ai, wr, m, fr); const float rstd = rs8[ai][m];
                    const bool samp = row >= MP; const int orow = samp ? row - MP : row;
                    float* d = (samp ? cks : ckp) + (size_t)orow * 256 + cb; bf16_t* c = CKV + (size_t)row * 256 + cb; float s = 0.f;
#pragma unroll
                    for (int bj = 0; bj < 2; ++bj)
#pragma unroll
                        for (int n = 0; n < 2; ++n) { const f32x4 x = acc[ai][bj][m][n] * rstd; s += sq4(x); stg4((d + 128 * bj + 16 * n), x); st_bf16x4(c + 128 * bj + 16 * n, x); }
                    s = add_x16(s); s = add_x32(s);
                    if (fq == 0) unsafeAtomicAdd(ssckv + row, s);
                }
        } else if (pn == 21) {
            const int cb = 32 * wc + 4 * fq;
#pragma unroll
            for (int ai = 0; ai < 2; ++ai)
#pragma unroll
                for (int m = 0; m < 4; ++m) { if ((m & 1) == 0) asm volatile("" ::: "memory");
                    const int row = row_of(u, ai, wr, m, fr); const float rstd = rs8[ai][m];
                    bf16_t* c = CQ + (size_t)row * 384 + cb; float s = 0.f;
#pragma unroll
                    for (int bj = 0; bj < 2; ++bj)
#pragma unroll
                        for (int n = 0; n < 2; ++n) { const f32x4 x = acc[ai][bj][m][n] * rstd; s += sq4(x); st_bf16x4(c + 128 * bj + 16 * n, x); }
                    s = add_x16(s); s = add_x32(s);
                    if (fq == 0) unsafeAtomicAdd(sscq + row, s);
                }
        } else {
#pragma unroll
            for (int ai = 0; ai < 2; ++ai)
#pragma unroll
                for (int m = 0; m < 4; ++m) { if ((m & 1) == 0) asm volatile("" ::: "memory");
                    const int row = row_of(u, ai, wr, m, fr); const float rstd = rs8[ai][m];
                    const bool samp = row >= MP; const int orow = samp ? row - MP : row; const int pos = samp ? 2048 + (orow & 31) : (row & 2047);
                    bf16_t* c = CQ + (size_t)row * 384 + 256 + 32 * wc + 4 * fq; float s = 0.f;
#pragma unroll
                    for (int n = 0; n < 2; ++n) { const f32x4 x = acc[ai][0][m][n] * rstd; s += sq4(x); st_bf16x4(c + 16 * n, x); }
                    s = add_x16(s); s = add_x32(s);
                    if (fq == 0) unsafeAtomicAdd(sscq + row, s);
                    if (wc < 2) {
                        const int i0 = 16 * wc + 4 * fq; const float* rt = rope + (size_t)pos * 64;
                        const f32x4 cs = ldg4(rt + i0), sn = ldg4(rt + 32 + i0);
                        const f32x4 x1 = acc[ai][1][m][0] * rstd, x2 = acc[ai][1][m][1] * rstd;
                        const f32x4 o1 = x1 * cs - x2 * sn, o2 = x2 * cs + x1 * sn;
                        float* d = (samp ? krs : krp) + (size_t)orow * 64 + i0; stg4(d, o1); stg4((d + 32), o2);
                        bf16_t* k = KR + (size_t)row * 64 + i0; st_bf16x4(k, o1); st_bf16x4(k + 32, o2);
                    }
                }
        }
    }
};

struct EpiQ {
    static constexpr bool PERM = false, AFTER_DRAIN = false;
    const float* sscq; const float* rope; bf16_t* QM;
    __device__ __forceinline__ void operator()(const f32x4 (&acc)[2][2][4][2], const Unit& u, int wr, int wc, int fr, int fq) const {
        const int pn = u.pn;
        LOAD_RS8(rs8, sscq, 1.f / 384.f, QS_MLA)
#pragma unroll
        for (int ai = 0; ai < 2; ++ai)
#pragma unroll
            for (int m = 0; m < 4; ++m) { if ((m & 1) == 0) asm volatile("" ::: "memory");
                const int row = row_of(u, ai, wr, m, fr); const float rs = rs8[ai][m];
                bf16_t* q = QM + (size_t)row * 1536;
                if (pn < 4) {
#pragma unroll
                    for (int bj = 0; bj < 2; ++bj)
#pragma unroll
                        for (int n = 0; n < 2; ++n) st_bf16x4(q + (2 * pn + bj) * 192 + 32 * wc + 16 * n + 4 * fq, acc[ai][bj][m][n] * rs);
                } else {
                    const int pos = row >= MP ? 2048 + ((row - MP) & 31) : (row & 2047); const float* rt = rope + (size_t)pos * 64;
                    bf16_t* qh = q + (4 * (pn - 4) + wc) * 192 + 128;
#pragma unroll
                    for (int n = 0; n < 2; ++n) {
                        const int i0 = 16 * n + 4 * fq; const f32x4 cs = ldg4(rt + i0), sn = ldg4(rt + 32 + i0);
                        const f32x4 x1 = acc[ai][0][m][n] * rs, x2 = acc[ai][1][m][n] * rs;
                        st_bf16x4(qh + i0, x1 * cs - x2 * sn); st_bf16x4(qh + 32 + i0, x2 * cs + x1 * sn);
                    }
                }
            }
    }
};

template <bool HAS_SS> struct EpiKV {
    static constexpr bool PERM = false, AFTER_DRAIN = false;
    const float* ss; bf16_t *O0, *O1;
    __device__ __forceinline__ void operator()(const f32x4 (&acc)[2][2][4][2], const Unit& u, int wr, int wc, int fr, int fq) const {
        bf16_t* base = (u.pn < 4 ? O0 : O1) + 256 * (u.pn & 3) + 32 * wc + 4 * fq;
        float rs8[2][4];
        if constexpr (HAS_SS) { LOAD_RS8(t8, ss, 1.f / 256.f, 1.f) _Pragma("unroll") for (int a = 0; a < 2; ++a) _Pragma("unroll") for (int b = 0; b < 4; ++b) rs8[a][b] = t8[a][b]; }
#pragma unroll
        for (int ai = 0; ai < 2; ++ai)
#pragma unroll
            for (int m = 0; m < 4; ++m) { if ((m & 1) == 0) asm volatile("" ::: "memory");
                const int row = row_of(u, ai, wr, m, fr); const float rs = HAS_SS ? rs8[ai][m] : 1.f;
                bf16_t* o = base + (size_t)row * 1024;
#pragma unroll
                for (int bj = 0; bj < 2; ++bj)
#pragma unroll
                    for (int n = 0; n < 2; ++n) st_bf16x4(o + 128 * bj + 16 * n, acc[ai][bj][m][n] * rs);
            }
    }
};

struct EpiRes {
    static constexpr bool PERM = false, AFTER_DRAIN = false;
    const float* xp; const float* xs; float* X; bf16_t* HX; float* ssn;
    __device__ __forceinline__ void operator()(const f32x4 (&acc)[2][2][4][2], const Unit& u, int wr, int wc, int fr, int fq) const {
        const int cb = 256 * u.pn + 32 * wc + 4 * fq;
#pragma unroll
        for (int ai = 0; ai < 2; ++ai)
#pragma unroll
            for (int m = 0; m < 4; ++m) { if ((m & 1) == 0) asm volatile("" ::: "memory");
                const int row = row_of(u, ai, wr, m, fr);
                bf16_t* h = HX + (size_t)row * 1024 + cb; float s = 0.f;
                f32x4 xo[2][2];
                if (xp) { const float* xi = (row >= MP ? xs + (size_t)(row - MP) * 1024 : xp + (size_t)row * 1024) + cb;
#pragma unroll
                    for (int bj = 0; bj < 2; ++bj)
#pragma unroll
                        for (int n = 0; n < 2; ++n) xo[bj][n] = ldg4(xi + 128 * bj + 16 * n); }
                else {
#pragma unroll
                    for (int bj = 0; bj < 2; ++bj)
#pragma unroll
                        for (int n = 0; n < 2; ++n) { const u32x2 w = ldgu2(h + 128 * bj + 16 * n);
                            xo[bj][n] = (f32x4){__uint_as_float(w.x << 16), __uint_as_float(w.x & 0xffff0000u), __uint_as_float(w.y << 16), __uint_as_float(w.y & 0xffff0000u)}; } }
#pragma unroll
                for (int bj = 0; bj < 2; ++bj)
#pragma unroll
                    for (int n = 0; n < 2; ++n) { const f32x4 x = xo[bj][n] + acc[ai][bj][m][n]; s += sq4(x); st_bf16x4(h + 128 * bj + 16 * n, x);
                        if (X) stg4((X + (size_t)row * 1024 + cb + 128 * bj + 16 * n), x); }
                s = add_x16(s); s = add_x32(s);
                if (fq == 0) unsafeAtomicAdd(ssn + row, s);
            }
    }
};

template <int CTRL> __device__ __forceinline__ float dpp_f(float old, float src) { return __int_as_float(__builtin_amdgcn_update_dpp(__float_as_int(old), __float_as_int(src), CTRL, 0xf, 0xf, false)); }
struct EpiUp {
    static constexpr bool PERM = false, AFTER_DRAIN = false;
    const float* ssx; bf16_t* ACT; bf16_t* UH; float* cvp; float* cvs; const float* wc; const float* bc; const float* stc;
    __device__ __forceinline__ void operator()(const f32x4 (&acc)[2][2][4][2], const Unit& u, int wr, int wc_, int fr, int fq) const {
        const int cb = 128 * u.pn + 32 * wc_ + 4 * fq;
        const bool samp = u.pm >= 256;
        LOAD_RS8(rs8, ssx, 1.f / 1024.f, 1.f)
#pragma unroll
        for (int ai = 0; ai < 2; ++ai)
#pragma unroll
            for (int m = 0; m < 4; ++m) { asm volatile("" ::: "memory");
                const int row = row_of(u, ai, wr, m, fr); const float rs = rs8[ai][m];
                const bool from_prev = samp ? (m & 1) : (m > 0);
                const bool seq0 = !samp && m == 0 && ((row - fr) & 2047) == 0;
                const bool defer = !samp && m == 0 && !seq0 && fr < 2;
                float* cv = nullptr;
                if (samp) { const int r = row - MP, sq = r & 31; if (sq >= 30) cv = cvs + ((size_t)(r >> 5) * 2 + (sq - 30)) * NUP + cb; }
                else { const int sq = row & 2047; if (sq >= 2046) cv = cvp + ((size_t)(row >> 11) * 2 + (sq - 2046)) * NUP + cb; }
                bf16_t* uh = nullptr;
                if (!samp) { if (m == 0 && fr < 2) uh = UH + ((size_t)(row >> 6) * 4 + fr) * NUP + cb; else if (m == 3 && fr >= 14) uh = UH + ((size_t)(row >> 6) * 4 + 2 + (fr - 14)) * NUP + cb; }
                const float* st0 = stc + (size_t)(samp ? (row - MP) >> 5 : 0) * 2 * NUP + cb;
#pragma unroll
                for (int n = 0; n < 2; ++n) {
                    f32x4 cc[2];
#pragma unroll
                    for (int bj = 0; bj < 2; ++bj) {
                        const int co = DFF * bj + 16 * n;
                        const f32x4 x = acc[ai][bj][m][n] * rs;
                        if (cv) stg4(cv + co, x);
                        if (uh) st_bf16x4(uh + co, x);
                        f32x4 c1, c2;
                        if (from_prev) { const f32x4 xp = acc[ai][bj][m > 0 ? m - 1 : 0][n] * rs8[ai][m > 0 ? m - 1 : 0];
#pragma unroll
                            for (int j = 0; j < 4; ++j) { c1[j] = dpp_f<0x121>(0.f, xp[j]); c2[j] = dpp_f<0x122>(0.f, xp[j]); } }
                        else if (samp) { c1 = ldg4(st0 + NUP + co); c2 = ldg4(st0 + (size_t)(fr & 1) * NUP + co); }
                        else { c1 = (f32x4){0.f, 0.f, 0.f, 0.f}; c2 = c1; }
                        const f32x4 w0 = ldg4(wc + cb + co), w1 = ldg4(wc + NUP + cb + co), w2 = ldg4(wc + 2 * NUP + cb + co), bb = ldg4(bc + cb + co);
#pragma unroll
                        for (int j = 0; j < 4; ++j) { const float p1 = dpp_f<0x111>(c1[j], x[j]), p2 = dpp_f<0x112>(c2[j], x[j]); cc[bj][j] = bb[j] + w0[j] * p2 + w1[j] * p1 + w2[j] * x[j]; }
                    }
                    if (!defer) { f32x4 r;
#pragma unroll
                        for (int j = 0; j < 4; ++j) r[j] = cc[0][j] * sigmoidf_(cc[0][j]) * cc[1][j];
                        st_bf16x4(ACT + (size_t)row * DFF + cb + 16 * n, r); }
                }
            }
    }
};
struct KVD { const bf16_t* k; const bf16_t* k2; const bf16_t* v; const float* kf; const float* vf; };
constexpr int ATT_KBUF = 64 * 400, ATT_VOFF = 2 * ATT_KBUF, ATT_VIMG = 32 * 320, ATT_VBUF = 2 * ATT_VIMG;

template <int DQK, bool F32M>
__device__ __forceinline__ void attn_pass(LAS unsigned char* lds, const int wid, const bf16_t* qrow, const KVD& dm, const KVD& dl, int nmain, int ntw, int ntc, f32x16 (&o)[4], float& linv) {
    constexpr int NCH = DQK / 8, KST = DQK * 2 + 16, NKI = NCH / 8, NS = DQK / 16;
    const int lane = LANE_ID(), tid = (wid << 6) | lane, r32 = lane & 31, hi = lane >> 5;
    bf16x8 q[NS];
#pragma unroll
    for (int s = 0; s < NS; ++s) q[s] = __builtin_bit_cast(bf16x8, ldgu4(qrow + 16 * s + 8 * hi));
    u32x4 kr[NKI], vr[2], kr2[F32M ? NKI : 1], vr2[F32M ? 2 : 1];
#define ATT_GLOADK(t) do { const bool lastt = (t) >= nmain; const KVD& d = lastt ? dl : dm; const int rb = lastt ? 0 : (t) * 64; const int rm = lastt ? 31 : 63; \
        _Pragma("unroll") for (int i = 0; i < NKI; ++i) { const int id = tid + 512 * i, kro = id / NCH, kc = id - kro * NCH; const int r = rb + (kro & rm); \
            if (F32M && !lastt) { const float* p_ = d.kf + (size_t)r * 1024 + kc * 8; kr[i] = ldgu4(p_); kr2[F32M ? i : 0] = ldgu4(p_ + 4); } \
            else kr[i] = (DQK == 64 || kc < 16) ? ldgu4(d.k + (size_t)r * 1024 + kc * 8) : ldgu4(d.k2 + (size_t)r * 64 + (kc - 16) * 8); } } while (0)
#define ATT_GLOADV(t) do { const bool lastt = (t) >= nmain; const KVD& d = lastt ? dl : dm; const int rb = lastt ? 0 : (t) * 64; const int rm = lastt ? 31 : 63; \
        _Pragma("unroll") for (int i = 0; i < 2; ++i) { const int r = rb + (((tid >> 4) + 32 * i) & rm); \
            if (F32M && !lastt) { const float* p_ = d.vf + (size_t)r * 1024 + (tid & 15) * 8; vr[i] = ldgu4(p_); vr2[F32M ? i : 0] = ldgu4(p_ + 4); } \
            else vr[i] = ldgu4(d.v + (size_t)r * 1024 + (tid & 15) * 8); } } while (0)
#define ATT_PK8(a_, b_) (u32x4){cvt_pk_bf16(__uint_as_float((a_).x), __uint_as_float((a_).y)), cvt_pk_bf16(__uint_as_float((a_).z), __uint_as_float((a_).w)), cvt_pk_bf16(__uint_as_float((b_).x), __uint_as_float((b_).y)), cvt_pk_bf16(__uint_as_float((b_).z), __uint_as_float((b_).w))}
#define ATT_LSTORE(b, tt) do { const bool cvt_ = F32M && (tt) < nmain; \
        _Pragma("unroll") for (int i = 0; i < NKI; ++i) { const int id = tid + 512 * i, kro = id / NCH, kc = id - kro * NCH; *(LAS u32x4*)(lds + (b) * ATT_KBUF + kro * KST + kc * 16) = cvt_ ? ATT_PK8(kr[i], kr2[F32M ? i : 0]) : kr[i]; } \
        _Pragma("unroll") for (int i = 0; i < 2; ++i) *(LAS u32x4*)(lds + ATT_VOFF + (b) * ATT_VBUF + i * ATT_VIMG + (tid >> 4) * 320 + (tid & 15) * 16) = cvt_ ? ATT_PK8(vr[i], vr2[F32M ? i : 0]) : vr[i]; } while (0)
    ATT_GLOADK(0); ATT_GLOADV(0); ATT_LSTORE(0, 0); __syncthreads();
    float m_run = 0.f, l_run = 0.f;
#pragma unroll
    for (int c = 0; c < 4; ++c)
#pragma unroll
        for (int r = 0; r < 16; ++r) o[c][r] = 0.f;
    const int vlane = (4 * hi + ((lane & 15) >> 2)) * 320 + (2 * ((lane >> 4) & 1) + ((lane & 3) >> 1)) * 16 + 8 * (lane & 1);
    for (int t = 0; t < ntw; ++t) {
        if (t + 1 < ntw) ATT_GLOADK(t + 1);
        bool vloaded = false;
        if (t < ntc) {
            const LAS unsigned char* kb = lds + (t & 1) * ATT_KBUF + r32 * KST + hi * 16;
            const LAS unsigned char* vb = lds + ATT_VOFF + (t & 1) * ATT_VBUF;
            f32x16 p0, p1;
#pragma unroll
            for (int r = 0; r < 16; ++r) { p0[r] = 0.f; p1[r] = 0.f; }
            constexpr int KCH = 2, NG = NS / KCH, NB = (DQK == 64) ? 2 : 1;
            bf16x8 kf[NB][2 * KCH];
#define ATT_LDK(ch, b) do { _Pragma("unroll") for (int j_ = 0; j_ < KCH; ++j_) { kf[b][2 * j_] = *(const LAS bf16x8*)(kb + (KCH * (ch) + j_) * 32); kf[b][2 * j_ + 1] = *(const LAS bf16x8*)(kb + 32 * KST + (KCH * (ch) + j_) * 32); } } while (0)
            ATT_LDK(0, 0); __builtin_amdgcn_sched_barrier(0);
#pragma unroll
            for (int ch = 0; ch < NG; ++ch) {
                if (NB == 2 && ch + 1 < NG) ATT_LDK(ch + 1, NB == 2 ? ((ch + 1) & 1) : 0);
                __builtin_amdgcn_sched_barrier(0);
#pragma unroll
                for (int j = 0; j < KCH; ++j) {
                    p0 = __builtin_amdgcn_mfma_f32_32x32x16_bf16(kf[NB == 2 ? (ch & 1) : 0][2 * j], q[KCH * ch + j], p0, 0, 0, 0);
                    p1 = __builtin_amdgcn_mfma_f32_32x32x16_bf16(kf[NB == 2 ? (ch & 1) : 0][2 * j + 1], q[KCH * ch + j], p1, 0, 0, 0);
                }
                __builtin_amdgcn_sched_barrier(0);
                if (NB == 1 && ch + 1 < NG) { ATT_LDK(ch + 1, 0); __builtin_amdgcn_sched_barrier(0); }
            }
#undef ATT_LDK
            bf16x8 vf[2][4];
#define ATT_LDV(cmb, b) do { _Pragma("unroll") for (int c_ = 0; c_ < 4; ++c_) { const LAS unsigned char* a0_ = vb + vlane + ((cmb) >> 1) * ATT_VIMG + (16 * ((cmb) & 1)) * 320 + c_ * 64; \
                const v4i16_t t0_ = __builtin_amdgcn_ds_read_tr16_b64_v4i16((LAS v4i16_t*)a0_), t1_ = __builtin_amdgcn_ds_read_tr16_b64_v4i16((LAS v4i16_t*)(a0_ + 8 * 320)); \
                vf[b][c_] = (bf16x8){t0_[0], t0_[1], t0_[2], t0_[3], t1_[0], t1_[1], t1_[2], t1_[3]}; } } while (0)
#pragma unroll
            for (int r = 0; r < 16; ++r) { p0[r] -= m_run; p1[r] -= m_run; }
            if (t >= nmain) { asm volatile("" ::: "memory");
#pragma unroll
                for (int r = 0; r < 16; ++r) p1[r] = -INFINITY;
            }
            float mt = __builtin_fmaxf(__builtin_fmaxf(p0[0], p1[0]), p0[1]);
#pragma unroll
            for (int r = 1; r < 15; r += 2) { mt = __builtin_fmaxf(__builtin_fmaxf(mt, p1[r]), p0[r + 1]); mt = __builtin_fmaxf(__builtin_fmaxf(mt, p1[r + 1]), p0[r + 2 < 16 ? r + 2 : 15]); }
            mt = __builtin_fmaxf(mt, p1[15]);
            mt = max_x32(mt);
            const float dref = (t == 0 || mt > 8.f) ? mt : 0.f;
            if (__builtin_amdgcn_ballot_w64(dref != 0.f) != 0ull) {
                m_run += dref;
#pragma unroll
                for (int r = 0; r < 16; ++r) { p0[r] -= dref; p1[r] -= dref; }
                if (t > 0) { const float f = fast_exp2(-dref); l_run *= f;
#pragma unroll
                    for (int c = 0; c < 4; ++c)
#pragma unroll
                        for (int r = 0; r < 16; ++r) o[c][r] *= f; }
            }
            float rs = 0.f;
#pragma unroll
            for (int r = 0; r < 16; ++r) { p0[r] = fast_exp2(p0[r]); p1[r] = fast_exp2(p1[r]); rs += p0[r] + p1[r]; }
            l_run += rs;
            asm volatile("" ::: "memory");
            if (t + 1 < ntw) { ATT_GLOADV(t + 1); vloaded = true; }
            bf16x8 pf[2][2];
#pragma unroll
            for (int ks = 0; ks < 2; ++ks) {
                u32x4 a, b;
                a.x = cvt_pk_bf16(p0[8 * ks + 0], p0[8 * ks + 1]); a.y = cvt_pk_bf16(p0[8 * ks + 2], p0[8 * ks + 3]); a.z = cvt_pk_bf16(p0[8 * ks + 4], p0[8 * ks + 5]); a.w = cvt_pk_bf16(p0[8 * ks + 6], p0[8 * ks + 7]);
                b.x = cvt_pk_bf16(p1[8 * ks + 0], p1[8 * ks + 1]); b.y = cvt_pk_bf16(p1[8 * ks + 2], p1[8 * ks + 3]); b.z = cvt_pk_bf16(p1[8 * ks + 4], p1[8 * ks + 5]); b.w = cvt_pk_bf16(p1[8 * ks + 6], p1[8 * ks + 7]);
                pf[0][ks] = __builtin_bit_cast(bf16x8, a); pf[1][ks] = __builtin_bit_cast(bf16x8, b);
            }
            __builtin_amdgcn_sched_barrier(0);
            ATT_LDV(0, 0); __builtin_amdgcn_sched_barrier(0);
#pragma unroll
            for (int cmb = 0; cmb < 4; ++cmb) {
                if (cmb + 1 < 4) ATT_LDV(cmb + 1, (cmb + 1) & 1);
                __builtin_amdgcn_sched_barrier(0);
#pragma unroll
                for (int c = 0; c < 4; ++c) o[c] = __builtin_amdgcn_mfma_f32_32x32x16_bf16(vf[cmb & 1][c], pf[cmb >> 1][cmb & 1], o[c], 0, 0, 0);
                __builtin_amdgcn_sched_barrier(0);
            }
#undef ATT_LDV
        }
        if (t + 1 < ntw) { if (!vloaded) ATT_GLOADV(t + 1); ATT_LSTORE((t + 1) & 1, t + 1); }
        __syncthreads();
    }
    const float lt = add_x32(l_run);
    linv = fast_rcp(lt);
#undef ATT_GLOADK
#undef ATT_PK8
#undef ATT_GLOADV
#undef ATT_LSTORE
}

struct AttnCtx { unsigned char* ws; const float* cdk; const float* cdv; const float* gda; float lam, lam1m; unsigned* counter; int l; };
constexpr int ATT_NUNITS = 128 + 2048;
__device__ __forceinline__ void attn_phase(LAS unsigned char* lds, const AttnCtx& C, const int wid) {
#define TID_NOW() LANE_ID()
    LAS unsigned* ubox = (LAS unsigned*)(lds + 131072);
    if (wid < 4) __builtin_amdgcn_s_setprio(3); else __builtin_amdgcn_s_setprio(0);
    const bf16_t* QDA = (const bf16_t*)(C.ws + W_QDA); const bf16_t* KDA = (const bf16_t*)(C.ws + W_KDA); const bf16_t* VDA = (const bf16_t*)(C.ws + W_VDA);
    const bf16_t* GG = (const bf16_t*)(C.ws + W_G); bf16_t* MRG = (bf16_t*)(C.ws + W_MRG);
    for (;;) {
        if (wid == 0 && TID_NOW() == 0) ubox[0] = atomicAdd(C.counter, 1u);
        __syncthreads();
        const int un = (int)ubox[0];
        __syncthreads();
        if (un >= ATT_NUNITS) break;
        const bool samp = un < 128;
        int b, h, qb = 0;
        if (samp) { b = un >> 3; h = un & 7; } else { const int v = un - 128; qb = 7 - (v >> 8); b = (v & 255) >> 3; h = v & 7; }
        const int row = samp ? MP + b * 32 + (TID_NOW() & 31) : b * 2048 + qb * 256 + wid * 32 + (TID_NOW() & 31);
        const int ntw = samp ? 33 : 4 * qb + 4, nmain = samp ? 32 : ntw, ntc = samp ? (wid == 0 ? 33 : 0) : 4 * qb + (wid >> 1) + 1;
        const size_t kr0 = (size_t)b * 2048;
        const size_t fr0 = (size_t)MP + b * 32;
        const size_t coff = (size_t)C.l * MC;
        f32x16 o[4]; float linv;
#ifndef NO_DIFF
        {
            unsigned o1[32];
#pragma unroll 1
            for (int st = 0; st < 2; ++st) {
                KVD dm, dl;
                const bf16_t* Kb = KDA; const bf16_t* Vb = VDA;
                dm.k = Kb + kr0 * 1024 + h * 128 + st * 64; dm.k2 = dm.k; dm.v = Vb + kr0 * 1024 + h * 128;
                dl.k = KDA + fr0 * 1024 + h * 128 + st * 64; dl.k2 = dl.k; dl.v = VDA + fr0 * 1024 + h * 128;
                dm.kf = C.cdk + (coff + kr0) * 1024 + h * 128 + st * 64; dm.vf = C.cdv + (coff + kr0) * 1024 + h * 128; dl.kf = nullptr; dl.vf = nullptr;
                if (samp) attn_pass<64, true>(lds, wid, QDA + (size_t)row * 1024 + h * 128 + st * 64, dm, dl, nmain, ntw, ntc, o, linv);
                else attn_pass<64, false>(lds, wid, QDA + (size_t)row * 1024 + h * 128 + st * 64, dm, dl, nmain, ntw, ntc, o, linv);
                if (st == 0) {
#pragma unroll
                    for (int c = 0; c < 4; ++c)
#pragma unroll
                        for (int r = 0; r < 16; r += 2) o1[c * 8 + (r >> 1)] = cvt_pk_bf16(o[c][r] * linv, o[c][r + 1] * linv);
                }
            }
            if (ntc > 0) {
                int rowe = row; asm volatile("" : "+v"(rowe));
                const int hi = (TID_NOW() >> 5) & 1;
                const float ll = C.lam * linv; float ss = 0.f;
#pragma unroll
                for (int c = 0; c < 4; ++c)
#pragma unroll
                    for (int r = 0; r < 16; r += 2) { const unsigned w = o1[c * 8 + (r >> 1)];
                        const float x0 = __uint_as_float(w << 16) - ll * o[c][r], x1 = __uint_as_float(w & 0xffff0000u) - ll * o[c][r + 1]; o[c][r] = x0; o[c][r + 1] = x1; ss += x0 * x0 + x1 * x1; }
                ss = add_x32(ss);
                const float rn = rsqrtf(ss * (1.f / 128.f) + EPS) * C.lam1m;
                const bf16_t* ga = GG + (size_t)rowe * 2048 + h * 128; bf16_t* mo = MRG + (size_t)rowe * 1024 + h * 128;
#pragma unroll
                for (int c = 0; c < 4; ++c)
#pragma unroll
                    for (int g = 0; g < 4; ++g) {
                        const int d0 = 32 * c + 8 * g + 4 * hi;
                        const u32x2 gw = ldgu2(ga + d0); const f32x4 gd = ldg4(C.gda + d0);
                        const float g0 = __uint_as_float(gw.x << 16), g1 = __uint_as_float(gw.x & 0xffff0000u), g2 = __uint_as_float(gw.y << 16), g3 = __uint_as_float(gw.y & 0xffff0000u);
                        f32x4 r; r[0] = o[c][4 * g + 0] * rn * gd[0] * g0; r[1] = o[c][4 * g + 1] * rn * gd[1] * g1; r[2] = o[c][4 * g + 2] * rn * gd[2] * g2; r[3] = o[c][4 * g + 3] * rn * gd[3] * g3;
                        st_bf16x4(mo + d0, r);
                    }
            }
        }
#endif
#ifndef NO_MLA
        {
            KVD dm, dl;
            const bf16_t* KN = (const bf16_t*)(C.ws + W_KN); const bf16_t* VM = (const bf16_t*)(C.ws + W_VM); const bf16_t* KR = (const bf16_t*)(C.ws + W_KR);
            dm.k = (samp ? (const bf16_t*)(C.ws + W_KNC) + coff * 1024 : KN) + kr0 * 1024 + h * 128; dm.k2 = (samp ? (const bf16_t*)(C.ws + W_KRC) + coff * 64 : KR) + kr0 * 64;
            dm.v = (samp ? (const bf16_t*)(C.ws + W_VMC) + coff * 1024 : VM) + kr0 * 1024 + h * 128;
            dl.k = KN + fr0 * 1024 + h * 128; dl.k2 = KR + fr0 * 64; dl.v = VM + fr0 * 1024 + h * 128;
            dm.kf = nullptr; dm.vf = nullptr; dl.kf = nullptr; dl.vf = nullptr;
            attn_pass<192, false>(lds, wid, (const bf16_t*)(C.ws + W_QM) + (size_t)row * 1536 + h * 192, dm, dl, nmain, ntw, ntc, o, linv);
            if (ntc > 0) {
                int rowe = row; asm volatile("" : "+v"(rowe));
                const int hi = (TID_NOW() >> 5) & 1;
                const bf16_t* gb = GG + (size_t)rowe * 2048 + 1024 + h * 128; bf16_t* mo = MRG + (size_t)rowe * 1024 + h * 128;
#pragma unroll
                for (int c = 0; c < 4; ++c)
#pragma unroll
                    for (int g = 0; g < 4; ++g) {
                        const int d0 = 32 * c + 8 * g + 4 * hi;
                        const u32x2 gw = ldgu2(gb + d0); const u32x2 xw = ldgu2(mo + d0);
                        const float g0 = __uint_as_float(gw.x << 16), g1 = __uint_as_float(gw.x & 0xffff0000u), g2 = __uint_as_float(gw.y << 16), g3 = __uint_as_float(gw.y & 0xffff0000u);
                        f32x4 r;
                        r[0] = __uint_as_float(xw.x << 16) + g0 * o[c][4 * g + 0] * linv; r[1] = __uint_as_float(xw.x & 0xffff0000u) + g1 * o[c][4 * g + 1] * linv;
                        r[2] = __uint_as_float(xw.y << 16) + g2 * o[c][4 * g + 2] * linv; r[3] = __uint_as_float(xw.y & 0xffff0000u) + g3 * o[c][4 * g + 3] * linv;
                        st_bf16x4(mo + d0, r);
                    }
            }
        }
#endif
    }
    __builtin_amdgcn_s_setprio(0);
}
__device__ __forceinline__ float wave_sum(float v) {
#pragma unroll
    for (int o = 1; o < 64; o <<= 1) v += __shfl_xor(v, o);
    return v;
}
__device__ __forceinline__ unsigned f2bf(float f) { unsigned u = __float_as_uint(f); return (u + 0x7fffu + ((u >> 16) & 1u)) >> 16; }
__device__ __forceinline__ unsigned pk2(float lo, float hi) { return f2bf(lo) | (f2bf(hi) << 16); }
__device__ __forceinline__ int ropemap(int v) { return 64 * ((v >> 5) & 3) + 32 * (v >> 7) + (v & 31); }

__device__ __forceinline__ void prep_weights(const Params& P, LAS unsigned char* lds, int gw, int ngw, int wave, int lane) {
    LAS float* scr = (LAS float*)(lds + wave * 8704);
    constexpr int IT0 = 16 * (NIN / 32), IT1 = 6 * (NQ / 32), IT2 = 4 * (NKV / 32), IT4 = 16 * 32, IT5 = 16 * (NUP / 32), IT6 = 44 * 32;
    constexpr int ITL = IT0 + IT1 + 2 * IT2 + IT4 + IT5 + IT6;
    for (int it = gw; it < 2 * ITL; it += ngw) {
        const int l = it / ITL; int r = it - l * ITL;
        int mat;
        if (r < IT0) mat = 0; else if ((r -= IT0) < IT1) mat = 1; else if ((r -= IT1) < IT2) mat = 2; else if ((r -= IT2) < IT2) mat = 3;
        else if ((r -= IT2) < IT4) mat = 4; else if ((r -= IT4) < IT5) mat = 5; else { r -= IT5; mat = 6; }
        const float* W; const float* gk = nullptr; bf16_t* WT; int K, NN; long stride;
        switch (mat) {
            case 0: W = P.in[8] + (size_t)l * 1024 * INC; gk = P.in[7] + l * 1024; WT = (bf16_t*)(P.ws + W_WIN) + (size_t)l * NIN * 1024; K = 1024; NN = NIN; stride = INC; break;
            case 1: W = P.in[16] + (size_t)l * QL * NQ; gk = P.in[15] + l * QL; WT = (bf16_t*)(P.ws + W_WQ) + (size_t)l * NQ * QL; K = QL; NN = NQ; stride = NQ; break;
            case 2: W = nullptr; gk = P.in[17] + l * KVL; WT = (bf16_t*)(P.ws + W_WKV) + (size_t)l * NKV * KVL; K = KVL; NN = NKV; stride = 128; break;
            case 3: W = nullptr; WT = (bf16_t*)(P.ws + W_WKVC) + (size_t)l * NKV * KVL; K = KVL; NN = NKV; stride = 128; break;
            case 4: W = P.in[20] + (size_t)l * 1024 * 1024; WT = (bf16_t*)(P.ws + W_WO) + (size_t)l * 1024 * 1024; K = 1024; NN = 1024; stride = 1024; break;
            case 5: W = P.in[22] + (size_t)l * 1024 * NUP; gk = P.in[21] + l * 1024; WT = (bf16_t*)(P.ws + W_WUP) + (size_t)l * NUP * 1024; K = 1024; NN = NUP; stride = NUP; break;
            default: W = P.in[25] + (size_t)l * DFF * 1024; WT = (bf16_t*)(P.ws + W_WDN) + (size_t)l * 1024 * DFF; K = DFF; NN = 1024; stride = 1024; break;
        }
        const int nblk = NN / 32, kb = r / nblk, nb = r - kb * nblk, k0 = 64 * kb, n0 = 32 * nb;
        const int np = n0 + (lane & 31); long off = -1;
        {
            const int tile = np >> 8, v = np & 255;
            switch (mat) {
                case 0:
                    if (tile < 4) off = 256 * tile + ropemap(v);
                    else if (tile < 8) off = 1024 + 256 * (tile - 4) + ropemap(v);
                    else if (tile < 12) off = 2048 + 256 * (tile - 8) + v;
                    else if (tile < 20) off = 3776 + 256 * (tile - 12) + v;
                    else if (tile == 20) off = 3456 + v;
                    else if (tile == 21) off = 3072 + v;
                    else { if (v < 128) off = 3072 + 256 + v; else { const int w = v - 128, wc = w >> 5; if (wc < 2) off = 3712 + 32 * ((w >> 4) & 1) + 16 * wc + (w & 15); } }
                    break;
                case 1:
                    if (tile < 4) off = (np >> 7) * 192 + (np & 127);
                    else { const int hh = 4 * (tile - 4) + ((v >> 5) & 3); off = hh * 192 + 128 + 32 * (v >> 7) + (v & 31); }
                    break;
                case 2: case 3: {
                    const int c = np & 1023, hh = c >> 7, n = c & 127;
                    W = (np < 1024 ? P.in[18] : P.in[19]) + (size_t)l * 8 * 256 * 128; off = (long)hh * 32768 + n; } break;
                case 5: off = (v < 128) ? 128 * tile + v : DFF + 128 * tile + (v - 128); break;
                default: off = np; break;
            }
        }
#pragma unroll 8
        for (int i = 0; i < 32; ++i) { const int kk = 2 * i + (lane >> 5); float v = 0.f;
            if (off >= 0) { v = W[(size_t)(k0 + kk) * stride + off]; if (gk) v *= gk[k0 + kk]; }
            scr[kk * 33 + (lane & 31)] = v; }
        asm volatile("s_waitcnt lgkmcnt(0)" ::: "memory");
        const int c = lane & 7;
#pragma unroll
        for (int j = 0; j < 4; ++j) { const int n = (lane >> 3) + 8 * j; const LAS float* s = scr + (8 * c) * 33 + n;
            u32x4 o; o.x = pk2(s[0 * 33], s[1 * 33]); o.y = pk2(s[2 * 33], s[3 * 33]); o.z = pk2(s[4 * 33], s[5 * 33]); o.w = pk2(s[6 * 33], s[7 * 33]);
            *(u32x4*)(WT + (size_t)(n0 + n) * K + k0 + 8 * c) = o; }
        asm volatile("s_waitcnt lgkmcnt(0)" ::: "memory");
    }
}

__device__ __forceinline__ void sincos_f(float a, float& s, float& c) {
    const float n = rintf(a * 0.6366197723675814f);
    float r = fmaf(-n, 1.5703125f, a); r = fmaf(-n, 4.837512969970703125e-4f, r); r = fmaf(-n, 7.54978995489188e-8f, r);
    const float r2 = r * r;
    const float sp = r + r * r2 * (-1.6666666667e-1f + r2 * (8.3333333333e-3f + r2 * (-1.9841269841e-4f + r2 * 2.7557319224e-6f)));
    const float cp = 1.f + r2 * (-0.5f + r2 * (4.1666666667e-2f + r2 * (-1.3888888889e-3f + r2 * (2.4801587302e-5f + r2 * -2.7557319224e-7f))));
    const int qd = ((int)n) & 3;
    s = (qd == 0) ? sp : (qd == 1) ? cp : (qd == 2) ? -sp : -cp;
    c = (qd == 0) ? cp : (qd == 1) ? -sp : (qd == 2) ? -cp : sp;
}

__device__ __forceinline__ void cvt_stream(const float* src, bf16_t* dst, size_t n8, size_t gt, size_t ngt) {
    for (size_t i = gt; i < n8; i += ngt) { const f32x4 a = *(const f32x4*)(src + i * 8), b = *(const f32x4*)(src + i * 8 + 4);
        u32x4 o; o.x = cvt_pk_bf16(a[0], a[1]); o.y = cvt_pk_bf16(a[2], a[3]); o.z = cvt_pk_bf16(b[0], b[1]); o.w = cvt_pk_bf16(b[2], b[3]); *(u32x4*)(dst + i * 8) = o; }
}

__device__ __forceinline__ void conv_fix_phase(const Params& P, int l, size_t gt, size_t ngt) {
    const bf16_t* UH = (const bf16_t*)(P.ws + W_U); bf16_t* ACT = (bf16_t*)(P.ws + W_ACT);
    const float* wc = P.in[23] + (size_t)l * 3 * NUP; const float* bc = P.in[24] + (size_t)l * NUP;
    constexpr int NCC = DFF / 8;
    for (size_t it = gt; it < (size_t)1024 * NCC; it += ngt) {
        const int sl = (int)(it / NCC), cc = (int)(it - (size_t)sl * NCC), j0 = cc * 8;
        if ((sl & 31) == 0) continue;
        float uu[4][2][8];
#pragma unroll
        for (int k = 0; k < 4; ++k)
#pragma unroll
            for (int gv = 0; gv < 2; ++gv) { const u32x4 a = ldgu4(UH + ((size_t)(k < 2 ? sl - 1 : sl) * 4 + (k < 2 ? 2 + k : k - 2)) * NUP + gv * DFF + j0);
#pragma unroll
                for (int e = 0; e < 4; ++e) { uu[k][gv][2 * e] = __uint_as_float(a[e] << 16); uu[k][gv][2 * e + 1] = __uint_as_float(a[e] & 0xffff0000u); } }
#pragma unroll
        for (int rr = 0; rr < 2; ++rr) {
            float res[8];
#pragma unroll
            for (int hf = 0; hf < 2; ++hf) {
                f32x4 w[2][4];
#pragma unroll
                for (int gv = 0; gv < 2; ++gv)
#pragma unroll
                    for (int k = 0; k < 4; ++k) w[gv][k] = ldg4((k < 3 ? wc + (size_t)k * NUP : bc) + gv * DFF + j0 + 4 * hf);
#pragma unroll
                for (int e = 0; e < 4; ++e) { const int q = 4 * hf + e;
                    const float cg = w[0][3][e] + w[0][0][e] * uu[rr][0][q] + w[0][1][e] * uu[rr + 1][0][q] + w[0][2][e] * uu[rr + 2][0][q];
                    const float cv = w[1][3][e] + w[1][0][e] * uu[rr][1][q] + w[1][1][e] * uu[rr + 1][1][q] + w[1][2][e] * uu[rr + 2][1][q];
                    res[q] = cg * sigmoidf_(cg) * cv; }
            }
            u32x4 o; o.x = cvt_pk_bf16(res[0], res[1]); o.y = cvt_pk_bf16(res[2], res[3]); o.z = cvt_pk_bf16(res[4], res[5]); o.w = cvt_pk_bf16(res[6], res[7]);
            *(GAS u32x4*)(ACT + ((size_t)(64 * sl + rr) * DFF + j0)) = o;
        }
    }
}
constexpr int LDS_BYTES = 147456;
template <class Epi> __device__ __forceinline__ void run_gemm(LAS unsigned char* lds, const int wid, const bf16_t* A, const bf16_t* Bt, int M, int N, int K, const Epi& E) {
    int gx = (int)gridDim.x, bx = (int)blockIdx.x, wv = wid; asm volatile("" : "+s"(gx), "+s"(bx), "+s"(wv));
    pg8::Gemm g{A, Bt, M, N, K}; pg8::StaticOrder S; S.init(M, N, gx, bx);
#ifndef NO_GEMM
    pg8::gemm_phase<Epi, pg8::StaticOrder, PG8_ALIGN, PG8_SP2>(lds, g, S, E, wv);
#endif
}

__global__ void __launch_bounds__(512, 2) fwd_megakernel(Params P) {
    extern __shared__ __attribute__((aligned(16))) unsigned char lds_raw[];
    LAS unsigned char* lds = (LAS unsigned char*)lds_raw;
    cg::grid_group grid = cg::this_grid();
    const int wave_s = __builtin_amdgcn_readfirstlane((int)threadIdx.x >> 6);
#define TID_DEFS const int lane = LANE_ID(), wave = wave_s, tid = (wave << 6) | lane; \
    const int G = gridDim.x, gw = blockIdx.x * 8 + wave, ngw = G * 8; const size_t gt = (size_t)blockIdx.x * 512 + tid, ngt = (size_t)G * 512; (void)lane; (void)gw; (void)ngw; (void)gt; (void)ngt;
    unsigned char* ws = P.ws; float* out = P.out;
#define gbar() do { asm volatile("s_waitcnt vmcnt(0) lgkmcnt(0)" ::: "memory"); __syncthreads(); bar_gen += gridDim.x; \
        if (wave_s == 0 && LANE_ID() == 0) { asm volatile("buffer_wbl2 sc1\n\ts_waitcnt vmcnt(0) lgkmcnt(0)" ::: "memory");     \
            __hip_atomic_fetch_add(ctl + 128, 1u, __ATOMIC_RELAXED, __HIP_MEMORY_SCOPE_AGENT); \
            while (__hip_atomic_load(ctl + 128, __ATOMIC_RELAXED, __HIP_MEMORY_SCOPE_AGENT) < bar_gen) __builtin_amdgcn_s_sleep(1); } \
        __syncthreads(); asm volatile("buffer_inv sc1\n\ts_waitcnt vmcnt(0) lgkmcnt(0)" ::: "memory");     } while (0)
#ifdef PROBE_SEL
    unsigned long long pr_acc = 0, pr_t0 = 0;
#define PR_BEGIN(c) do { if ((PROBE_SEL >> (c)) & 1) pr_t0 = __builtin_amdgcn_s_memrealtime(); } while (0)
#define PR_END(c) do { if ((PROBE_SEL >> (c)) & 1) pr_acc += __builtin_amdgcn_s_memrealtime() - pr_t0; } while (0)
#else
#define PR_BEGIN(c)
#define PR_END(c)
#endif
#define OPAQ() do { unsigned a_ = (unsigned)(uintptr_t)P.ws, b_ = (unsigned)((uintptr_t)P.ws >> 32), c_ = (unsigned)(uintptr_t)P.out, d_ = (unsigned)((uintptr_t)P.out >> 32); \
        asm volatile("" : "+s"(a_), "+s"(b_), "+s"(c_), "+s"(d_)); ws = (unsigned char*)(((uintptr_t)b_ << 32) | a_); out = (float*)(((uintptr_t)d_ << 32) | c_); } while (0)
    unsigned* ctl = (unsigned*)(ws + W_CTL); float* ctlf = (float*)(ws + W_CTL);
    float* rope = (float*)(ws + W_ROPE); float* SS = (float*)(ws + W_SS);
#define B_HX ((bf16_t*)(ws + W_HX))
#define B_X ((float*)(ws + W_X))
#define B_QDA ((bf16_t*)(ws + W_QDA))
#define B_KDA ((bf16_t*)(ws + W_KDA))
#define B_VDA ((bf16_t*)(ws + W_VDA))
#define B_GG ((bf16_t*)(ws + W_G))
#define B_CKV ((bf16_t*)(ws + W_CKV))
#define B_CQ ((bf16_t*)(ws + W_CQ))
#define B_KR ((bf16_t*)(ws + W_KR))
#define B_QM ((bf16_t*)(ws + W_QM))
#define B_KN ((bf16_t*)(ws + W_KN))
#define B_VM ((bf16_t*)(ws + W_VM))
#define B_MRG ((bf16_t*)(ws + W_MRG))
#define B_U ((bf16_t*)(ws + W_U))
#define B_ACT ((bf16_t*)(ws + W_ACT))
#define B_KC ((bf16_t*)(ws + W_KC))
#define B_VC ((bf16_t*)(ws + W_VC))
#define B_KRC ((bf16_t*)(ws + W_KRC))
#define B_CKVC ((bf16_t*)(ws + W_CKVC))
#define B_KNC ((bf16_t*)(ws + W_KNC))
#define B_VMC ((bf16_t*)(ws + W_VMC))
    PR_BEGIN(0);
    {
    TID_DEFS
#ifndef NO_PREP
    prep_weights(P, lds, gw, ngw, wave, lane);
#endif
    for (size_t idx = gt; idx < (size_t)2080 * 32; idx += ngt) {
        const int pos = (int)(idx >> 5), i = (int)(idx & 31);
        double inv = 1.0; for (int k = 0; k < i; ++k) inv *= 0.74989420933245582730;
        const double ang = (double)pos * inv; const double n = __builtin_rint(ang * 0.63661977236758134308);
        double r = __builtin_fma(-n, 1.57079632679489655800, ang); r = __builtin_fma(-n, 6.12323399573676603587e-17, r);
        const float rf = (float)r, r2 = rf * rf;
        const float sp = rf + rf * r2 * (-1.6666666667e-1f + r2 * (8.3333333333e-3f + r2 * (-1.9841269841e-4f + r2 * 2.7557319224e-6f)));
        const float cp = 1.f + r2 * (-0.5f + r2 * (4.1666666667e-2f + r2 * (-1.3888888889e-3f + r2 * (2.4801587302e-5f + r2 * -2.7557319224e-7f))));
        const int qd = ((int)n) & 3;
        rope[(size_t)pos * 64 + 32 + i] = (qd == 0) ? sp : (qd == 1) ? cp : (qd == 2) ? -sp : -cp;
        rope[(size_t)pos * 64 + i] = (qd == 0) ? cp : (qd == 1) ? -sp : (qd == 2) ? -cp : sp;
    }
    for (size_t idx = gt; idx < (size_t)8 * MT; idx += ngt) SS[MT + idx] = 0.f;
    if (blockIdx.x == 0 && tid < 64) {
        if (tid < 5) __hip_atomic_store(ctl + (tid == 4 ? 128 : tid * 16), 0u, __ATOMIC_RELAXED, __HIP_MEMORY_SCOPE_AGENT);
        for (int l = 0; l < 2; ++l) {
        OPAQ();
            const float a = wave_sum(P.in[10][l * 64 + lane] * P.in[11][l * 64 + lane]), b = wave_sum(P.in[12][l * 64 + lane] * P.in[13][l * 64 + lane]);
            const float li = 0.8f - 0.6f * expf(-0.3f * (float)l);
            if (lane == 0) { ctlf[64 + 2 * l] = expf(a) - expf(b) + li; ctlf[65 + 2 * l] = 1.f - li; }
        }
    }
    for (int row0 = 2 * gw; row0 < MT; row0 += 2 * ngw) {
        f32x4 v[2][4]; float s2[2] = {0.f, 0.f};
#pragma unroll
        for (int k = 0; k < 2; ++k) { const int row = row0 + k; const float* xr = (row >= MP ? P.in[1] + (size_t)(row - MP) * 1024 : P.in[0] + (size_t)row * 1024);
#pragma unroll
            for (int j = 0; j < 4; ++j) v[k][j] = ldg4(xr + 256 * j + 4 * lane); }
#pragma unroll
        for (int k = 0; k < 2; ++k) { const int row = row0 + k;
#pragma unroll
            for (int j = 0; j < 4; ++j) { s2[k] += sq4(v[k][j]); st_bf16x4(B_HX + (size_t)row * 1024 + 256 * j + 4 * lane, v[k][j]); }
            const float s = wave_sum(s2[k]); if (lane == 0) SS[row] = s; }
    }
    cvt_stream(P.in[4], B_CKVC, (size_t)2 * MC * 256 / 8, gt, ngt);
    cvt_stream(P.in[5], B_KRC, (size_t)2 * MC * 64 / 8, gt, ngt);
    }
    asm volatile("s_waitcnt vmcnt(0) lgkmcnt(0)" ::: "memory"); __syncthreads();
    if (wave_s == 0) asm volatile("buffer_wbl2 sc1\n\ts_waitcnt vmcnt(0) lgkmcnt(0)" ::: "memory");
    grid.sync();
    asm volatile("buffer_inv sc1\n\ts_waitcnt vmcnt(0) lgkmcnt(0)" ::: "memory");
    unsigned bar_gen = 0;
    PR_END(0);

#pragma unroll 1
    for (int l = 0; l < 2; ++l) {
        OPAQ();
        float* ssx_attn = SS + (size_t)(2 * l) * MT; float* ssx_ffn = SS + (size_t)(2 * l + 1) * MT; float* ssx_next = SS + (size_t)(2 * l + 2) * MT;
        float* sscq = SS + (size_t)(5 + l) * MT; float* ssckv = SS + (size_t)(7 + l) * MT;
        float* ckp = out + O_CKVP + (size_t)l * MP * 256; float* cks = out + O_CKVS + (size_t)l * MSMP * 256;
        PR_BEGIN(1);
        {
            EpiInProj E; E.ws = ws; E.out = out; E.bgate = P.in[9] + (size_t)l * 2048; E.l = l;
            run_gemm(lds, wave_s, B_HX, (const bf16_t*)(ws + W_WIN) + (size_t)l * NIN * 1024, MT, NIN, 1024, E);
        }
        gbar(); OPAQ();
        PR_END(1);
        PR_BEGIN(2);
        {
            EpiQ E; E.sscq = sscq; E.rope = rope; E.QM = B_QM;
            run_gemm(lds, wave_s, B_CQ, (const bf16_t*)(ws + W_WQ) + (size_t)l * NQ * QL, MT, NQ, QL, E);
        }
        {
            EpiKV<true> E; E.ss = ssckv; E.O0 = B_KN; E.O1 = B_VM;
            run_gemm(lds, wave_s, B_CKV, (const bf16_t*)(ws + W_WKV) + (size_t)l * NKV * KVL, MT, NKV, KVL, E);
        }
        if (l == 0) {
#pragma unroll 1
            for (int l2 = 0; l2 < 2; ++l2) {
                EpiKV<false> E; E.ss = nullptr; E.O0 = B_KNC + (size_t)l2 * MC * 1024; E.O1 = B_VMC + (size_t)l2 * MC * 1024;
                run_gemm(lds, wave_s, B_CKVC + (size_t)l2 * MC * 256, (const bf16_t*)(ws + W_WKVC) + (size_t)l2 * NKV * KVL, MC, NKV, KVL, E);
            }
        }
        {
            TID_DEFS
            const float* gk = P.in[17] + (size_t)l * 256;
            for (size_t idx = gt; idx < (size_t)MT * 64; idx += ngt) {
                const int row = (int)(idx >> 6), c4 = (int)(idx & 63);
                float* p = (row >= MP ? cks + (size_t)(row - MP) * 256 : ckp + (size_t)row * 256) + 4 * c4;
                const float rs = rsqrtf(ssckv[row] * (1.f / 256.f) + EPS); const f32x4 g = *(const f32x4*)(gk + 4 * c4);
                *(f32x4*)p = *(const f32x4*)p * rs * g;
            }
        }
        gbar(); OPAQ();
        PR_END(2);
        PR_BEGIN(3);
        {
            AttnCtx C; C.ws = ws; C.cdk = P.in[2]; C.cdv = P.in[3]; C.gda = P.in[14] + (size_t)l * 128; C.lam = __int_as_float(__builtin_amdgcn_readfirstlane(__float_as_int(ctlf[64 + 2 * l]))); C.lam1m = __int_as_float(__builtin_amdgcn_readfirstlane(__float_as_int(ctlf[65 + 2 * l]))); C.counter = ctl + 16 * l; C.l = l;
#ifndef NO_ATTN
            { int wv = wave_s; asm volatile("" : "+s"(wv)); attn_phase(lds, C, wv); }
#ifdef PROBE_ATTN2
            gbar(); OPAQ(); C.counter = ctl + 32 + 16 * l; { int wv = wave_s; asm volatile("" : "+s"(wv)); attn_phase(lds, C, wv); }
#endif
#endif
        }
        gbar(); OPAQ();
        PR_END(3);
        PR_BEGIN(4);
        {
            EpiRes E; E.xp = (l == 0) ? P.in[0] : nullptr; E.xs = P.in[1]; E.X = nullptr; E.HX = B_HX; E.ssn = ssx_ffn;
            run_gemm(lds, wave_s, B_MRG, (const bf16_t*)(ws + W_WO) + (size_t)l * 1024 * 1024, MT, 1024, 1024, E);
        }
        gbar(); OPAQ();
        PR_END(4);
        PR_BEGIN(5);
        {
            EpiUp E; E.ssx = ssx_ffn; E.ACT = B_ACT; E.UH = B_U; E.cvp = out + O_CVP + (size_t)l * 32 * 2 * NUP; E.cvs = out + O_CVS + (size_t)l * 16 * 2 * NUP;
            E.wc = P.in[23] + (size_t)l * 3 * NUP; E.bc = P.in[24] + (size_t)l * NUP; E.stc = P.in[6] + (size_t)l * 16 * 2 * NUP;
            run_gemm(lds, wave_s, B_HX, (const bf16_t*)(ws + W_WUP) + (size_t)l * NUP * 1024, MT, NUP, 1024, E);
        }
        gbar(); OPAQ();
        PR_END(5);
#ifndef NO_CONV
        PR_BEGIN(6);
        { TID_DEFS conv_fix_phase(P, l, gt, ngt); }
#endif
        gbar(); OPAQ();
        PR_END(6);
        PR_BEGIN(7);
        {
            EpiRes E; E.xp = nullptr; E.xs = nullptr; E.X = nullptr; E.HX = B_HX; E.ssn = ssx_next;
            run_gemm(lds, wave_s, B_ACT, (const bf16_t*)(ws + W_WDN) + (size_t)l * 1024 * DFF, MT, 1024, DFF, E);
        }
        gbar(); OPAQ();
        PR_END(7);
    }
    PR_BEGIN(8);
    {
        TID_DEFS
        const float* ssf = SS + (size_t)4 * MT; const float* gf = P.in[26];
        for (size_t base = gt; base < (size_t)MT * 256; base += 4 * ngt) {
            u32x2 hw[4]; float sv[4]; f32x4 gv[4];
#pragma unroll
            for (int k = 0; k < 4; ++k) { const size_t idx = base + (size_t)k * ngt; if (idx < (size_t)MT * 256) { const int row = (int)(idx >> 8), c4 = (int)(idx & 255);
                hw[k] = ldgu2(B_HX + (size_t)row * 1024 + 4 * c4); sv[k] = ldg1(ssf + row); gv[k] = ldg4(gf + 4 * c4); } }
#pragma unroll
            for (int k = 0; k < 4; ++k) { const size_t idx = base + (size_t)k * ngt; if (idx < (size_t)MT * 256) { const int row = (int)(idx >> 8), c4 = (int)(idx & 255);
                const float rs = rsqrtf(sv[k] * (1.f / 1024.f) + EPS);
                const f32x4 xv = (f32x4){__uint_as_float(hw[k].x << 16), __uint_as_float(hw[k].x & 0xffff0000u), __uint_as_float(hw[k].y << 16), __uint_as_float(hw[k].y & 0xffff0000u)};
                stg4(out + (size_t)row * 1024 + 4 * c4, xv * rs * gv[k]); } }
        }
    }
#ifdef PROBE_SEL
    PR_END(8);
    if (blockIdx.x == 0) { const unsigned long long s0 = __builtin_amdgcn_s_memrealtime(); while (__builtin_amdgcn_s_memrealtime() - s0 < pr_acc) __builtin_amdgcn_s_sleep(32); }
#endif
}

extern "C" void kernel_launch(void* const* d_in, const int* in_sizes, int n_in, void* d_out, int out_size, void* d_ws, size_t ws_size, hipStream_t stream) {
    static int grid_blocks = 0;
    if (grid_blocks == 0) {
        if (n_in != 27 || (size_t)out_size != O_END || ws_size < W_END) { fprintf(stderr, "kernel_launch: unexpected problem (n_in %d, out %d vs %zu, ws %zu vs %zu)\n", n_in, out_size, (size_t)O_END, ws_size, (size_t)W_END); grid_blocks = -1; return; }
        int dev = 0, cus = 0, per_cu = 0;
        (void)hipGetDevice(&dev); (void)hipDeviceGetAttribute(&cus, hipDeviceAttributeMultiprocessorCount, dev);
        (void)hipFuncSetAttribute((const void*)fwd_megakernel, hipFuncAttributeMaxDynamicSharedMemorySize, LDS_BYTES);
        (void)hipOccupancyMaxActiveBlocksPerMultiprocessor(&per_cu, (const void*)fwd_megakernel, 512, LDS_BYTES);
        if (per_cu < 1) per_cu = 1;
        grid_blocks = cus * per_cu;
    }
    if (grid_blocks < 0) return;
    Params p{};
    for (int i = 0; i < 27; ++i) p.in[i] = (const float*)d_in[i];
    p.out = (float*)d_out; p.ws = (unsigned char*)d_ws;
    void* args[] = {&p};
    hipError_t e = hipLaunchCooperativeKernel((void*)fwd_megakernel, dim3(grid_blocks), dim3(512), args, LDS_BYTES, stream);
    if (e != hipSuccess) fprintf(stderr, "cooperative launch failed: %s (grid %d)\n", hipGetErrorString(e), grid_blocks);
}
```

```cpp
#include <hip/hip_runtime.h>
#include <hip/hip_cooperative_groups.h>
#include <cstdio>
#include <cstdint>
namespace cg = cooperative_groups;
#define LANE_ID() ({ int l_ = (int)__builtin_amdgcn_mbcnt_hi(~0u, __builtin_amdgcn_mbcnt_lo(~0u, 0u)); asm volatile("" : "+v"(l_)); l_; })
namespace pg8 {
#define PG8_LAS __attribute__((address_space(3)))
typedef unsigned short bf16_t;
typedef short bf16x8 __attribute__((ext_vector_type(8)));
typedef float f32x4 __attribute__((ext_vector_type(4)));
typedef unsigned u32x4 __attribute__((ext_vector_type(4)));
constexpr int BM = 256, BK = 64, HALF = 128, HTB = HALF * BK * 2  , STAGE_BYTES = 8 * HTB, NXCD = 8, WGM = 8;

__host__ __device__ __forceinline__ int lds_byte(int r, int c) { const int st = (r >> 4) * 2 + (c >> 5), rr = r & 15, cc = c & 31, ob = rr * 64 + cc * 2; return st * 1024 + (ob ^ (((ob >> 9) & 1) << 5)); }
__host__ __device__ __forceinline__ void stage_rc(int b, int& R, int& C) { const int st = b / 1024, sb = b % 1024, swz = sb ^ (((sb >> 9) & 1) << 5); R = (st >> 1) * 16 + swz / 64; C = (st & 1) * 32 + (swz % 64) / 2; }
__host__ __device__ __forceinline__ int perm32(int rho) { const int n = rho >> 4, i = rho & 15; return 8 * (i >> 2) + 4 * n + (i & 3); }

struct Unit { int pm, pn; };
struct Gemm { const bf16_t* A; const bf16_t* Bt; int M, N, K; };

struct StaticOrder {
    int nM, nN, nwg, G, c;
    __host__ __device__ void init(int M, int N, int G_, int c_) { nM = M / BM; nN = N / BM; nwg = nM * nN; G = G_; c = c_; }
    __host__ __device__ bool next(int i, Unit& u) const {
        const long L = (long)i * G + c; if (L >= nwg) return false;
        int wgid = (int)L; { const int q = nwg / NXCD, r = nwg % NXCD, xcd = wgid % NXCD, off = wgid / NXCD; wgid = (xcd < r ? xcd * (q + 1) : r * (q + 1) + (xcd - r) * q) + off; }
        const int nig = WGM * nN, gid = wgid / nig, fm = gid * WGM, gsz = (nM - fm) < WGM ? (nM - fm) : WGM;
        u.pm = fm + ((wgid % nig) % gsz); u.pn = (wgid % nig) / gsz; return true;
    }
    __device__ __forceinline__ void a_ready(const Unit&) const {}
    __device__ __forceinline__ void done(const Unit&) const {}
};

typedef float f32x2_cv __attribute__((ext_vector_type(2))); typedef __bf16 bf16x2_cv __attribute__((ext_vector_type(2)));
__device__ __forceinline__ unsigned cvt_pk_bf16(float lo, float hi) { f32x2_cv v = {lo, hi}; bf16x2_cv b = __builtin_convertvector(v, bf16x2_cv); return __builtin_bit_cast(unsigned, b); }
template <class Epi, class Sched, bool ALIGN_EPI = false, bool SP2 = false>
__device__ __forceinline__ void gemm_phase(PG8_LAS unsigned char* lds, const Gemm g, const Sched& S, const Epi& E, const int wid_in) {
    const int wid = wid_in, lane = LANE_ID(), tid = (wid << 6) | lane, wr = wid >> 2, wc = wid & 3, fr = lane & 15, fq = lane >> 4;
    const int K = g.K, nt = K / BK;
    unsigned voffA[2], voffB[2];
#pragma unroll
    for (int i = 0; i < 2; ++i) { int R, C; stage_rc(tid * 16 + i * 8192, R, C); const int Rb = Epi::PERM ? ((R & ~31) + perm32(R & 31)) : R;
        voffA[i] = (unsigned)(R * K + C) * 2u; voffB[i] = (unsigned)(Rb * K + C) * 2u; }
    const size_t kstep = (size_t)(BK * 2);
    const size_t hstep = (size_t)HALF * K * 2;
    const size_t tstep = 2 * hstep;
    const unsigned ldsw = (unsigned)wid * 1024u;
    const int aoff = lds_byte(wr * 64 + fr, fq * 8), boff = lds_byte(wc * 32 + fr, fq * 8);
#define PG8_SA(b, h) (((b) * 2 + (h)) * HTB)
#define PG8_SB(b, h) ((4 + (b) * 2 + (h)) * HTB)
#define PG8_STAGE(bufoff, gbase, voff) do { _Pragma("unroll") for (int _i = 0; _i < 2; ++_i) \
        __builtin_amdgcn_global_load_lds((const unsigned*)((const char*)(gbase) + (voff)[_i]), (PG8_LAS unsigned*)(lds + (bufoff) + ldsw + _i * 8192), 16, 0, 0); } while (0)
#define PG8_LDA(dst, b, h) do { _Pragma("unroll") for (int m = 0; m < 4; ++m) _Pragma("unroll") for (int k = 0; k < 2; ++k) dst[m][k] = *(const PG8_LAS bf16x8*)(lds + PG8_SA(b, h) + aoff + m * 2048 + k * 1024); } while (0)
#define PG8_LDB(dst, b, h) do { _Pragma("unroll") for (int n = 0; n < 2; ++n) _Pragma("unroll") for (int k = 0; k < 2; ++k) dst[n][k] = *(const PG8_LAS bf16x8*)(lds + PG8_SB(b, h) + boff + n * 2048 + k * 1024); } while (0)
#define PG8_MMA(ai, bj, At, Bt) do { __builtin_amdgcn_s_setprio(1); _Pragma("unroll") for (int m = 0; m < 4; ++m) _Pragma("unroll") for (int n = 0; n < 2; ++n) _Pragma("unroll") for (int k = 0; k < 2; ++k) \
        acc[ai][bj][m][n] = __builtin_amdgcn_mfma_f32_16x16x32_bf16(Bt[n][k], At[m][k], acc[ai][bj][m][n], 0, 0, 0); __builtin_amdgcn_s_setprio(0); } while (0)
#define PG8_WAIT_V(n) asm volatile("s_waitcnt vmcnt(" #n ")" ::: "memory")
#define PG8_WAIT_L(n) asm volatile("s_waitcnt lgkmcnt(" #n ")" ::: "memory")
#define PG8_BAR __builtin_amdgcn_s_barrier()
#define PG8_SCHED __builtin_amdgcn_sched_barrier(0)
    Unit cur, nxt; int ui = 0;
    if (!S.next(0, cur)) return;
    f32x4 acc[2][2][4][2];
#pragma unroll
    for (int a = 0; a < 2; ++a)
#pragma unroll
        for (int b = 0; b < 2; ++b)
#pragma unroll
            for (int m = 0; m < 4; ++m)
#pragma unroll
                for (int n = 0; n < 2; ++n) acc[a][b][m][n] = (f32x4){0.f, 0.f, 0.f, 0.f};
    bf16x8 At[4][2], B0[2][2], B1[2][2];
    const char* cA = (const char*)g.A + (size_t)cur.pm * tstep; const char* cB = (const char*)g.Bt + (size_t)cur.pn * tstep;
    S.a_ready(cur);
    if constexpr (SP2) {
        PG8_STAGE(PG8_SB(0, 0), cB, voffB); PG8_STAGE(PG8_SB(0, 1), cB + hstep, voffB); PG8_STAGE(PG8_SA(0, 0), cA, voffA); PG8_STAGE(PG8_SA(0, 1), cA + hstep, voffA);
        if (wr == 1) PG8_BAR;
        PG8_WAIT_V(2); PG8_BAR;
        PG8_STAGE(PG8_SB(1, 0), cB + kstep, voffB); PG8_STAGE(PG8_SA(1, 0), cA + kstep, voffA); PG8_STAGE(PG8_SB(1, 1), cB + hstep + kstep, voffB);
        PG8_WAIT_V(6); PG8_BAR;
    } else {
        PG8_STAGE(PG8_SB(0, 0), cB, voffB); PG8_STAGE(PG8_SA(0, 0), cA, voffA); PG8_STAGE(PG8_SB(0, 1), cB + hstep, voffB); PG8_STAGE(PG8_SA(0, 1), cA + hstep, voffA);
        if (wr == 1) PG8_BAR;
        PG8_WAIT_V(4); PG8_BAR;
        PG8_STAGE(PG8_SB(1, 0), cB + kstep, voffB); PG8_STAGE(PG8_SA(1, 0), cA + kstep, voffA); PG8_STAGE(PG8_SB(1, 1), cB + hstep + kstep, voffB);
        PG8_WAIT_V(6); PG8_BAR;
    }
    for (;;) {
        const bool has_next = S.next(ui + 1, nxt);
        const char* nA = has_next ? (const char*)g.A + (size_t)nxt.pm * tstep : cA; const char* nB = has_next ? (const char*)g.Bt + (size_t)nxt.pn * tstep : cB;
        for (int t = 0; t < nt; t += 2) {
            const bool last = (t == nt - 2);
            const char* a1 = cA + (size_t)(t + 1) * kstep;
            const char* a2 = last ? nA : cA + (size_t)(t + 2) * kstep; const char* b2 = last ? nB : cB + (size_t)(t + 2) * kstep;
            const char* a3 = a2 + kstep; const char* b3 = b2 + kstep;
            if (last && has_next) S.a_ready(nxt);
            if constexpr (SP2) {
            PG8_LDB(B0, 0, 0); PG8_LDB(B1, 0, 1); PG8_SCHED; PG8_LDA(At, 0, 0); PG8_STAGE(PG8_SA(1, 1), a1 + hstep, voffA);
            PG8_WAIT_V(8); PG8_WAIT_L(0); PG8_BAR; PG8_MMA(0, 0, At, B0); PG8_MMA(0, 1, At, B1); PG8_BAR; PG8_SCHED;
            PG8_LDA(At, 0, 1); PG8_STAGE(PG8_SB(0, 0), b2, voffB); PG8_STAGE(PG8_SB(0, 1), b2 + hstep, voffB); PG8_STAGE(PG8_SA(0, 0), a2, voffA);
            PG8_WAIT_V(8); PG8_WAIT_L(0); PG8_BAR; PG8_MMA(1, 0, At, B0); PG8_MMA(1, 1, At, B1); PG8_BAR; PG8_SCHED;
            PG8_LDB(B0, 1, 0); PG8_LDB(B1, 1, 1); PG8_SCHED; PG8_LDA(At, 1, 0); PG8_STAGE(PG8_SA(0, 1), a2 + hstep, voffA);
            PG8_WAIT_V(8); PG8_WAIT_L(0); PG8_BAR; PG8_MMA(0, 0, At, B0); PG8_MMA(0, 1, At, B1); PG8_BAR; PG8_SCHED;
            PG8_LDA(At, 1, 1); PG8_STAGE(PG8_SB(1, 0), b3, voffB); PG8_STAGE(PG8_SB(1, 1), b3 + hstep, voffB); PG8_STAGE(PG8_SA(1, 0), a3, voffA);
            PG8_WAIT_V(8); PG8_WAIT_L(0); PG8_BAR; PG8_MMA(1, 0, At, B0); PG8_MMA(1, 1, At, B1); PG8_BAR; PG8_SCHED;
            } else {
            PG8_LDB(B0, 0, 0); PG8_SCHED; PG8_LDA(At, 0, 0); PG8_STAGE(PG8_SA(1, 1), a1 + hstep, voffA);
            PG8_WAIT_L(8); PG8_BAR; PG8_WAIT_L(0); PG8_MMA(0, 0, At, B0); PG8_BAR; PG8_SCHED;
            PG8_LDB(B1, 0, 1); PG8_STAGE(PG8_SB(0, 0), b2, voffB);
            PG8_BAR; PG8_WAIT_L(0); PG8_MMA(0, 1, At, B1); PG8_BAR;
            PG8_LDA(At, 0, 1); PG8_STAGE(PG8_SA(0, 0), a2, voffA);
            PG8_BAR; PG8_WAIT_L(0); PG8_MMA(1, 0, At, B0); PG8_BAR; PG8_SCHED;
            PG8_STAGE(PG8_SB(0, 1), b2 + hstep, voffB);
            PG8_WAIT_V(6); PG8_BAR; PG8_MMA(1, 1, At, B1); PG8_BAR;
            PG8_LDB(B0, 1, 0); PG8_SCHED; PG8_LDA(At, 1, 0); PG8_STAGE(PG8_SA(0, 1), a2 + hstep, voffA);
            PG8_WAIT_L(8); PG8_BAR; PG8_WAIT_L(0); PG8_MMA(0, 0, At, B0); PG8_BAR; PG8_SCHED;
            PG8_LDB(B1, 1, 1); PG8_STAGE(PG8_SB(1, 0), b3, voffB);
            PG8_BAR; PG8_WAIT_L(0); PG8_MMA(0, 1, At, B1); PG8_BAR;
            PG8_LDA(At, 1, 1); PG8_STAGE(PG8_SA(1, 0), a3, voffA);
            PG8_BAR; PG8_WAIT_L(0); PG8_MMA(1, 0, At, B0); PG8_BAR; PG8_SCHED;
            PG8_STAGE(PG8_SB(1, 1), b3 + hstep, voffB);
            PG8_WAIT_V(6); PG8_BAR; PG8_MMA(1, 1, At, B1); PG8_BAR;
            }
        }
        if constexpr (ALIGN_EPI) { if (wr == 0) PG8_BAR; }
        if constexpr (!Epi::AFTER_DRAIN) { const int le = LANE_ID(); E(acc, cur, wr, wc, le & 15, le >> 4); S.done(cur); }
        if (!has_next) break;
#pragma unroll
        for (int a = 0; a < 2; ++a)
#pragma unroll
            for (int b = 0; b < 2; ++b)
#pragma unroll
                for (int m = 0; m < 4; ++m)
#pragma unroll
                    for (int n = 0; n < 2; ++n) acc[a][b][m][n] = (f32x4){0.f, 0.f, 0.f, 0.f};
        cur = nxt; cA = nA; cB = nB; ++ui;
        if constexpr (ALIGN_EPI) { if (wr == 1) PG8_BAR; }
    }
    PG8_WAIT_V(0);
    if constexpr (!ALIGN_EPI) { if (wr == 0) PG8_BAR; }
    PG8_BAR;
    if constexpr (Epi::AFTER_DRAIN) { E.fused(acc, cur, wr, wc, fr, fq, lds, wid, lane); S.done(cur); }
#undef PG8_SA
#undef PG8_SB
#undef PG8_STAGE
#undef PG8_LDA
#undef PG8_LDB
#undef PG8_MMA
#undef PG8_WAIT_V
#undef PG8_WAIT_L
#undef PG8_BAR
#undef PG8_SCHED
}
}
#define PG8_SP2 true
#define PG8_ALIGN true
using pg8::bf16_t; using pg8::bf16x8; using pg8::f32x4; using pg8::Unit; using pg8::cvt_pk_bf16;
#define LAS __attribute__((address_space(3)))
typedef float f32x16 __attribute__((ext_vector_type(16)));
typedef unsigned u32x2 __attribute__((ext_vector_type(2)));
typedef unsigned u32x4 __attribute__((ext_vector_type(4)));
typedef short v4i16_t __attribute__((ext_vector_type(4)));

constexpr int MP = 65536, MSMP = 512, MT = MP + MSMP, MC = 32768;
constexpr int INC = 5824, NIN = 5888, QL = 384, KVL = 256, NQ = 1536, NKV = 2048, DFF = 2816, NUP = 5632;
constexpr float EPS = 1e-6f, LOG2E = 1.4426950408889634f;
constexpr float QS_DA = 0.125f * LOG2E;
constexpr float QS_MLA = 0.07216878364870322f * LOG2E;
constexpr size_t O_DKP = (size_t)MT * 1024;
constexpr size_t O_DVP = O_DKP + 2 * (size_t)MP * 1024;
constexpr size_t O_CKVP = O_DVP + 2 * (size_t)MP * 1024;
constexpr size_t O_KRP = O_CKVP + 2 * (size_t)MP * 256;
constexpr size_t O_CVP = O_KRP + 2 * (size_t)MP * 64;
constexpr size_t O_DKS = O_CVP + 2 * 32 * 2 * 5632;
constexpr size_t O_DVS = O_DKS + 2 * 512 * 1024;
constexpr size_t O_CKVS = O_DVS + 2 * 512 * 1024;
constexpr size_t O_KRS = O_CKVS + 2 * 512 * 256;
constexpr size_t O_CVS = O_KRS + 2 * 512 * 64;
constexpr size_t O_END = O_CVS + 2 * 16 * 2 * 5632;
constexpr size_t A256(size_t x) { return (x + 255) & ~(size_t)255; }
constexpr size_t W_CTL = 0;
constexpr size_t W_ROPE = 4096;
constexpr size_t W_SS = A256(W_ROPE + (size_t)2080 * 64 * 4);
constexpr size_t W_WIN = A256(W_SS + (size_t)9 * MT * 4);
constexpr size_t W_WQ = A256(W_WIN + (size_t)2 * NIN * 1024 * 2);
constexpr size_t W_WKV = A256(W_WQ + (size_t)2 * NQ * QL * 2);
constexpr size_t W_WKVC = A256(W_WKV + (size_t)2 * NKV * KVL * 2);
constexpr size_t W_WO = A256(W_WKVC + (size_t)2 * NKV * KVL * 2);
constexpr size_t W_WUP = A256(W_WO + (size_t)2 * 1024 * 1024 * 2);
constexpr size_t W_WDN = A256(W_WUP + (size_t)2 * NUP * 1024 * 2);
constexpr size_t W_HX = A256(W_WDN + (size_t)2 * 1024 * DFF * 2);
constexpr size_t W_X = A256(W_HX + (size_t)MT * 1024 * 2);
constexpr size_t W_QDA = A256(W_X + (size_t)MT * 1024 * 4);
constexpr size_t W_KDA = A256(W_QDA + (size_t)MT * 1024 * 2);
constexpr size_t W_VDA = A256(W_KDA + (size_t)MT * 1024 * 2);
constexpr size_t W_G = A256(W_VDA + (size_t)MT * 1024 * 2);
constexpr size_t W_CKV = A256(W_G + (size_t)MT * 2048 * 2);
constexpr size_t W_CQ = A256(W_CKV + (size_t)MT * 256 * 2);
constexpr size_t W_KR = A256(W_CQ + (size_t)MT * 384 * 2);
constexpr size_t W_QM = A256(W_KR + (size_t)MT * 64 * 2);
constexpr size_t W_KN = A256(W_QM + (size_t)MT * 1536 * 2);
constexpr size_t W_VM = A256(W_KN + (size_t)MT * 1024 * 2);
constexpr size_t W_MRG = A256(W_VM + (size_t)MT * 1024 * 2);
constexpr size_t W_U = A256(W_MRG + (size_t)MT * 1024 * 2);
constexpr size_t W_ACT = A256(W_U + (size_t)MT * NUP * 2);
constexpr size_t W_KC = A256(W_ACT + (size_t)MT * DFF * 2);
constexpr size_t W_VC = A256(W_KC + (size_t)2 * MC * 1024 * 2);
constexpr size_t W_KRC = A256(W_VC + (size_t)2 * MC * 1024 * 2);
constexpr size_t W_CKVC = A256(W_KRC + (size_t)2 * MC * 64 * 2);
constexpr size_t W_KNC = A256(W_CKVC + (size_t)2 * MC * 256 * 2);
constexpr size_t W_VMC = A256(W_KNC + (size_t)2 * MC * 1024 * 2);
constexpr size_t W_END = A256(W_VMC + (size_t)2 * MC * 1024 * 2);

struct Params { const float* in[27]; float* out; unsigned char* ws; };

#define GAS __attribute__((address_space(1)))
__device__ __forceinline__ void st_bf16x4(bf16_t* p, f32x4 v) { u32x2 w; w.x = cvt_pk_bf16(v[0], v[1]); w.y = cvt_pk_bf16(v[2], v[3]); *(GAS u32x2*)p = w; }
__device__ __forceinline__ f32x4 ldg4(const float* p) { return *(const GAS f32x4*)p; }
__device__ __forceinline__ void stg4(float* p, f32x4 v) { *(GAS f32x4*)p = v; }
__device__ __forceinline__ u32x4 ldgu4(const void* p) { return *(const GAS u32x4*)p; }
__device__ __forceinline__ u32x2 ldgu2(const void* p) { return *(const GAS u32x2*)p; }
__device__ __forceinline__ float ldg1(const float* p) { return *(const GAS float*)p; }
__device__ __forceinline__ float fast_rcp(float x) { return __builtin_amdgcn_rcpf(x); }
__device__ __forceinline__ float fast_exp2(float x) { return __builtin_amdgcn_exp2f(x); }
__device__ __forceinline__ float sigmoidf_(float x) { return fast_rcp(1.f + fast_exp2(-x * LOG2E)); }
__device__ __forceinline__ float bf2f(unsigned short b) { return __uint_as_float((unsigned)b << 16); }
__device__ __forceinline__ int row_of(const Unit& u, int ai, int wr, int m, int fr) { return u.pm * 256 + ai * 128 + wr * 64 + m * 16 + fr; }
__device__ __forceinline__ float sq4(f32x4 v) { return (v[0] * v[0] + v[1] * v[1]) + (v[2] * v[2] + v[3] * v[3]); }

__device__ __forceinline__ float add_x16(float s) { return s + __int_as_float(__builtin_amdgcn_ds_swizzle(__float_as_int(s), 0x401F)); }
__device__ __forceinline__ float add_x32(float s) { auto rr = __builtin_amdgcn_permlane32_swap(__float_as_uint(s), __float_as_uint(s), false, false); return __uint_as_float(rr[0]) + __uint_as_float(rr[1]); }
__device__ __forceinline__ float max_x32(float s) { auto rr = __builtin_amdgcn_permlane32_swap(__float_as_uint(s), __float_as_uint(s), false, false); return fmaxf(__uint_as_float(rr[0]), __uint_as_float(rr[1])); }
#define LOAD_RS8(name, ptr, scale, mul) float name[2][4]; { _Pragma("unroll") for (int ai_ = 0; ai_ < 2; ++ai_) _Pragma("unroll") for (int m_ = 0; m_ < 4; ++m_) name[ai_][m_] = ldg1((ptr) + row_of(u, ai_, wr, m_, fr)); \
    _Pragma("unroll") for (int ai_ = 0; ai_ < 2; ++ai_) _Pragma("unroll") for (int m_ = 0; m_ < 4; ++m_) name[ai_][m_] = rsqrtf(name[ai_][m_] * (scale) + EPS) * (mul); }
struct EpiInProj {
    static constexpr bool PERM = false, AFTER_DRAIN = false;
    unsigned char* ws; float* out; const float* bgate; int l;
    __device__ __forceinline__ void operator()(const f32x4 (&acc)[2][2][4][2], const Unit& u, int wr, int wc, int fr, int fq) const {
        const int pn = u.pn;
        const float* SSb = (const float*)(ws + W_SS); const float* ssx = SSb + (size_t)(2 * l) * MT; const float* rope = (const float*)(ws + W_ROPE);
        float* sscq = (float*)(ws + W_SS) + (size_t)(5 + l) * MT; float* ssckv = (float*)(ws + W_SS) + (size_t)(7 + l) * MT;
        bf16_t* QDA = (bf16_t*)(ws + W_QDA); bf16_t* KDA = (bf16_t*)(ws + W_KDA); bf16_t* VDA = (bf16_t*)(ws + W_VDA); bf16_t* G = (bf16_t*)(ws + W_G);
        bf16_t* CKV = (bf16_t*)(ws + W_CKV); bf16_t* CQ = (bf16_t*)(ws + W_CQ); bf16_t* KR = (bf16_t*)(ws + W_KR);
        float* dkp = out + O_DKP + (size_t)l * MP * 1024; float* dks = out + O_DKS + (size_t)l * MSMP * 1024; float* dvp = out + O_DVP + (size_t)l * MP * 1024; float* dvs = out + O_DVS + (size_t)l * MSMP * 1024;
        float* ckp = out + O_CKVP + (size_t)l * MP * 256; float* cks = out + O_CKVS + (size_t)l * MSMP * 256; float* krp = out + O_KRP + (size_t)l * MP * 64; float* krs = out + O_KRS + (size_t)l * MSMP * 64;
        LOAD_RS8(rs8, ssx, 1.f / 1024.f, 1.f)
        if (pn < 8) {
            const bool isk = pn >= 4; const int cb = 256 * (pn & 3) + 64 * wc;
#pragma unroll
            for (int ai = 0; ai < 2; ++ai)
#pragma unroll
                for (int m = 0; m < 4; ++m) { if ((m & 1) == 0) asm volatile("" ::: "memory");
                    const int row = row_of(u, ai, wr, m, fr); const float rstd = rs8[ai][m];
                    const bool samp = row >= MP; const int orow = samp ? row - MP : row; const int pos = samp ? 2048 + (orow & 31) : (row & 2047);
                    const float* rt = rope + (size_t)pos * 64;
#pragma unroll
                    for (int n = 0; n < 2; ++n) {
                        const int i0 = 16 * n + 4 * fq; const f32x4 cs = ldg4(rt + i0), sn = ldg4(rt + 32 + i0);
                        const f32x4 x1 = acc[ai][0][m][n] * rstd, x2 = acc[ai][1][m][n] * rstd;
                        f32x4 o1 = x1 * cs - x2 * sn, o2 = x2 * cs + x1 * sn;
                        if (!isk) { o1 = o1 * QS_DA; o2 = o2 * QS_DA; bf16_t* q = QDA + (size_t)row * 1024 + cb + i0; st_bf16x4(q, o1); st_bf16x4(q + 32, o2); }
                        else { bf16_t* k = KDA + (size_t)row * 1024 + cb + i0; st_bf16x4(k, o1); st_bf16x4(k + 32, o2);
                               float* d = (samp ? dks : dkp) + (size_t)orow * 1024 + cb + i0; stg4(d, o1); stg4((d + 32), o2); }
                    }
                }
        } else if (pn < 12) {
            const int cb = 256 * (pn - 8) + 32 * wc + 4 * fq;
#pragma unroll
            for (int ai = 0; ai < 2; ++ai)
#pragma unroll
                for (int m = 0; m < 4; ++m) { if ((m & 1) == 0) asm volatile("" ::: "memory");
                    const int row = row_of(u, ai, wr, m, fr); const float rstd = rs8[ai][m];
                    const bool samp = row >= MP; const int orow = samp ? row - MP : row;
                    float* d = (samp ? dvs : dvp) + (size_t)orow * 1024 + cb; bf16_t* v = VDA + (size_t)row * 1024 + cb;
#pragma unroll
                    for (int bj = 0; bj < 2; ++bj)
#pragma unroll
                        for (int n = 0; n < 2; ++n) { const f32x4 x = acc[ai][bj][m][n] * rstd; stg4((d + 128 * bj + 16 * n), x); st_bf16x4(v + 128 * bj + 16 * n, x); }
                }
        } else if (pn < 20) {
            const int cb = 256 * (pn - 12) + 32 * wc + 4 * fq;
            f32x4 bv[2][2];
#pragma unroll
            for (int bj = 0; bj < 2; ++bj)
#pragma unroll
                for (int n = 0; n < 2; ++n) bv[bj][n] = ldg4(bgate + cb + 128 * bj + 16 * n);
#pragma unroll
            for (int ai = 0; ai < 2; ++ai)
#pragma unroll
                for (int m = 0; m < 4; ++m) { if ((m & 1) == 0) asm volatile("" ::: "memory");
                    const int row = row_of(u, ai, wr, m, fr); const float rstd = rs8[ai][m];
                    bf16_t* g = G + (size_t)row * 2048 + cb;
#pragma unroll
                    for (int bj = 0; bj < 2; ++bj)
#pragma unroll
                        for (int n = 0; n < 2; ++n) { f32x4 x = acc[ai][bj][m][n] * rstd + bv[bj][n];
                            x[0] = sigmoidf_(x[0]); x[1] = sigmoidf_(x[1]); x[2] = sigmoidf_(x[2]); x[3] = sigmoidf_(x[3]); st_bf16x4(g + 128 * bj + 16 * n, x); }
                }
        } else if (pn == 20) {
            const int cb = 32 * wc + 4 * fq;
#pragma unroll
            for (int ai = 0; ai < 2; ++ai)
#pragma unroll
                for (int m = 0; m < 4; ++m) { if ((m & 1) == 0) asm volatile("" ::: "memory");
                    const int row = row_of(u, ai, wr, m, fr); const float rstd = rs8[ai][m];
                    const bool samp = row >= MP; const int orow = samp ? row - MP : row;
                    float* d = (samp ? cks : ckp) + (size_t)orow * 256 + cb; bf16_t* c = CKV + (size_t)row * 256 + cb; float s = 0.f;
#pragma unroll
                    for (int bj = 0; bj < 2; ++bj)
#pragma unroll
                        for (int n = 0; n < 2; ++n) { const f32x4 x = acc[ai][bj][m][n] * rstd; s += sq4(x); stg4((d + 128 * bj + 16 * n), x); st_bf16x4(c + 128 * bj + 16 * n, x); }
                    s = add_x16(s); s = add_x32(s);
                    if (fq == 0) unsafeAtomicAdd(ssckv + row, s);
                }
        } else if (pn == 21) {
            const int cb = 32 * wc + 4 * fq;
#pragma unroll
            for (int ai = 0; ai < 2; ++ai)
#pragma unroll
                for (int m = 0; m < 4; ++m) { if ((m & 1) == 0) asm volatile("" ::: "memory");
                    const int row = row_of(u, ai, wr, m, fr); const float rstd = rs8[ai][m];
                    bf16_t* c = CQ + (size_t)row * 384 + cb; float s = 0.f;
#pragma unroll
                    for (int bj = 0; bj < 2; ++bj)
#pragma unroll
                        for (int n = 0; n < 2; ++n) { const f32x4 x = acc[ai][bj][m][n] * rstd; s += sq4(x); st_bf16x4(c + 128 * bj + 16 * n, x); }
                    s = add_x16(s); s = add_x32(s);
                    if (fq == 0) unsafeAtomicAdd(sscq + row, s);
                }
        } else {
#pragma unroll
            for (int ai = 0; ai < 2; ++ai)
#pragma unroll
                for (int m = 0; m < 4; ++m) { if ((m & 1) == 0) asm volatile("" ::: "memory");
                    const int row = row_of(u, ai, wr, m, fr); const float rstd = rs8[ai][m];
                    const bool samp = row >= MP; const int orow = samp ? row - MP : row; const int pos = samp ? 2048 + (orow & 31) : (row & 2047);
                    bf16_t* c = CQ + (size_t)row * 384 + 256 + 32 * wc + 4 * fq; float s = 0.f;
#pragma unroll
                    for (int n = 0; n < 2; ++n) { const f32x4 x = acc[ai][0][m][n] * rstd; s += sq4(x); st_bf16x4(c + 16 * n, x); }
                    s = add_x16(s); s = add_x32(s);
                    if (fq == 0) unsafeAtomicAdd(sscq + row, s);
                    if (wc < 2) {
                        const int i0 = 16 * wc + 4 * fq; const float* rt = rope + (size_t)pos * 64;
                        const f32x4 cs = ldg4(rt + i0), sn = ldg4(rt + 32 + i0);
                        const f32x4 x1 = acc[ai][1][m][0] * rstd, x2 = acc[ai][1][m][1] * rstd;
                        const f32x4 o1 = x1 * cs - x2 * sn, o2 = x2 * cs + x1 * sn;
                        float* d = (samp ? krs : krp) + (size_t)orow * 64 + i0; stg4(d, o1); stg4((d + 32), o2);
                        bf16_t* k = KR + (size_t)row * 64 + i0; st_bf16x4(k, o1); st_bf16x4(k + 32, o2);
                    }
                }
        }
    }
};

struct EpiQ {
    static constexpr bool PERM = false, AFTER_DRAIN = false;
    const float* sscq; const float* rope; bf16_t* QM;
    __device__ __forceinline__ void operator()(const f32x4 (&acc)[2][2][4][2], const Unit& u, int wr, int wc, int fr, int fq) const {
        const int pn = u.pn;
        LOAD_RS8(rs8, sscq, 1.f / 384.f, QS_MLA)
#pragma unroll
        for (int ai = 0; ai < 2; ++ai)
#pragma unroll
            for (int m = 0; m < 4; ++m) { if ((m & 1) == 0) asm volatile("" ::: "memory");
                const int row = row_of(u, ai, wr, m, fr); const float rs = rs8[ai][m];
                bf16_t* q = QM + (size_t)row * 1536;
                if (pn < 4) {
#pragma unroll
                    for (int bj = 0; bj < 2; ++bj)
#pragma unroll
                        for (int n = 0; n < 2; ++n) st_bf16x4(q + (2 * pn + bj) * 192 + 32 * wc + 16 * n + 4 * fq, acc[ai][bj][m][n] * rs);
                } else {
                    const int pos = row >= MP ? 2048 + ((row - MP) & 31) : (row & 2047); const float* rt = rope + (size_t)pos * 64;
                    bf16_t* qh = q + (4 * (pn - 4) + wc) * 192 + 128;
#pragma unroll
                    for (int n = 0; n < 2; ++n) {
                        const int i0 = 16 * n + 4 * fq; const f32x4 cs = ldg4(rt + i0), sn = ldg4(rt + 32 + i0);
                        const f32x4 x1 = acc[ai][0][m][n] * rs, x2 = acc[ai][1][m][n] * rs;
                        st_bf16x4(qh + i0, x1 * cs - x2 * sn); st_bf16x4(qh + 32 + i0, x2 * cs + x1 * sn);
                    }
                }
            }
    }
};

template <bool HAS_SS> struct EpiKV {
    static constexpr bool PERM = false, AFTER_DRAIN = false;
    const float* ss; bf16_t *O0, *O1;
    __device__ __forceinline__ void operator()(const f32x4 (&acc)[2][2][4][2], const Unit& u, int wr, int wc, int fr, int fq) const {
        bf16_t* base = (u.pn < 4 ? O0 : O1) + 256 * (u.pn & 3) + 32 * wc + 4 * fq;
        float rs8[2][4];
        if constexpr (HAS_SS) { LOAD_RS8(t8, ss, 1.f / 256.f, 1.f) _Pragma("unroll") for (int a = 0; a < 2; ++a) _Pragma("unroll") for (int b = 0; b < 4; ++b) rs8[a][b] = t8[a][b]; }
#pragma unroll
        for (int ai = 0; ai < 2; ++ai)
#pragma unroll
            for (int m = 0; m < 4; ++m) { if ((m & 1) == 0) asm volatile("" ::: "memory");
                const int row = row_of(u, ai, wr, m, fr); const float rs = HAS_SS ? rs8[ai][m] : 1.f;
                bf16_t* o = base + (size_t)row * 1024;
#pragma unroll
                for (int bj = 0; bj < 2; ++bj)
#pragma unroll
                    for (int n = 0; n < 2; ++n) st_bf16x4(o + 128 * bj + 16 * n, acc[ai][bj][m][n] * rs);
            }
    }
};

struct EpiRes {
    static constexpr bool PERM = false, AFTER_DRAIN = false;
    const float* xp; const float* xs; float* X; bf16_t* HX; float* ssn;
    __device__ __forceinline__ void operator()(const f32x4 (&acc)[2][2][4][2], const Unit& u, int wr, int wc, int fr, int fq) const {
        const int cb = 256 * u.pn + 32 * wc + 4 * fq;
#pragma unroll
        for (int ai = 0; ai < 2; ++ai)
#pragma unroll
            for (int m = 0; m < 4; ++m) { if ((m & 1) == 0) asm volatile("" ::: "memory");
                const int row = row_of(u, ai, wr, m, fr);
                bf16_t* h = HX + (size_t)row * 1024 + cb; float s = 0.f;
                f32x4 xo[2][2];
                if (xp) { const float* xi = (row >= MP ? xs + (size_t)(row - MP) * 1024 : xp + (size_t)row * 1024) + cb;
#pragma unroll
                    for (int bj = 0; bj < 2; ++bj)
#pragma unroll
                        for (int n = 0; n < 2; ++n) xo[bj][n] = ldg4(xi + 128 * bj + 16 * n); }
                else {
#pragma unroll
                    for (int bj = 0; bj < 2; ++bj)
#pragma unroll
                        for (int n = 0; n < 2; ++n) { const u32x2 w = ldgu2(h + 128 * bj + 16 * n);
                            xo[bj][n] = (f32x4){__uint_as_float(w.x << 16), __uint_as_float(w.x & 0xffff0000u), __uint_as_float(w.y << 16), __uint_as_float(w.y & 0xffff0000u)}; } }
#pragma unroll
                for (int bj = 0; bj < 2; ++bj)
#pragma unroll
                    for (int n = 0; n < 2; ++n) { const f32x4 x = xo[bj][n] + acc[ai][bj][m][n]; s += sq4(x); st_bf16x4(h + 128 * bj + 16 * n, x);
                        if (X) stg4((X + (size_t)row * 1024 + cb + 128 * bj + 16 * n), x); }
                s = add_x16(s); s = add_x32(s);
                if (fq == 0) unsafeAtomicAdd(ssn + row, s);
            }
    }
};

template <int CTRL> __device__ __forceinline__ float dpp_f(float old, float src) { return __int_as_float(__builtin_amdgcn_update_dpp(__float_as_int(old), __float_as_int(src), CTRL, 0xf, 0xf, false)); }
struct EpiUp {
    static constexpr bool PERM = false, AFTER_DRAIN = false;
    const float* ssx; bf16_t* ACT; bf16_t* UH; float* cvp; float* cvs; const float* wc; const float* bc; const float* stc;
    __device__ __forceinline__ void operator()(const f32x4 (&acc)[2][2][4][2], const Unit& u, int wr, int wc_, int fr, int fq) const {
        const int cb = 128 * u.pn + 32 * wc_ + 4 * fq;
        const bool samp = u.pm >= 256;
        LOAD_RS8(rs8, ssx, 1.f / 1024.f, 1.f)
#pragma unroll
        for (int ai = 0; ai < 2; ++ai)
#pragma unroll
            for (int m = 0; m < 4; ++m) { asm volatile("" ::: "memory");
                const int row = row_of(u, ai, wr, m, fr); const float rs = rs8[ai][m];
                const bool from_prev = samp ? (m & 1) : (m > 0);
                const bool seq0 = !samp && m == 0 && ((row - fr) & 2047) == 0;
                const bool defer = !samp && m == 0 && !seq0 && fr < 2;
                float* cv = nullptr;
                if (samp) { const int r = row - MP, sq = r & 31; if (sq >= 30) cv = cvs + ((size_t)(r >> 5) * 2 + (sq - 30)) * NUP + cb; }
                else { const int sq = row & 2047; if (sq >= 2046) cv = cvp + ((size_t)(row >> 11) * 2 + (sq - 2046)) * NUP + cb; }
                bf16_t* uh = nullptr;
                if (!samp) { if (m == 0 && fr < 2) uh = UH + ((size_t)(row >> 6) * 4 + fr) * NUP + cb; else if (m == 3 && fr >= 14) uh = UH + ((size_t)(row >> 6) * 4 + 2 + (fr - 14)) * NUP + cb; }
                const float* st0 = stc + (size_t)(samp ? (row - MP) >> 5 : 0) * 2 * NUP + cb;
#pragma unroll
                for (int n = 0; n < 2; ++n) {
                    f32x4 cc[2];
#pragma unroll
                    for (int bj = 0; bj < 2; ++bj) {
                        const int co = DFF * bj + 16 * n;
                        const f32x4 x = acc[ai][bj][m][n] * rs;
                        if (cv) stg4(cv + co, x);
                        if (uh) st_bf16x4(uh + co, x);
                        f32x4 c1, c2;
                        if (from_prev) { const f32x4 xp = acc[ai][bj][m > 0 ? m - 1 : 0][n] * rs8[ai][m > 0 ? m - 1 : 0];
#pragma unroll
                            for (int j = 0; j < 4; ++j) { c1[j] = dpp_f<0x121>(0.f, xp[j]); c2[j] = dpp_f<0x122>(0.f, xp[j]); } }
                        else if (samp) { c1 = ldg4(st0 + NUP + co); c2 = ldg4(st0 + (size_t)(fr & 1) * NUP + co); }
                        else { c1 = (f32x4){0.f, 0.f, 0.f, 0.f}; c2 = c1; }
                        const f32x4 w0 = ldg4(wc + cb + co), w1 = ldg4(wc + NUP + cb + co), w2 = ldg4(wc + 2 * NUP + cb + co), bb = ldg4(bc + cb + co);
#pragma unroll
                        for (int j = 0; j < 4; ++j) { const float p1 = dpp_f<0x111>(c1[j], x[j]), p2 = dpp_f<0x112>(c2[j], x[j]); cc[bj][j] = bb[j] + w0[j] * p2 + w1[j] * p1 + w2[j] * x[j]; }
                    }
                    if (!defer) { f32x4 r;
#pragma unroll
                        for (int j = 0; j < 4; ++j) r[j] = cc[0][j] * sigmoidf_(cc[0][j]) * cc[1][j];
                        st_bf16x4(ACT + (size_t)row * DFF + cb + 16 * n, r); }
                }
            }
    }
};
struct KVD { const bf16_t* k; const bf16_t* k2; const bf16_t* v; const float* kf; const float* vf; };
constexpr int ATT_KBUF = 64 * 400, ATT_VOFF = 2 * ATT_KBUF, ATT_VIMG = 32 * 320, ATT_VBUF = 2 * ATT_VIMG;

template <int DQK, bool F32M>
__device__ __forceinline__ void attn_pass(LAS unsigned char* lds, const int wid, const bf16_t* qrow, const KVD& dm, const KVD& dl, int nmain, int ntw, int ntc, f32x16 (&o)[4], float& linv) {
    constexpr int NCH = DQK / 8, KST = DQK * 2 + 16, NKI = NCH / 8, NS = DQK / 16;
    const int lane = LANE_ID(), tid = (wid << 6) | lane, r32 = lane & 31, hi = lane >> 5;
    bf16x8 q[NS];
#pragma unroll
    for (int s = 0; s < NS; ++s) q[s] = __builtin_bit_cast(bf16x8, ldgu4(qrow + 16 * s + 8 * hi));
    u32x4 kr[NKI], vr[2], kr2[F32M ? NKI : 1], vr2[F32M ? 2 : 1];
#define ATT_GLOADK(t) do { const bool lastt = (t) >= nmain; const KVD& d = lastt ? dl : dm; const int rb = lastt ? 0 : (t) * 64; const int rm = lastt ? 31 : 63; \
        _Pragma("unroll") for (int i = 0; i < NKI; ++i) { const int id = tid + 512 * i, kro = id / NCH, kc = id - kro * NCH; const int r = rb + (kro & rm); \
            if (F32M && !lastt) { const float* p_ = d.kf + (size_t)r * 1024 + kc * 8; kr[i] = ldgu4(p_); kr2[F32M ? i : 0] = ldgu4(p_ + 4); } \
            else kr[i] = (DQK == 64 || kc < 16) ? ldgu4(d.k + (size_t)r * 1024 + kc * 8) : ldgu4(d.k2 + (size_t)r * 64 + (kc - 16) * 8); } } while (0)
#define ATT_GLOADV(t) do { const bool lastt = (t) >= nmain; const KVD& d = lastt ? dl : dm; const int rb = lastt ? 0 : (t) * 64; const int rm = lastt ? 31 : 63; \
        _Pragma("unroll") for (int i = 0; i < 2; ++i) { const int r = rb + (((tid >> 4) + 32 * i) & rm); \
            if (F32M && !lastt) { const float* p_ = d.vf + (size_t)r * 1024 + (tid & 15) * 8; vr[i] = ldgu4(p_); vr2[F32M ? i : 0] = ldgu4(p_ + 4); } \
            else vr[i] = ldgu4(d.v + (size_t)r * 1024 + (tid & 15) * 8); } } while (0)
#define ATT_PK8(a_, b_) (u32x4){cvt_pk_bf16(__uint_as_float((a_).x), __uint_as_float((a_).y)), cvt_pk_bf16(__uint_as_float((a_).z), __uint_as_float((a_).w)), cvt_pk_bf16(__uint_as_float((b_).x), __uint_as_float((b_).y)), cvt_pk_bf16(__uint_as_float((b_).z), __uint_as_float((b_).w))}
#define ATT_LSTORE(b, tt) do { const bool cvt_ = F32M && (tt) < nmain; \
        _Pragma("unroll") for (int i = 0; i < NKI; ++i) { const int id = tid + 512 * i, kro = id / NCH, kc = id - kro * NCH; *(LAS u32x4*)(lds + (b) * ATT_KBUF + kro * KST + kc * 16) = cvt_ ? ATT_PK8(kr[i], kr2[F32M ? i : 0]) : kr[i]; } \
        _Pragma("unroll") for (int i = 0; i < 2; ++i) *(LAS u32x4*)(lds + ATT_VOFF + (b) * ATT_VBUF + i * ATT_VIMG + (tid >> 4) * 320 + (tid & 15) * 16) = cvt_ ? ATT_PK8(vr[i], vr2[F32M ? i : 0]) : vr[i]; } while (0)
    ATT_GLOADK(0); ATT_GLOADV(0); ATT_LSTORE(0, 0); __syncthreads();
    float m_run = 0.f, l_run = 0.f;
#pragma unroll
    for (int c = 0; c < 4; ++c)
#pragma unroll
        for (int r = 0; r < 16; ++r) o[c][r] = 0.f;
    const int vlane = (4 * hi + ((lane & 15) >> 2)) * 320 + (2 * ((lane >> 4) & 1) + ((lane & 3) >> 1)) * 16 + 8 * (lane & 1);
    for (int t = 0; t < ntw; ++t) {
        if (t + 1 < ntw) ATT_GLOADK(t + 1);
        bool vloaded = false;
        if (t < ntc) {
            const LAS unsigned char* kb = lds + (t & 1) * ATT_KBUF + r32 * KST + hi * 16;
            const LAS unsigned char* vb = lds + ATT_VOFF + (t & 1) * ATT_VBUF;
            f32x16 p0, p1;
#pragma unroll
            for (int r = 0; r < 16; ++r) { p0[r] = 0.f; p1[r] = 0.f; }
            constexpr int KCH = 2, NG = NS / KCH, NB = (DQK == 64) ? 2 : 1;
            bf16x8 kf[NB][2 * KCH];
#define ATT_LDK(ch, b) do { _Pragma("unroll") for (int j_ = 0; j_ < KCH; ++j_) { kf[b][2 * j_] = *(const LAS bf16x8*)(kb + (KCH * (ch) + j_) * 32); kf[b][2 * j_ + 1] = *(const LAS bf16x8*)(kb + 32 * KST + (KCH * (ch) + j_) * 32); } } while (0)
            ATT_LDK(0, 0); __builtin_amdgcn_sched_barrier(0);
#pragma unroll
            for (int ch = 0; ch < NG; ++ch) {
                if (NB == 2 && ch + 1 < NG) ATT_LDK(ch + 1, NB == 2 ? ((ch + 1) & 1) : 0);
                __builtin_amdgcn_sched_barrier(0);
#pragma unroll
                for (int j = 0; j < KCH; ++j) {
                    p0 = __builtin_amdgcn_mfma_f32_32x32x16_bf16(kf[NB == 2 ? (ch & 1) : 0][2 * j], q[KCH * ch + j], p0, 0, 0, 0);
                    p1 = __builtin_amdgcn_mfma_f32_32x32x16_bf16(kf[NB == 2 ? (ch & 1) : 0][2 * j + 1], q[KCH * ch + j], p1, 0, 0, 0);
                }
                __builtin_amdgcn_sched_barrier(0);
                if (NB == 1 && ch + 1 < NG) { ATT_LDK(ch + 1, 0); __builtin_amdgcn_sched_barrier(0); }
            }
#undef ATT_LDK
            bf16x8 vf[2][4];
#define ATT_LDV(cmb, b) do { _Pragma("unroll") for (int c_ = 0; c_ < 4; ++c_) { const LAS unsigned char* a0_ = vb + vlane + ((cmb) >> 1) * ATT_VIMG + (16 * ((cmb) & 1)) * 320 + c_ * 64; \
                const v4i16_t t0_ = __builtin_amdgcn_ds_read_tr16_b64_v4i16((LAS v4i16_t*)a0_), t1_ = __builtin_amdgcn_ds_read_tr16_b64_v4i16((LAS v4i16_t*)(a0_ + 8 * 320)); \
                vf[b][c_] = (bf16x8){t0_[0], t0_[1], t0_[2], t0_[3], t1_[0], t1_[1], t1_[2], t1_[3]}; } } while (0)
#pragma unroll
            for (int r = 0; r < 16; ++r) { p0[r] -= m_run; p1[r] -= m_run; }
            if (t >= nmain) { asm volatile("" ::: "memory");
#pragma unroll
                for (int r = 0; r < 16; ++r) p1[r] = -INFINITY;
            }
            float mt = __builtin_fmaxf(__builtin_fmaxf(p0[0], p1[0]), p0[1]);
#pragma unroll
            for (int r = 1; r < 15; r += 2) { mt = __builtin_fmaxf(__builtin_fmaxf(mt, p1[r]), p0[r + 1]); mt = __builtin_fmaxf(__builtin_fmaxf(mt, p1[r + 1]), p0[r + 2 < 16 ? r + 2 : 15]); }
            mt = __builtin_fmaxf(mt, p1[15]);
            mt = max_x32(mt);
            const float dref = (t == 0 || mt > 8.f) ? mt : 0.f;
            if (__builtin_amdgcn_ballot_w64(dref != 0.f) != 0ull) {
                m_run += dref;
#pragma unroll
                for (int r = 0; r < 16; ++r) { p0[r] -= dref; p1[r] -= dref; }
                if (t > 0) { const float f = fast_exp2(-dref); l_run *= f;
#pragma unroll
                    for (int c = 0; c < 4; ++c)
#pragma unroll
                        for (int r = 0; r < 16; ++r) o[c][r] *= f; }
            }
            float rs = 0.f;
#pragma unroll
            for (int r = 0; r < 16; ++r) { p0[r] = fast_exp2(p0[r]); p1[r] = fast_exp2(p1[r]); rs += p0[r] + p1[r]; }
            l_run += rs;
            asm volatile("" ::: "memory");
            if (t + 1 < ntw) { ATT_GLOADV(t + 1); vloaded = true; }
            bf16x8 pf[2][2];
#pragma unroll
            for (int ks = 0; ks < 2; ++ks) {
                u32x4 a, b;
                a.x = cvt_pk_bf16(p0[8 * ks + 0], p0[8 * ks + 1]); a.y = cvt_pk_bf16(p0[8 * ks + 2], p0[8 * ks + 3]); a.z = cvt_pk_bf16(p0[8 * ks + 4], p0[8 * ks + 5]); a.w = cvt_pk_bf16(p0[8 * ks + 6], p0[8 * ks + 7]);
                b.x = cvt_pk_bf16(p1[8 * ks + 0], p1[8 * ks + 1]); b.y = cvt_pk_bf16(p1[8 * ks + 2], p1[8 * ks + 3]); b.z = cvt_pk_bf16(p1[8 * ks + 4], p1[8 * ks + 5]); b.w = cvt_pk_bf16(p1[8 * ks + 6], p1[8 * ks + 7]);
                pf[0][ks] = __builtin_bit_cast(bf16x8, a); pf[1][ks] = __builtin_bit_cast(bf16x8, b);
            }
            __builtin_amdgcn_sched_barrier(0);
            ATT_LDV(0, 0); __builtin_amdgcn_sched_barrier(0);
#pragma unroll
            for (int cmb = 0; cmb < 4; ++cmb) {
                if (cmb + 1 < 4) ATT_LDV(cmb + 1, (cmb + 1) & 1);
                __builtin_amdgcn_sched_barrier(0);
#pragma unroll
                for (int c = 0; c < 4; ++c) o[c] = __builtin_amdgcn_mfma_f32_32x32x16_bf16(vf[cmb & 1][c], pf[cmb >> 1][cmb & 1], o[c], 0, 0, 0);
                __builtin_amdgcn_sched_barrier(0);
            }
#undef ATT_LDV
        }
        if (t + 1 < ntw) { if (!vloaded) ATT_GLOADV(t + 1); ATT_LSTORE((t + 1) & 1, t + 1); }
        __syncthreads();
    }
    const float lt = add_x32(l_run);
    linv = fast_rcp(lt);
#undef ATT_GLOADK
#undef ATT_PK8
#undef ATT_GLOADV
#undef ATT_LSTORE
}

struct AttnCtx { unsigned char* ws; const float* cdk; const float* cdv; const float* gda; float lam, lam1m; unsigned* counter; int l; };
constexpr int ATT_NUNITS = 128 + 2048;
__device__ __forceinline__ void attn_phase(LAS unsigned char* lds, const AttnCtx& C, const int wid) {
#define TID_NOW() LANE_ID()
    LAS unsigned* ubox = (LAS unsigned*)(lds + 131072);
    if (wid < 4) __builtin_amdgcn_s_setprio(3); else __builtin_amdgcn_s_setprio(0);
    const bf16_t* QDA = (const bf16_t*)(C.ws + W_QDA); const bf16_t* KDA = (const bf16_t*)(C.ws + W_KDA); const bf16_t* VDA = (const bf16_t*)(C.ws + W_VDA);
    const bf16_t* GG = (const bf16_t*)(C.ws + W_G); bf16_t* MRG = (bf16_t*)(C.ws + W_MRG);
    for (;;) {
        if (wid == 0 && TID_NOW() == 0) ubox[0] = atomicAdd(C.counter, 1u);
        __syncthreads();
        const int un = (int)ubox[0];
        __syncthreads();
        if (un >= ATT_NUNITS) break;
        const bool samp = un < 128;
        int b, h, qb = 0;
        if (samp) { b = un >> 3; h = un & 7; } else { const int v = un - 128; qb = 7 - (v >> 8); b = (v & 255) >> 3; h = v & 7; }
        const int row = samp ? MP + b * 32 + (TID_NOW() & 31) : b * 2048 + qb * 256 + wid * 32 + (TID_NOW() & 31);
        const int ntw = samp ? 33 : 4 * qb + 4, nmain = samp ? 32 : ntw, ntc = samp ? (wid == 0 ? 33 : 0) : 4 * qb + (wid >> 1) + 1;
        const size_t kr0 = (size_t)b * 2048;
        const size_t fr0 = (size_t)MP + b * 32;
        const size_t coff = (size_t)C.l * MC;
        f32x16 o[4]; float linv;
#ifndef NO_DIFF
        {
            unsigned o1[32];
#pragma unroll 1
            for (int st = 0; st < 2; ++st) {
                KVD dm, dl;
                const bf16_t* Kb = KDA; const bf16_t* Vb = VDA;
                dm.k = Kb + kr0 * 1024 + h * 128 + st * 64; dm.k2 = dm.k; dm.v = Vb + kr0 * 1024 + h * 128;
                dl.k = KDA + fr0 * 1024 + h * 128 + st * 64; dl.k2 = dl.k; dl.v = VDA + fr0 * 1024 + h * 128;
                dm.kf = C.cdk + (coff + kr0) * 1024 + h * 128 + st * 64; dm.vf = C.cdv + (coff + kr0) * 1024 + h * 128; dl.kf = nullptr; dl.vf = nullptr;
                if (samp) attn_pass<64, true>(lds, wid, QDA + (size_t)row * 1024 + h * 128 + st * 64, dm, dl, nmain, ntw, ntc, o, linv);
                else attn_pass<64, false>(lds, wid, QDA + (size_t)row * 1024 + h * 128 + st * 64, dm, dl, nmain, ntw, ntc, o, linv);
                if (st == 0) {
#pragma unroll
                    for (int c = 0; c < 4; ++c)
#pragma unroll
                        for (int r = 0; r < 16; r += 2) o1[c * 8 + (r >> 1)] = cvt_pk_bf16(o[c][r] * linv, o[c][r + 1] * linv);
                }
            }
            if (ntc > 0) {
                int rowe = row; asm volatile("" : "+v"(rowe));
                const int hi = (TID_NOW() >> 5) & 1;
                const float ll = C.lam * linv; float ss = 0.f;
#pragma unroll
                for (int c = 0; c < 4; ++c)
#pragma unroll
                    for (int r = 0; r < 16; r += 2) { const unsigned w = o1[c * 8 + (r >> 1)];
                        const float x0 = __uint_as_float(w << 16) - ll * o[c][r], x1 = __uint_as_float(w & 0xffff0000u) - ll * o[c][r + 1]; o[c][r] = x0; o[c][r + 1] = x1; ss += x0 * x0 + x1 * x1; }
                ss = add_x32(ss);
                const float rn = rsqrtf(ss * (1.f / 128.f) + EPS) * C.lam1m;
                const bf16_t* ga = GG + (size_t)rowe * 2048 + h * 128; bf16_t* mo = MRG + (size_t)rowe * 1024 + h * 128;
#pragma unroll
                for (int c = 0; c < 4; ++c)
#pragma unroll
                    for (int g = 0; g < 4; ++g) {
                        const int d0 = 32 * c + 8 * g + 4 * hi;
                        const u32x2 gw = ldgu2(ga + d0); const f32x4 gd = ldg4(C.gda + d0);
                        const float g0 = __uint_as_float(gw.x << 16), g1 = __uint_as_float(gw.x & 0xffff0000u), g2 = __uint_as_float(gw.y << 16), g3 = __uint_as_float(gw.y & 0xffff0000u);
                        f32x4 r; r[0] = o[c][4 * g + 0] * rn * gd[0] * g0; r[1] = o[c][4 * g + 1] * rn * gd[1] * g1; r[2] = o[c][4 * g + 2] * rn * gd[2] * g2; r[3] = o[c][4 * g + 3] * rn * gd[3] * g3;
                        st_bf16x4(mo + d0, r);
                    }
            }
        }
#endif
#ifndef NO_MLA
        {
            KVD dm, dl;
            const bf16_t* KN = (const bf16_t*)(C.ws + W_KN); const bf16_t* VM = (const bf16_t*)(C.ws + W_VM); const bf16_t* KR = (const bf16_t*)(C.ws + W_KR);
            dm.k = (samp ? (const bf16_t*)(C.ws + W_KNC) + coff * 1024 : KN) + kr0 * 1024 + h * 128; dm.k2 = (samp ? (const bf16_t*)(C.ws + W_KRC) + coff * 64 : KR) + kr0 * 64;
            dm.v = (samp ? (const bf16_t*)(C.ws + W_VMC) + coff * 1024 : VM) + kr0 * 1024 + h * 128;
            dl.k = KN + fr0 * 1024 + h * 128; dl.k2 = KR + fr0 * 64; dl.v = VM + fr0 * 1024 + h * 128;
            dm.kf = nullptr; dm.vf = nullptr; dl.kf = nullptr; dl.vf = nullptr;
            attn_pass<192, false>(lds, wid, (const bf16_t*)(C.ws + W_QM) + (size_t)row * 1536 + h * 192, dm, dl, nmain, ntw, ntc, o, linv);
            if (ntc > 0) {
                int rowe = row; asm volatile("" : "+v"(rowe));
                const int hi = (TID_NOW() >> 5) & 1;
                const bf16_t* gb = GG + (size_t)rowe * 2048 + 1024 + h * 128; bf16_t* mo = MRG + (size_t)rowe * 1024 + h * 128;
#pragma unroll
                for (int c = 0; c < 4; ++c)
#pragma unroll
                    for (int g = 0; g < 4; ++g) {
                        const int d0 = 32 * c + 8 * g + 4 * hi;
                        const u32x2 gw = ldgu2(gb + d0); const u32x2 xw = ldgu2(mo + d0);
                        const float g0 = __uint_as_float(gw.x << 16), g1 = __uint_as_float(gw.x & 0xffff0000u), g2 = __uint_as_float(gw.y << 16), g3 = __uint_as_float(gw.y & 0xffff0000u);
                        f32x4 r;
                        r[0] = __uint_as_float(xw.x << 16) + g0 * o[c][4 * g + 0] * linv; r[1] = __uint_as_float(xw.x & 0xffff0000u) + g1 * o[c][4 * g + 1] * linv;
                        r[2] = __uint_as_float(xw.y << 16) + g2 * o[c][4 * g + 2] * linv; r[3] = __uint_as_float(xw.y & 0xffff0000u) + g3 * o[c][4 * g + 3] * linv;
                        st_bf16x4(mo + d0, r);
                    }
            }
        }
#endif
    }
    __builtin_amdgcn_s_setprio(0);
}
__device__ __forceinline__ float wave_sum(float v) {
#pragma unroll
    for (int o = 1; o < 64; o <<= 1) v += __shfl_xor(v, o);
    return v;
}
__device__ __forceinline__ unsigned f2bf(float f) { unsigned u = __float_as_uint(f); return (u + 0x7fffu + ((u >> 16) & 1u)) >> 16; }
__device__ __forceinline__ unsigned pk2(float lo, float hi) { return f2bf(lo) | (f2bf(hi) << 16); }
__device__ __forceinline__ int ropemap(int v) { return 64 * ((v >> 5) & 3) + 32 * (v >> 7) + (v & 31); }

__device__ __forceinline__ void prep_weights(const Params& P, LAS unsigned char* lds, int gw, int ngw, int wave, int lane) {
    LAS float* scr = (LAS float*)(lds + wave * 8704);
    constexpr int IT0 = 16 * (NIN / 32), IT1 = 6 * (NQ / 32), IT2 = 4 * (NKV / 32), IT4 = 16 * 32, IT5 = 16 * (NUP / 32), IT6 = 44 * 32;
    constexpr int ITL = IT0 + IT1 + 2 * IT2 + IT4 + IT5 + IT6;
    for (int it = gw; it < 2 * ITL; it += ngw) {
        const int l = it / ITL; int r = it - l * ITL;
        int mat;
        if (r < IT0) mat = 0; else if ((r -= IT0) < IT1) mat = 1; else if ((r -= IT1) < IT2) mat = 2; else if ((r -= IT2) < IT2) mat = 3;
        else if ((r -= IT2) < IT4) mat = 4; else if ((r -= IT4) < IT5) mat = 5; else { r -= IT5; mat = 6; }
        const float* W; const float* gk = nullptr; bf16_t* WT; int K, NN; long stride;
        switch (mat) {
            case 0: W = P.in[8] + (size_t)l * 1024 * INC; gk = P.in[7] + l * 1024; WT = (bf16_t*)(P.ws + W_WIN) + (size_t)l * NIN * 1024; K = 1024; NN = NIN; stride = INC; break;
            case 1: W = P.in[16] + (size_t)l * QL * NQ; gk = P.in[15] + l * QL; WT = (bf16_t*)(P.ws + W_WQ) + (size_t)l * NQ * QL; K = QL; NN = NQ; stride = NQ; break;
            case 2: W = nullptr; gk = P.in[17] + l * KVL; WT = (bf16_t*)(P.ws + W_WKV) + (size_t)l * NKV * KVL; K = KVL; NN = NKV; stride = 128; break;
            case 3: W = nullptr; WT = (bf16_t*)(P.ws + W_WKVC) + (size_t)l * NKV * KVL; K = KVL; NN = NKV; stride = 128; break;
            case 4: W = P.in[20] + (size_t)l * 1024 * 1024; WT = (bf16_t*)(P.ws + W_WO) + (size_t)l * 1024 * 1024; K = 1024; NN = 1024; stride = 1024; break;
            case 5: W = P.in[22] + (size_t)l * 1024 * NUP; gk = P.in[21] + l * 1024; WT = (bf16_t*)(P.ws + W_WUP) + (size_t)l * NUP * 1024; K = 1024; NN = NUP; stride = NUP; break;
            default: W = P.in[25] + (size_t)l * DFF * 1024; WT = (bf16_t*)(P.ws + W_WDN) + (size_t)l * 1024 * DFF; K = DFF; NN = 1024; stride = 1024; break;
        }
        const int nblk = NN / 32, kb = r / nblk, nb = r - kb * nblk, k0 = 64 * kb, n0 = 32 * nb;
        const int np = n0 + (lane & 31); long off = -1;
        {
            const int tile = np >> 8, v = np & 255;
            switch (mat) {
                case 0:
                    if (tile < 4) off = 256 * tile + ropemap(v);
                    else if (tile < 8) off = 1024 + 256 * (tile - 4) + ropemap(v);
                    else if (tile < 12) off = 2048 + 256 * (tile - 8) + v;
                    else if (tile < 20) off = 3776 + 256 * (tile - 12) + v;
                    else if (tile == 20) off = 3456 + v;
                    else if (tile == 21) off = 3072 + v;
                    else { if (v < 128) off = 3072 + 256 + v; else { const int w = v - 128, wc = w >> 5; if (wc < 2) off = 3712 + 32 * ((w >> 4) & 1) + 16 * wc + (w & 15); } }
                    break;
                case 1:
                    if (tile < 4) off = (np >> 7) * 192 + (np & 127);
                    else { const int hh = 4 * (tile - 4) + ((v >> 5) & 3); off = hh * 192 + 128 + 32 * (v >> 7) + (v & 31); }
                    break;
                case 2: case 3: {
                    const int c = np & 1023, hh = c >> 7, n = c & 127;
                    W = (np < 1024 ? P.in[18] : P.in[19]) + (size_t)l * 8 * 256 * 128; off = (long)hh * 32768 + n; } break;
                case 5: off = (v < 128) ? 128 * tile + v : DFF + 128 * tile + (v - 128); break;
                default: off = np; break;
            }
        }
#pragma unroll 16
        for (int i = 0; i < 32; ++i) { const int kk = 2 * i + (lane >> 5); float v = 0.f;
            if (off >= 0) { v = W[(size_t)(k0 + kk) * stride + off]; if (gk) v *= gk[k0 + kk]; }
            scr[kk * 33 + (lane & 31)] = v; }
        asm volatile("s_waitcnt lgkmcnt(0)" ::: "memory");
        const int c = lane & 7;
#pragma unroll
        for (int j = 0; j < 4; ++j) { const int n = (lane >> 3) + 8 * j; const LAS float* s = scr + (8 * c) * 33 + n;
            u32x4 o; o.x = pk2(s[0 * 33], s[1 * 33]); o.y = pk2(s[2 * 33], s[3 * 33]); o.z = pk2(s[4 * 33], s[5 * 33]); o.w = pk2(s[6 * 33], s[7 * 33]);
            *(u32x4*)(WT + (size_t)(n0 + n) * K + k0 + 8 * c) = o; }
        asm volatile("s_waitcnt lgkmcnt(0)" ::: "memory");
    }
}

__device__ __forceinline__ void sincos_f(float a, float& s, float& c) {
    const float n = rintf(a * 0.6366197723675814f);
    float r = fmaf(-n, 1.5703125f, a); r = fmaf(-n, 4.837512969970703125e-4f, r); r = fmaf(-n, 7.54978995489188e-8f, r);
    const float r2 = r * r;
    const float sp = r + r * r2 * (-1.6666666667e-1f + r2 * (8.3333333333e-3f + r2 * (-1.9841269841e-4f + r2 * 2.7557319224e-6f)));
    const float cp = 1.f + r2 * (-0.5f + r2 * (4.1666666667e-2f + r2 * (-1.3888888889e-3f + r2 * (2.4801587302e-5f + r2 * -2.7557319224e-7f))));
    const int qd = ((int)n) & 3;
    s = (qd == 0) ? sp : (qd == 1) ? cp : (qd == 2) ? -sp : -cp;
    c = (qd == 0) ? cp : (qd == 1) ? -sp : (qd == 2) ? -cp : sp;
}

__device__ __forceinline__ void cvt_stream(const float* src, bf16_t* dst, size_t n8, size_t gt, size_t ngt) {
    for (size_t i = gt; i < n8; i += 2 * ngt) { const size_t i2 = i + ngt; const bool h2 = i2 < n8;
        const f32x4 a = ldg4(src + i * 8), b = ldg4(src + i * 8 + 4); f32x4 c = a, d = b; if (h2) { c = ldg4(src + i2 * 8); d = ldg4(src + i2 * 8 + 4); }
        u32x4 o; o.x = cvt_pk_bf16(a[0], a[1]); o.y = cvt_pk_bf16(a[2], a[3]); o.z = cvt_pk_bf16(b[0], b[1]); o.w = cvt_pk_bf16(b[2], b[3]); *(GAS u32x4*)(dst + i * 8) = o;
        if (h2) { u32x4 p; p.x = cvt_pk_bf16(c[0], c[1]); p.y = cvt_pk_bf16(c[2], c[3]); p.z = cvt_pk_bf16(d[0], d[1]); p.w = cvt_pk_bf16(d[2], d[3]); *(GAS u32x4*)(dst + i2 * 8) = p; } }
}

__device__ __forceinline__ void conv_fix_phase(const Params& P, int l, size_t gt, size_t ngt) {
    const bf16_t* UH = (const bf16_t*)(P.ws + W_U); bf16_t* ACT = (bf16_t*)(P.ws + W_ACT);
    const float* wc = P.in[23] + (size_t)l * 3 * NUP; const float* bc = P.in[24] + (size_t)l * NUP;
    constexpr int NCC = DFF / 8;
    for (size_t it = gt; it < (size_t)1024 * NCC; it += ngt) {
        const int sl = (int)(it / NCC), cc = (int)(it - (size_t)sl * NCC), j0 = cc * 8;
        if ((sl & 31) == 0) continue;
        float uu[4][2][8];
#pragma unroll
        for (int k = 0; k < 4; ++k)
#pragma unroll
            for (int gv = 0; gv < 2; ++gv) { const u32x4 a = ldgu4(UH + ((size_t)(k < 2 ? sl - 1 : sl) * 4 + (k < 2 ? 2 + k : k - 2)) * NUP + gv * DFF + j0);
#pragma unroll
                for (int e = 0; e < 4; ++e) { uu[k][gv][2 * e] = __uint_as_float(a[e] << 16); uu[k][gv][2 * e + 1] = __uint_as_float(a[e] & 0xffff0000u); } }
#pragma unroll
        for (int rr = 0; rr < 2; ++rr) {
            float res[8];
#pragma unroll
            for (int hf = 0; hf < 2; ++hf) {
                f32x4 w[2][4];
#pragma unroll
                for (int gv = 0; gv < 2; ++gv)
#pragma unroll
                    for (int k = 0; k < 4; ++k) w[gv][k] = ldg4((k < 3 ? wc + (size_t)k * NUP : bc) + gv * DFF + j0 + 4 * hf);
#pragma unroll
                for (int e = 0; e < 4; ++e) { const int q = 4 * hf + e;
                    const float cg = w[0][3][e] + w[0][0][e] * uu[rr][0][q] + w[0][1][e] * uu[rr + 1][0][q] + w[0][2][e] * uu[rr + 2][0][q];
                    const float cv = w[1][3][e] + w[1][0][e] * uu[rr][1][q] + w[1][1][e] * uu[rr + 1][1][q] + w[1][2][e] * uu[rr + 2][1][q];
                    res[q] = cg * sigmoidf_(cg) * cv; }
            }
            u32x4 o; o.x = cvt_pk_bf16(res[0], res[1]); o.y = cvt_pk_bf16(res[2], res[3]); o.z = cvt_pk_bf16(res[4], res[5]); o.w = cvt_pk_bf16(res[6], res[7]);
            *(GAS u32x4*)(ACT + ((size_t)(64 * sl + rr) * DFF + j0)) = o;
        }
    }
}
constexpr int LDS_BYTES = 147456;
template <class Epi> __device__ __forceinline__ void run_gemm(LAS unsigned char* lds, const int wid, const bf16_t* A, const bf16_t* Bt, int M, int N, int K, const Epi& E) {
    int gx = (int)gridDim.x, bx = (int)blockIdx.x, wv = wid; asm volatile("" : "+s"(gx), "+s"(bx), "+s"(wv));
    pg8::Gemm g{A, Bt, M, N, K}; pg8::StaticOrder S; S.init(M, N, gx, bx);
#ifndef NO_GEMM
    pg8::gemm_phase<Epi, pg8::StaticOrder, PG8_ALIGN, PG8_SP2>(lds, g, S, E, wv);
#endif
}

__global__ void __launch_bounds__(512, 2) fwd_megakernel(Params P) {
    extern __shared__ __attribute__((aligned(16))) unsigned char lds_raw[];
    LAS unsigned char* lds = (LAS unsigned char*)lds_raw;
    cg::grid_group grid = cg::this_grid();
    const int wave_s = __builtin_amdgcn_readfirstlane((int)threadIdx.x >> 6);
#define TID_DEFS const int lane = LANE_ID(), wave = wave_s, tid = (wave << 6) | lane; \
    const int G = gridDim.x, gw = blockIdx.x * 8 + wave, ngw = G * 8; const size_t gt = (size_t)blockIdx.x * 512 + tid, ngt = (size_t)G * 512; (void)lane; (void)gw; (void)ngw; (void)gt; (void)ngt;
    unsigned char* ws = P.ws; float* out = P.out;
#define gbar() do { asm volatile("s_waitcnt vmcnt(0) lgkmcnt(0)" ::: "memory"); __syncthreads(); bar_gen += gridDim.x; \
        if (wave_s == 0 && LANE_ID() == 0) { asm volatile("buffer_wbl2 sc1\n\ts_waitcnt vmcnt(0) lgkmcnt(0)" ::: "memory");     \
            __hip_atomic_fetch_add(ctl + 128, 1u, __ATOMIC_RELAXED, __HIP_MEMORY_SCOPE_AGENT); \
            while (__hip_atomic_load(ctl + 128, __ATOMIC_RELAXED, __HIP_MEMORY_SCOPE_AGENT) < bar_gen) __builtin_amdgcn_s_sleep(1); } \
        __syncthreads(); asm volatile("buffer_inv sc1\n\ts_waitcnt vmcnt(0) lgkmcnt(0)" ::: "memory");     } while (0)
#ifdef PROBE_SEL
    unsigned long long pr_acc = 0, pr_t0 = 0;
#define PR_BEGIN(c) do { if ((PROBE_SEL >> (c)) & 1) pr_t0 = __builtin_amdgcn_s_memrealtime(); } while (0)
#define PR_END(c) do { if ((PROBE_SEL >> (c)) & 1) pr_acc += __builtin_amdgcn_s_memrealtime() - pr_t0; } while (0)
#else
#define PR_BEGIN(c)
#define PR_END(c)
#endif
#define OPAQ() do { unsigned a_ = (unsigned)(uintptr_t)P.ws, b_ = (unsigned)((uintptr_t)P.ws >> 32), c_ = (unsigned)(uintptr_t)P.out, d_ = (unsigned)((uintptr_t)P.out >> 32); \
        asm volatile("" : "+s"(a_), "+s"(b_), "+s"(c_), "+s"(d_)); ws = (unsigned char*)(((uintptr_t)b_ << 32) | a_); out = (float*)(((uintptr_t)d_ << 32) | c_); } while (0)
    unsigned* ctl = (unsigned*)(ws + W_CTL); float* ctlf = (float*)(ws + W_CTL);
    float* rope = (float*)(ws + W_ROPE); float* SS = (float*)(ws + W_SS);
#define B_HX ((bf16_t*)(ws + W_HX))
#define B_X ((float*)(ws + W_X))
#define B_QDA ((bf16_t*)(ws + W_QDA))
#define B_KDA ((bf16_t*)(ws + W_KDA))
#define B_VDA ((bf16_t*)(ws + W_VDA))
#define B_GG ((bf16_t*)(ws + W_G))
#define B_CKV ((bf16_t*)(ws + W_CKV))
#define B_CQ ((bf16_t*)(ws + W_CQ))
#define B_KR ((bf16_t*)(ws + W_KR))
#define B_QM ((bf16_t*)(ws + W_QM))
#define B_KN ((bf16_t*)(ws + W_KN))
#define B_VM ((bf16_t*)(ws + W_VM))
#define B_MRG ((bf16_t*)(ws + W_MRG))
#define B_U ((bf16_t*)(ws + W_U))
#define B_ACT ((bf16_t*)(ws + W_ACT))
#define B_KC ((bf16_t*)(ws + W_KC))
#define B_VC ((bf16_t*)(ws + W_VC))
#define B_KRC ((bf16_t*)(ws + W_KRC))
#define B_CKVC ((bf16_t*)(ws + W_CKVC))
#define B_KNC ((bf16_t*)(ws + W_KNC))
#define B_VMC ((bf16_t*)(ws + W_VMC))
    PR_BEGIN(0);
    {
    TID_DEFS
#ifndef NO_PREP
    prep_weights(P, lds, gw, ngw, wave, lane);
#endif
    for (size_t idx = gt; idx < (size_t)2080 * 32; idx += ngt) {
        const int pos = (int)(idx >> 5), i = (int)(idx & 31);
        double inv = 1.0; for (int k = 0; k < i; ++k) inv *= 0.74989420933245582730;
        const double ang = (double)pos * inv; const double n = __builtin_rint(ang * 0.63661977236758134308);
        double r = __builtin_fma(-n, 1.57079632679489655800, ang); r = __builtin_fma(-n, 6.12323399573676603587e-17, r);
        const float rf = (float)r, r2 = rf * rf;
        const float sp = rf + rf * r2 * (-1.6666666667e-1f + r2 * (8.3333333333e-3f + r2 * (-1.9841269841e-4f + r2 * 2.7557319224e-6f)));
        const float cp = 1.f + r2 * (-0.5f + r2 * (4.1666666667e-2f + r2 * (-1.3888888889e-3f + r2 * (2.4801587302e-5f + r2 * -2.7557319224e-7f))));
        const int qd = ((int)n) & 3;
        rope[(size_t)pos * 64 + 32 + i] = (qd == 0) ? sp : (qd == 1) ? cp : (qd == 2) ? -sp : -cp;
        rope[(size_t)pos * 64 + i] = (qd == 0) ? cp : (qd == 1) ? -sp : (qd == 2) ? -cp : sp;
    }
    for (size_t idx = gt; idx < (size_t)8 * MT; idx += ngt) SS[MT + idx] = 0.f;
    if (blockIdx.x == 0 && tid < 64) {
        if (tid < 5) __hip_atomic_store(ctl + (tid == 4 ? 128 : tid * 16), 0u, __ATOMIC_RELAXED, __HIP_MEMORY_SCOPE_AGENT);
        for (int l = 0; l < 2; ++l) {
        OPAQ();
            const float a = wave_sum(P.in[10][l * 64 + lane] * P.in[11][l * 64 + lane]), b = wave_sum(P.in[12][l * 64 + lane] * P.in[13][l * 64 + lane]);
            const float li = 0.8f - 0.6f * expf(-0.3f * (float)l);
            if (lane == 0) { ctlf[64 + 2 * l] = expf(a) - expf(b) + li; ctlf[65 + 2 * l] = 1.f - li; }
        }
    }
    for (int row0 = 2 * gw; row0 < MT; row0 += 2 * ngw) {
        f32x4 v[2][4]; float s2[2] = {0.f, 0.f};
#pragma unroll
        for (int k = 0; k < 2; ++k) { const int row = row0 + k; const float* xr = (row >= MP ? P.in[1] + (size_t)(row - MP) * 1024 : P.in[0] + (size_t)row * 1024);
#pragma unroll
            for (int j = 0; j < 4; ++j) v[k][j] = ldg4(xr + 256 * j + 4 * lane); }
#pragma unroll
        for (int k = 0; k < 2; ++k) { const int row = row0 + k;
#pragma unroll
            for (int j = 0; j < 4; ++j) { s2[k] += sq4(v[k][j]); st_bf16x4(B_HX + (size_t)row * 1024 + 256 * j + 4 * lane, v[k][j]); }
            const float s = wave_sum(s2[k]); if (lane == 0) SS[row] = s; }
    }
    cvt_stream(P.in[4], B_CKVC, (size_t)2 * MC * 256 / 8, gt, ngt);
    cvt_stream(P.in[5], B_KRC, (size_t)2 * MC * 64 / 8, gt, ngt);
    }
    asm volatile("s_waitcnt vmcnt(0) lgkmcnt(0)" ::: "memory"); __syncthreads();
    if (wave_s == 0) asm volatile("buffer_wbl2 sc1\n\ts_waitcnt vmcnt(0) lgkmcnt(0)" ::: "memory");
    grid.sync();
    asm volatile("buffer_inv sc1\n\ts_waitcnt vmcnt(0) lgkmcnt(0)" ::: "memory");
    unsigned bar_gen = 0;
    PR_END(0);

#pragma unroll 1
    for (int l = 0; l < 2; ++l) {
        OPAQ();
        float* ssx_attn = SS + (size_t)(2 * l) * MT; float* ssx_ffn = SS + (size_t)(2 * l + 1) * MT; float* ssx_next = SS + (size_t)(2 * l + 2) * MT;
        float* sscq = SS + (size_t)(5 + l) * MT; float* ssckv = SS + (size_t)(7 + l) * MT;
        float* ckp = out + O_CKVP + (size_t)l * MP * 256; float* cks = out + O_CKVS + (size_t)l * MSMP * 256;
        PR_BEGIN(1);
        {
            EpiInProj E; E.ws = ws; E.out = out; E.bgate = P.in[9] + (size_t)l * 2048; E.l = l;
            run_gemm(lds, wave_s, B_HX, (const bf16_t*)(ws + W_WIN) + (size_t)l * NIN * 1024, MT, NIN, 1024, E);
        }
        gbar(); OPAQ();
        PR_END(1);
        PR_BEGIN(2);
        {
            EpiQ E; E.sscq = sscq; E.rope = rope; E.QM = B_QM;
            run_gemm(lds, wave_s, B_CQ, (const bf16_t*)(ws + W_WQ) + (size_t)l * NQ * QL, MT, NQ, QL, E);
        }
        {
            EpiKV<true> E; E.ss = ssckv; E.O0 = B_KN; E.O1 = B_VM;
            run_gemm(lds, wave_s, B_CKV, (const bf16_t*)(ws + W_WKV) + (size_t)l * NKV * KVL, MT, NKV, KVL, E);
        }
        if (l == 0) {
#pragma unroll 1
            for (int l2 = 0; l2 < 2; ++l2) {
                EpiKV<false> E; E.ss = nullptr; E.O0 = B_KNC + (size_t)l2 * MC * 1024; E.O1 = B_VMC + (size_t)l2 * MC * 1024;
                run_gemm(lds, wave_s, B_CKVC + (size_t)l2 * MC * 256, (const bf16_t*)(ws + W_WKVC) + (size_t)l2 * NKV * KVL, MC, NKV, KVL, E);
            }
        }
        {
            TID_DEFS
            const float* gk = P.in[17] + (size_t)l * 256;
            for (size_t idx = gt; idx < (size_t)MT * 64; idx += ngt) {
                const int row = (int)(idx >> 6), c4 = (int)(idx & 63);
                float* p = (row >= MP ? cks + (size_t)(row - MP) * 256 : ckp + (size_t)row * 256) + 4 * c4;
                const float rs = rsqrtf(ssckv[row] * (1.f / 256.f) + EPS); const f32x4 g = *(const f32x4*)(gk + 4 * c4);
                *(f32x4*)p = *(const f32x4*)p * rs * g;
            }
        }
        gbar(); OPAQ();
        PR_END(2);
        PR_BEGIN(3);
        {
            AttnCtx C; C.ws = ws; C.cdk = P.in[2]; C.cdv = P.in[3]; C.gda = P.in[14] + (size_t)l * 128; C.lam = __int_as_float(__builtin_amdgcn_readfirstlane(__float_as_int(ctlf[64 + 2 * l]))); C.lam1m = __int_as_float(__builtin_amdgcn_readfirstlane(__float_as_int(ctlf[65 + 2 * l]))); C.counter = ctl + 16 * l; C.l = l;
#ifndef NO_ATTN
            { int wv = wave_s; asm volatile("" : "+s"(wv)); attn_phase(lds, C, wv); }
#ifdef PROBE_ATTN2
            gbar(); OPAQ(); C.counter = ctl + 32 + 16 * l; { int wv = wave_s; asm volatile("" : "+s"(wv)); attn_phase(lds, C, wv); }
#endif
#endif
        }
        gbar(); OPAQ();
        PR_END(3);
        PR_BEGIN(4);
        {
            EpiRes E; E.xp = (l == 0) ? P.in[0] : nullptr; E.xs = P.in[1]; E.X = nullptr; E.HX = B_HX; E.ssn = ssx_ffn;
            run_gemm(lds, wave_s, B_MRG, (const bf16_t*)(ws + W_WO) + (size_t)l * 1024 * 1024, MT, 1024, 1024, E);
        }
        gbar(); OPAQ();
        PR_END(4);
        PR_BEGIN(5);
        {
            EpiUp E; E.ssx = ssx_ffn; E.ACT = B_ACT; E.UH = B_U; E.cvp = out + O_CVP + (size_t)l * 32 * 2 * NUP; E.cvs = out + O_CVS + (size_t)l * 16 * 2 * NUP;
            E.wc = P.in[23] + (size_t)l * 3 * NUP; E.bc = P.in[24] + (size_t)l * NUP; E.stc = P.in[6] + (size_t)l * 16 * 2 * NUP;
            run_gemm(lds, wave_s, B_HX, (const bf16_t*)(ws + W_WUP) + (size_t)l * NUP * 1024, MT, NUP, 1024, E);
        }
        gbar(); OPAQ();
        PR_END(5);
#ifndef NO_CONV
        PR_BEGIN(6);
        { TID_DEFS conv_fix_phase(P, l, gt, ngt); }
#endif
        gbar(); OPAQ();
        PR_END(6);
        PR_BEGIN(7);
        {
            EpiRes E; E.xp = nullptr; E.xs = nullptr; E.X = nullptr; E.HX = B_HX; E.ssn = ssx_next;
            run_gemm(lds, wave_s, B_ACT, (const bf16_t*)(ws + W_WDN) + (size_t)l * 1024 * DFF, MT, 1024, DFF, E);
        }
        gbar(); OPAQ();
        PR_END(7);
    }
    PR_BEGIN(8);
    {
        TID_DEFS
        const float* ssf = SS + (size_t)4 * MT; const float* gf = P.in[26];
        for (size_t base = gt; base < (size_t)MT * 256; base += 4 * ngt) {
            u32x2 hw[4]; float sv[4]; f32x4 gv[4];
#pragma unroll
            for (int k = 0; k < 4; ++k) { const size_t idx = base + (size_t)k * ngt; if (idx < (size_t)MT * 256) { const int row = (int)(idx >> 8), c4 = (int)(idx & 255);
                hw[k] = ldgu2(B_HX + (size_t)row * 1024 + 4 * c4); sv[k] = ldg1(ssf + row); gv[k] = ldg4(gf + 4 * c4); } }
#pragma unroll
            for (int k = 0; k < 4; ++k) { const size_t idx = base + (size_t)k * ngt; if (idx < (size_t)MT * 256) { const int row = (int)(idx >> 8), c4 = (int)(idx & 255);
                const float rs = rsqrtf(sv[k] * (1.f / 1024.f) + EPS);
                const f32x4 xv = (f32x4){__uint_as_float(hw[k].x << 16), __uint_as_float(hw[k].x & 0xffff0000u), __uint_as_float(hw[k].y << 16), __uint_as_float(hw[k].y & 0xffff0000u)};
                stg4(out + (size_t)row * 1024 + 4 * c4, xv * rs * gv[k]); } }
        }
    }
#ifdef PROBE_SEL
    PR_END(8);
    if (blockIdx.x == 0) { const unsigned long long s0 = __builtin_amdgcn_s_memrealtime(); while (__builtin_amdgcn_s_memrealtime() - s0 < pr_acc) __builtin_amdgcn_s_sleep(32); }
#endif
}

extern "C" void kernel_launch(void* const* d_in, const int* in_sizes, int n_in, void* d_out, int out_size, void* d_ws, size_t ws_size, hipStream_t stream) {
    static int grid_blocks = 0;
    if (grid_blocks == 0) {
        if (n_in != 27 || (size_t)out_size != O_END || ws_size < W_END) { fprintf(stderr, "kernel_launch: unexpected problem (n_in %d, out %d vs %zu, ws %zu vs %zu)\n", n_in, out_size, (size_t)O_END, ws_size, (size_t)W_END); grid_blocks = -1; return; }
        int dev = 0, cus = 0, per_cu = 0;
        (void)hipGetDevice(&dev); (void)hipDeviceGetAttribute(&cus, hipDeviceAttributeMultiprocessorCount, dev);
        (void)hipFuncSetAttribute((const void*)fwd_megakernel, hipFuncAttributeMaxDynamicSharedMemorySize, LDS_BYTES);
        (void)hipOccupancyMaxActiveBlocksPerMultiprocessor(&per_cu, (const void*)fwd_megakernel, 512, LDS_BYTES);
        if (per_cu < 1) per_cu = 1;
        grid_blocks = cus * per_cu;
    }
    if (grid_blocks < 0) return;
    Params p{};
    for (int i = 0; i < 27; ++i) p.in[i] = (const float*)d_in[i];
    p.out = (float*)d_out; p.ws = (unsigned char*)d_ws;
    void* args[] = {&p};
    hipError_t e = hipLaunchCooperativeKernel((void*)fwd_megakernel, dim3(grid_blocks), dim3(512), args, LDS_BYTES, stream);
    if (e != hipSuccess) fprintf(stderr, "cooperative launch failed: %s (grid %d)\n", hipGetErrorString(e), grid_blocks);
}
```
